# Optimizing an MI355X kernel written in HIP

```python
import jax, jax.numpy as jnp
from jax import lax
import numpy as np

D_MODEL = 1024
BATCH = 8
SEQ = 8192
DEPTH = 2

MIX_WIDTH = D_MODEL
ATTN_WIDTH = MIX_WIDTH // 2
POOL_WIDTH = MIX_WIDTH - ATTN_WIDTH
HEAD_DIM = 64
N_HEADS = ATTN_WIDTH // HEAD_DIM
N_KV_HEADS = 2
GROUP = N_HEADS // N_KV_HEADS
KV_WIDTH = N_KV_HEADS * HEAD_DIM
WINDOW = 128
BLOCK = 128
ROT_DIM = HEAD_DIM // 4
ROPE_THETA = 500000.0
POOL_WINDOWS = (2, 4, 8, 16)
N_POOL_GROUPS = len(POOL_WINDOWS)
POOL_GROUP_WIDTH = POOL_WIDTH // N_POOL_GROUPS
IN_WIDTH = ATTN_WIDTH + 2 * KV_WIDTH + POOL_WIDTH
D_FF = ((int(np.ceil(8 * D_MODEL / 3)) + 255) // 256) * 256
N_MOD = 6
EPS = 1e-6
NEG_INF = -1e30

kernel_name = "hybrid_swa_sink_pool_swiglu_block"


def rms_norm(x, g):
    xf = x.astype(jnp.float32)
    y = xf * lax.rsqrt(jnp.mean(xf * xf, axis=-1, keepdims=True) + EPS)
    return (y * g.astype(jnp.float32)).astype(x.dtype)


def partial_rotary(t, positions):
    inv_freq = ROPE_THETA ** (-jnp.arange(0, ROT_DIM, 2, dtype=jnp.float32) / ROT_DIM)
    ang = positions.astype(jnp.float32)[:, :, None] * inv_freq
    cos = jnp.cos(ang)[:, :, None, :]
    sin = jnp.sin(ang)[:, :, None, :]
    tf = t.astype(jnp.float32)
    half = ROT_DIM // 2
    t1, t2, rest = tf[..., :half], tf[..., half:ROT_DIM], tf[..., ROT_DIM:]
    rot = jnp.concatenate([t1 * cos - t2 * sin, t2 * cos + t1 * sin, rest], axis=-1)
    return rot.astype(t.dtype)


def sliding_window_attention_with_sinks(q, k, v, sinks):
    B, S = q.shape[0], q.shape[1]
    nb = S // BLOCK
    qb = q.reshape(B, nb, BLOCK, N_KV_HEADS, GROUP, HEAD_DIM)
    kb = k.reshape(B, nb, BLOCK, N_KV_HEADS, HEAD_DIM)
    vb = v.reshape(B, nb, BLOCK, N_KV_HEADS, HEAD_DIM)
    pad = ((0, 0), (1, 0), (0, 0), (0, 0), (0, 0))
    k_cat = jnp.concatenate([jnp.pad(kb, pad)[:, :-1], kb], axis=2)
    v_cat = jnp.concatenate([jnp.pad(vb, pad)[:, :-1], vb], axis=2)
    scores = jnp.einsum("bnqkgd,bnskd->bnkgqs", qb, k_cat).astype(jnp.float32)
    scores = scores * (HEAD_DIM ** -0.5)
    qi = jnp.arange(BLOCK)[:, None]
    kj = jnp.arange(2 * BLOCK)[None, :]
    diff = qi + BLOCK - kj
    blk = jnp.arange(nb)[:, None, None]
    key_abs = blk * BLOCK + kj[None] - BLOCK
    valid = (diff[None] >= 0) & (diff[None] < WINDOW) & (key_abs >= 0)
    scores = jnp.where(valid[None, :, None, None], scores, NEG_INF)
    sink = jnp.broadcast_to(
        sinks.astype(jnp.float32).reshape(1, 1, N_KV_HEADS, GROUP, 1, 1),
        scores.shape[:-1] + (1,))
    probs = jax.nn.softmax(jnp.concatenate([scores, sink], axis=-1), axis=-1)[..., :-1]
    out = jnp.einsum("bnkgqs,bnskd->bnqkgd", probs.astype(v.dtype), v_cat)
    return out.reshape(B, S, N_HEADS * HEAD_DIM)


def causal_pool_mixer(u, pool_w, pool_scale):
    S = u.shape[1]
    t = jnp.arange(S, dtype=jnp.float32)[None, :, None]
    outs = []
    for gi, w in enumerate(POOL_WINDOWS):
        ug = u[..., gi * POOL_GROUP_WIDTH:(gi + 1) * POOL_GROUP_WIDTH].astype(jnp.float32)
        cs = jnp.pad(jnp.cumsum(ug, axis=1), ((0, 0), (1, 0), (0, 0)))
        upper = cs[:, 1:]
        lower = jnp.pad(cs, ((0, 0), (w - 1, 0), (0, 0)))[:, :S]
        count = jnp.minimum(t + 1.0, float(w))
        pooled = (upper - lower) / count - ug
        outs.append(jnp.einsum("bsc,cd->bsd", pooled.astype(u.dtype), pool_w[gi]))
    return jnp.concatenate(outs, axis=-1) * pool_scale


def setup_inputs(seed: int = 0) -> dict:
    key = jax.random.key(seed)
    ks = jax.random.split(key, 20)
    f32 = jnp.float32
    def nrm(k, shape, scale):
        return jax.random.normal(k, shape, f32) * scale
    x = jax.random.normal(ks[0], (BATCH, SEQ, D_MODEL), f32)
    c = jax.random.normal(ks[1], (BATCH, D_MODEL), f32)
    offsets = jax.random.randint(ks[2], (BATCH, 1), 0, 4096, dtype=jnp.int32)
    positions = (offsets + jnp.arange(SEQ, dtype=jnp.int32)[None, :]).astype(jnp.int32)
    return {
        "x": x,
        "c": c,
        "positions": positions,
        "ada_w": nrm(ks[3], (DEPTH, D_MODEL, N_MOD * D_MODEL), D_MODEL ** -0.5),
        "ada_b": nrm(ks[4], (DEPTH, N_MOD * D_MODEL), 0.02),
        "w_in": nrm(ks[5], (DEPTH, D_MODEL, IN_WIDTH), D_MODEL ** -0.5),
        "b_in": nrm(ks[6], (DEPTH, IN_WIDTH), 0.02),
        "sinks": nrm(ks[7], (DEPTH, N_HEADS), 1.0),
        "pool_w": nrm(ks[8], (DEPTH, N_POOL_GROUPS, POOL_GROUP_WIDTH, POOL_GROUP_WIDTH), POOL_GROUP_WIDTH ** -0.5),
        "pool_scale": 1.0 + nrm(ks[9], (DEPTH, POOL_WIDTH), 0.1),
        "w_out": nrm(ks[10], (DEPTH, MIX_WIDTH, D_MODEL), MIX_WIDTH ** -0.5),
        "w_gate": nrm(ks[11], (DEPTH, D_MODEL, D_FF), D_MODEL ** -0.5),
        "w_up": nrm(ks[12], (DEPTH, D_MODEL, D_FF), D_MODEL ** -0.5),
        "w_down": nrm(ks[13], (DEPTH, D_FF, D_MODEL), D_FF ** -0.5),
        "g_pre_mix": 1.0 + nrm(ks[14], (DEPTH, D_MODEL), 0.02),
        "g_post_mix": 1.0 + nrm(ks[15], (DEPTH, D_MODEL), 0.02),
        "g_pre_ffn": 1.0 + nrm(ks[16], (DEPTH, D_MODEL), 0.02),
        "g_post_ffn": 1.0 + nrm(ks[17], (DEPTH, D_MODEL), 0.02),
    }


def reference(x, c, positions, ada_w, ada_b, w_in, b_in, sinks, pool_w, pool_scale,
              w_out, w_gate, w_up, w_down, g_pre_mix, g_post_mix, g_pre_ffn, g_post_ffn):
    B, S = x.shape[0], x.shape[1]
    c_act = jax.nn.silu(c)
    for l in range(DEPTH):
        mod = c_act @ ada_w[l] + ada_b[l]
        shift_m, scale_m, gate_m, shift_f, scale_f, gate_f = [
            m[:, None, :] for m in jnp.split(mod, N_MOD, axis=-1)]

        h = rms_norm(x, g_pre_mix[l]) * (1.0 + scale_m) + shift_m
        proj = h @ w_in[l] + b_in[l]
        q, k, v, u = jnp.split(
            proj, [ATTN_WIDTH, ATTN_WIDTH + KV_WIDTH, ATTN_WIDTH + 2 * KV_WIDTH], axis=-1)
        q = partial_rotary(q.reshape(B, S, N_HEADS, HEAD_DIM), positions)
        k = partial_rotary(k.reshape(B, S, N_KV_HEADS, HEAD_DIM), positions)
        v = v.reshape(B, S, N_KV_HEADS, HEAD_DIM)
        attn_out = sliding_window_attention_with_sinks(q, k, v, sinks[l])
        pool_out = causal_pool_mixer(u, pool_w[l], pool_scale[l])
        mix = jnp.concatenate([attn_out, pool_out], axis=-1) @ w_out[l]
        x = x + gate_m * rms_norm(mix, g_post_mix[l])

        h = rms_norm(x, g_pre_ffn[l]) * (1.0 + scale_f) + shift_f
        f = (jax.nn.silu(h @ w_gate[l]) * (h @ w_up[l])) @ w_down[l]
        x = x + gate_f * rms_norm(f, g_post_ffn[l])
    return x
```

```cpp
#include <hip/hip_runtime.h>
#include <hip/hip_cooperative_groups.h>
#include <cstdio>
#include <cstdint>
namespace cg = cooperative_groups;
#define LAS __attribute__((address_space(3)))
namespace pg8 {
#define PG8_LAS __attribute__((address_space(3)))
typedef unsigned short bf16_t;
typedef short bf16x8 __attribute__((ext_vector_type(8)));
typedef float f32x4 __attribute__((ext_vector_type(4)));
typedef unsigned u32x4 __attribute__((ext_vector_type(4)));
constexpr int BM = 256, BK = 64, HALF = 128, HTB = HALF * BK * 2  , STAGE_BYTES = 8 * HTB, NXCD = 8, WGM = 8;

__host__ __device__ __forceinline__ int lds_byte(int r, int c) { const int st = (r >> 4) * 2 + (c >> 5), rr = r & 15, cc = c & 31, ob = rr * 64 + cc * 2; return st * 1024 + (ob ^ (((ob >> 9) & 1) << 5)); }
__host__ __device__ __forceinline__ void stage_rc(int b, int& R, int& C) { const int st = b / 1024, sb = b % 1024, swz = sb ^ (((sb >> 9) & 1) << 5); R = (st >> 1) * 16 + swz / 64; C = (st & 1) * 32 + (swz % 64) / 2; }
__host__ __device__ __forceinline__ int perm32(int rho) { const int n = rho >> 4, i = rho & 15; return 8 * (i >> 2) + 4 * n + (i & 3); }

struct Unit { int pm, pn; };
struct Gemm { const bf16_t* A; const bf16_t* Bt; int M, N, K; };

struct StaticOrder {
    int nM, nN, nwg, G, c;
    __host__ __device__ void init(int M, int N, int G_, int c_) { nM = M / BM; nN = N / BM; nwg = nM * nN; G = G_; c = c_; }
    __host__ __device__ bool next(int i, Unit& u) const {
        const long L = (long)i * G + c; if (L >= nwg) return false;
        int wgid = (int)L; { const int q = nwg / NXCD, r = nwg % NXCD, xcd = wgid % NXCD, off = wgid / NXCD; wgid = (xcd < r ? xcd * (q + 1) : r * (q + 1) + (xcd - r) * q) + off; }
        const int nig = WGM * nN, gid = wgid / nig, fm = gid * WGM, gsz = (nM - fm) < WGM ? (nM - fm) : WGM;
        u.pm = fm + ((wgid % nig) % gsz); u.pn = (wgid % nig) / gsz; return true;
    }
    __device__ __forceinline__ void a_ready(const Unit&) const {}
    __device__ __forceinline__ void done(const Unit&) const {}
};

__device__ __forceinline__ unsigned cvt_pk_bf16(float lo, float hi) { unsigned r; asm volatile("v_cvt_pk_bf16_f32 %0, %1, %2" : "=v"(r) : "v"(lo), "v"(hi)); return r; }
typedef float f32x2 __attribute__((ext_vector_type(2)));
__device__ __forceinline__ f32x2 gelu_pk(f32x2 v) {
    const f32x2 av = __builtin_elementwise_abs(v), d = av * 0.2316418882f + 1.0f;
    f32x2 t; t.x = __builtin_amdgcn_rcpf(d.x); t.y = __builtin_amdgcn_rcpf(d.y);
    f32x2 q = t * 0.5307027145f + (-0.7265760135f); q = q * t + 0.7107068705f; q = q * t + (-0.142248368f); q = q * t + 0.127414796f; q = q * t;
    const f32x2 s = (v * v) * (-0.72134752044f);
    f32x2 e; e.x = __builtin_amdgcn_exp2f(s.x); e.y = __builtin_amdgcn_exp2f(s.y);
    const f32x2 m = v * (q * e), r = v - m;
    f32x2 o; o.x = v.x < 0.f ? m.x : r.x; o.y = v.y < 0.f ? m.y : r.y; return o;
}

template <int ACT  > struct EpiBf16 {
    static constexpr bool PERM = true, AFTER_DRAIN = false; static_assert(ACT == 0 || ACT == 1, "EpiBf16: ACT is 0 (none) or 1 (gelu_pk)");
    bf16_t* O; int ldc; const float* bias; int split_cols; size_t split_stride; float scale0;
    __device__ __forceinline__ void operator()(const f32x4 (&acc)[2][2][4][2], const Unit& u, int wr, int wc, int fr, int fq) const {
        const int row0 = u.pm * BM + wr * 64 + fr; int colt = u.pn * BM; bf16_t* base = O;
        float sc = 1.f; if (split_cols) { const int t = colt / split_cols; base += (size_t)t * split_stride; colt -= t * split_cols; if (t == 0) sc = scale0; }
        const int col0 = colt + wc * 32 + 8 * fq, bcol0 = u.pn * BM + wc * 32 + 8 * fq;
        f32x4 bv[2][2];
#pragma unroll
        for (int bj = 0; bj < 2; ++bj)
#pragma unroll
            for (int n = 0; n < 2; ++n) bv[bj][n] = bias ? *(const f32x4*)(bias + bcol0 + bj * HALF + 4 * n) : (f32x4){0.f, 0.f, 0.f, 0.f};
#pragma unroll
        for (int ai = 0; ai < 2; ++ai)
#pragma unroll
            for (int m = 0; m < 4; ++m) { bf16_t* rowp = base + (size_t)(row0 + ai * HALF + m * 16) * ldc + col0;
#pragma unroll
                for (int bj = 0; bj < 2; ++bj) { f32x4 v0 = acc[ai][bj][m][0] + bv[bj][0], v1 = acc[ai][bj][m][1] + bv[bj][1];
                    if (ACT == 1) { f32x2 a = gelu_pk((f32x2){v0[0], v0[1]}), b = gelu_pk((f32x2){v0[2], v0[3]}), c = gelu_pk((f32x2){v1[0], v1[1]}), d = gelu_pk((f32x2){v1[2], v1[3]});
                        v0 = (f32x4){a.x, a.y, b.x, b.y}; v1 = (f32x4){c.x, c.y, d.x, d.y}; }
                    v0 = v0 * sc; v1 = v1 * sc; u32x4 w; w.x = cvt_pk_bf16(v0[0], v0[1]); w.y = cvt_pk_bf16(v0[2], v0[3]); w.z = cvt_pk_bf16(v1[0], v1[1]); w.w = cvt_pk_bf16(v1[2], v1[3]);
                    *(u32x4*)(rowp + bj * HALF) = w; } }
    }
};
template <class Epi, class Sched, bool ALIGN_EPI = false, bool SP2 = false>
__device__ __forceinline__ void gemm_phase(PG8_LAS unsigned char* lds, const Gemm g, const Sched& S, const Epi& E) {
    int tid_ = threadIdx.x; asm volatile("" : "+v"(tid_)); const int tid = tid_, wid = __builtin_amdgcn_readfirstlane(tid >> 6), lane = tid & 63, wr = wid >> 2, wc = wid & 3, fr = lane & 15, fq = lane >> 4;
    const int K = g.K, nt = K / BK;
    unsigned voffA[2], voffB[2];
#pragma unroll
    for (int i = 0; i < 2; ++i) { int R, C; stage_rc(tid * 16 + i * 8192, R, C); const int Rb = Epi::PERM ? ((R & ~31) + perm32(R & 31)) : R;
        voffA[i] = (unsigned)(R * K + C) * 2u; voffB[i] = (unsigned)(Rb * K + C) * 2u; }
    const size_t kstep = (size_t)(BK * 2);
    const size_t hstep = (size_t)HALF * K * 2;
    const size_t tstep = 2 * hstep;
    const unsigned ldsw = (unsigned)wid * 1024u;
    const int aoff = lds_byte(wr * 64 + fr, fq * 8), boff = lds_byte(wc * 32 + fr, fq * 8);
#define PG8_SA(b, h) (((b) * 2 + (h)) * HTB)
#define PG8_SB(b, h) ((4 + (b) * 2 + (h)) * HTB)
#define PG8_STAGE(bufoff, gbase, voff) do { _Pragma("unroll") for (int _i = 0; _i < 2; ++_i) \
        __builtin_amdgcn_global_load_lds((const unsigned*)((const char*)(gbase) + (voff)[_i]), (PG8_LAS unsigned*)(lds + (bufoff) + ldsw + _i * 8192), 16, 0, 0); } while (0)
#define PG8_LDA(dst, b, h) do { _Pragma("unroll") for (int m = 0; m < 4; ++m) _Pragma("unroll") for (int k = 0; k < 2; ++k) dst[m][k] = *(const PG8_LAS bf16x8*)(lds + PG8_SA(b, h) + aoff + m * 2048 + k * 1024); } while (0)
#define PG8_LDB(dst, b, h) do { _Pragma("unroll") for (int n = 0; n < 2; ++n) _Pragma("unroll") for (int k = 0; k < 2; ++k) dst[n][k] = *(const PG8_LAS bf16x8*)(lds + PG8_SB(b, h) + boff + n * 2048 + k * 1024); } while (0)
#define PG8_MMA(ai, bj, At, Bt) do { __builtin_amdgcn_s_setprio(1); _Pragma("unroll") for (int m = 0; m < 4; ++m) _Pragma("unroll") for (int n = 0; n < 2; ++n) _Pragma("unroll") for (int k = 0; k < 2; ++k) \
        acc[ai][bj][m][n] = __builtin_amdgcn_mfma_f32_16x16x32_bf16(Bt[n][k], At[m][k], acc[ai][bj][m][n], 0, 0, 0); __builtin_amdgcn_s_setprio(0); } while (0)
#define PG8_WAIT_V(n) asm volatile("s_waitcnt vmcnt(" #n ")" ::: "memory")
#define PG8_WAIT_L(n) asm volatile("s_waitcnt lgkmcnt(" #n ")" ::: "memory")
#define PG8_BAR __builtin_amdgcn_s_barrier()
#define PG8_SCHED __builtin_amdgcn_sched_barrier(0)
    Unit cur, nxt; int ui = 0;
    if (!S.next(0, cur)) return;
    f32x4 acc[2][2][4][2];
#pragma unroll
    for (int a = 0; a < 2; ++a)
#pragma unroll
        for (int b = 0; b < 2; ++b)
#pragma unroll
            for (int m = 0; m < 4; ++m)
#pragma unroll
                for (int n = 0; n < 2; ++n) acc[a][b][m][n] = (f32x4){0.f, 0.f, 0.f, 0.f};
    bf16x8 At[4][2], B0[2][2], B1[2][2];
    const char* cA = (const char*)g.A + (size_t)cur.pm * tstep; const char* cB = (const char*)g.Bt + (size_t)cur.pn * tstep;
    S.a_ready(cur);
    if constexpr (SP2) {
        PG8_STAGE(PG8_SB(0, 0), cB, voffB); PG8_STAGE(PG8_SB(0, 1), cB + hstep, voffB); PG8_STAGE(PG8_SA(0, 0), cA, voffA); PG8_STAGE(PG8_SA(0, 1), cA + hstep, voffA);
        if (wr == 1) PG8_BAR;
        PG8_WAIT_V(2); PG8_BAR;
        PG8_STAGE(PG8_SB(1, 0), cB + kstep, voffB); PG8_STAGE(PG8_SA(1, 0), cA + kstep, voffA); PG8_STAGE(PG8_SB(1, 1), cB + hstep + kstep, voffB);
        PG8_WAIT_V(6); PG8_BAR;
    } else {
        PG8_STAGE(PG8_SB(0, 0), cB, voffB); PG8_STAGE(PG8_SA(0, 0), cA, voffA); PG8_STAGE(PG8_SB(0, 1), cB + hstep, voffB); PG8_STAGE(PG8_SA(0, 1), cA + hstep, voffA);
        if (wr == 1) PG8_BAR;
        PG8_WAIT_V(4); PG8_BAR;
        PG8_STAGE(PG8_SB(1, 0), cB + kstep, voffB); PG8_STAGE(PG8_SA(1, 0), cA + kstep, voffA); PG8_STAGE(PG8_SB(1, 1), cB + hstep + kstep, voffB);
        PG8_WAIT_V(6); PG8_BAR;
    }
    for (;;) {
        const bool has_next = S.next(ui + 1, nxt);
        const char* nA = has_next ? (const char*)g.A + (size_t)nxt.pm * tstep : cA; const char* nB = has_next ? (const char*)g.Bt + (size_t)nxt.pn * tstep : cB;
        for (int t = 0; t < nt; t += 2) {
            const bool last = (t == nt - 2);
            const char* a1 = cA + (size_t)(t + 1) * kstep;
            const char* a2 = last ? nA : cA + (size_t)(t + 2) * kstep; const char* b2 = last ? nB : cB + (size_t)(t + 2) * kstep;
            const char* a3 = a2 + kstep; const char* b3 = b2 + kstep;
            if (last && has_next) S.a_ready(nxt);
            if constexpr (SP2) {
            PG8_LDB(B0, 0, 0); PG8_LDB(B1, 0, 1); PG8_SCHED; PG8_LDA(At, 0, 0); PG8_STAGE(PG8_SA(1, 1), a1 + hstep, voffA);
            PG8_WAIT_V(8); PG8_WAIT_L(0); PG8_BAR; PG8_MMA(0, 0, At, B0); PG8_MMA(0, 1, At, B1); PG8_BAR; PG8_SCHED;
            PG8_LDA(At, 0, 1); PG8_STAGE(PG8_SB(0, 0), b2, voffB); PG8_STAGE(PG8_SB(0, 1), b2 + hstep, voffB); PG8_STAGE(PG8_SA(0, 0), a2, voffA);
            PG8_WAIT_V(8); PG8_WAIT_L(0); PG8_BAR; PG8_MMA(1, 0, At, B0); PG8_MMA(1, 1, At, B1); PG8_BAR; PG8_SCHED;
            PG8_LDB(B0, 1, 0); PG8_LDB(B1, 1, 1); PG8_SCHED; PG8_LDA(At, 1, 0); PG8_STAGE(PG8_SA(0, 1), a2 + hstep, voffA);
            PG8_WAIT_V(8); PG8_WAIT_L(0); PG8_BAR; PG8_MMA(0, 0, At, B0); PG8_MMA(0, 1, At, B1); PG8_BAR; PG8_SCHED;
            PG8_LDA(At, 1, 1); PG8_STAGE(PG8_SB(1, 0), b3, voffB); PG8_STAGE(PG8_SB(1, 1), b3 + hstep, voffB); PG8_STAGE(PG8_SA(1, 0), a3, voffA);
            PG8_WAIT_V(8); PG8_WAIT_L(0); PG8_BAR; PG8_MMA(1, 0, At, B0); PG8_MMA(1, 1, At, B1); PG8_BAR; PG8_SCHED;
            } else {
            PG8_LDB(B0, 0, 0); PG8_SCHED; PG8_LDA(At, 0, 0); PG8_STAGE(PG8_SA(1, 1), a1 + hstep, voffA);
            PG8_WAIT_L(8); PG8_BAR; PG8_WAIT_L(0); PG8_MMA(0, 0, At, B0); PG8_BAR; PG8_SCHED;
            PG8_LDB(B1, 0, 1); PG8_STAGE(PG8_SB(0, 0), b2, voffB);
            PG8_BAR; PG8_WAIT_L(0); PG8_MMA(0, 1, At, B1); PG8_BAR;
            PG8_LDA(At, 0, 1); PG8_STAGE(PG8_SA(0, 0), a2, voffA);
            PG8_BAR; PG8_WAIT_L(0); PG8_MMA(1, 0, At, B0); PG8_BAR; PG8_SCHED;
            PG8_STAGE(PG8_SB(0, 1), b2 + hstep, voffB);
            PG8_WAIT_V(6); PG8_BAR; PG8_MMA(1, 1, At, B1); PG8_BAR;
            PG8_LDB(B0, 1, 0); PG8_SCHED; PG8_LDA(At, 1, 0); PG8_STAGE(PG8_SA(0, 1), a2 + hstep, voffA);
            PG8_WAIT_L(8); PG8_BAR; PG8_WAIT_L(0); PG8_MMA(0, 0, At, B0); PG8_BAR; PG8_SCHED;
            PG8_LDB(B1, 1, 1); PG8_STAGE(PG8_SB(1, 0), b3, voffB);
            PG8_BAR; PG8_WAIT_L(0); PG8_MMA(0, 1, At, B1); PG8_BAR;
            PG8_LDA(At, 1, 1); PG8_STAGE(PG8_SA(1, 0), a3, voffA);
            PG8_BAR; PG8_WAIT_L(0); PG8_MMA(1, 0, At, B0); PG8_BAR; PG8_SCHED;
            PG8_STAGE(PG8_SB(1, 1), b3 + hstep, voffB);
            PG8_WAIT_V(6); PG8_BAR; PG8_MMA(1, 1, At, B1); PG8_BAR;
            }
        }
        if constexpr (ALIGN_EPI) { if (wr == 0) PG8_BAR; }
        if constexpr (!Epi::AFTER_DRAIN) { E(acc, cur, wr, wc, fr, fq); S.done(cur); }
        if (!has_next) break;
#pragma unroll
        for (int a = 0; a < 2; ++a)
#pragma unroll
            for (int b = 0; b < 2; ++b)
#pragma unroll
                for (int m = 0; m < 4; ++m)
#pragma unroll
                    for (int n = 0; n < 2; ++n) acc[a][b][m][n] = (f32x4){0.f, 0.f, 0.f, 0.f};
        cur = nxt; cA = nA; cB = nB; ++ui;
        if constexpr (ALIGN_EPI) { if (wr == 1) PG8_BAR; }
    }
    PG8_WAIT_V(0);
    if constexpr (!ALIGN_EPI) { if (wr == 0) PG8_BAR; }
    PG8_BAR;
    if constexpr (Epi::AFTER_DRAIN) { E.fused(acc, cur, wr, wc, fr, fq, lds, wid, lane); S.done(cur); }
#undef PG8_SA
#undef PG8_SB
#undef PG8_STAGE
#undef PG8_LDA
#undef PG8_LDB
#undef PG8_MMA
#undef PG8_WAIT_V
#undef PG8_WAIT_L
#undef PG8_BAR
#undef PG8_SCHED
}
}
#define XB_TMO      128
#define XB_XCNT(j)  (256  + 64 * (j))
#define XB_XSUB(j)  (1280 + 64 * (j))
#define XB_XGEN(j)  (2304 + 64 * (j))
#define XB_TOP      3328
#define XB_TOPGEN   3392
#define XCD_BAR_WORDS 3456
#define XB_SPIN_CAP (1u << 18)

__device__ __forceinline__ unsigned xb_ld(unsigned* p)              { return __hip_atomic_load(p, __ATOMIC_RELAXED, __HIP_MEMORY_SCOPE_AGENT); }
__device__ __forceinline__ unsigned xb_add(unsigned* p, unsigned v) { return __hip_atomic_fetch_add(p, v, __ATOMIC_RELAXED, __HIP_MEMORY_SCOPE_AGENT); }
__device__ __forceinline__ unsigned xb_xcc_id() { return (unsigned)__builtin_amdgcn_s_getreg((3 << 11) | 20) & 0xFu; }
#define XB_SPIN(cond, bar) do { unsigned _sp = 0; while (cond) { __builtin_amdgcn_s_sleep(1); \
    if ((++_sp & 255u) == 0u) { if (xb_ld(&(bar)[XB_TMO])) break; if (_sp > XB_SPIN_CAP) { atomicAdd(&(bar)[XB_TMO], 1u); break; } } } } while (0)

struct XcdBarrier {
    unsigned* bar; unsigned x;
    volatile LAS unsigned* st;
};

__device__ __forceinline__ XcdBarrier xcd_barrier_post(unsigned* bar, volatile LAS unsigned* st) {
    XcdBarrier b; b.bar = bar; b.x = xb_xcc_id(); b.st = st;
    if (threadIdx.x == 0) (void)xb_add(&bar[XB_XCNT(b.x)], 1u);
    return b;
}
__device__ __forceinline__ void xcd_barrier_complete(unsigned* bar, unsigned x, unsigned& nloc, unsigned& nx) {
    const unsigned G = gridDim.x * gridDim.y * gridDim.z;
    unsigned sum, cnt, mine, sp = 0u;
    for (;;) {
        sum = 0u; cnt = 0u; mine = 0u;
#pragma unroll
        for (unsigned j = 0; j < 16; ++j) { const unsigned c = xb_ld(&bar[XB_XCNT(j)]); sum += c; cnt += (c > 0u) ? 1u : 0u; mine = (j == x) ? c : mine; }
        if (sum == G) break;
        __builtin_amdgcn_s_sleep(1);
        if ((++sp & 255u) == 0u) { if (xb_ld(&bar[XB_TMO])) break; if (sp > XB_SPIN_CAP) { atomicAdd(&bar[XB_TMO], 1u); break; } }
    }
    nloc = mine > 0u ? mine : 1u; nx = cnt > 0u ? cnt : 1u;
}

__device__ __forceinline__ void xcd_barrier(const XcdBarrier& b) {
    asm volatile("s_waitcnt vmcnt(0)" ::: "memory");
    __syncthreads();
    if (threadIdx.x == 0) {
        unsigned* bar = b.bar;
        __builtin_amdgcn_s_waitcnt(0);
        unsigned nloc = b.st[0], nx = b.st[1];
        if (nloc == 0u) { xcd_barrier_complete(bar, b.x, nloc, nx); b.st[0] = nloc; b.st[1] = nx; }
        const unsigned old = xb_add(&bar[XB_XSUB(b.x)], 1u);
        const unsigned gen = old / nloc;
        if (old + 1u == (gen + 1u) * nloc) {
            __builtin_amdgcn_fence(__ATOMIC_RELEASE, "agent");
            asm volatile("s_waitcnt vmcnt(0)" ::: "memory");
            const unsigned og = xb_add(&bar[XB_TOP], 1u);
            const unsigned tg = og / nx;
            if (og + 1u == (tg + 1u) * nx) xb_add(&bar[XB_TOPGEN], 1u);
            else XB_SPIN(xb_ld(&bar[XB_TOPGEN]) == tg, bar);
            __builtin_amdgcn_fence(__ATOMIC_ACQUIRE, "agent");
            xb_add(&bar[XB_XGEN(b.x)], 1u);
            asm volatile("s_waitcnt vmcnt(0)" ::: "memory");
        } else {
            XB_SPIN(xb_ld(&bar[XB_XGEN(b.x)]) == gen, bar);
            __builtin_amdgcn_fence(__ATOMIC_ACQUIRE, "agent");
            asm volatile("s_waitcnt vmcnt(0)" ::: "memory");
        }
    }
    __syncthreads();
}

constexpr int NB = 8, SEQ = 8192, DM = 1024, DEPTH = 2;
constexpr int T = NB * SEQ;
constexpr int INW = 1280, DFF = 2816, NMODW = 6 * DM;
constexpr int KCH = 32;
constexpr float EPS = 1e-6f;
constexpr float LOG2E = 1.4426950408889634f;

#define LAS __attribute__((address_space(3)))
typedef unsigned short bf16;
typedef unsigned v4u __attribute__((ext_vector_type(4)));
typedef unsigned v2u __attribute__((ext_vector_type(2)));
typedef float f32x4 __attribute__((ext_vector_type(4)));
typedef short bf16x8 __attribute__((ext_vector_type(8)));

constexpr size_t MiB = 1u << 20;
constexpr size_t WS_MODP = 640 * MiB;
constexpr size_t WS_MODF = 8 * MiB;
constexpr size_t WS_CS = 9 * MiB;
constexpr size_t WS_W = 16 * MiB, W_LAYER = 24 * MiB;
constexpr size_t W_IN = 0, W_OUT = 3 * MiB, W_GU = 5 * MiB, W_DN = 16 * MiB, W_PW = 22 * MiB;
constexpr size_t WS_H = 64 * MiB;
constexpr size_t WS_MIX = 192 * MiB;
constexpr size_t WS_PROJ = 320 * MiB;
constexpr size_t WS_CONCAT = 480 * MiB;
constexpr size_t WS_ACT = 320 * MiB;
constexpr size_t WS_XA = 672 * MiB;
constexpr size_t WS_XB = 800 * MiB;
constexpr size_t WS_END = 928 * MiB;

constexpr int RING_BYTES = 131072;
constexpr int LDS_BYTES = 147456;

struct Args {
    const float* x; const float* c; const int* pos; const float* ada_w; const float* ada_b; const float* w_in; const float* b_in;
    const float* sinks; const float* pool_w; const float* pool_scale; const float* w_out; const float* w_gate; const float* w_up;
    const float* w_down; const float* g_pre_mix; const float* g_post_mix; const float* g_pre_ffn; const float* g_post_ffn;
    float* out; unsigned char* ws;
};

__device__ __constant__ double c_inv_freq[8] = {1.0, 0.19392274474868576, 0.03760603093086393, 0.007292664737217109,
                                                0.001414213562373095, 0.0002742481756762073, 5.318295896944988e-05, 1.031338537721246e-05};

__device__ __forceinline__ unsigned pk2(float lo, float hi) { return pg8::cvt_pk_bf16(lo, hi); }
__device__ __forceinline__ float bf_lo(unsigned w) { return __uint_as_float(w << 16); }
__device__ __forceinline__ float bf_hi(unsigned w) { return __uint_as_float(w & 0xffff0000u); }
__device__ __forceinline__ float wave_sum(float v) {
#pragma unroll
    for (int o = 1; o < 64; o <<= 1) v += __shfl_xor(v, o);
    return v;
}

namespace pg8 {
struct EpiInProj {
    static constexpr bool PERM = true, AFTER_DRAIN = false;
    bf16_t* O; const float* bias; const float* cs;
    __device__ __forceinline__ void operator()(const f32x4 (&acc)[2][2][4][2], const Unit& u, int wr, int wc, int fr, int fq) const {
        const int row0 = u.pm * BM + wr * 64 + fr; const int colt = u.pn * BM; const int col0 = colt + wc * 32 + 8 * fq;
        f32x4 bv[2][2];
#pragma unroll
        for (int bj = 0; bj < 2; ++bj)
#pragma unroll
            for (int n = 0; n < 2; ++n) bv[bj][n] = *(const f32x4*)(bias + col0 + bj * HALF + 4 * n);
        const bool rot_wave = (colt < 640) && ((wc & 1) == 0);
#pragma unroll
        for (int ai = 0; ai < 2; ++ai)
#pragma unroll
        for (int mh = 0; mh < 2; ++mh) {
            f32x4 cc[2][4];
#pragma unroll
            for (int mm = 0; mm < 2; ++mm)
#pragma unroll
                for (int q = 0; q < 4; ++q) cc[mm][q] = (f32x4){1.f, 1.f, 1.f, 1.f};
            if (rot_wave && fq < 2) {
#pragma unroll
                for (int mm = 0; mm < 2; ++mm) { const float* cr = cs + (size_t)(row0 + ai * HALF + (2 * mh + mm) * 16) * 16;
#pragma unroll
                    for (int q = 0; q < 4; ++q) cc[mm][q] = *(const f32x4*)(cr + 4 * q); }
            }
#pragma unroll
            for (int mm = 0; mm < 2; ++mm) {
                const int m = 2 * mh + mm;
                const int row = row0 + ai * HALF + m * 16;
                bf16_t* rowp = O + (size_t)row * INW + col0;
#pragma unroll
                for (int bj = 0; bj < 2; ++bj) {
                    f32x4 v0 = acc[ai][bj][m][0] + bv[bj][0], v1 = acc[ai][bj][m][1] + bv[bj][1];
                    const int cb = colt + bj * HALF;
                    if (rot_wave && cb < 640) {
                        f32x4 p0, p1;
#pragma unroll
                        for (int e = 0; e < 4; ++e) { p0[e] = __shfl_xor(v0[e], 16); p1[e] = __shfl_xor(v1[e], 16); }
                        if (fq == 0) { v0 = v0 * cc[mm][0] - p0 * cc[mm][2]; v1 = v1 * cc[mm][1] - p1 * cc[mm][3]; }
                        else if (fq == 1) { v0 = v0 * cc[mm][0] + p0 * cc[mm][2]; v1 = v1 * cc[mm][1] + p1 * cc[mm][3]; }
                    }
                    if (cb < 512) { v0 = v0 * 0.125f; v1 = v1 * 0.125f; }
                    u32x4 w; w.x = cvt_pk_bf16(v0[0], v0[1]); w.y = cvt_pk_bf16(v0[2], v0[3]); w.z = cvt_pk_bf16(v1[0], v1[1]); w.w = cvt_pk_bf16(v1[2], v1[3]);
                    *(u32x4*)(rowp + bj * HALF) = w;
                }
            }
        }
    }
};
struct EpiSwiGLU {
    static constexpr bool PERM = true, AFTER_DRAIN = false;
    bf16_t* O;
    __device__ __forceinline__ void operator()(const f32x4 (&acc)[2][2][4][2], const Unit& u, int wr, int wc, int fr, int fq) const {
        typedef float f32x2 __attribute__((ext_vector_type(2)));
        const int row0 = u.pm * BM + wr * 64 + fr; const int col0 = u.pn * HALF + wc * 32 + 8 * fq;
#pragma unroll
        for (int ai = 0; ai < 2; ++ai)
#pragma unroll
            for (int m = 0; m < 4; ++m) {
                bf16_t* rowp = O + (size_t)(row0 + ai * HALF + m * 16) * DFF + col0;
                f32x2 G[4], U[4], t[4], r[4];
#pragma unroll
                for (int n = 0; n < 2; ++n) { G[2 * n] = (f32x2){acc[ai][0][m][n][0], acc[ai][0][m][n][1]}; G[2 * n + 1] = (f32x2){acc[ai][0][m][n][2], acc[ai][0][m][n][3]};
                                              U[2 * n] = (f32x2){acc[ai][1][m][n][0], acc[ai][1][m][n][1]}; U[2 * n + 1] = (f32x2){acc[ai][1][m][n][2], acc[ai][1][m][n][3]}; }
#pragma unroll
                for (int q = 0; q < 4; ++q) { t[q].x = __builtin_amdgcn_exp2f(G[q].x); t[q].y = __builtin_amdgcn_exp2f(G[q].y); }
#pragma unroll
                for (int q = 0; q < 4; ++q) { t[q] = t[q] + 1.0f; r[q] = G[q] * U[q]; }
#pragma unroll
                for (int q = 0; q < 4; ++q) { t[q].x = __builtin_amdgcn_rcpf(t[q].x); t[q].y = __builtin_amdgcn_rcpf(t[q].y); }
#pragma unroll
                for (int q = 0; q < 4; ++q) r[q] = r[q] * t[q];
                u32x4 w; w.x = cvt_pk_bf16(r[0].x, r[0].y); w.y = cvt_pk_bf16(r[1].x, r[1].y); w.z = cvt_pk_bf16(r[2].x, r[2].y); w.w = cvt_pk_bf16(r[3].x, r[3].y);
                *(u32x4*)rowp = w;
            }
    }
};
struct DualOrder {
    StaticOrder so; int c, rounds, hot;
    __device__ bool next(int i, Unit& u) const { if (hot) { if (i >= rounds) return false; u.pm = (c % 8) * 2 + ((c / 8) & 1); u.pn = ((c / 8) >> 1) & 3; return true; } return so.next(i, u); }
    __device__ __forceinline__ void a_ready(const Unit&) const {}
    __device__ __forceinline__ void done(const Unit&) const {}
};
}

__device__ __forceinline__ void transpose_item(const float* W, int K, int N, bf16* WT, int drow0, LAS float* scr, int k0, int n0, int lane, float wscale = 1.0f) {
#pragma unroll
    for (int ih = 0; ih < 32; ih += 16) {
        float tv[16];
#pragma unroll
        for (int i = 0; i < 16; ++i) tv[i] = W[(size_t)(k0 + 2 * (ih + i) + (lane >> 5)) * N + n0 + (lane & 31)];
#pragma unroll
        for (int i = 0; i < 16; ++i) scr[(2 * (ih + i) + (lane >> 5)) * 33 + (lane & 31)] = tv[i] * wscale;
    }
    asm volatile("s_waitcnt lgkmcnt(0)" ::: "memory");
    const int c = lane & 7;
#pragma unroll
    for (int j = 0; j < 4; ++j) { const int n = (lane >> 3) + 8 * j; const LAS float* s = scr + (8 * c) * 33 + n;
        v4u o; o.x = pk2(s[0 * 33], s[1 * 33]); o.y = pk2(s[2 * 33], s[3 * 33]); o.z = pk2(s[4 * 33], s[5 * 33]); o.w = pk2(s[6 * 33], s[7 * 33]);
        *(v4u*)(WT + (size_t)(drow0 + n) * K + k0 + 8 * c) = o; }
    asm volatile("s_waitcnt lgkmcnt(0)" ::: "memory");
}

__device__ __forceinline__ void prologue(const Args& a, LAS unsigned char* lds) {
    int tid_ = threadIdx.x; asm volatile("" : "+v"(tid_)); const int tid = tid_, lane = tid & 63, wave = tid >> 6;
    unsigned char* ws = a.ws;
    __syncthreads();
    {
        LAS float* sc = (LAS float*)lds;
        for (int i = tid; i < NB * DM; i += 512) { const float v = a.c[i]; sc[i] = v / (1.0f + __expf(-v)); }
        __syncthreads();
        float* modp = (float*)(ws + WS_MODP);
        for (int item = blockIdx.x; item < DEPTH * KCH * 12; item += gridDim.x) {
            const int l = item / (KCH * 12), r = item % (KCH * 12), kc = r / 12, cb = r % 12, n = cb * 512 + tid;
            constexpr int KPI = DM / KCH;
            const float* w = a.ada_w + ((size_t)l * DM + kc * KPI) * NMODW + n;
            float acc[8];
#pragma unroll
            for (int b = 0; b < 8; ++b) acc[b] = 0.f;
#pragma unroll 1
            for (int kh = 0; kh < KPI; kh += 16) {
                float wv[16];
#pragma unroll
                for (int k = 0; k < 16; ++k) wv[k] = w[(size_t)(kh + k) * NMODW];
#pragma unroll
                for (int k = 0; k < 16; ++k) {
                    const LAS float* sp = sc + kc * KPI + kh + k;
#pragma unroll
                    for (int b = 0; b < 8; ++b) acc[b] += sp[b * DM] * wv[k];
                    if ((k & 3) == 3) asm volatile("" ::: "memory");
                }
            }
#pragma unroll
            for (int b = 0; b < 8; ++b) modp[((size_t)(l * KCH + kc) * 8 + b) * NMODW + n] = acc[b];
        }
        __syncthreads();
    }
    {
        float* cs = (float*)(ws + WS_CS);
        for (int idx = blockIdx.x * 512 + tid; idx < T * 8; idx += gridDim.x * 512) {
            const int row = idx >> 3, j = idx & 7;
            const double rev = (double)a.pos[row] * c_inv_freq[j] * 0.15915494309189535;
            const float fr = (float)(rev - floor(rev));
            cs[(size_t)row * 16 + j] = __builtin_amdgcn_cosf(fr);
            cs[(size_t)row * 16 + 8 + j] = __builtin_amdgcn_sinf(fr);
        }
    }
    {
        LAS float* scr = (LAS float*)(lds + wave * 16384);
        const int gw = blockIdx.x * 8 + wave, ngw = gridDim.x * 8;
        constexpr int I_IN = 16 * 40, I_OUT = 16 * 32, I_G = 16 * 88, I_D = 44 * 32, I_P = 4 * 8;
        constexpr int PER_L = I_IN + I_OUT + 2 * I_G + I_D + I_P;
        for (int it = gw; it < DEPTH * PER_L; it += ngw) {
            const int l = it / PER_L; int r = it % PER_L;
            unsigned char* wl = ws + WS_W + (size_t)l * W_LAYER;
            if (r < I_IN) { const int kb = r / 40, nb = r % 40; transpose_item(a.w_in + (size_t)l * DM * INW, DM, INW, (bf16*)(wl + W_IN), 32 * nb, scr, 64 * kb, 32 * nb, lane); continue; } r -= I_IN;
            if (r < I_OUT) { const int kb = r / 32, nb = r % 32; transpose_item(a.w_out + (size_t)l * DM * DM, DM, DM, (bf16*)(wl + W_OUT), 32 * nb, scr, 64 * kb, 32 * nb, lane); continue; } r -= I_OUT;
            if (r < 2 * I_G) { const int up = r >= I_G; if (up) r -= I_G; const int kb = r / 88, nb = r % 88, n0 = 32 * nb;
                transpose_item((up ? a.w_up : a.w_gate) + (size_t)l * DM * DFF, DM, DFF, (bf16*)(wl + W_GU), 256 * (n0 >> 7) + (n0 & 127) + (up ? 128 : 0), scr, 64 * kb, n0, lane, up ? -0.6931471805599453f : -1.4426950408889634f); continue; } r -= 2 * I_G;
            if (r < I_D) { const int kb = r / 32, nb = r % 32; transpose_item(a.w_down + (size_t)l * DFF * DM, DFF, DM, (bf16*)(wl + W_DN), 32 * nb, scr, 64 * kb, 32 * nb, lane); continue; } r -= I_D;
            { const int gi = r / 8, q = r % 8, kb = q / 4, nb = q % 4;
              transpose_item(a.pool_w + ((size_t)l * 4 + gi) * 128 * 128, 128, 128, (bf16*)(wl + W_PW) + (size_t)gi * 128 * 128, 32 * nb, scr, 64 * kb, 32 * nb, lane); }
        }
    }
}

__device__ __forceinline__ float mod_val(const Args& a, int l, int b, int idx, int col) {
    const float* modp = (const float*)(a.ws + WS_MODP);
    const int n = idx * DM + col;
    float s = a.ada_b[l * NMODW + n];
#pragma unroll
    for (int kc = 0; kc < KCH; ++kc) s += modp[((size_t)(l * KCH + kc) * 8 + b) * NMODW + n];
    return s;
}
__device__ __forceinline__ float mod_fin(const Args& a, int l, int b, int idx, int col) {
    return ((const float*)(a.ws + WS_MODF))[((size_t)(l * 8 + b)) * NMODW + idx * DM + col];
}
__device__ __forceinline__ void mod_finalize(const Args& a) {
    float* modf = (float*)(a.ws + WS_MODF);
    for (int i = blockIdx.x * 512 + threadIdx.x; i < DEPTH * 8 * NMODW; i += gridDim.x * 512) {
        const int l = i / (8 * NMODW), r = i % (8 * NMODW), b = r / NMODW, n = r % NMODW;
        modf[i] = mod_val(a, l, b, n / DM, n % DM);
    }
}
__device__ __forceinline__ void unpack8(const v4u w, float (&f)[8]) {
#pragma unroll
    for (int e = 0; e < 4; ++e) { f[2 * e] = bf_lo(w[e]); f[2 * e + 1] = bf_hi(w[e]); }
}
__device__ __forceinline__ v4u pack8(const float (&f)[8]) { return (v4u){pk2(f[0], f[1]), pk2(f[2], f[3]), pk2(f[4], f[5]), pk2(f[6], f[7])}; }
__device__ __forceinline__ void rowwise_phase(const Args& a, LAS unsigned char* lds, bool from_partials, bool has_y, bool has_h, bool xin_bf, int xout_mode,
        const void* xin, const bf16* y, float* xout, bf16* xoutb, bf16* hout,
        int l_y, int gate_idx, const float* g_post, int l_h, int shift_idx, int scale_idx, const float* g_pre) {
    int tid_ = threadIdx.x; asm volatile("" : "+v"(tid_)); const int tid = tid_, lane = tid & 63, wave = tid >> 6;
    LAS float* vec = (LAS float*)lds;
    for (int tile = blockIdx.x; tile < T / 256; tile += gridDim.x) {
        const int b = tile / (SEQ / 256);
        __syncthreads();
        for (int col = tid; col < DM; col += 512) {
            if (from_partials) {
                if (has_y) vec[col] = mod_val(a, l_y, b, gate_idx, col) * g_post[col];
                if (has_h) { vec[DM + col] = g_pre[col] * (1.0f + mod_val(a, l_h, b, scale_idx, col)); vec[2 * DM + col] = mod_val(a, l_h, b, shift_idx, col); }
            } else {
                if (has_y) vec[col] = mod_fin(a, l_y, b, gate_idx, col) * g_post[col];
                if (has_h) { vec[DM + col] = g_pre[col] * (1.0f + mod_fin(a, l_h, b, scale_idx, col)); vec[2 * DM + col] = mod_fin(a, l_h, b, shift_idx, col); }
            }
        }
        __syncthreads();
#pragma unroll 1
        for (int r = wave * 4; r < 256; r += 32) {
            float v[4][2][8]; v4u yv[4][2];
#pragma unroll
            for (int h = 0; h < 4; ++h)
#pragma unroll
                for (int j = 0; j < 2; ++j) { const size_t off = ((size_t)tile * 256 + r + h) * DM + 8 * lane + 512 * j;
                    if (xin_bf) unpack8(*(const v4u*)((const bf16*)xin + off), v[h][j]);
                    else { const f32x4 p0 = *(const f32x4*)((const float*)xin + off), p1 = *(const f32x4*)((const float*)xin + off + 4);
                        v[h][j][0] = p0.x; v[h][j][1] = p0.y; v[h][j][2] = p0.z; v[h][j][3] = p0.w; v[h][j][4] = p1.x; v[h][j][5] = p1.y; v[h][j][6] = p1.z; v[h][j][7] = p1.w; }
                    yv[h][j] = has_y ? *(const v4u*)(y + off) : (v4u){0u, 0u, 0u, 0u}; }
            if (has_y) {
                float rstd[4];
#pragma unroll
                for (int h = 0; h < 4; ++h) { float ss = 0.f;
#pragma unroll
                    for (int j = 0; j < 2; ++j) { float yf[8]; unpack8(yv[h][j], yf);
#pragma unroll
                        for (int e = 0; e < 8; ++e) ss += yf[e] * yf[e]; }
                    rstd[h] = __builtin_amdgcn_rsqf(wave_sum(ss) * (1.0f / DM) + EPS); }
#pragma unroll
                for (int j = 0; j < 2; ++j) { const LAS float* gpp = vec + 8 * lane + 512 * j; const f32x4 g0 = *(const LAS f32x4*)gpp, g1 = *(const LAS f32x4*)(gpp + 4);
                    const float gp[8] = {g0.x, g0.y, g0.z, g0.w, g1.x, g1.y, g1.z, g1.w};
#pragma unroll
                    for (int h = 0; h < 4; ++h) { float yf[8]; unpack8(yv[h][j], yf);
#pragma unroll
                        for (int e = 0; e < 8; ++e) v[h][j][e] += gp[e] * (yf[e] * rstd[h]); } }
            }
            if (xout_mode == 1) {
#pragma unroll
                for (int h = 0; h < 4; ++h)
#pragma unroll
                    for (int j = 0; j < 2; ++j) { float* o = xout + ((size_t)tile * 256 + r + h) * DM + 8 * lane + 512 * j;
                        *(f32x4*)o = (f32x4){v[h][j][0], v[h][j][1], v[h][j][2], v[h][j][3]}; *(f32x4*)(o + 4) = (f32x4){v[h][j][4], v[h][j][5], v[h][j][6], v[h][j][7]}; }
            } else if (xout_mode == 2) {
#pragma unroll
                for (int h = 0; h < 4; ++h)
#pragma unroll
                    for (int j = 0; j < 2; ++j) { const v4u w = pack8(v[h][j]);
                        *(v4u*)(xoutb + ((size_t)tile * 256 + r + h) * DM + 8 * lane + 512 * j) = w;
                        unpack8(w, v[h][j]); }
            }
            if (has_h) {
                float rstd[4];
#pragma unroll
                for (int h = 0; h < 4; ++h) { float ss = 0.f;
#pragma unroll
                    for (int j = 0; j < 2; ++j)
#pragma unroll
                        for (int e = 0; e < 8; ++e) ss += v[h][j][e] * v[h][j][e];
                    rstd[h] = __builtin_amdgcn_rsqf(wave_sum(ss) * (1.0f / DM) + EPS); }
#pragma unroll
                for (int j = 0; j < 2; ++j) { const LAS float* gsp = vec + DM + 8 * lane + 512 * j; const LAS float* shp = vec + 2 * DM + 8 * lane + 512 * j;
                    const f32x4 a0 = *(const LAS f32x4*)gsp, a1 = *(const LAS f32x4*)(gsp + 4), b0 = *(const LAS f32x4*)shp, b1 = *(const LAS f32x4*)(shp + 4);
                    const float gs[8] = {a0.x, a0.y, a0.z, a0.w, a1.x, a1.y, a1.z, a1.w}, sh[8] = {b0.x, b0.y, b0.z, b0.w, b1.x, b1.y, b1.z, b1.w};
#pragma unroll
                    for (int h = 0; h < 4; ++h) { float hv[8];
#pragma unroll
                        for (int e = 0; e < 8; ++e) hv[e] = v[h][j][e] * rstd[h] * gs[e] + sh[e];
                        *(v4u*)(hout + ((size_t)tile * 256 + r + h) * DM + 8 * lane + 512 * j) = pack8(hv); } }
            }
        }
    }
}

__device__ __forceinline__ void attn_phase(LAS unsigned char* lds, const bf16* PROJ, bf16* CONCAT, const float* sinks) {
    int tid_ = threadIdx.x; asm volatile("" : "+v"(tid_)); const int tid = tid_, lane = tid & 63, wave = tid >> 6, fr = lane & 15, fq = lane >> 4;
    LAS bf16* Ks = (LAS bf16*)lds;
    LAS bf16* Vt = (LAS bf16*)(lds + 36864);
    v4u kv[4], vv[4];
#define ATT_LOAD_KV(uu) do { const int kh_ = (uu) & 1, n_ = ((uu) >> 1) & 63, b_ = (uu) >> 7; const long rb_ = (long)b_ * SEQ + n_ * 128 - 128; \
        _Pragma("unroll") for (int i = 0; i < 4; ++i) { const int kj = lane + 64 * i; kv[i] = (v4u){0u, 0u, 0u, 0u}; vv[i] = (v4u){0u, 0u, 0u, 0u}; \
            if (n_ > 0 || kj >= 128) { const bf16* p = PROJ + (size_t)(rb_ + kj) * INW + kh_ * 64 + wave * 8; kv[i] = *(const v4u*)(p + 512); vv[i] = *(const v4u*)(p + 640); } } } while (0)
    if ((int)blockIdx.x < NB * 64 * 2) ATT_LOAD_KV((int)blockIdx.x);
    for (int u = blockIdx.x; u < NB * 64 * 2; u += gridDim.x) {
        const int kh = u & 1, n = (u >> 1) & 63, b = u >> 7;
        const int g = wave >> 1, h = kh * 4 + g;
        const size_t qrow0 = (size_t)b * SEQ + n * 128 + (wave & 1) * 64 + fr;
        bf16x8 qf[4][2];
#pragma unroll
        for (int i = 0; i < 4; ++i) { const bf16* qp = PROJ + (qrow0 + 16 * i) * INW + h * 64 + 8 * fq; qf[i][0] = *(const bf16x8*)qp; qf[i][1] = *(const bf16x8*)(qp + 32); }
#pragma unroll
        for (int i = 0; i < 4; ++i) { const int kj = lane + 64 * i;
            *(LAS v4u*)(Ks + kj * 72 + wave * 8) = kv[i];
#pragma unroll
            for (int e = 0; e < 4; ++e) { Vt[(wave * 8 + 2 * e) * 272 + kj] = (bf16)(vv[i][e] & 0xffffu); Vt[(wave * 8 + 2 * e + 1) * 272 + kj] = (bf16)(vv[i][e] >> 16); } }
        __syncthreads();
        if (u + (int)gridDim.x < NB * 64 * 2) ATT_LOAD_KV(u + (int)gridDim.x);
        const float sink = sinks[h];
        const int firstblk = (n == 0);
#pragma unroll
        for (int p = 0; p < 2; ++p) {
            const int q16a = (wave & 1) * 4 + 2 * p, kt0 = q16a;
            f32x4 st[2][10];
#pragma unroll
            for (int t = 0; t < 10; ++t) {
                const LAS bf16* kp = Ks + (16 * (kt0 + t) + fr) * 72 + 8 * fq;
                const bf16x8 k0 = *(const LAS bf16x8*)kp, k1 = *(const LAS bf16x8*)(kp + 32);
#pragma unroll
                for (int x = 0; x < 2; ++x) {
                    if (x + 8 - t == 9 || x + 8 - t == -1) { st[x][t] = (f32x4){-1e30f, -1e30f, -1e30f, -1e30f}; continue; }
                    f32x4 acc = (f32x4){0.f, 0.f, 0.f, 0.f};
                    acc = __builtin_amdgcn_mfma_f32_16x16x32_bf16(k0, qf[2 * p + x][0], acc, 0, 0, 0);
                    acc = __builtin_amdgcn_mfma_f32_16x16x32_bf16(k1, qf[2 * p + x][1], acc, 0, 0, 0);
                    st[x][t] = acc;
                }
            }
            float inv[2];
#pragma unroll
            for (int x = 0; x < 2; ++x) {
                float mx = -1e30f;
#pragma unroll
                for (int t = 0; t < 10; ++t) {
                    const int D = x + 8 - t;
                    if (D == 9 || D == -1) continue;
                    const bool tile_off = firstblk && (kt0 + t < 8);
#pragma unroll
                    for (int r = 0; r < 4; ++r) { const int dl = fr - 4 * fq - r;
                        bool valid = !tile_off;
                        if (D == 8) valid = valid && (dl < 0);
                        if (D == 0) valid = valid && (dl >= 0);
                        const float sv = valid ? st[x][t][r] : -1e30f; st[x][t][r] = sv; mx = fmaxf(mx, sv); }
                }
                mx = fmaxf(mx, __shfl_xor(mx, 16)); mx = fmaxf(mx, __shfl_xor(mx, 32)); mx = fmaxf(mx, sink);
                const float mb = mx * LOG2E;
                float lsum = 0.f;
#pragma unroll
                for (int t = 0; t < 10; ++t) {
                    const int D = x + 8 - t;
                    if (D == 9 || D == -1) { st[x][t] = (f32x4){0.f, 0.f, 0.f, 0.f}; continue; }
#pragma unroll
                    for (int r = 0; r < 4; ++r) { const float pe = __builtin_amdgcn_exp2f(st[x][t][r] * LOG2E - mb); st[x][t][r] = pe; lsum += pe; }
                }
                lsum += __shfl_xor(lsum, 16); lsum += __shfl_xor(lsum, 32); lsum += __builtin_amdgcn_exp2f(sink * LOG2E - mb);
                inv[x] = 1.0f / lsum;
            }
            f32x4 ot[2][4];
#pragma unroll
            for (int x = 0; x < 2; ++x)
#pragma unroll
                for (int dt = 0; dt < 4; ++dt) ot[x][dt] = (f32x4){0.f, 0.f, 0.f, 0.f};
#pragma unroll
            for (int s2 = 0; s2 < 5; ++s2) {
                bf16x8 pf[2];
#pragma unroll
                for (int x = 0; x < 2; ++x) { v4u pw; pw.x = pk2(st[x][2 * s2][0], st[x][2 * s2][1]); pw.y = pk2(st[x][2 * s2][2], st[x][2 * s2][3]);
                    pw.z = pk2(st[x][2 * s2 + 1][0], st[x][2 * s2 + 1][1]); pw.w = pk2(st[x][2 * s2 + 1][2], st[x][2 * s2 + 1][3]); pf[x] = __builtin_bit_cast(bf16x8, pw); }
#pragma unroll
                for (int dt = 0; dt < 4; ++dt) {
                    const LAS bf16* vp = Vt + (16 * dt + fr) * 272 + 16 * (kt0 + 2 * s2) + 4 * fq;
                    const v2u lo = *(const LAS v2u*)vp, hi = *(const LAS v2u*)(vp + 16);
                    const bf16x8 vf = __builtin_bit_cast(bf16x8, (v4u){lo.x, lo.y, hi.x, hi.y});
#pragma unroll
                    for (int x = 0; x < 2; ++x) ot[x][dt] = __builtin_amdgcn_mfma_f32_16x16x32_bf16(vf, pf[x], ot[x][dt], 0, 0, 0);
                }
            }
#pragma unroll
            for (int x = 0; x < 2; ++x) {
                bf16* op = CONCAT + (qrow0 + 16 * (2 * p + x)) * DM + h * 64 + 4 * fq;
#pragma unroll
                for (int dt = 0; dt < 4; ++dt) *(v2u*)(op + 16 * dt) = (v2u){pk2(ot[x][dt][0] * inv[x], ot[x][dt][1] * inv[x]), pk2(ot[x][dt][2] * inv[x], ot[x][dt][3] * inv[x])};
            }
        }
        __syncthreads();
    }
#undef ATT_LOAD_KV
}

constexpr int PL_US = 136;
template <int W> __device__ __forceinline__ void pool_load(const bf16* PROJ, int gi, int tt, int lane, v4u (&raw)[8]) {
    const size_t t0 = (size_t)tt * 16; const int s0 = (int)(t0 & (SEQ - 1));
    const int ch = lane & 15, rs = lane >> 4;
#pragma unroll
    for (int i = 0; i < 8; ++i) { const int r = rs + 4 * i;
        raw[i] = (v4u){0u, 0u, 0u, 0u};
        if (4 * i + 3 >= 17 - W) { if (s0 - 16 + r >= 0) raw[i] = *(const v4u*)(PROJ + (t0 - 16 + r) * INW + 768 + gi * 128 + ch * 8); } }
}
template <int W> __device__ __forceinline__ void pool_compute(bf16* CONCAT, const LAS bf16* wl, LAS bf16* ust, const float* pscale, int gi, int tt, int lane, const v4u (&raw)[8]) {
    const int fr = lane & 15, fq = lane >> 4;
    const size_t t0 = (size_t)tt * 16; const int s0 = (int)(t0 & (SEQ - 1));
    {
        const int ch = lane & 15, rs = lane >> 4;
#pragma unroll
        for (int i = 0; i < 8; ++i) { const int r = rs + 4 * i; if (4 * i + 3 >= 17 - W) *(LAS v4u*)(ust + r * PL_US + ch * 8) = raw[i]; }
    }
    const int s = s0 + fr;
    const float invc = 1.0f / (float)((s + 1 < W) ? (s + 1) : W);
    bf16x8 pf[4];
#pragma unroll
    for (int ks = 0; ks < 4; ++ks) {
        const LAS bf16* up = ust + (16 + fr) * PL_US + 32 * ks + 8 * fq;
        float sum[8];
        const v4u cur = *(const LAS v4u*)up;
#pragma unroll
        for (int e = 0; e < 4; ++e) { sum[2 * e] = bf_lo(cur[e]); sum[2 * e + 1] = bf_hi(cur[e]); }
#pragma unroll
        for (int j = 1; j < W; ++j) { const v4u rw = *(const LAS v4u*)(up - j * PL_US);
#pragma unroll
            for (int e = 0; e < 4; ++e) { sum[2 * e] += bf_lo(rw[e]); sum[2 * e + 1] += bf_hi(rw[e]); } }
        v4u o;
#pragma unroll
        for (int e = 0; e < 4; ++e) o[e] = pk2(sum[2 * e] * invc - bf_lo(cur[e]), sum[2 * e + 1] * invc - bf_hi(cur[e]));
        pf[ks] = __builtin_bit_cast(bf16x8, o);
    }
    const size_t R = t0 + fr;
#pragma unroll
    for (int nt = 0; nt < 8; ++nt) {
        f32x4 acc = (f32x4){0.f, 0.f, 0.f, 0.f};
        const LAS bf16* wp = wl + (16 * nt + fr) * PL_US + 8 * fq;
#pragma unroll
        for (int ks = 0; ks < 4; ++ks) acc = __builtin_amdgcn_mfma_f32_16x16x32_bf16(*(const LAS bf16x8*)(wp + 32 * ks), pf[ks], acc, 0, 0, 0);
        const int d = gi * 128 + 16 * nt + 4 * fq;
        const f32x4 sc = *(const f32x4*)(pscale + d);
        *(v2u*)(CONCAT + R * DM + 512 + d) = (v2u){pk2(acc[0] * sc.x, acc[1] * sc.y), pk2(acc[2] * sc.z, acc[3] * sc.w)};
    }
}
template <int W> __device__ __forceinline__ void pool_group(const bf16* PROJ, bf16* CONCAT, const LAS bf16* wl, LAS bf16* ust, const float* pscale, int gi, int gw, int ngw, int lane) {
    v4u ra[8], rb[8];
    int tt = gw;
    if (tt < T / 16) pool_load<W>(PROJ, gi, tt, lane, ra);
    while (tt < T / 16) {
        const int tn = tt + ngw;
        if (tn < T / 16) pool_load<W>(PROJ, gi, tn, lane, rb);
        pool_compute<W>(CONCAT, wl, ust, pscale, gi, tt, lane, ra);
        tt = tn;
        if (tt >= T / 16) break;
        const int tn2 = tt + ngw;
        if (tn2 < T / 16) pool_load<W>(PROJ, gi, tn2, lane, ra);
        pool_compute<W>(CONCAT, wl, ust, pscale, gi, tt, lane, rb);
        tt = tn2;
    }
}
__device__ __forceinline__ void pool_phase(LAS unsigned char* lds, const bf16* PROJ, bf16* CONCAT, const bf16* PWT, const float* pscale) {
    int tid_ = threadIdx.x; asm volatile("" : "+v"(tid_)); const int tid = tid_, lane = tid & 63, wave = tid >> 6;
    LAS bf16* wl = (LAS bf16*)lds;
    LAS bf16* ust = (LAS bf16*)(lds + 36864 + wave * 8704);
    const int gw = blockIdx.x * 8 + wave, ngw = gridDim.x * 8;
#pragma unroll 1
    for (int gi = 0; gi < 4; ++gi) {
        __syncthreads();
        { const int row = tid >> 2, q = tid & 3; const bf16* src = PWT + ((size_t)gi * 128 + row) * 128 + q * 32;
#pragma unroll
          for (int e = 0; e < 4; ++e) *(LAS v4u*)(wl + row * PL_US + q * 32 + e * 8) = *(const v4u*)(src + e * 8); }
        __syncthreads();
        if (gi == 0) pool_group<2>(PROJ, CONCAT, wl, ust, pscale, gi, gw, ngw, lane);
        else if (gi == 1) pool_group<4>(PROJ, CONCAT, wl, ust, pscale, gi, gw, ngw, lane);
        else if (gi == 2) pool_group<8>(PROJ, CONCAT, wl, ust, pscale, gi, gw, ngw, lane);
        else pool_group<16>(PROJ, CONCAT, wl, ust, pscale, gi, gw, ngw, lane);
    }
    __syncthreads();
}

#ifndef REP_P
#define REP_P 1
#endif
#ifndef REP_G
#define REP_G 1
#endif
#ifndef REP_R
#define REP_R 1
#endif
#ifndef REP_G
#define REP_G 1
#endif
#ifndef REP_IN
#define REP_IN REP_G
#endif
#ifndef REP_GU
#define REP_GU REP_G
#endif
#ifndef REP_DN
#define REP_DN REP_G
#endif
#ifndef REP_PL
#define REP_PL 1
#endif
#ifndef REP_A
#define REP_A 1
#endif
__global__ void __launch_bounds__(512, 2) fwd_kernel(Args a) {
    extern __shared__ __attribute__((aligned(16))) unsigned char lds_raw[];
    cg::grid_group grid = cg::this_grid();
    LAS unsigned char* lds = (LAS unsigned char*)lds_raw;
    unsigned char* ws = a.ws;
    bf16* H = (bf16*)(ws + WS_H); bf16* MIX = (bf16*)(ws + WS_MIX); bf16* PROJ = (bf16*)(ws + WS_PROJ);
    bf16* CONCAT = (bf16*)(ws + WS_CONCAT); bf16* ACT = (bf16*)(ws + WS_ACT);
    const float* cs = (const float*)(ws + WS_CS); bf16* XA = (bf16*)(ws + WS_XA); bf16* XB = (bf16*)(ws + WS_XB);
    volatile LAS unsigned* MISC = (volatile LAS unsigned*)(lds + RING_BYTES + 64);
    if (threadIdx.x == 0) { MISC[0] = 0u; MISC[1] = 0u; }
    __syncthreads();
    XcdBarrier bar = xcd_barrier_post((unsigned*)ws, MISC);
#define SEAM() xcd_barrier(bar)

    for (int rep = 0; rep < REP_P; ++rep) prologue(a, lds);
    if (a.ws == nullptr) grid.sync();
    SEAM();
    for (int rep = 0; rep < REP_R; ++rep) rowwise_phase(a, lds, true, false, true, false, 2, a.x, nullptr, nullptr, XB, H, 0, 0, nullptr, 0, 0, 1, a.g_pre_mix);
    mod_finalize(a);
    SEAM();
#pragma unroll 1
    for (int l = 0; l < DEPTH; ++l) {
        unsigned char* wl = ws + WS_W + (size_t)l * W_LAYER;
        for (int rep = 0; rep < REP_IN; ++rep) {
            pg8::Gemm g{H, (const bf16*)(wl + W_IN), T, INW, DM}; pg8::StaticOrder S; S.init(T, INW, gridDim.x, blockIdx.x);
            pg8::EpiInProj E{PROJ, a.b_in + l * INW, cs};
            pg8::gemm_phase<pg8::EpiInProj, pg8::StaticOrder, true, true>(lds, g, S, E);
        }
        SEAM();
        for (int rep = 0; rep < REP_A; ++rep) attn_phase(lds, PROJ, CONCAT, a.sinks + l * 8);
        for (int rep = 0; rep < REP_PL; ++rep) pool_phase(lds, PROJ, CONCAT, (const bf16*)(wl + W_PW), a.pool_scale + l * 512);
        SEAM();
        for (int rep = 0; rep < REP_G; ++rep) {
            pg8::Gemm g{CONCAT, (const bf16*)(wl + W_OUT), T, DM, DM}; pg8::StaticOrder S; S.init(T, DM, gridDim.x, blockIdx.x);
            pg8::EpiBf16<0> E{MIX, DM, nullptr, 0, 0, 1.f};
            pg8::gemm_phase<pg8::EpiBf16<0>, pg8::StaticOrder, true, true>(lds, g, S, E);
        }
        SEAM();
        for (int rep = 0; rep < REP_R; ++rep) rowwise_phase(a, lds, false, true, true, true, 2, XB, MIX, nullptr, XA, H, l, 2, a.g_post_mix + l * DM, l, 3, 4, a.g_pre_ffn + l * DM);
        SEAM();
#if defined(PROBE_HOT)
#pragma unroll 1
        for (int rep = 0; rep < 2; ++rep) {
            pg8::Gemm g{H, (const bf16*)(wl + W_GU), T, 2 * DFF, rep == 0 ? PROBE_HOT_K : DM}; pg8::DualOrder S; S.so.init(T, 2 * DFF, gridDim.x, blockIdx.x); S.c = blockIdx.x; S.rounds = 22; S.hot = (rep == 0);
            pg8::EpiSwiGLU E{rep == 0 ? MIX : ACT};
            pg8::gemm_phase<pg8::EpiSwiGLU, pg8::DualOrder, true, true>(lds, g, S, E);
            if (rep == 0) SEAM();
        }
#else
        for (int rep = 0; rep < REP_GU; ++rep) {
            pg8::Gemm g{H, (const bf16*)(wl + W_GU), T, 2 * DFF, DM}; pg8::StaticOrder S; S.init(T, 2 * DFF, gridDim.x, blockIdx.x);
            pg8::EpiSwiGLU E{ACT};
            pg8::gemm_phase<pg8::EpiSwiGLU, pg8::StaticOrder, true, true>(lds, g, S, E);
        }
#endif
        SEAM();
        for (int rep = 0; rep < REP_DN; ++rep) {
            pg8::Gemm g{ACT, (const bf16*)(wl + W_DN), T, DM, DFF}; pg8::StaticOrder S; S.init(T, DM, gridDim.x, blockIdx.x);
            pg8::EpiBf16<0> E{MIX, DM, nullptr, 0, 0, 1.f};
            pg8::gemm_phase<pg8::EpiBf16<0>, pg8::StaticOrder, true, true>(lds, g, S, E);
        }
        SEAM();
        const bool more = (l + 1 < DEPTH);
        for (int rep = 0; rep < REP_R; ++rep) rowwise_phase(a, lds, false, true, more, true, more ? 2 : 1, XA, MIX, a.out, XB, H, l, 5, a.g_post_ffn + l * DM, l + 1, 0, 1, a.g_pre_mix + (more ? (l + 1) * DM : 0));
        if (more) SEAM();
    }
}

extern "C" void kernel_launch(void* const* d_in, const int* in_sizes, int n_in, void* d_out, int out_size, void* d_ws, size_t ws_size, hipStream_t stream) {
    static int grid_blocks = 0;
    if (grid_blocks == 0) {
        if (n_in != 18 || out_size != T * DM || ws_size < WS_END) { fprintf(stderr, "kernel_launch: unexpected shapes (n_in %d, out %d, ws %zu)\n", n_in, out_size, ws_size); grid_blocks = -1; return; }
        int dev = 0, cus = 0, per_cu = 0;
        hipGetDevice(&dev);
        hipDeviceGetAttribute(&cus, hipDeviceAttributeMultiprocessorCount, dev);
        if (hipFuncSetAttribute((const void*)fwd_kernel, hipFuncAttributeMaxDynamicSharedMemorySize, LDS_BYTES) != hipSuccess) { fprintf(stderr, "kernel_launch: hipFuncSetAttribute failed\n"); grid_blocks = -1; return; }
        if (hipOccupancyMaxActiveBlocksPerMultiprocessor(&per_cu, (const void*)fwd_kernel, 512, LDS_BYTES) != hipSuccess || per_cu < 1) { fprintf(stderr, "kernel_launch: occupancy query gave %d\n", per_cu); per_cu = 1; }
        (void)hipGetLastError();
        grid_blocks = cus * per_cu;
    }
    if (grid_blocks < 0) return;
    if (hipMemsetAsync(d_ws, 0, 65536, stream) != hipSuccess) { fprintf(stderr, "kernel_launch: memset failed\n"); return; }
    Args a{};
    a.x = (const float*)d_in[0]; a.c = (const float*)d_in[1]; a.pos = (const int*)d_in[2]; a.ada_w = (const float*)d_in[3]; a.ada_b = (const float*)d_in[4];
    a.w_in = (const float*)d_in[5]; a.b_in = (const float*)d_in[6]; a.sinks = (const float*)d_in[7]; a.pool_w = (const float*)d_in[8]; a.pool_scale = (const float*)d_in[9];
    a.w_out = (const float*)d_in[10]; a.w_gate = (const float*)d_in[11]; a.w_up = (const float*)d_in[12]; a.w_down = (const float*)d_in[13];
    a.g_pre_mix = (const float*)d_in[14]; a.g_post_mix = (const float*)d_in[15]; a.g_pre_ffn = (const float*)d_in[16]; a.g_post_ffn = (const float*)d_in[17];
    a.out = (float*)d_out; a.ws = (unsigned char*)d_ws;
    void* args[] = {&a};
    hipError_t e = hipLaunchCooperativeKernel((const void*)fwd_kernel, dim3(grid_blocks), dim3(512), args, LDS_BYTES, stream);
    if (e != hipSuccess) fprintf(stderr, "cooperative launch failed: %s (grid %d)\n", hipGetErrorString(e), grid_blocks);
}
```

```cpp
#include <hip/hip_runtime.h>
#include <hip/hip_cooperative_groups.h>
#include <cstdio>
#include <cstdint>
namespace cg = cooperative_groups;
#define LAS __attribute__((address_space(3)))
namespace pg8 {
#define PG8_LAS __attribute__((address_space(3)))
typedef unsigned short bf16_t;
typedef short bf16x8 __attribute__((ext_vector_type(8)));
typedef float f32x4 __attribute__((ext_vector_type(4)));
typedef unsigned u32x4 __attribute__((ext_vector_type(4)));
constexpr int BM = 256, BK = 64, HALF = 128, HTB = HALF * BK * 2  , STAGE_BYTES = 8 * HTB, NXCD = 8, WGM = 8;

__host__ __device__ __forceinline__ int lds_byte(int r, int c) { const int st = (r >> 4) * 2 + (c >> 5), rr = r & 15, cc = c & 31, ob = rr * 64 + cc * 2; return st * 1024 + (ob ^ (((ob >> 9) & 1) << 5)); }
__host__ __device__ __forceinline__ void stage_rc(int b, int& R, int& C) { const int st = b / 1024, sb = b % 1024, swz = sb ^ (((sb >> 9) & 1) << 5); R = (st >> 1) * 16 + swz / 64; C = (st & 1) * 32 + (swz % 64) / 2; }
__host__ __device__ __forceinline__ int perm32(int rho) { const int n = rho >> 4, i = rho & 15; return 8 * (i >> 2) + 4 * n + (i & 3); }

struct Unit { int pm, pn; };
struct Gemm { const bf16_t* A; const bf16_t* Bt; int M, N, K; };

struct StaticOrder {
    int nM, nN, nwg, G, c;
    __host__ __device__ void init(int M, int N, int G_, int c_) { nM = M / BM; nN = N / BM; nwg = nM * nN; G = G_; c = c_; }
    __host__ __device__ bool next(int i, Unit& u) const {
        const long L = (long)i * G + c; if (L >= nwg) return false;
        int wgid = (int)L; { const int q = nwg / NXCD, r = nwg % NXCD, xcd = wgid % NXCD, off = wgid / NXCD; wgid = (xcd < r ? xcd * (q + 1) : r * (q + 1) + (xcd - r) * q) + off; }
        const int nig = WGM * nN, gid = wgid / nig, fm = gid * WGM, gsz = (nM - fm) < WGM ? (nM - fm) : WGM;
        u.pm = fm + ((wgid % nig) % gsz); u.pn = (wgid % nig) / gsz; return true;
    }
    __device__ __forceinline__ void a_ready(const Unit&) const {}
    __device__ __forceinline__ void done(const Unit&) const {}
};

__device__ __forceinline__ unsigned cvt_pk_bf16(float lo, float hi) { unsigned r; asm volatile("v_cvt_pk_bf16_f32 %0, %1, %2" : "=v"(r) : "v"(lo), "v"(hi)); return r; }
typedef float f32x2 __attribute__((ext_vector_type(2)));
__device__ __forceinline__ f32x2 gelu_pk(f32x2 v) {
    const f32x2 av = __builtin_elementwise_abs(v), d = av * 0.2316418882f + 1.0f;
    f32x2 t; t.x = __builtin_amdgcn_rcpf(d.x); t.y = __builtin_amdgcn_rcpf(d.y);
    f32x2 q = t * 0.5307027145f + (-0.7265760135f); q = q * t + 0.7107068705f; q = q * t + (-0.142248368f); q = q * t + 0.127414796f; q = q * t;
    const f32x2 s = (v * v) * (-0.72134752044f);
    f32x2 e; e.x = __builtin_amdgcn_exp2f(s.x); e.y = __builtin_amdgcn_exp2f(s.y);
    const f32x2 m = v * (q * e), r = v - m;
    f32x2 o; o.x = v.x < 0.f ? m.x : r.x; o.y = v.y < 0.f ? m.y : r.y; return o;
}

template <int ACT  > struct EpiBf16 {
    static constexpr bool PERM = true, AFTER_DRAIN = false; static_assert(ACT == 0 || ACT == 1, "EpiBf16: ACT is 0 (none) or 1 (gelu_pk)");
    bf16_t* O; int ldc; const float* bias; int split_cols; size_t split_stride; float scale0;
    __device__ __forceinline__ void operator()(const f32x4 (&acc)[2][2][4][2], const Unit& u, int wr, int wc, int fr, int fq) const {
        const int row0 = u.pm * BM + wr * 64 + fr; int colt = u.pn * BM; bf16_t* base = O;
        float sc = 1.f; if (split_cols) { const int t = colt / split_cols; base += (size_t)t * split_stride; colt -= t * split_cols; if (t == 0) sc = scale0; }
        const int col0 = colt + wc * 32 + 8 * fq, bcol0 = u.pn * BM + wc * 32 + 8 * fq;
        f32x4 bv[2][2];
#pragma unroll
        for (int bj = 0; bj < 2; ++bj)
#pragma unroll
            for (int n = 0; n < 2; ++n) bv[bj][n] = bias ? *(const f32x4*)(bias + bcol0 + bj * HALF + 4 * n) : (f32x4){0.f, 0.f, 0.f, 0.f};
#pragma unroll
        for (int ai = 0; ai < 2; ++ai)
#pragma unroll
            for (int m = 0; m < 4; ++m) { bf16_t* rowp = base + (size_t)(row0 + ai * HALF + m * 16) * ldc + col0;
#pragma unroll
                for (int bj = 0; bj < 2; ++bj) { f32x4 v0 = acc[ai][bj][m][0] + bv[bj][0], v1 = acc[ai][bj][m][1] + bv[bj][1];
                    if (ACT == 1) { f32x2 a = gelu_pk((f32x2){v0[0], v0[1]}), b = gelu_pk((f32x2){v0[2], v0[3]}), c = gelu_pk((f32x2){v1[0], v1[1]}), d = gelu_pk((f32x2){v1[2], v1[3]});
                        v0 = (f32x4){a.x, a.y, b.x, b.y}; v1 = (f32x4){c.x, c.y, d.x, d.y}; }
                    v0 = v0 * sc; v1 = v1 * sc; u32x4 w; w.x = cvt_pk_bf16(v0[0], v0[1]); w.y = cvt_pk_bf16(v0[2], v0[3]); w.z = cvt_pk_bf16(v1[0], v1[1]); w.w = cvt_pk_bf16(v1[2], v1[3]);
                    *(u32x4*)(rowp + bj * HALF) = w; } }
    }
};
template <class Epi, class Sched, bool ALIGN_EPI = false, bool SP2 = false>
__device__ __forceinline__ void gemm_phase(PG8_LAS unsigned char* lds, const Gemm g, const Sched& S, const Epi& E) {
    int tid_ = threadIdx.x; asm volatile("" : "+v"(tid_)); const int tid = tid_, wid = __builtin_amdgcn_readfirstlane(tid >> 6), lane = tid & 63, wr = wid >> 2, wc = wid & 3, fr = lane & 15, fq = lane >> 4;
    const int K = g.K, nt = K / BK;
    unsigned voffA[2], voffB[2];
#pragma unroll
    for (int i = 0; i < 2; ++i) { int R, C; stage_rc(tid * 16 + i * 8192, R, C); const int Rb = Epi::PERM ? ((R & ~31) + perm32(R & 31)) : R;
        voffA[i] = (unsigned)(R * K + C) * 2u; voffB[i] = (unsigned)(Rb * K + C) * 2u; }
    const size_t kstep = (size_t)(BK * 2);
    const size_t hstep = (size_t)HALF * K * 2;
    const size_t tstep = 2 * hstep;
    const unsigned ldsw = (unsigned)wid * 1024u;
    const int aoff = lds_byte(wr * 64 + fr, fq * 8), boff = lds_byte(wc * 32 + fr, fq * 8);
#define PG8_SA(b, h) (((b) * 2 + (h)) * HTB)
#define PG8_SB(b, h) ((4 + (b) * 2 + (h)) * HTB)
#define PG8_STAGE(bufoff, gbase, voff) do { _Pragma("unroll") for (int _i = 0; _i < 2; ++_i) \
        __builtin_amdgcn_global_load_lds((const unsigned*)((const char*)(gbase) + (voff)[_i]), (PG8_LAS unsigned*)(lds + (bufoff) + ldsw + _i * 8192), 16, 0, 0); } while (0)
#define PG8_LDA(dst, b, h) do { _Pragma("unroll") for (int m = 0; m < 4; ++m) _Pragma("unroll") for (int k = 0; k < 2; ++k) dst[m][k] = *(const PG8_LAS bf16x8*)(lds + PG8_SA(b, h) + aoff + m * 2048 + k * 1024); } while (0)
#define PG8_LDB(dst, b, h) do { _Pragma("unroll") for (int n = 0; n < 2; ++n) _Pragma("unroll") for (int k = 0; k < 2; ++k) dst[n][k] = *(const PG8_LAS bf16x8*)(lds + PG8_SB(b, h) + boff + n * 2048 + k * 1024); } while (0)
#define PG8_MMA(ai, bj, At, Bt) do { __builtin_amdgcn_s_setprio(1); _Pragma("unroll") for (int m = 0; m < 4; ++m) _Pragma("unroll") for (int n = 0; n < 2; ++n) _Pragma("unroll") for (int k = 0; k < 2; ++k) \
        acc[ai][bj][m][n] = __builtin_amdgcn_mfma_f32_16x16x32_bf16(Bt[n][k], At[m][k], acc[ai][bj][m][n], 0, 0, 0); __builtin_amdgcn_s_setprio(0); } while (0)
#define PG8_WAIT_V(n) asm volatile("s_waitcnt vmcnt(" #n ")" ::: "memory")
#define PG8_WAIT_L(n) asm volatile("s_waitcnt lgkmcnt(" #n ")" ::: "memory")
#define PG8_BAR __builtin_amdgcn_s_barrier()
#define PG8_SCHED __builtin_amdgcn_sched_barrier(0)
    Unit cur, nxt; int ui = 0;
    if (!S.next(0, cur)) return;
    f32x4 acc[2][2][4][2];
#pragma unroll
    for (int a = 0; a < 2; ++a)
#pragma unroll
        for (int b = 0; b < 2; ++b)
#pragma unroll
            for (int m = 0; m < 4; ++m)
#pragma unroll
                for (int n = 0; n < 2; ++n) acc[a][b][m][n] = (f32x4){0.f, 0.f, 0.f, 0.f};
    bf16x8 At[4][2], B0[2][2], B1[2][2];
    const char* cA = (const char*)g.A + (size_t)cur.pm * tstep; const char* cB = (const char*)g.Bt + (size_t)cur.pn * tstep;
    S.a_ready(cur);
    if constexpr (SP2) {
        PG8_STAGE(PG8_SB(0, 0), cB, voffB); PG8_STAGE(PG8_SB(0, 1), cB + hstep, voffB); PG8_STAGE(PG8_SA(0, 0), cA, voffA); PG8_STAGE(PG8_SA(0, 1), cA + hstep, voffA);
        if (wr == 1) PG8_BAR;
        PG8_WAIT_V(2); PG8_BAR;
        PG8_STAGE(PG8_SB(1, 0), cB + kstep, voffB); PG8_STAGE(PG8_SA(1, 0), cA + kstep, voffA); PG8_STAGE(PG8_SB(1, 1), cB + hstep + kstep, voffB);
        PG8_WAIT_V(6); PG8_BAR;
    } else {
        PG8_STAGE(PG8_SB(0, 0), cB, voffB); PG8_STAGE(PG8_SA(0, 0), cA, voffA); PG8_STAGE(PG8_SB(0, 1), cB + hstep, voffB); PG8_STAGE(PG8_SA(0, 1), cA + hstep, voffA);
        if (wr == 1) PG8_BAR;
        PG8_WAIT_V(4); PG8_BAR;
        PG8_STAGE(PG8_SB(1, 0), cB + kstep, voffB); PG8_STAGE(PG8_SA(1, 0), cA + kstep, voffA); PG8_STAGE(PG8_SB(1, 1), cB + hstep + kstep, voffB);
        PG8_WAIT_V(6); PG8_BAR;
    }
    for (;;) {
        const bool has_next = S.next(ui + 1, nxt);
        const char* nA = has_next ? (const char*)g.A + (size_t)nxt.pm * tstep : cA; const char* nB = has_next ? (const char*)g.Bt + (size_t)nxt.pn * tstep : cB;
        for (int t = 0; t < nt; t += 2) {
            const bool last = (t == nt - 2);
            const char* a1 = cA + (size_t)(t + 1) * kstep;
            const char* a2 = last ? nA : cA + (size_t)(t + 2) * kstep; const char* b2 = last ? nB : cB + (size_t)(t + 2) * kstep;
            const char* a3 = a2 + kstep; const char* b3 = b2 + kstep;
            if (last && has_next) S.a_ready(nxt);
            if constexpr (SP2) {
            PG8_LDB(B0, 0, 0); PG8_LDB(B1, 0, 1); PG8_SCHED; PG8_LDA(At, 0, 0); PG8_STAGE(PG8_SA(1, 1), a1 + hstep, voffA);
            PG8_WAIT_V(8); PG8_WAIT_L(0); PG8_BAR; PG8_MMA(0, 0, At, B0); PG8_MMA(0, 1, At, B1); PG8_BAR; PG8_SCHED;
            PG8_LDA(At, 0, 1); PG8_STAGE(PG8_SB(0, 0), b2, voffB); PG8_STAGE(PG8_SB(0, 1), b2 + hstep, voffB); PG8_STAGE(PG8_SA(0, 0), a2, voffA);
            PG8_WAIT_V(8); PG8_WAIT_L(0); PG8_BAR; PG8_MMA(1, 0, At, B0); PG8_MMA(1, 1, At, B1); PG8_BAR; PG8_SCHED;
            PG8_LDB(B0, 1, 0); PG8_LDB(B1, 1, 1); PG8_SCHED; PG8_LDA(At, 1, 0); PG8_STAGE(PG8_SA(0, 1), a2 + hstep, voffA);
            PG8_WAIT_V(8); PG8_WAIT_L(0); PG8_BAR; PG8_MMA(0, 0, At, B0); PG8_MMA(0, 1, At, B1); PG8_BAR; PG8_SCHED;
            PG8_LDA(At, 1, 1); PG8_STAGE(PG8_SB(1, 0), b3, voffB); PG8_STAGE(PG8_SB(1, 1), b3 + hstep, voffB); PG8_STAGE(PG8_SA(1, 0), a3, voffA);
            PG8_WAIT_V(8); PG8_WAIT_L(0); PG8_BAR; PG8_MMA(1, 0, At, B0); PG8_MMA(1, 1, At, B1); PG8_BAR; PG8_SCHED;
            } else {
            PG8_LDB(B0, 0, 0); PG8_SCHED; PG8_LDA(At, 0, 0); PG8_STAGE(PG8_SA(1, 1), a1 + hstep, voffA);
            PG8_WAIT_L(8); PG8_BAR; PG8_WAIT_L(0); PG8_MMA(0, 0, At, B0); PG8_BAR; PG8_SCHED;
            PG8_LDB(B1, 0, 1); PG8_STAGE(PG8_SB(0, 0), b2, voffB);
            PG8_BAR; PG8_WAIT_L(0); PG8_MMA(0, 1, At, B1); PG8_BAR;
            PG8_LDA(At, 0, 1); PG8_STAGE(PG8_SA(0, 0), a2, voffA);
            PG8_BAR; PG8_WAIT_L(0); PG8_MMA(1, 0, At, B0); PG8_BAR; PG8_SCHED;
            PG8_STAGE(PG8_SB(0, 1), b2 + hstep, voffB);
            PG8_WAIT_V(6); PG8_BAR; PG8_MMA(1, 1, At, B1); PG8_BAR;
            PG8_LDB(B0, 1, 0); PG8_SCHED; PG8_LDA(At, 1, 0); PG8_STAGE(PG8_SA(0, 1), a2 + hstep, voffA);
            PG8_WAIT_L(8); PG8_BAR; PG8_WAIT_L(0); PG8_MMA(0, 0, At, B0); PG8_BAR; PG8_SCHED;
            PG8_LDB(B1, 1, 1); PG8_STAGE(PG8_SB(1, 0), b3, voffB);
            PG8_BAR; PG8_WAIT_L(0); PG8_MMA(0, 1, At, B1); PG8_BAR;
            PG8_LDA(At, 1, 1); PG8_STAGE(PG8_SA(1, 0), a3, voffA);
            PG8_BAR; PG8_WAIT_L(0); PG8_MMA(1, 0, At, B0); PG8_BAR; PG8_SCHED;
            PG8_STAGE(PG8_SB(1, 1), b3 + hstep, voffB);
            PG8_WAIT_V(6); PG8_BAR; PG8_MMA(1, 1, At, B1); PG8_BAR;
            }
        }
        if constexpr (ALIGN_EPI) { if (wr == 0) PG8_BAR; }
        if constexpr (!Epi::AFTER_DRAIN) { E(acc, cur, wr, wc, fr, fq); S.done(cur); }
        if (!has_next) break;
#pragma unroll
        for (int a = 0; a < 2; ++a)
#pragma unroll
            for (int b = 0; b < 2; ++b)
#pragma unroll
                for (int m = 0; m < 4; ++m)
#pragma unroll
                    for (int n = 0; n < 2; ++n) acc[a][b][m][n] = (f32x4){0.f, 0.f, 0.f, 0.f};
        cur = nxt; cA = nA; cB = nB; ++ui;
        if constexpr (ALIGN_EPI) { if (wr == 1) PG8_BAR; }
    }
    PG8_WAIT_V(0);
    if constexpr (!ALIGN_EPI) { if (wr == 0) PG8_BAR; }
    PG8_BAR;
    if constexpr (Epi::AFTER_DRAIN) { E.fused(acc, cur, wr, wc, fr, fq, lds, wid, lane); S.done(cur); }
#undef PG8_SA
#undef PG8_SB
#undef PG8_STAGE
#undef PG8_LDA
#undef PG8_LDB
#undef PG8_MMA
#undef PG8_WAIT_V
#undef PG8_WAIT_L
#undef PG8_BAR
#undef PG8_SCHED
}
}
#define XB_TMO      128
#define XB_XCNT(j)  (256  + 64 * (j))
#define XB_XSUB(j)  (1280 + 64 * (j))
#define XB_XGEN(j)  (2304 + 64 * (j))
#define XB_TOP      3328
#define XB_TOPGEN   3392
#define XCD_BAR_WORDS 3456
#define XB_SPIN_CAP (1u << 18)

__device__ __forceinline__ unsigned xb_ld(unsigned* p)              { return __hip_atomic_load(p, __ATOMIC_RELAXED, __HIP_MEMORY_SCOPE_AGENT); }
__device__ __forceinline__ unsigned xb_add(unsigned* p, unsigned v) { return __hip_atomic_fetch_add(p, v, __ATOMIC_RELAXED, __HIP_MEMORY_SCOPE_AGENT); }
__device__ __forceinline__ unsigned xb_xcc_id() { return (unsigned)__builtin_amdgcn_s_getreg((3 << 11) | 20) & 0xFu; }
#define XB_SPIN(cond, bar) do { unsigned _sp = 0; while (cond) { __builtin_amdgcn_s_sleep(1); \
    if ((++_sp & 255u) == 0u) { if (xb_ld(&(bar)[XB_TMO])) break; if (_sp > XB_SPIN_CAP) { atomicAdd(&(bar)[XB_TMO], 1u); break; } } } } while (0)

struct XcdBarrier {
    unsigned* bar; unsigned x;
    volatile LAS unsigned* st;
};

__device__ __forceinline__ XcdBarrier xcd_barrier_post(unsigned* bar, volatile LAS unsigned* st) {
    XcdBarrier b; b.bar = bar; b.x = xb_xcc_id(); b.st = st;
    if (threadIdx.x == 0) (void)xb_add(&bar[XB_XCNT(b.x)], 1u);
    return b;
}
__device__ __forceinline__ void xcd_barrier_complete(unsigned* bar, unsigned x, unsigned& nloc, unsigned& nx) {
    const unsigned G = gridDim.x * gridDim.y * gridDim.z;
    unsigned sum, cnt, mine, sp = 0u;
    for (;;) {
        sum = 0u; cnt = 0u; mine = 0u;
#pragma unroll
        for (unsigned j = 0; j < 16; ++j) { const unsigned c = xb_ld(&bar[XB_XCNT(j)]); sum += c; cnt += (c > 0u) ? 1u : 0u; mine = (j == x) ? c : mine; }
        if (sum == G) break;
        __builtin_amdgcn_s_sleep(1);
        if ((++sp & 255u) == 0u) { if (xb_ld(&bar[XB_TMO])) break; if (sp > XB_SPIN_CAP) { atomicAdd(&bar[XB_TMO], 1u); break; } }
    }
    nloc = mine > 0u ? mine : 1u; nx = cnt > 0u ? cnt : 1u;
}

__device__ __forceinline__ void xcd_barrier(const XcdBarrier& b) {
    asm volatile("s_waitcnt vmcnt(0)" ::: "memory");
    __syncthreads();
    if (threadIdx.x == 0) {
        unsigned* bar = b.bar;
        __builtin_amdgcn_s_waitcnt(0);
        unsigned nloc = b.st[0], nx = b.st[1];
        if (nloc == 0u) { xcd_barrier_complete(bar, b.x, nloc, nx); b.st[0] = nloc; b.st[1] = nx; }
        const unsigned old = xb_add(&bar[XB_XSUB(b.x)], 1u);
        const unsigned gen = old / nloc;
        if (old + 1u == (gen + 1u) * nloc) {
            __builtin_amdgcn_fence(__ATOMIC_RELEASE, "agent");
            asm volatile("s_waitcnt vmcnt(0)" ::: "memory");
            const unsigned og = xb_add(&bar[XB_TOP], 1u);
            const unsigned tg = og / nx;
            if (og + 1u == (tg + 1u) * nx) xb_add(&bar[XB_TOPGEN], 1u);
            else XB_SPIN(xb_ld(&bar[XB_TOPGEN]) == tg, bar);
            __builtin_amdgcn_fence(__ATOMIC_ACQUIRE, "agent");
            xb_add(&bar[XB_XGEN(b.x)], 1u);
            asm volatile("s_waitcnt vmcnt(0)" ::: "memory");
        } else {
            XB_SPIN(xb_ld(&bar[XB_XGEN(b.x)]) == gen, bar);
            __builtin_amdgcn_fence(__ATOMIC_ACQUIRE, "agent");
            asm volatile("s_waitcnt vmcnt(0)" ::: "memory");
        }
    }
    __syncthreads();
}

constexpr int NB = 8, SEQ = 8192, DM = 1024, DEPTH = 2;
constexpr int T = NB * SEQ;
constexpr int INW = 1280, DFF = 2816, NMODW = 6 * DM;
constexpr int KCH = 32;
constexpr float EPS = 1e-6f;
constexpr float LOG2E = 1.4426950408889634f;

#define LAS __attribute__((address_space(3)))
typedef unsigned short bf16;
typedef unsigned v4u __attribute__((ext_vector_type(4)));
typedef unsigned v2u __attribute__((ext_vector_type(2)));
typedef float f32x4 __attribute__((ext_vector_type(4)));
typedef short bf16x8 __attribute__((ext_vector_type(8)));

constexpr size_t MiB = 1u << 20;
constexpr size_t WS_MODP = 640 * MiB;
constexpr size_t WS_MODF = 8 * MiB;
constexpr size_t WS_CS = 9 * MiB;
constexpr size_t WS_W = 16 * MiB, W_LAYER = 24 * MiB;
constexpr size_t W_IN = 0, W_OUT = 3 * MiB, W_GU = 5 * MiB, W_DN = 16 * MiB, W_PW = 22 * MiB;
constexpr size_t WS_H = 64 * MiB;
constexpr size_t WS_MIX = 192 * MiB;
constexpr size_t WS_PROJ = 320 * MiB;
constexpr size_t WS_CONCAT = 480 * MiB;
constexpr size_t WS_ACT = 320 * MiB;
constexpr size_t WS_XA = 672 * MiB;
constexpr size_t WS_XB = 800 * MiB;
constexpr size_t WS_END = 928 * MiB;

constexpr int RING_BYTES = 131072;
constexpr int LDS_BYTES = 147456;

struct Args {
    const float* x; const float* c; const int* pos; const float* ada_w; const float* ada_b; const float* w_in; const float* b_in;
    const float* sinks; const float* pool_w; const float* pool_scale; const float* w_out; const float* w_gate; const float* w_up;
    const float* w_down; const float* g_pre_mix; const float* g_post_mix; const float* g_pre_ffn; const float* g_post_ffn;
    float* out; unsigned char* ws;
};

__device__ __constant__ double c_inv_freq[8] = {1.0, 0.19392274474868576, 0.03760603093086393, 0.007292664737217109,
                                                0.001414213562373095, 0.0002742481756762073, 5.318295896944988e-05, 1.031338537721246e-05};

__device__ __forceinline__ unsigned pk2(float lo, float hi) { return pg8::cvt_pk_bf16(lo, hi); }
__device__ __forceinline__ float bf_lo(unsigned w) { return __uint_as_float(w << 16); }
__device__ __forceinline__ float bf_hi(unsigned w) { return __uint_as_float(w & 0xffff0000u); }
__device__ __forceinline__ float wave_sum(float v) {
#pragma unroll
    for (int o = 1; o < 64; o <<= 1) v += __shfl_xor(v, o);
    return v;
}

namespace pg8 {
struct EpiInProj {
    static constexpr bool PERM = true, AFTER_DRAIN = false;
    bf16_t* O; const float* bias; const float* cs;
    __device__ __forceinline__ void operator()(const f32x4 (&acc)[2][2][4][2], const Unit& u, int wr, int wc, int fr, int fq) const {
        const int row0 = u.pm * BM + wr * 64 + fr; const int colt = u.pn * BM; const int col0 = colt + wc * 32 + 8 * fq;
        f32x4 bv[2][2];
#pragma unroll
        for (int bj = 0; bj < 2; ++bj)
#pragma unroll
            for (int n = 0; n < 2; ++n) bv[bj][n] = *(const f32x4*)(bias + col0 + bj * HALF + 4 * n);
        const bool rot_wave = (colt < 640) && ((wc & 1) == 0);
#pragma unroll
        for (int ai = 0; ai < 2; ++ai)
#pragma unroll
        for (int mh = 0; mh < 2; ++mh) {
            f32x4 cc[2][4];
#pragma unroll
            for (int mm = 0; mm < 2; ++mm)
#pragma unroll
                for (int q = 0; q < 4; ++q) cc[mm][q] = (f32x4){1.f, 1.f, 1.f, 1.f};
            if (rot_wave && fq < 2) {
#pragma unroll
                for (int mm = 0; mm < 2; ++mm) { const float* cr = cs + (size_t)(row0 + ai * HALF + (2 * mh + mm) * 16) * 16;
#pragma unroll
                    for (int q = 0; q < 4; ++q) cc[mm][q] = *(const f32x4*)(cr + 4 * q); }
            }
#pragma unroll
            for (int mm = 0; mm < 2; ++mm) {
                const int m = 2 * mh + mm;
                const int row = row0 + ai * HALF + m * 16;
                bf16_t* rowp = O + (size_t)row * INW + col0;
#pragma unroll
                for (int bj = 0; bj < 2; ++bj) {
                    f32x4 v0 = acc[ai][bj][m][0] + bv[bj][0], v1 = acc[ai][bj][m][1] + bv[bj][1];
                    const int cb = colt + bj * HALF;
                    if (rot_wave && cb < 640) {
                        f32x4 p0, p1;
#pragma unroll
                        for (int e = 0; e < 4; ++e) { p0[e] = __shfl_xor(v0[e], 16); p1[e] = __shfl_xor(v1[e], 16); }
                        if (fq == 0) { v0 = v0 * cc[mm][0] - p0 * cc[mm][2]; v1 = v1 * cc[mm][1] - p1 * cc[mm][3]; }
                        else if (fq == 1) { v0 = v0 * cc[mm][0] + p0 * cc[mm][2]; v1 = v1 * cc[mm][1] + p1 * cc[mm][3]; }
                    }
                    if (cb < 512) { v0 = v0 * 0.125f; v1 = v1 * 0.125f; }
                    u32x4 w; w.x = cvt_pk_bf16(v0[0], v0[1]); w.y = cvt_pk_bf16(v0[2], v0[3]); w.z = cvt_pk_bf16(v1[0], v1[1]); w.w = cvt_pk_bf16(v1[2], v1[3]);
                    *(u32x4*)(rowp + bj * HALF) = w;
                }
            }
        }
    }
};
struct EpiSwiGLU {
    static constexpr bool PERM = true, AFTER_DRAIN = false;
    bf16_t* O;
    __device__ __forceinline__ void operator()(const f32x4 (&acc)[2][2][4][2], const Unit& u, int wr, int wc, int fr, int fq) const {
        typedef float f32x2 __attribute__((ext_vector_type(2)));
        const int row0 = u.pm * BM + wr * 64 + fr; const int col0 = u.pn * HALF + wc * 32 + 8 * fq;
#pragma unroll
        for (int ai = 0; ai < 2; ++ai)
#pragma unroll
            for (int m = 0; m < 4; ++m) {
                bf16_t* rowp = O + (size_t)(row0 + ai * HALF + m * 16) * DFF + col0;
                f32x2 G[4], U[4], t[4], r[4];
#pragma unroll
                for (int n = 0; n < 2; ++n) { G[2 * n] = (f32x2){acc[ai][0][m][n][0], acc[ai][0][m][n][1]}; G[2 * n + 1] = (f32x2){acc[ai][0][m][n][2], acc[ai][0][m][n][3]};
                                              U[2 * n] = (f32x2){acc[ai][1][m][n][0], acc[ai][1][m][n][1]}; U[2 * n + 1] = (f32x2){acc[ai][1][m][n][2], acc[ai][1][m][n][3]}; }
#pragma unroll
                for (int q = 0; q < 4; ++q) { t[q].x = __builtin_amdgcn_exp2f(G[q].x); t[q].y = __builtin_amdgcn_exp2f(G[q].y); }
#pragma unroll
                for (int q = 0; q < 4; ++q) { t[q] = t[q] + 1.0f; r[q] = G[q] * U[q]; }
#pragma unroll
                for (int q = 0; q < 4; ++q) { t[q].x = __builtin_amdgcn_rcpf(t[q].x); t[q].y = __builtin_amdgcn_rcpf(t[q].y); }
#pragma unroll
                for (int q = 0; q < 4; ++q) r[q] = r[q] * t[q];
                u32x4 w; w.x = cvt_pk_bf16(r[0].x, r[0].y); w.y = cvt_pk_bf16(r[1].x, r[1].y); w.z = cvt_pk_bf16(r[2].x, r[2].y); w.w = cvt_pk_bf16(r[3].x, r[3].y);
                *(u32x4*)rowp = w;
            }
    }
};
struct DualOrder {
    StaticOrder so; int c, rounds, hot;
    __device__ bool next(int i, Unit& u) const { if (hot) { if (i >= rounds) return false; u.pm = (c % 8) * 2 + ((c / 8) & 1); u.pn = ((c / 8) >> 1) & 3; return true; } return so.next(i, u); }
    __device__ __forceinline__ void a_ready(const Unit&) const {}
    __device__ __forceinline__ void done(const Unit&) const {}
};
}

__device__ __forceinline__ void transpose_item(const float* W, int K, int N, bf16* WT, int drow0, LAS float* scr, int k0, int n0, int lane, float wscale = 1.0f) {
#pragma unroll
    for (int ih = 0; ih < 32; ih += 16) {
        float tv[16];
#pragma unroll
        for (int i = 0; i < 16; ++i) tv[i] = W[(size_t)(k0 + 2 * (ih + i) + (lane >> 5)) * N + n0 + (lane & 31)];
#pragma unroll
        for (int i = 0; i < 16; ++i) scr[(2 * (ih + i) + (lane >> 5)) * 33 + (lane & 31)] = tv[i] * wscale;
    }
    asm volatile("s_waitcnt lgkmcnt(0)" ::: "memory");
    const int c = lane & 7;
#pragma unroll
    for (int j = 0; j < 4; ++j) { const int n = (lane >> 3) + 8 * j; const LAS float* s = scr + (8 * c) * 33 + n;
        v4u o; o.x = pk2(s[0 * 33], s[1 * 33]); o.y = pk2(s[2 * 33], s[3 * 33]); o.z = pk2(s[4 * 33], s[5 * 33]); o.w = pk2(s[6 * 33], s[7 * 33]);
        *(v4u*)(WT + (size_t)(drow0 + n) * K + k0 + 8 * c) = o; }
    asm volatile("s_waitcnt lgkmcnt(0)" ::: "memory");
}

__device__ __forceinline__ void prologue(const Args& a, LAS unsigned char* lds) {
    int tid_ = threadIdx.x; asm volatile("" : "+v"(tid_)); const int tid = tid_, lane = tid & 63, wave = tid >> 6;
    unsigned char* ws = a.ws;
    __syncthreads();
    {
        LAS float* sc = (LAS float*)lds;
        for (int i = tid; i < NB * DM; i += 512) { const float v = a.c[i]; sc[i] = v / (1.0f + __expf(-v)); }
        __syncthreads();
        float* modp = (float*)(ws + WS_MODP);
        for (int item = blockIdx.x; item < DEPTH * KCH * 12; item += gridDim.x) {
            const int l = item / (KCH * 12), r = item % (KCH * 12), kc = r / 12, cb = r % 12, n = cb * 512 + tid;
            constexpr int KPI = DM / KCH;
            const float* w = a.ada_w + ((size_t)l * DM + kc * KPI) * NMODW + n;
            float acc[8];
#pragma unroll
            for (int b = 0; b < 8; ++b) acc[b] = 0.f;
#pragma unroll 1
            for (int kh = 0; kh < KPI; kh += 16) {
                float wv[16];
#pragma unroll
                for (int k = 0; k < 16; ++k) wv[k] = w[(size_t)(kh + k) * NMODW];
#pragma unroll
                for (int k = 0; k < 16; ++k) {
                    const LAS float* sp = sc + kc * KPI + kh + k;
#pragma unroll
                    for (int b = 0; b < 8; ++b) acc[b] += sp[b * DM] * wv[k];
                    if ((k & 3) == 3) asm volatile("" ::: "memory");
                }
            }
#pragma unroll
            for (int b = 0; b < 8; ++b) modp[((size_t)(l * KCH + kc) * 8 + b) * NMODW + n] = acc[b];
        }
        __syncthreads();
    }
    {
        float* cs = (float*)(ws + WS_CS);
        for (int idx = blockIdx.x * 512 + tid; idx < T * 8; idx += gridDim.x * 512) {
            const int row = idx >> 3, j = idx & 7;
            const double rev = (double)a.pos[row] * c_inv_freq[j] * 0.15915494309189535;
            const float fr = (float)(rev - floor(rev));
            cs[(size_t)row * 16 + j] = __builtin_amdgcn_cosf(fr);
            cs[(size_t)row * 16 + 8 + j] = __builtin_amdgcn_sinf(fr);
        }
    }
    {
        LAS float* scr = (LAS float*)(lds + wave * 16384);
        const int gw = blockIdx.x * 8 + wave, ngw = gridDim.x * 8;
        constexpr int I_IN = 16 * 40, I_OUT = 16 * 32, I_G = 16 * 88, I_D = 44 * 32, I_P = 4 * 8;
        constexpr int PER_L = I_IN + I_OUT + 2 * I_G + I_D + I_P;
        for (int it = gw; it < DEPTH * PER_L; it += ngw) {
            const int l = it / PER_L; int r = it % PER_L;
            unsigned char* wl = ws + WS_W + (size_t)l * W_LAYER;
            if (r < I_IN) { const int kb = r / 40, nb = r % 40; transpose_item(a.w_in + (size_t)l * DM * INW, DM, INW, (bf16*)(wl + W_IN), 32 * nb, scr, 64 * kb, 32 * nb, lane); continue; } r -= I_IN;
            if (r < I_OUT) { const int kb = r / 32, nb = r % 32; transpose_item(a.w_out + (size_t)l * DM * DM, DM, DM, (bf16*)(wl + W_OUT), 32 * nb, scr, 64 * kb, 32 * nb, lane); continue; } r -= I_OUT;
            if (r < 2 * I_G) { const int up = r >= I_G; if (up) r -= I_G; const int kb = r / 88, nb = r % 88, n0 = 32 * nb;
                transpose_item((up ? a.w_up : a.w_gate) + (size_t)l * DM * DFF, DM, DFF, (bf16*)(wl + W_GU), 256 * (n0 >> 7) + (n0 & 127) + (up ? 128 : 0), scr, 64 * kb, n0, lane, up ? -0.6931471805599453f : -1.4426950408889634f); continue; } r -= 2 * I_G;
            if (r < I_D) { const int kb = r / 32, nb = r % 32; transpose_item(a.w_down + (size_t)l * DFF * DM, DFF, DM, (bf16*)(wl + W_DN), 32 * nb, scr, 64 * kb, 32 * nb, lane); continue; } r -= I_D;
            { const int gi = r / 8, q = r % 8, kb = q / 4, nb = q % 4;
              transpose_item(a.pool_w + ((size_t)l * 4 + gi) * 128 * 128, 128, 128, (bf16*)(wl + W_PW) + (size_t)gi * 128 * 128, 32 * nb, scr, 64 * kb, 32 * nb, lane); }
        }
    }
}

__device__ __forceinline__ float mod_val(const Args& a, int l, int b, int idx, int col) {
    const float* modp = (const float*)(a.ws + WS_MODP);
    const int n = idx * DM + col;
    float s = a.ada_b[l * NMODW + n];
#pragma unroll
    for (int kc = 0; kc < KCH; ++kc) s += modp[((size_t)(l * KCH + kc) * 8 + b) * NMODW + n];
    return s;
}
__device__ __forceinline__ float mod_fin(const Args& a, int l, int b, int idx, int col) {
    return ((const float*)(a.ws + WS_MODF))[((size_t)(l * 8 + b)) * NMODW + idx * DM + col];
}
__device__ __forceinline__ void mod_finalize(const Args& a) {
    float* modf = (float*)(a.ws + WS_MODF);
    for (int i = blockIdx.x * 512 + threadIdx.x; i < DEPTH * 8 * NMODW; i += gridDim.x * 512) {
        const int l = i / (8 * NMODW), r = i % (8 * NMODW), b = r / NMODW, n = r % NMODW;
        modf[i] = mod_val(a, l, b, n / DM, n % DM);
    }
}
__device__ __forceinline__ void unpack8(const v4u w, float (&f)[8]) {
#pragma unroll
    for (int e = 0; e < 4; ++e) { f[2 * e] = bf_lo(w[e]); f[2 * e + 1] = bf_hi(w[e]); }
}
__device__ __forceinline__ v4u pack8(const float (&f)[8]) { return (v4u){pk2(f[0], f[1]), pk2(f[2], f[3]), pk2(f[4], f[5]), pk2(f[6], f[7])}; }
__device__ __forceinline__ void rowwise_phase(const Args& a, LAS unsigned char* lds, bool from_partials, bool has_y, bool has_h, bool xin_bf, int xout_mode,
        const void* xin, const bf16* y, float* xout, bf16* xoutb, bf16* hout,
        int l_y, int gate_idx, const float* g_post, int l_h, int shift_idx, int scale_idx, const float* g_pre) {
    int tid_ = threadIdx.x; asm volatile("" : "+v"(tid_)); const int tid = tid_, lane = tid & 63, wave = tid >> 6;
    LAS float* vec = (LAS float*)lds;
    for (int tile = blockIdx.x; tile < T / 256; tile += gridDim.x) {
        const int b = tile / (SEQ / 256);
        __syncthreads();
        for (int col = tid; col < DM; col += 512) {
            if (from_partials) {
                if (has_y) vec[col] = mod_val(a, l_y, b, gate_idx, col) * g_post[col];
                if (has_h) { vec[DM + col] = g_pre[col] * (1.0f + mod_val(a, l_h, b, scale_idx, col)); vec[2 * DM + col] = mod_val(a, l_h, b, shift_idx, col); }
            } else {
                if (has_y) vec[col] = mod_fin(a, l_y, b, gate_idx, col) * g_post[col];
                if (has_h) { vec[DM + col] = g_pre[col] * (1.0f + mod_fin(a, l_h, b, scale_idx, col)); vec[2 * DM + col] = mod_fin(a, l_h, b, shift_idx, col); }
            }
        }
        __syncthreads();
#pragma unroll 1
        for (int r = wave * 4; r < 256; r += 32) {
            float v[4][2][8]; v4u yv[4][2];
#pragma unroll
            for (int h = 0; h < 4; ++h)
#pragma unroll
                for (int j = 0; j < 2; ++j) { const size_t off = ((size_t)tile * 256 + r + h) * DM + 8 * lane + 512 * j;
                    if (xin_bf) unpack8(__builtin_nontemporal_load((const v4u*)((const bf16*)xin + off)), v[h][j]);
                    else { const f32x4 p0 = __builtin_nontemporal_load((const f32x4*)((const float*)xin + off)), p1 = __builtin_nontemporal_load((const f32x4*)((const float*)xin + off + 4));
                        v[h][j][0] = p0.x; v[h][j][1] = p0.y; v[h][j][2] = p0.z; v[h][j][3] = p0.w; v[h][j][4] = p1.x; v[h][j][5] = p1.y; v[h][j][6] = p1.z; v[h][j][7] = p1.w; }
                    yv[h][j] = has_y ? __builtin_nontemporal_load((const v4u*)(y + off)) : (v4u){0u, 0u, 0u, 0u}; }
            if (has_y) {
                float rstd[4];
#pragma unroll
                for (int h = 0; h < 4; ++h) { float ss = 0.f;
#pragma unroll
                    for (int j = 0; j < 2; ++j) { float yf[8]; unpack8(yv[h][j], yf);
#pragma unroll
                        for (int e = 0; e < 8; ++e) ss += yf[e] * yf[e]; }
                    rstd[h] = __builtin_amdgcn_rsqf(wave_sum(ss) * (1.0f / DM) + EPS); }
#pragma unroll
                for (int j = 0; j < 2; ++j) { const LAS float* gpp = vec + 8 * lane + 512 * j; const f32x4 g0 = *(const LAS f32x4*)gpp, g1 = *(const LAS f32x4*)(gpp + 4);
                    const float gp[8] = {g0.x, g0.y, g0.z, g0.w, g1.x, g1.y, g1.z, g1.w};
#pragma unroll
                    for (int h = 0; h < 4; ++h) { float yf[8]; unpack8(yv[h][j], yf);
#pragma unroll
                        for (int e = 0; e < 8; ++e) v[h][j][e] += gp[e] * (yf[e] * rstd[h]); } }
            }
            if (xout_mode == 1) {
#pragma unroll
                for (int h = 0; h < 4; ++h)
#pragma unroll
                    for (int j = 0; j < 2; ++j) { float* o = xout + ((size_t)tile * 256 + r + h) * DM + 8 * lane + 512 * j;
                        __builtin_nontemporal_store((f32x4){v[h][j][0], v[h][j][1], v[h][j][2], v[h][j][3]}, (f32x4*)o); __builtin_nontemporal_store((f32x4){v[h][j][4], v[h][j][5], v[h][j][6], v[h][j][7]}, (f32x4*)(o + 4)); }
            } else if (xout_mode == 2) {
#pragma unroll
                for (int h = 0; h < 4; ++h)
#pragma unroll
                    for (int j = 0; j < 2; ++j) { const v4u w = pack8(v[h][j]);
                        __builtin_nontemporal_store(w, (v4u*)(xoutb + ((size_t)tile * 256 + r + h) * DM + 8 * lane + 512 * j));
                        unpack8(w, v[h][j]); }
            }
            if (has_h) {
                float rstd[4];
#pragma unroll
                for (int h = 0; h < 4; ++h) { float ss = 0.f;
#pragma unroll
                    for (int j = 0; j < 2; ++j)
#pragma unroll
                        for (int e = 0; e < 8; ++e) ss += v[h][j][e] * v[h][j][e];
                    rstd[h] = __builtin_amdgcn_rsqf(wave_sum(ss) * (1.0f / DM) + EPS); }
#pragma unroll
                for (int j = 0; j < 2; ++j) { const LAS float* gsp = vec + DM + 8 * lane + 512 * j; const LAS float* shp = vec + 2 * DM + 8 * lane + 512 * j;
                    const f32x4 a0 = *(const LAS f32x4*)gsp, a1 = *(const LAS f32x4*)(gsp + 4), b0 = *(const LAS f32x4*)shp, b1 = *(const LAS f32x4*)(shp + 4);
                    const float gs[8] = {a0.x, a0.y, a0.z, a0.w, a1.x, a1.y, a1.z, a1.w}, sh[8] = {b0.x, b0.y, b0.z, b0.w, b1.x, b1.y, b1.z, b1.w};
#pragma unroll
                    for (int h = 0; h < 4; ++h) { float hv[8];
#pragma unroll
                        for (int e = 0; e < 8; ++e) hv[e] = v[h][j][e] * rstd[h] * gs[e] + sh[e];
                        *(v4u*)(hout + ((size_t)tile * 256 + r + h) * DM + 8 * lane + 512 * j) = pack8(hv); } }
            }
        }
    }
}

__device__ __forceinline__ void attn_phase(LAS unsigned char* lds, const bf16* PROJ, bf16* CONCAT, const float* sinks) {
    int tid_ = threadIdx.x; asm volatile("" : "+v"(tid_)); const int tid = tid_, lane = tid & 63, wave = tid >> 6, fr = lane & 15, fq = lane >> 4;
    LAS bf16* Ks = (LAS bf16*)lds;
    LAS bf16* Vt = (LAS bf16*)(lds + 36864);
    v4u kv[4], vv[4];
#define ATT_LOAD_KV(uu) do { const int kh_ = (uu) & 1, n_ = ((uu) >> 1) & 63, b_ = (uu) >> 7; const long rb_ = (long)b_ * SEQ + n_ * 128 - 128; \
        _Pragma("unroll") for (int i = 0; i < 4; ++i) { const int kj = lane + 64 * i; kv[i] = (v4u){0u, 0u, 0u, 0u}; vv[i] = (v4u){0u, 0u, 0u, 0u}; \
            if (n_ > 0 || kj >= 128) { const bf16* p = PROJ + (size_t)(rb_ + kj) * INW + kh_ * 64 + wave * 8; kv[i] = *(const v4u*)(p + 512); vv[i] = *(const v4u*)(p + 640); } } } while (0)
    if ((int)blockIdx.x < NB * 64 * 2) ATT_LOAD_KV((int)blockIdx.x);
    for (int u = blockIdx.x; u < NB * 64 * 2; u += gridDim.x) {
        const int kh = u & 1, n = (u >> 1) & 63, b = u >> 7;
        const int g = wave >> 1, h = kh * 4 + g;
        const size_t qrow0 = (size_t)b * SEQ + n * 128 + (wave & 1) * 64 + fr;
        bf16x8 qf[4][2];
#pragma unroll
        for (int i = 0; i < 4; ++i) { const bf16* qp = PROJ + (qrow0 + 16 * i) * INW + h * 64 + 8 * fq; qf[i][0] = *(const bf16x8*)qp; qf[i][1] = *(const bf16x8*)(qp + 32); }
#pragma unroll
        for (int i = 0; i < 4; ++i) { const int kj = lane + 64 * i;
            *(LAS v4u*)(Ks + kj * 72 + wave * 8) = kv[i];
#pragma unroll
            for (int e = 0; e < 4; ++e) { Vt[(wave * 8 + 2 * e) * 272 + kj] = (bf16)(vv[i][e] & 0xffffu); Vt[(wave * 8 + 2 * e + 1) * 272 + kj] = (bf16)(vv[i][e] >> 16); } }
        __syncthreads();
        if (u + (int)gridDim.x < NB * 64 * 2) ATT_LOAD_KV(u + (int)gridDim.x);
        const float sink = sinks[h];
        const int firstblk = (n == 0);
#pragma unroll
        for (int p = 0; p < 2; ++p) {
            const int q16a = (wave & 1) * 4 + 2 * p, kt0 = q16a;
            f32x4 st[2][10];
#pragma unroll
            for (int t = 0; t < 10; ++t) {
                const LAS bf16* kp = Ks + (16 * (kt0 + t) + fr) * 72 + 8 * fq;
                const bf16x8 k0 = *(const LAS bf16x8*)kp, k1 = *(const LAS bf16x8*)(kp + 32);
#pragma unroll
                for (int x = 0; x < 2; ++x) {
                    if (x + 8 - t == 9 || x + 8 - t == -1) { st[x][t] = (f32x4){-1e30f, -1e30f, -1e30f, -1e30f}; continue; }
                    f32x4 acc = (f32x4){0.f, 0.f, 0.f, 0.f};
                    acc = __builtin_amdgcn_mfma_f32_16x16x32_bf16(k0, qf[2 * p + x][0], acc, 0, 0, 0);
                    acc = __builtin_amdgcn_mfma_f32_16x16x32_bf16(k1, qf[2 * p + x][1], acc, 0, 0, 0);
                    st[x][t] = acc;
                }
            }
            float inv[2];
#pragma unroll
            for (int x = 0; x < 2; ++x) {
                float mx = -1e30f;
#pragma unroll
                for (int t = 0; t < 10; ++t) {
                    const int D = x + 8 - t;
                    if (D == 9 || D == -1) continue;
                    const bool tile_off = firstblk && (kt0 + t < 8);
#pragma unroll
                    for (int r = 0; r < 4; ++r) { const int dl = fr - 4 * fq - r;
                        bool valid = !tile_off;
                        if (D == 8) valid = valid && (dl < 0);
                        if (D == 0) valid = valid && (dl >= 0);
                        const float sv = valid ? st[x][t][r] : -1e30f; st[x][t][r] = sv; mx = fmaxf(mx, sv); }
                }
                mx = fmaxf(mx, __shfl_xor(mx, 16)); mx = fmaxf(mx, __shfl_xor(mx, 32)); mx = fmaxf(mx, sink);
                const float mb = mx * LOG2E;
                float lsum = 0.f;
#pragma unroll
                for (int t = 0; t < 10; ++t) {
                    const int D = x + 8 - t;
                    if (D == 9 || D == -1) { st[x][t] = (f32x4){0.f, 0.f, 0.f, 0.f}; continue; }
#pragma unroll
                    for (int r = 0; r < 4; ++r) { const float pe = __builtin_amdgcn_exp2f(st[x][t][r] * LOG2E - mb); st[x][t][r] = pe; lsum += pe; }
                }
                lsum += __shfl_xor(lsum, 16); lsum += __shfl_xor(lsum, 32); lsum += __builtin_amdgcn_exp2f(sink * LOG2E - mb);
                inv[x] = 1.0f / lsum;
            }
            f32x4 ot[2][4];
#pragma unroll
            for (int x = 0; x < 2; ++x)
#pragma unroll
                for (int dt = 0; dt < 4; ++dt) ot[x][dt] = (f32x4){0.f, 0.f, 0.f, 0.f};
#pragma unroll
            for (int s2 = 0; s2 < 5; ++s2) {
                bf16x8 pf[2];
#pragma unroll
                for (int x = 0; x < 2; ++x) { v4u pw; pw.x = pk2(st[x][2 * s2][0], st[x][2 * s2][1]); pw.y = pk2(st[x][2 * s2][2], st[x][2 * s2][3]);
                    pw.z = pk2(st[x][2 * s2 + 1][0], st[x][2 * s2 + 1][1]); pw.w = pk2(st[x][2 * s2 + 1][2], st[x][2 * s2 + 1][3]); pf[x] = __builtin_bit_cast(bf16x8, pw); }
#pragma unroll
                for (int dt = 0; dt < 4; ++dt) {
                    const LAS bf16* vp = Vt + (16 * dt + fr) * 272 + 16 * (kt0 + 2 * s2) + 4 * fq;
                    const v2u lo = *(const LAS v2u*)vp, hi = *(const LAS v2u*)(vp + 16);
                    const bf16x8 vf = __builtin_bit_cast(bf16x8, (v4u){lo.x, lo.y, hi.x, hi.y});
#pragma unroll
                    for (int x = 0; x < 2; ++x) ot[x][dt] = __builtin_amdgcn_mfma_f32_16x16x32_bf16(vf, pf[x], ot[x][dt], 0, 0, 0);
                }
            }
#pragma unroll
            for (int x = 0; x < 2; ++x) {
                bf16* op = CONCAT + (qrow0 + 16 * (2 * p + x)) * DM + h * 64 + 4 * fq;
#pragma unroll
                for (int dt = 0; dt < 4; ++dt) *(v2u*)(op + 16 * dt) = (v2u){pk2(ot[x][dt][0] * inv[x], ot[x][dt][1] * inv[x]), pk2(ot[x][dt][2] * inv[x], ot[x][dt][3] * inv[x])};
            }
        }
        __syncthreads();
    }
#undef ATT_LOAD_KV
}

constexpr int PL_US = 136;
template <int W> __device__ __forceinline__ void pool_load(const bf16* PROJ, int gi, int tt, int lane, v4u (&raw)[8]) {
    const size_t t0 = (size_t)tt * 16; const int s0 = (int)(t0 & (SEQ - 1));
    const int ch = lane & 15, rs = lane >> 4;
#pragma unroll
    for (int i = 0; i < 8; ++i) { const int r = rs + 4 * i;
        raw[i] = (v4u){0u, 0u, 0u, 0u};
        if (4 * i + 3 >= 17 - W) { if (s0 - 16 + r >= 0) raw[i] = *(const v4u*)(PROJ + (t0 - 16 + r) * INW + 768 + gi * 128 + ch * 8); } }
}
template <int W> __device__ __forceinline__ void pool_compute(bf16* CONCAT, const LAS bf16* wl, LAS bf16* ust, const float* pscale, int gi, int tt, int lane, const v4u (&raw)[8]) {
    const int fr = lane & 15, fq = lane >> 4;
    const size_t t0 = (size_t)tt * 16; const int s0 = (int)(t0 & (SEQ - 1));
    {
        const int ch = lane & 15, rs = lane >> 4;
#pragma unroll
        for (int i = 0; i < 8; ++i) { const int r = rs + 4 * i; if (4 * i + 3 >= 17 - W) *(LAS v4u*)(ust + r * PL_US + ch * 8) = raw[i]; }
    }
    const int s = s0 + fr;
    const float invc = 1.0f / (float)((s + 1 < W) ? (s + 1) : W);
    bf16x8 pf[4];
#pragma unroll
    for (int ks = 0; ks < 4; ++ks) {
        const LAS bf16* up = ust + (16 + fr) * PL_US + 32 * ks + 8 * fq;
        float sum[8];
        const v4u cur = *(const LAS v4u*)up;
#pragma unroll
        for (int e = 0; e < 4; ++e) { sum[2 * e] = bf_lo(cur[e]); sum[2 * e + 1] = bf_hi(cur[e]); }
#pragma unroll
        for (int j = 1; j < W; ++j) { const v4u rw = *(const LAS v4u*)(up - j * PL_US);
#pragma unroll
            for (int e = 0; e < 4; ++e) { sum[2 * e] += bf_lo(rw[e]); sum[2 * e + 1] += bf_hi(rw[e]); } }
        v4u o;
#pragma unroll
        for (int e = 0; e < 4; ++e) o[e] = pk2(sum[2 * e] * invc - bf_lo(cur[e]), sum[2 * e + 1] * invc - bf_hi(cur[e]));
        pf[ks] = __builtin_bit_cast(bf16x8, o);
    }
    const size_t R = t0 + fr;
#pragma unroll
    for (int nt = 0; nt < 8; ++nt) {
        f32x4 acc = (f32x4){0.f, 0.f, 0.f, 0.f};
        const LAS bf16* wp = wl + (16 * nt + fr) * PL_US + 8 * fq;
#pragma unroll
        for (int ks = 0; ks < 4; ++ks) acc = __builtin_amdgcn_mfma_f32_16x16x32_bf16(*(const LAS bf16x8*)(wp + 32 * ks), pf[ks], acc, 0, 0, 0);
        const int d = gi * 128 + 16 * nt + 4 * fq;
        const f32x4 sc = *(const f32x4*)(pscale + d);
        *(v2u*)(CONCAT + R * DM + 512 + d) = (v2u){pk2(acc[0] * sc.x, acc[1] * sc.y), pk2(acc[2] * sc.z, acc[3] * sc.w)};
    }
}
template <int W> __device__ __forceinline__ void pool_group(const bf16* PROJ, bf16* CONCAT, const LAS bf16* wl, LAS bf16* ust, const float* pscale, int gi, int gw, int ngw, int lane) {
    v4u ra[8], rb[8];
    int tt = gw;
    if (tt < T / 16) pool_load<W>(PROJ, gi, tt, lane, ra);
    while (tt < T / 16) {
        const int tn = tt + ngw;
        if (tn < T / 16) pool_load<W>(PROJ, gi, tn, lane, rb);
        pool_compute<W>(CONCAT, wl, ust, pscale, gi, tt, lane, ra);
        tt = tn;
        if (tt >= T / 16) break;
        const int tn2 = tt + ngw;
        if (tn2 < T / 16) pool_load<W>(PROJ, gi, tn2, lane, ra);
        pool_compute<W>(CONCAT, wl, ust, pscale, gi, tt, lane, rb);
        tt = tn2;
    }
}
__device__ __forceinline__ void pool_phase(LAS unsigned char* lds, const bf16* PROJ, bf16* CONCAT, const bf16* PWT, const float* pscale) {
    int tid_ = threadIdx.x; asm volatile("" : "+v"(tid_)); const int tid = tid_, lane = tid & 63, wave = tid >> 6;
    LAS bf16* wl = (LAS bf16*)lds;
    LAS bf16* ust = (LAS bf16*)(lds + 36864 + wave * 8704);
    const int gw = blockIdx.x * 8 + wave, ngw = gridDim.x * 8;
#pragma unroll 1
    for (int gi = 0; gi < 4; ++gi) {
        __syncthreads();
        { const int row = tid >> 2, q = tid & 3; const bf16* src = PWT + ((size_t)gi * 128 + row) * 128 + q * 32;
#pragma unroll
          for (int e = 0; e < 4; ++e) *(LAS v4u*)(wl + row * PL_US + q * 32 + e * 8) = *(const v4u*)(src + e * 8); }
        __syncthreads();
        if (gi == 0) pool_group<2>(PROJ, CONCAT, wl, ust, pscale, gi, gw, ngw, lane);
        else if (gi == 1) pool_group<4>(PROJ, CONCAT, wl, ust, pscale, gi, gw, ngw, lane);
        else if (gi == 2) pool_group<8>(PROJ, CONCAT, wl, ust, pscale, gi, gw, ngw, lane);
        else pool_group<16>(PROJ, CONCAT, wl, ust, pscale, gi, gw, ngw, lane);
    }
    __syncthreads();
}

#ifndef REP_P
#define REP_P 1
#endif
#ifndef REP_G
#define REP_G 1
#endif
#ifndef REP_R
#define REP_R 1
#endif
#ifndef REP_G
#define REP_G 1
#endif
#ifndef REP_IN
#define REP_IN REP_G
#endif
#ifndef REP_GU
#define REP_GU REP_G
#endif
#ifndef REP_DN
#define REP_DN REP_G
#endif
#ifndef REP_PL
#define REP_PL 1
#endif
#ifndef REP_A
#define REP_A 1
#endif
__global__ void __launch_bounds__(512, 2) fwd_kernel(Args a) {
    extern __shared__ __attribute__((aligned(16))) unsigned char lds_raw[];
    cg::grid_group grid = cg::this_grid();
    LAS unsigned char* lds = (LAS unsigned char*)lds_raw;
    unsigned char* ws = a.ws;
    bf16* H = (bf16*)(ws + WS_H); bf16* MIX = (bf16*)(ws + WS_MIX); bf16* PROJ = (bf16*)(ws + WS_PROJ);
    bf16* CONCAT = (bf16*)(ws + WS_CONCAT); bf16* ACT = (bf16*)(ws + WS_ACT);
    const float* cs = (const float*)(ws + WS_CS); bf16* XA = (bf16*)(ws + WS_XA); bf16* XB = (bf16*)(ws + WS_XB);
    volatile LAS unsigned* MISC = (volatile LAS unsigned*)(lds + RING_BYTES + 64);
    if (threadIdx.x == 0) { MISC[0] = 0u; MISC[1] = 0u; }
    __syncthreads();
    XcdBarrier bar = xcd_barrier_post((unsigned*)ws, MISC);
#define SEAM() xcd_barrier(bar)

    for (int rep = 0; rep < REP_P; ++rep) prologue(a, lds);
    if (a.ws == nullptr) grid.sync();
    SEAM();
    for (int rep = 0; rep < REP_R; ++rep) rowwise_phase(a, lds, true, false, true, false, 2, a.x, nullptr, nullptr, XB, H, 0, 0, nullptr, 0, 0, 1, a.g_pre_mix);
    mod_finalize(a);
    SEAM();
#pragma unroll 1
    for (int l = 0; l < DEPTH; ++l) {
        unsigned char* wl = ws + WS_W + (size_t)l * W_LAYER;
        for (int rep = 0; rep < REP_IN; ++rep) {
            pg8::Gemm g{H, (const bf16*)(wl + W_IN), T, INW, DM}; pg8::StaticOrder S; S.init(T, INW, gridDim.x, blockIdx.x);
            pg8::EpiInProj E{PROJ, a.b_in + l * INW, cs};
            pg8::gemm_phase<pg8::EpiInProj, pg8::StaticOrder, true, true>(lds, g, S, E);
        }
        SEAM();
        for (int rep = 0; rep < REP_A; ++rep) attn_phase(lds, PROJ, CONCAT, a.sinks + l * 8);
        for (int rep = 0; rep < REP_PL; ++rep) pool_phase(lds, PROJ, CONCAT, (const bf16*)(wl + W_PW), a.pool_scale + l * 512);
        SEAM();
        for (int rep = 0; rep < REP_G; ++rep) {
            pg8::Gemm g{CONCAT, (const bf16*)(wl + W_OUT), T, DM, DM}; pg8::StaticOrder S; S.init(T, DM, gridDim.x, blockIdx.x);
            pg8::EpiBf16<0> E{MIX, DM, nullptr, 0, 0, 1.f};
            pg8::gemm_phase<pg8::EpiBf16<0>, pg8::StaticOrder, true, true>(lds, g, S, E);
        }
        SEAM();
        for (int rep = 0; rep < REP_R; ++rep) rowwise_phase(a, lds, false, true, true, true, 2, XB, MIX, nullptr, XA, H, l, 2, a.g_post_mix + l * DM, l, 3, 4, a.g_pre_ffn + l * DM);
        SEAM();
#if defined(PROBE_HOT)
#pragma unroll 1
        for (int rep = 0; rep < 2; ++rep) {
            pg8::Gemm g{H, (const bf16*)(wl + W_GU), T, 2 * DFF, rep == 0 ? PROBE_HOT_K : DM}; pg8::DualOrder S; S.so.init(T, 2 * DFF, gridDim.x, blockIdx.x); S.c = blockIdx.x; S.rounds = 22; S.hot = (rep == 0);
            pg8::EpiSwiGLU E{rep == 0 ? MIX : ACT};
            pg8::gemm_phase<pg8::EpiSwiGLU, pg8::DualOrder, true, true>(lds, g, S, E);
            if (rep == 0) SEAM();
        }
#else
        for (int rep = 0; rep < REP_GU; ++rep) {
            pg8::Gemm g{H, (const bf16*)(wl + W_GU), T, 2 * DFF, DM}; pg8::StaticOrder S; S.init(T, 2 * DFF, gridDim.x, blockIdx.x);
            pg8::EpiSwiGLU E{ACT};
            pg8::gemm_phase<pg8::EpiSwiGLU, pg8::StaticOrder, true, true>(lds, g, S, E);
        }
#endif
        SEAM();
        for (int rep = 0; rep < REP_DN; ++rep) {
            pg8::Gemm g{ACT, (const bf16*)(wl + W_DN), T, DM, DFF}; pg8::StaticOrder S; S.init(T, DM, gridDim.x, blockIdx.x);
            pg8::EpiBf16<0> E{MIX, DM, nullptr, 0, 0, 1.f};
            pg8::gemm_phase<pg8::EpiBf16<0>, pg8::StaticOrder, true, true>(lds, g, S, E);
        }
        SEAM();
        const bool more = (l + 1 < DEPTH);
        for (int rep = 0; rep < REP_R; ++rep) rowwise_phase(a, lds, false, true, more, true, more ? 2 : 1, XA, MIX, a.out, XB, H, l, 5, a.g_post_ffn + l * DM, l + 1, 0, 1, a.g_pre_mix + (more ? (l + 1) * DM : 0));
        if (more) SEAM();
    }
}

extern "C" void kernel_launch(void* const* d_in, const int* in_sizes, int n_in, void* d_out, int out_size, void* d_ws, size_t ws_size, hipStream_t stream) {
    static int grid_blocks = 0;
    if (grid_blocks == 0) {
        if (n_in != 18 || out_size != T * DM || ws_size < WS_END) { fprintf(stderr, "kernel_launch: unexpected shapes (n_in %d, out %d, ws %zu)\n", n_in, out_size, ws_size); grid_blocks = -1; return; }
        int dev = 0, cus = 0, per_cu = 0;
        hipGetDevice(&dev);
        hipDeviceGetAttribute(&cus, hipDeviceAttributeMultiprocessorCount, dev);
        if (hipFuncSetAttribute((const void*)fwd_kernel, hipFuncAttributeMaxDynamicSharedMemorySize, LDS_BYTES) != hipSuccess) { fprintf(stderr, "kernel_launch: hipFuncSetAttribute failed\n"); grid_blocks = -1; return; }
        if (hipOccupancyMaxActiveBlocksPerMultiprocessor(&per_cu, (const void*)fwd_kernel, 512, LDS_BYTES) != hipSuccess || per_cu < 1) { fprintf(stderr, "kernel_launch: occupancy query gave %d\n", per_cu); per_cu = 1; }
        (void)hipGetLastError();
        grid_blocks = cus * per_cu;
    }
    if (grid_blocks < 0) return;
    if (hipMemsetAsync(d_ws, 0, 65536, stream) != hipSuccess) { fprintf(stderr, "kernel_launch: memset failed\n"); return; }
    Args a{};
    a.x = (const float*)d_in[0]; a.c = (const float*)d_in[1]; a.pos = (const int*)d_in[2]; a.ada_w = (const float*)d_in[3]; a.ada_b = (const float*)d_in[4];
    a.w_in = (const float*)d_in[5]; a.b_in = (const float*)d_in[6]; a.sinks = (const float*)d_in[7]; a.pool_w = (const float*)d_in[8]; a.pool_scale = (const float*)d_in[9];
    a.w_out = (const float*)d_in[10]; a.w_gate = (const float*)d_in[11]; a.w_up = (const float*)d_in[12]; a.w_down = (const float*)d_in[13];
    a.g_pre_mix = (const float*)d_in[14]; a.g_post_mix = (const float*)d_in[15]; a.g_pre_ffn = (const float*)d_in[16]; a.g_post_ffn = (const float*)d_in[17];
    a.out = (float*)d_out; a.ws = (unsigned char*)d_ws;
    void* args[] = {&a};
    hipError_t e = hipLaunchCooperativeKernel((const void*)fwd_kernel, dim3(grid_blocks), dim3(512), args, LDS_BYTES, stream);
    if (e != hipSuccess) fprintf(stderr, "cooperative launch failed: %s (grid %d)\n", hipGetErrorString(e), grid_blocks);
}
```

```cpp
#include <hip/hip_runtime.h>
#include <hip/hip_cooperative_groups.h>
#include <cstdio>
#include <cstdint>
namespace cg = cooperative_groups;
#define LAS __attribute__((address_space(3)))
namespace pg8 {
#define PG8_LAS __attribute__((address_space(3)))
typedef unsigned short bf16_t;
typedef short bf16x8 __attribute__((ext_vector_type(8)));
typedef float f32x4 __attribute__((ext_vector_type(4)));
typedef unsigned u32x4 __attribute__((ext_vector_type(4)));
constexpr int BM = 256, BK = 64, HALF = 128, HTB = HALF * BK * 2  , STAGE_BYTES = 8 * HTB, NXCD = 8, WGM = 8;

__host__ __device__ __forceinline__ int lds_byte(int r, int c) { const int st = (r >> 4) * 2 + (c >> 5), rr = r & 15, cc = c & 31, ob = rr * 64 + cc * 2; return st * 1024 + (ob ^ (((ob >> 9) & 1) << 5)); }
__host__ __device__ __forceinline__ void stage_rc(int b, int& R, int& C) { const int st = b / 1024, sb = b % 1024, swz = sb ^ (((sb >> 9) & 1) << 5); R = (st >> 1) * 16 + swz / 64; C = (st & 1) * 32 + (swz % 64) / 2; }
__host__ __device__ __forceinline__ int perm32(int rho) { const int n = rho >> 4, i = rho & 15; return 8 * (i >> 2) + 4 * n + (i & 3); }

struct Unit { int pm, pn; };
struct Gemm { const bf16_t* A; const bf16_t* Bt; int M, N, K; };

struct StaticOrder {
    int nM, nN, nwg, G, c;
    __host__ __device__ void init(int M, int N, int G_, int c_) { nM = M / BM; nN = N / BM; nwg = nM * nN; G = G_; c = c_; }
    __host__ __device__ bool next(int i, Unit& u) const {
        const long L = (long)i * G + c; if (L >= nwg) return false;
        int wgid = (int)L; { const int q = nwg / NXCD, r = nwg % NXCD, xcd = wgid % NXCD, off = wgid / NXCD; wgid = (xcd < r ? xcd * (q + 1) : r * (q + 1) + (xcd - r) * q) + off; }
        const int nig = WGM * nN, gid = wgid / nig, fm = gid * WGM, gsz = (nM - fm) < WGM ? (nM - fm) : WGM;
        u.pm = fm + ((wgid % nig) % gsz); u.pn = (wgid % nig) / gsz; return true;
    }
    __device__ __forceinline__ void a_ready(const Unit&) const {}
    __device__ __forceinline__ void done(const Unit&) const {}
};

__device__ __forceinline__ unsigned cvt_pk_bf16(float lo, float hi) { unsigned r; asm volatile("v_cvt_pk_bf16_f32 %0, %1, %2" : "=v"(r) : "v"(lo), "v"(hi)); return r; }
typedef float f32x2 __attribute__((ext_vector_type(2)));
__device__ __forceinline__ f32x2 gelu_pk(f32x2 v) {
    const f32x2 av = __builtin_elementwise_abs(v), d = av * 0.2316418882f + 1.0f;
    f32x2 t; t.x = __builtin_amdgcn_rcpf(d.x); t.y = __builtin_amdgcn_rcpf(d.y);
    f32x2 q = t * 0.5307027145f + (-0.7265760135f); q = q * t + 0.7107068705f; q = q * t + (-0.142248368f); q = q * t + 0.127414796f; q = q * t;
    const f32x2 s = (v * v) * (-0.72134752044f);
    f32x2 e; e.x = __builtin_amdgcn_exp2f(s.x); e.y = __builtin_amdgcn_exp2f(s.y);
    const f32x2 m = v * (q * e), r = v - m;
    f32x2 o; o.x = v.x < 0.f ? m.x : r.x; o.y = v.y < 0.f ? m.y : r.y; return o;
}

template <int ACT  > struct EpiBf16 {
    static constexpr bool PERM = true, AFTER_DRAIN = false; static_assert(ACT == 0 || ACT == 1, "EpiBf16: ACT is 0 (none) or 1 (gelu_pk)");
    bf16_t* O; int ldc; const float* bias; int split_cols; size_t split_stride; float scale0;
    __device__ __forceinline__ void operator()(const f32x4 (&acc)[2][2][4][2], const Unit& u, int wr, int wc, int fr, int fq) const {
        const int row0 = u.pm * BM + wr * 64 + fr; int colt = u.pn * BM; bf16_t* base = O;
        float sc = 1.f; if (split_cols) { const int t = colt / split_cols; base += (size_t)t * split_stride; colt -= t * split_cols; if (t == 0) sc = scale0; }
        const int col0 = colt + wc * 32 + 8 * fq, bcol0 = u.pn * BM + wc * 32 + 8 * fq;
        f32x4 bv[2][2];
#pragma unroll
        for (int bj = 0; bj < 2; ++bj)
#pragma unroll
            for (int n = 0; n < 2; ++n) bv[bj][n] = bias ? *(const f32x4*)(bias + bcol0 + bj * HALF + 4 * n) : (f32x4){0.f, 0.f, 0.f, 0.f};
#pragma unroll
        for (int ai = 0; ai < 2; ++ai)
#pragma unroll
            for (int m = 0; m < 4; ++m) { bf16_t* rowp = base + (size_t)(row0 + ai * HALF + m * 16) * ldc + col0;
#pragma unroll
                for (int bj = 0; bj < 2; ++bj) { f32x4 v0 = acc[ai][bj][m][0] + bv[bj][0], v1 = acc[ai][bj][m][1] + bv[bj][1];
                    if (ACT == 1) { f32x2 a = gelu_pk((f32x2){v0[0], v0[1]}), b = gelu_pk((f32x2){v0[2], v0[3]}), c = gelu_pk((f32x2){v1[0], v1[1]}), d = gelu_pk((f32x2){v1[2], v1[3]});
                        v0 = (f32x4){a.x, a.y, b.x, b.y}; v1 = (f32x4){c.x, c.y, d.x, d.y}; }
                    v0 = v0 * sc; v1 = v1 * sc; u32x4 w; w.x = cvt_pk_bf16(v0[0], v0[1]); w.y = cvt_pk_bf16(v0[2], v0[3]); w.z = cvt_pk_bf16(v1[0], v1[1]); w.w = cvt_pk_bf16(v1[2], v1[3]);
                    *(u32x4*)(rowp + bj * HALF) = w; } }
    }
};
template <class Epi, class Sched, bool ALIGN_EPI = false, bool SP2 = false, int A_AUX = 0  >
__device__ __forceinline__ void gemm_phase(PG8_LAS unsigned char* lds, const Gemm g, const Sched& S, const Epi& E) {
    int tid_ = threadIdx.x; asm volatile("" : "+v"(tid_)); const int tid = tid_, wid = __builtin_amdgcn_readfirstlane(tid >> 6), lane = tid & 63, wr = wid >> 2, wc = wid & 3, fr = lane & 15, fq = lane >> 4;
    const int K = g.K, nt = K / BK;
    unsigned voffA[2], voffB[2];
#pragma unroll
    for (int i = 0; i < 2; ++i) { int R, C; stage_rc(tid * 16 + i * 8192, R, C); const int Rb = Epi::PERM ? ((R & ~31) + perm32(R & 31)) : R;
        voffA[i] = (unsigned)(R * K + C) * 2u; voffB[i] = (unsigned)(Rb * K + C) * 2u; }
    const size_t kstep = (size_t)(BK * 2);
    const size_t hstep = (size_t)HALF * K * 2;
    const size_t tstep = 2 * hstep;
    const unsigned ldsw = (unsigned)wid * 1024u;
    const int aoff = lds_byte(wr * 64 + fr, fq * 8), boff = lds_byte(wc * 32 + fr, fq * 8);
#define PG8_SA(b, h) (((b) * 2 + (h)) * HTB)
#define PG8_SB(b, h) ((4 + (b) * 2 + (h)) * HTB)
#define PG8_STAGE(bufoff, gbase, voff) do { _Pragma("unroll") for (int _i = 0; _i < 2; ++_i) \
        __builtin_amdgcn_global_load_lds((const unsigned*)((const char*)(gbase) + (voff)[_i]), (PG8_LAS unsigned*)(lds + (bufoff) + ldsw + _i * 8192), 16, 0, 0); } while (0)
#define PG8_STAGEA(bufoff, gbase, voff) do { _Pragma("unroll") for (int _i = 0; _i < 2; ++_i) \
        __builtin_amdgcn_global_load_lds((const unsigned*)((const char*)(gbase) + (voff)[_i]), (PG8_LAS unsigned*)(lds + (bufoff) + ldsw + _i * 8192), 16, 0, A_AUX); } while (0)
#define PG8_LDA(dst, b, h) do { _Pragma("unroll") for (int m = 0; m < 4; ++m) _Pragma("unroll") for (int k = 0; k < 2; ++k) dst[m][k] = *(const PG8_LAS bf16x8*)(lds + PG8_SA(b, h) + aoff + m * 2048 + k * 1024); } while (0)
#define PG8_LDB(dst, b, h) do { _Pragma("unroll") for (int n = 0; n < 2; ++n) _Pragma("unroll") for (int k = 0; k < 2; ++k) dst[n][k] = *(const PG8_LAS bf16x8*)(lds + PG8_SB(b, h) + boff + n * 2048 + k * 1024); } while (0)
#define PG8_MMA(ai, bj, At, Bt) do { __builtin_amdgcn_s_setprio(1); _Pragma("unroll") for (int m = 0; m < 4; ++m) _Pragma("unroll") for (int n = 0; n < 2; ++n) _Pragma("unroll") for (int k = 0; k < 2; ++k) \
        acc[ai][bj][m][n] = __builtin_amdgcn_mfma_f32_16x16x32_bf16(Bt[n][k], At[m][k], acc[ai][bj][m][n], 0, 0, 0); __builtin_amdgcn_s_setprio(0); } while (0)
#define PG8_WAIT_V(n) asm volatile("s_waitcnt vmcnt(" #n ")" ::: "memory")
#define PG8_WAIT_L(n) asm volatile("s_waitcnt lgkmcnt(" #n ")" ::: "memory")
#define PG8_BAR __builtin_amdgcn_s_barrier()
#define PG8_SCHED __builtin_amdgcn_sched_barrier(0)
    Unit cur, nxt; int ui = 0;
    if (!S.next(0, cur)) return;
    f32x4 acc[2][2][4][2];
#pragma unroll
    for (int a = 0; a < 2; ++a)
#pragma unroll
        for (int b = 0; b < 2; ++b)
#pragma unroll
            for (int m = 0; m < 4; ++m)
#pragma unroll
                for (int n = 0; n < 2; ++n) acc[a][b][m][n] = (f32x4){0.f, 0.f, 0.f, 0.f};
    bf16x8 At[4][2], B0[2][2], B1[2][2];
    const char* cA = (const char*)g.A + (size_t)cur.pm * tstep; const char* cB = (const char*)g.Bt + (size_t)cur.pn * tstep;
    S.a_ready(cur);
    if constexpr (SP2) {
        PG8_STAGE(PG8_SB(0, 0), cB, voffB); PG8_STAGE(PG8_SB(0, 1), cB + hstep, voffB); PG8_STAGEA(PG8_SA(0, 0), cA, voffA); PG8_STAGEA(PG8_SA(0, 1), cA + hstep, voffA);
        if (wr == 1) PG8_BAR;
        PG8_WAIT_V(2); PG8_BAR;
        PG8_STAGE(PG8_SB(1, 0), cB + kstep, voffB); PG8_STAGEA(PG8_SA(1, 0), cA + kstep, voffA); PG8_STAGE(PG8_SB(1, 1), cB + hstep + kstep, voffB);
        PG8_WAIT_V(6); PG8_BAR;
    } else {
        PG8_STAGE(PG8_SB(0, 0), cB, voffB); PG8_STAGEA(PG8_SA(0, 0), cA, voffA); PG8_STAGE(PG8_SB(0, 1), cB + hstep, voffB); PG8_STAGEA(PG8_SA(0, 1), cA + hstep, voffA);
        if (wr == 1) PG8_BAR;
        PG8_WAIT_V(4); PG8_BAR;
        PG8_STAGE(PG8_SB(1, 0), cB + kstep, voffB); PG8_STAGEA(PG8_SA(1, 0), cA + kstep, voffA); PG8_STAGE(PG8_SB(1, 1), cB + hstep + kstep, voffB);
        PG8_WAIT_V(6); PG8_BAR;
    }
    for (;;) {
        const bool has_next = S.next(ui + 1, nxt);
        const char* nA = has_next ? (const char*)g.A + (size_t)nxt.pm * tstep : cA; const char* nB = has_next ? (const char*)g.Bt + (size_t)nxt.pn * tstep : cB;
        for (int t = 0; t < nt; t += 2) {
            const bool last = (t == nt - 2);
            const char* a1 = cA + (size_t)(t + 1) * kstep;
            const char* a2 = last ? nA : cA + (size_t)(t + 2) * kstep; const char* b2 = last ? nB : cB + (size_t)(t + 2) * kstep;
            const char* a3 = a2 + kstep; const char* b3 = b2 + kstep;
            if (last && has_next) S.a_ready(nxt);
            if constexpr (SP2) {
            PG8_LDB(B0, 0, 0); PG8_LDB(B1, 0, 1); PG8_SCHED; PG8_LDA(At, 0, 0); PG8_STAGEA(PG8_SA(1, 1), a1 + hstep, voffA);
            PG8_WAIT_V(8); PG8_WAIT_L(0); PG8_BAR; PG8_MMA(0, 0, At, B0); PG8_MMA(0, 1, At, B1); PG8_BAR; PG8_SCHED;
            PG8_LDA(At, 0, 1); PG8_STAGE(PG8_SB(0, 0), b2, voffB); PG8_STAGE(PG8_SB(0, 1), b2 + hstep, voffB); PG8_STAGEA(PG8_SA(0, 0), a2, voffA);
            PG8_WAIT_V(8); PG8_WAIT_L(0); PG8_BAR; PG8_MMA(1, 0, At, B0); PG8_MMA(1, 1, At, B1); PG8_BAR; PG8_SCHED;
            PG8_LDB(B0, 1, 0); PG8_LDB(B1, 1, 1); PG8_SCHED; PG8_LDA(At, 1, 0); PG8_STAGEA(PG8_SA(0, 1), a2 + hstep, voffA);
            PG8_WAIT_V(8); PG8_WAIT_L(0); PG8_BAR; PG8_MMA(0, 0, At, B0); PG8_MMA(0, 1, At, B1); PG8_BAR; PG8_SCHED;
            PG8_LDA(At, 1, 1); PG8_STAGE(PG8_SB(1, 0), b3, voffB); PG8_STAGE(PG8_SB(1, 1), b3 + hstep, voffB); PG8_STAGEA(PG8_SA(1, 0), a3, voffA);
            PG8_WAIT_V(8); PG8_WAIT_L(0); PG8_BAR; PG8_MMA(1, 0, At, B0); PG8_MMA(1, 1, At, B1); PG8_BAR; PG8_SCHED;
            } else {
            PG8_LDB(B0, 0, 0); PG8_SCHED; PG8_LDA(At, 0, 0); PG8_STAGEA(PG8_SA(1, 1), a1 + hstep, voffA);
            PG8_WAIT_L(8); PG8_BAR; PG8_WAIT_L(0); PG8_MMA(0, 0, At, B0); PG8_BAR; PG8_SCHED;
            PG8_LDB(B1, 0, 1); PG8_STAGE(PG8_SB(0, 0), b2, voffB);
            PG8_BAR; PG8_WAIT_L(0); PG8_MMA(0, 1, At, B1); PG8_BAR;
            PG8_LDA(At, 0, 1); PG8_STAGEA(PG8_SA(0, 0), a2, voffA);
            PG8_BAR; PG8_WAIT_L(0); PG8_MMA(1, 0, At, B0); PG8_BAR; PG8_SCHED;
            PG8_STAGE(PG8_SB(0, 1), b2 + hstep, voffB);
            PG8_WAIT_V(6); PG8_BAR; PG8_MMA(1, 1, At, B1); PG8_BAR;
            PG8_LDB(B0, 1, 0); PG8_SCHED; PG8_LDA(At, 1, 0); PG8_STAGEA(PG8_SA(0, 1), a2 + hstep, voffA);
            PG8_WAIT_L(8); PG8_BAR; PG8_WAIT_L(0); PG8_MMA(0, 0, At, B0); PG8_BAR; PG8_SCHED;
            PG8_LDB(B1, 1, 1); PG8_STAGE(PG8_SB(1, 0), b3, voffB);
            PG8_BAR; PG8_WAIT_L(0); PG8_MMA(0, 1, At, B1); PG8_BAR;
            PG8_LDA(At, 1, 1); PG8_STAGEA(PG8_SA(1, 0), a3, voffA);
            PG8_BAR; PG8_WAIT_L(0); PG8_MMA(1, 0, At, B0); PG8_BAR; PG8_SCHED;
            PG8_STAGE(PG8_SB(1, 1), b3 + hstep, voffB);
            PG8_WAIT_V(6); PG8_BAR; PG8_MMA(1, 1, At, B1); PG8_BAR;
            }
        }
        if constexpr (ALIGN_EPI) { if (wr == 0) PG8_BAR; }
        if constexpr (!Epi::AFTER_DRAIN) { E(acc, cur, wr, wc, fr, fq); S.done(cur); }
        if (!has_next) break;
#pragma unroll
        for (int a = 0; a < 2; ++a)
#pragma unroll
            for (int b = 0; b < 2; ++b)
#pragma unroll
                for (int m = 0; m < 4; ++m)
#pragma unroll
                    for (int n = 0; n < 2; ++n) acc[a][b][m][n] = (f32x4){0.f, 0.f, 0.f, 0.f};
        cur = nxt; cA = nA; cB = nB; ++ui;
        if constexpr (ALIGN_EPI) { if (wr == 1) PG8_BAR; }
    }
    PG8_WAIT_V(0);
    if constexpr (!ALIGN_EPI) { if (wr == 0) PG8_BAR; }
    PG8_BAR;
    if constexpr (Epi::AFTER_DRAIN) { E.fused(acc, cur, wr, wc, fr, fq, lds, wid, lane); S.done(cur); }
#undef PG8_SA
#undef PG8_SB
#undef PG8_STAGE
#undef PG8_STAGEA
#undef PG8_LDA
#undef PG8_LDB
#undef PG8_MMA
#undef PG8_WAIT_V
#undef PG8_WAIT_L
#undef PG8_BAR
#undef PG8_SCHED
}
}
#define XB_TMO      128
#define XB_XCNT(j)  (256  + 64 * (j))
#define XB_XSUB(j)  (1280 + 64 * (j))
#define XB_XGEN(j)  (2304 + 64 * (j))
#define XB_TOP      3328
#define XB_TOPGEN   3392
#define XCD_BAR_WORDS 3456
#define XB_SPIN_CAP (1u << 18)

__device__ __forceinline__ unsigned xb_ld(unsigned* p)              { return __hip_atomic_load(p, __ATOMIC_RELAXED, __HIP_MEMORY_SCOPE_AGENT); }
__device__ __forceinline__ unsigned xb_add(unsigned* p, unsigned v) { return __hip_atomic_fetch_add(p, v, __ATOMIC_RELAXED, __HIP_MEMORY_SCOPE_AGENT); }
__device__ __forceinline__ unsigned xb_xcc_id() { return (unsigned)__builtin_amdgcn_s_getreg((3 << 11) | 20) & 0xFu; }
#define XB_SPIN(cond, bar) do { unsigned _sp = 0; while (cond) { __builtin_amdgcn_s_sleep(1); \
    if ((++_sp & 255u) == 0u) { if (xb_ld(&(bar)[XB_TMO])) break; if (_sp > XB_SPIN_CAP) { atomicAdd(&(bar)[XB_TMO], 1u); break; } } } } while (0)

struct XcdBarrier {
    unsigned* bar; unsigned x;
    volatile LAS unsigned* st;
};

__device__ __forceinline__ XcdBarrier xcd_barrier_post(unsigned* bar, volatile LAS unsigned* st) {
    XcdBarrier b; b.bar = bar; b.x = xb_xcc_id(); b.st = st;
    if (threadIdx.x == 0) (void)xb_add(&bar[XB_XCNT(b.x)], 1u);
    return b;
}
__device__ __forceinline__ void xcd_barrier_complete(unsigned* bar, unsigned x, unsigned& nloc, unsigned& nx) {
    const unsigned G = gridDim.x * gridDim.y * gridDim.z;
    unsigned sum, cnt, mine, sp = 0u;
    for (;;) {
        sum = 0u; cnt = 0u; mine = 0u;
#pragma unroll
        for (unsigned j = 0; j < 16; ++j) { const unsigned c = xb_ld(&bar[XB_XCNT(j)]); sum += c; cnt += (c > 0u) ? 1u : 0u; mine = (j == x) ? c : mine; }
        if (sum == G) break;
        __builtin_amdgcn_s_sleep(1);
        if ((++sp & 255u) == 0u) { if (xb_ld(&bar[XB_TMO])) break; if (sp > XB_SPIN_CAP) { atomicAdd(&bar[XB_TMO], 1u); break; } }
    }
    nloc = mine > 0u ? mine : 1u; nx = cnt > 0u ? cnt : 1u;
}

__device__ __forceinline__ void xcd_barrier(const XcdBarrier& b) {
    asm volatile("s_waitcnt vmcnt(0)" ::: "memory");
    __syncthreads();
    if (threadIdx.x == 0) {
        unsigned* bar = b.bar;
        __builtin_amdgcn_s_waitcnt(0);
        unsigned nloc = b.st[0], nx = b.st[1];
        if (nloc == 0u) { xcd_barrier_complete(bar, b.x, nloc, nx); b.st[0] = nloc; b.st[1] = nx; }
        const unsigned old = xb_add(&bar[XB_XSUB(b.x)], 1u);
        const unsigned gen = old / nloc;
        if (old + 1u == (gen + 1u) * nloc) {
            __builtin_amdgcn_fence(__ATOMIC_RELEASE, "agent");
            asm volatile("s_waitcnt vmcnt(0)" ::: "memory");
            const unsigned og = xb_add(&bar[XB_TOP], 1u);
            const unsigned tg = og / nx;
            if (og + 1u == (tg + 1u) * nx) xb_add(&bar[XB_TOPGEN], 1u);
            else XB_SPIN(xb_ld(&bar[XB_TOPGEN]) == tg, bar);
            __builtin_amdgcn_fence(__ATOMIC_ACQUIRE, "agent");
            xb_add(&bar[XB_XGEN(b.x)], 1u);
            asm volatile("s_waitcnt vmcnt(0)" ::: "memory");
        } else {
            XB_SPIN(xb_ld(&bar[XB_XGEN(b.x)]) == gen, bar);
            __builtin_amdgcn_fence(__ATOMIC_ACQUIRE, "agent");
            asm volatile("s_waitcnt vmcnt(0)" ::: "memory");
        }
    }
    __syncthreads();
}

constexpr int NB = 8, SEQ = 8192, DM = 1024, DEPTH = 2;
constexpr int T = NB * SEQ;
constexpr int INW = 1280, DFF = 2816, NMODW = 6 * DM;
constexpr int KCH = 32;
constexpr float EPS = 1e-6f;
constexpr float LOG2E = 1.4426950408889634f;

#define LAS __attribute__((address_space(3)))
typedef unsigned short bf16;
typedef unsigned v4u __attribute__((ext_vector_type(4)));
typedef unsigned v2u __attribute__((ext_vector_type(2)));
typedef float f32x4 __attribute__((ext_vector_type(4)));
typedef short bf16x8 __attribute__((ext_vector_type(8)));

constexpr size_t MiB = 1u << 20;
constexpr size_t WS_MODP = 640 * MiB;
constexpr size_t WS_MODF = 8 * MiB;
constexpr size_t WS_CS = 9 * MiB;
constexpr size_t WS_W = 16 * MiB, W_LAYER = 24 * MiB;
constexpr size_t W_IN = 0, W_OUT = 3 * MiB, W_GU = 5 * MiB, W_DN = 16 * MiB, W_PW = 22 * MiB;
constexpr size_t WS_H = 64 * MiB;
constexpr size_t WS_MIX = 192 * MiB;
constexpr size_t WS_PROJ = 320 * MiB;
constexpr size_t WS_CONCAT = 480 * MiB;
constexpr size_t WS_ACT = 320 * MiB;
constexpr size_t WS_XA = 672 * MiB;
constexpr size_t WS_XB = 800 * MiB;
constexpr size_t WS_END = 928 * MiB;

constexpr int RING_BYTES = 131072;
constexpr int LDS_BYTES = 147456;

struct Args {
    const float* x; const float* c; const int* pos; const float* ada_w; const float* ada_b; const float* w_in; const float* b_in;
    const float* sinks; const float* pool_w; const float* pool_scale; const float* w_out; const float* w_gate; const float* w_up;
    const float* w_down; const float* g_pre_mix; const float* g_post_mix; const float* g_pre_ffn; const float* g_post_ffn;
    float* out; unsigned char* ws;
};

__device__ __constant__ double c_inv_freq[8] = {1.0, 0.19392274474868576, 0.03760603093086393, 0.007292664737217109,
                                                0.001414213562373095, 0.0002742481756762073, 5.318295896944988e-05, 1.031338537721246e-05};

__device__ __forceinline__ unsigned pk2(float lo, float hi) { return pg8::cvt_pk_bf16(lo, hi); }
__device__ __forceinline__ float bf_lo(unsigned w) { return __uint_as_float(w << 16); }
__device__ __forceinline__ float bf_hi(unsigned w) { return __uint_as_float(w & 0xffff0000u); }
__device__ __forceinline__ float wave_sum(float v) {
#pragma unroll
    for (int o = 1; o < 64; o <<= 1) v += __shfl_xor(v, o);
    return v;
}

namespace pg8 {
struct EpiInProj {
    static constexpr bool PERM = true, AFTER_DRAIN = false;
    bf16_t* O; const float* bias; const float* cs;
    __device__ __forceinline__ void operator()(const f32x4 (&acc)[2][2][4][2], const Unit& u, int wr, int wc, int fr, int fq) const {
        const int row0 = u.pm * BM + wr * 64 + fr; const int colt = u.pn * BM; const int col0 = colt + wc * 32 + 8 * fq;
        f32x4 bv[2][2];
#pragma unroll
        for (int bj = 0; bj < 2; ++bj)
#pragma unroll
            for (int n = 0; n < 2; ++n) bv[bj][n] = *(const f32x4*)(bias + col0 + bj * HALF + 4 * n);
        const bool rot_wave = (colt < 640) && ((wc & 1) == 0);
#pragma unroll
        for (int ai = 0; ai < 2; ++ai)
#pragma unroll
        for (int mh = 0; mh < 2; ++mh) {
            f32x4 cc[2][4];
#pragma unroll
            for (int mm = 0; mm < 2; ++mm)
#pragma unroll
                for (int q = 0; q < 4; ++q) cc[mm][q] = (f32x4){1.f, 1.f, 1.f, 1.f};
            if (rot_wave && fq < 2) {
#pragma unroll
                for (int mm = 0; mm < 2; ++mm) { const float* cr = cs + (size_t)(row0 + ai * HALF + (2 * mh + mm) * 16) * 16;
#pragma unroll
                    for (int q = 0; q < 4; ++q) cc[mm][q] = *(const f32x4*)(cr + 4 * q); }
            }
#pragma unroll
            for (int mm = 0; mm < 2; ++mm) {
                const int m = 2 * mh + mm;
                const int row = row0 + ai * HALF + m * 16;
                bf16_t* rowp = O + (size_t)row * INW + col0;
#pragma unroll
                for (int bj = 0; bj < 2; ++bj) {
                    f32x4 v0 = acc[ai][bj][m][0] + bv[bj][0], v1 = acc[ai][bj][m][1] + bv[bj][1];
                    const int cb = colt + bj * HALF;
                    if (rot_wave && cb < 640) {
                        f32x4 p0, p1;
#pragma unroll
                        for (int e = 0; e < 4; ++e) { p0[e] = __shfl_xor(v0[e], 16); p1[e] = __shfl_xor(v1[e], 16); }
                        if (fq == 0) { v0 = v0 * cc[mm][0] - p0 * cc[mm][2]; v1 = v1 * cc[mm][1] - p1 * cc[mm][3]; }
                        else if (fq == 1) { v0 = v0 * cc[mm][0] + p0 * cc[mm][2]; v1 = v1 * cc[mm][1] + p1 * cc[mm][3]; }
                    }
                    if (cb < 512) { v0 = v0 * 0.125f; v1 = v1 * 0.125f; }
                    u32x4 w; w.x = cvt_pk_bf16(v0[0], v0[1]); w.y = cvt_pk_bf16(v0[2], v0[3]); w.z = cvt_pk_bf16(v1[0], v1[1]); w.w = cvt_pk_bf16(v1[2], v1[3]);
                    *(u32x4*)(rowp + bj * HALF) = w;
                }
            }
        }
    }
};
struct EpiSwiGLU {
    static constexpr bool PERM = true, AFTER_DRAIN = false;
    bf16_t* O;
    __device__ __forceinline__ void operator()(const f32x4 (&acc)[2][2][4][2], const Unit& u, int wr, int wc, int fr, int fq) const {
        typedef float f32x2 __attribute__((ext_vector_type(2)));
        const int row0 = u.pm * BM + wr * 64 + fr; const int col0 = u.pn * HALF + wc * 32 + 8 * fq;
#pragma unroll
        for (int ai = 0; ai < 2; ++ai)
#pragma unroll
            for (int m = 0; m < 4; ++m) {
                bf16_t* rowp = O + (size_t)(row0 + ai * HALF + m * 16) * DFF + col0;
                f32x2 G[4], U[4], t[4], r[4];
#pragma unroll
                for (int n = 0; n < 2; ++n) { G[2 * n] = (f32x2){acc[ai][0][m][n][0], acc[ai][0][m][n][1]}; G[2 * n + 1] = (f32x2){acc[ai][0][m][n][2], acc[ai][0][m][n][3]};
                                              U[2 * n] = (f32x2){acc[ai][1][m][n][0], acc[ai][1][m][n][1]}; U[2 * n + 1] = (f32x2){acc[ai][1][m][n][2], acc[ai][1][m][n][3]}; }
#pragma unroll
                for (int q = 0; q < 4; ++q) { t[q].x = __builtin_amdgcn_exp2f(G[q].x); t[q].y = __builtin_amdgcn_exp2f(G[q].y); }
#pragma unroll
                for (int q = 0; q < 4; ++q) { t[q] = t[q] + 1.0f; r[q] = G[q] * U[q]; }
#pragma unroll
                for (int q = 0; q < 4; ++q) { t[q].x = __builtin_amdgcn_rcpf(t[q].x); t[q].y = __builtin_amdgcn_rcpf(t[q].y); }
#pragma unroll
                for (int q = 0; q < 4; ++q) r[q] = r[q] * t[q];
                u32x4 w; w.x = cvt_pk_bf16(r[0].x, r[0].y); w.y = cvt_pk_bf16(r[1].x, r[1].y); w.z = cvt_pk_bf16(r[2].x, r[2].y); w.w = cvt_pk_bf16(r[3].x, r[3].y);
                *(u32x4*)rowp = w;
            }
    }
};
struct DualOrder {
    StaticOrder so; int c, rounds, hot;
    __device__ bool next(int i, Unit& u) const { if (hot) { if (i >= rounds) return false; u.pm = (c % 8) * 2 + ((c / 8) & 1); u.pn = ((c / 8) >> 1) & 3; return true; } return so.next(i, u); }
    __device__ __forceinline__ void a_ready(const Unit&) const {}
    __device__ __forceinline__ void done(const Unit&) const {}
};
}

__device__ __forceinline__ void transpose_item(const float* W, int K, int N, bf16* WT, int drow0, LAS float* scr, int k0, int n0, int lane, float wscale = 1.0f) {
#pragma unroll
    for (int ih = 0; ih < 32; ih += 16) {
        float tv[16];
#pragma unroll
        for (int i = 0; i < 16; ++i) tv[i] = __builtin_nontemporal_load(W + (size_t)(k0 + 2 * (ih + i) + (lane >> 5)) * N + n0 + (lane & 31));
#pragma unroll
        for (int i = 0; i < 16; ++i) scr[(2 * (ih + i) + (lane >> 5)) * 33 + (lane & 31)] = tv[i] * wscale;
    }
    asm volatile("s_waitcnt lgkmcnt(0)" ::: "memory");
    const int c = lane & 7;
#pragma unroll
    for (int j = 0; j < 4; ++j) { const int n = (lane >> 3) + 8 * j; const LAS float* s = scr + (8 * c) * 33 + n;
        v4u o; o.x = pk2(s[0 * 33], s[1 * 33]); o.y = pk2(s[2 * 33], s[3 * 33]); o.z = pk2(s[4 * 33], s[5 * 33]); o.w = pk2(s[6 * 33], s[7 * 33]);
        *(v4u*)(WT + (size_t)(drow0 + n) * K + k0 + 8 * c) = o; }
    asm volatile("s_waitcnt lgkmcnt(0)" ::: "memory");
}

__device__ __forceinline__ void prologue(const Args& a, LAS unsigned char* lds) {
    int tid_ = threadIdx.x; asm volatile("" : "+v"(tid_)); const int tid = tid_, lane = tid & 63, wave = tid >> 6;
    unsigned char* ws = a.ws;
    __syncthreads();
    {
        LAS float* sc = (LAS float*)lds;
        for (int i = tid; i < NB * DM; i += 512) { const float v = a.c[i]; sc[i] = v / (1.0f + __expf(-v)); }
        __syncthreads();
        float* modp = (float*)(ws + WS_MODP);
        for (int item = blockIdx.x; item < DEPTH * KCH * 12; item += gridDim.x) {
            const int l = item / (KCH * 12), r = item % (KCH * 12), kc = r / 12, cb = r % 12, n = cb * 512 + tid;
            constexpr int KPI = DM / KCH;
            const float* w = a.ada_w + ((size_t)l * DM + kc * KPI) * NMODW + n;
            float acc[8];
#pragma unroll
            for (int b = 0; b < 8; ++b) acc[b] = 0.f;
#pragma unroll 1
            for (int kh = 0; kh < KPI; kh += 16) {
                float wv[16];
#pragma unroll
                for (int k = 0; k < 16; ++k) wv[k] = __builtin_nontemporal_load(w + (size_t)(kh + k) * NMODW);
#pragma unroll
                for (int k = 0; k < 16; ++k) {
                    const LAS float* sp = sc + kc * KPI + kh + k;
#pragma unroll
                    for (int b = 0; b < 8; ++b) acc[b] += sp[b * DM] * wv[k];
                    if ((k & 3) == 3) asm volatile("" ::: "memory");
                }
            }
#pragma unroll
            for (int b = 0; b < 8; ++b) modp[((size_t)(l * KCH + kc) * 8 + b) * NMODW + n] = acc[b];
        }
        __syncthreads();
    }
    {
        float* cs = (float*)(ws + WS_CS);
        for (int idx = blockIdx.x * 512 + tid; idx < T * 8; idx += gridDim.x * 512) {
            const int row = idx >> 3, j = idx & 7;
            const double rev = (double)a.pos[row] * c_inv_freq[j] * 0.15915494309189535;
            const float fr = (float)(rev - floor(rev));
            cs[(size_t)row * 16 + j] = __builtin_amdgcn_cosf(fr);
            cs[(size_t)row * 16 + 8 + j] = __builtin_amdgcn_sinf(fr);
        }
    }
    {
        LAS float* scr = (LAS float*)(lds + wave * 16384);
        const int gw = blockIdx.x * 8 + wave, ngw = gridDim.x * 8;
        constexpr int I_IN = 16 * 40, I_OUT = 16 * 32, I_G = 16 * 88, I_D = 44 * 32, I_P = 4 * 8;
        constexpr int PER_L = I_IN + I_OUT + 2 * I_G + I_D + I_P;
        for (int it = gw; it < DEPTH * PER_L; it += ngw) {
            const int l = it / PER_L; int r = it % PER_L;
            unsigned char* wl = ws + WS_W + (size_t)l * W_LAYER;
            if (r < I_IN) { const int kb = r / 40, nb = r % 40; transpose_item(a.w_in + (size_t)l * DM * INW, DM, INW, (bf16*)(wl + W_IN), 32 * nb, scr, 64 * kb, 32 * nb, lane); continue; } r -= I_IN;
            if (r < I_OUT) { const int kb = r / 32, nb = r % 32; transpose_item(a.w_out + (size_t)l * DM * DM, DM, DM, (bf16*)(wl + W_OUT), 32 * nb, scr, 64 * kb, 32 * nb, lane); continue; } r -= I_OUT;
            if (r < 2 * I_G) { const int up = r >= I_G; if (up) r -= I_G; const int kb = r / 88, nb = r % 88, n0 = 32 * nb;
                transpose_item((up ? a.w_up : a.w_gate) + (size_t)l * DM * DFF, DM, DFF, (bf16*)(wl + W_GU), 256 * (n0 >> 7) + (n0 & 127) + (up ? 128 : 0), scr, 64 * kb, n0, lane, up ? -0.6931471805599453f : -1.4426950408889634f); continue; } r -= 2 * I_G;
            if (r < I_D) { const int kb = r / 32, nb = r % 32; transpose_item(a.w_down + (size_t)l * DFF * DM, DFF, DM, (bf16*)(wl + W_DN), 32 * nb, scr, 64 * kb, 32 * nb, lane); continue; } r -= I_D;
            { const int gi = r / 8, q = r % 8, kb = q / 4, nb = q % 4;
              transpose_item(a.pool_w + ((size_t)l * 4 + gi) * 128 * 128, 128, 128, (bf16*)(wl + W_PW) + (size_t)gi * 128 * 128, 32 * nb, scr, 64 * kb, 32 * nb, lane); }
        }
    }
}

__device__ __forceinline__ float mod_val(const Args& a, int l, int b, int idx, int col) {
    const float* modp = (const float*)(a.ws + WS_MODP);
    const int n = idx * DM + col;
    float s = a.ada_b[l * NMODW + n];
#pragma unroll
    for (int kc = 0; kc < KCH; ++kc) s += modp[((size_t)(l * KCH + kc) * 8 + b) * NMODW + n];
    return s;
}
__device__ __forceinline__ float mod_fin(const Args& a, int l, int b, int idx, int col) {
    return ((const float*)(a.ws + WS_MODF))[((size_t)(l * 8 + b)) * NMODW + idx * DM + col];
}
__device__ __forceinline__ void mod_finalize(const Args& a) {
    float* modf = (float*)(a.ws + WS_MODF);
    for (int i = blockIdx.x * 512 + threadIdx.x; i < DEPTH * 8 * NMODW; i += gridDim.x * 512) {
        const int l = i / (8 * NMODW), r = i % (8 * NMODW), b = r / NMODW, n = r % NMODW;
        modf[i] = mod_val(a, l, b, n / DM, n % DM);
    }
}
__device__ __forceinline__ void unpack8(const v4u w, float (&f)[8]) {
#pragma unroll
    for (int e = 0; e < 4; ++e) { f[2 * e] = bf_lo(w[e]); f[2 * e + 1] = bf_hi(w[e]); }
}
__device__ __forceinline__ v4u pack8(const float (&f)[8]) { return (v4u){pk2(f[0], f[1]), pk2(f[2], f[3]), pk2(f[4], f[5]), pk2(f[6], f[7])}; }
__device__ __forceinline__ void rowwise_phase(const Args& a, LAS unsigned char* lds, bool from_partials, bool has_y, bool has_h, bool xin_bf, int xout_mode,
        const void* xin, const bf16* y, float* xout, bf16* xoutb, bf16* hout,
        int l_y, int gate_idx, const float* g_post, int l_h, int shift_idx, int scale_idx, const float* g_pre) {
    int tid_ = threadIdx.x; asm volatile("" : "+v"(tid_)); const int tid = tid_, lane = tid & 63, wave = tid >> 6;
    LAS float* vec = (LAS float*)lds;
    for (int tile = blockIdx.x; tile < T / 256; tile += gridDim.x) {
        const int b = tile / (SEQ / 256);
        __syncthreads();
        for (int col = tid; col < DM; col += 512) {
            if (from_partials) {
                if (has_y) vec[col] = mod_val(a, l_y, b, gate_idx, col) * g_post[col];
                if (has_h) { vec[DM + col] = g_pre[col] * (1.0f + mod_val(a, l_h, b, scale_idx, col)); vec[2 * DM + col] = mod_val(a, l_h, b, shift_idx, col); }
            } else {
                if (has_y) vec[col] = mod_fin(a, l_y, b, gate_idx, col) * g_post[col];
                if (has_h) { vec[DM + col] = g_pre[col] * (1.0f + mod_fin(a, l_h, b, scale_idx, col)); vec[2 * DM + col] = mod_fin(a, l_h, b, shift_idx, col); }
            }
        }
        __syncthreads();
#pragma unroll 1
        for (int r = wave * 4; r < 256; r += 32) {
            float v[4][2][8]; v4u yv[4][2];
#pragma unroll
            for (int h = 0; h < 4; ++h)
#pragma unroll
                for (int j = 0; j < 2; ++j) { const size_t off = ((size_t)tile * 256 + r + h) * DM + 8 * lane + 512 * j;
                    if (xin_bf) unpack8(__builtin_nontemporal_load((const v4u*)((const bf16*)xin + off)), v[h][j]);
                    else { const f32x4 p0 = __builtin_nontemporal_load((const f32x4*)((const float*)xin + off)), p1 = __builtin_nontemporal_load((const f32x4*)((const float*)xin + off + 4));
                        v[h][j][0] = p0.x; v[h][j][1] = p0.y; v[h][j][2] = p0.z; v[h][j][3] = p0.w; v[h][j][4] = p1.x; v[h][j][5] = p1.y; v[h][j][6] = p1.z; v[h][j][7] = p1.w; }
                    yv[h][j] = has_y ? __builtin_nontemporal_load((const v4u*)(y + off)) : (v4u){0u, 0u, 0u, 0u}; }
            if (has_y) {
                float rstd[4];
#pragma unroll
                for (int h = 0; h < 4; ++h) { float ss = 0.f;
#pragma unroll
                    for (int j = 0; j < 2; ++j) { float yf[8]; unpack8(yv[h][j], yf);
#pragma unroll
                        for (int e = 0; e < 8; ++e) ss += yf[e] * yf[e]; }
                    rstd[h] = __builtin_amdgcn_rsqf(wave_sum(ss) * (1.0f / DM) + EPS); }
#pragma unroll
                for (int j = 0; j < 2; ++j) { const LAS float* gpp = vec + 8 * lane + 512 * j; const f32x4 g0 = *(const LAS f32x4*)gpp, g1 = *(const LAS f32x4*)(gpp + 4);
                    const float gp[8] = {g0.x, g0.y, g0.z, g0.w, g1.x, g1.y, g1.z, g1.w};
#pragma unroll
                    for (int h = 0; h < 4; ++h) { float yf[8]; unpack8(yv[h][j], yf);
#pragma unroll
                        for (int e = 0; e < 8; ++e) v[h][j][e] += gp[e] * (yf[e] * rstd[h]); } }
            }
            if (xout_mode == 1) {
#pragma unroll
                for (int h = 0; h < 4; ++h)
#pragma unroll
                    for (int j = 0; j < 2; ++j) { float* o = xout + ((size_t)tile * 256 + r + h) * DM + 8 * lane + 512 * j;
                        __builtin_nontemporal_store((f32x4){v[h][j][0], v[h][j][1], v[h][j][2], v[h][j][3]}, (f32x4*)o); __builtin_nontemporal_store((f32x4){v[h][j][4], v[h][j][5], v[h][j][6], v[h][j][7]}, (f32x4*)(o + 4)); }
            } else if (xout_mode == 2) {
#pragma unroll
                for (int h = 0; h < 4; ++h)
#pragma unroll
                    for (int j = 0; j < 2; ++j) { const v4u w = pack8(v[h][j]);
                        __builtin_nontemporal_store(w, (v4u*)(xoutb + ((size_t)tile * 256 + r + h) * DM + 8 * lane + 512 * j));
                        unpack8(w, v[h][j]); }
            }
            if (has_h) {
                float rstd[4];
#pragma unroll
                for (int h = 0; h < 4; ++h) { float ss = 0.f;
#pragma unroll
                    for (int j = 0; j < 2; ++j)
#pragma unroll
                        for (int e = 0; e < 8; ++e) ss += v[h][j][e] * v[h][j][e];
                    rstd[h] = __builtin_amdgcn_rsqf(wave_sum(ss) * (1.0f / DM) + EPS); }
#pragma unroll
                for (int j = 0; j < 2; ++j) { const LAS float* gsp = vec + DM + 8 * lane + 512 * j; const LAS float* shp = vec + 2 * DM + 8 * lane + 512 * j;
                    const f32x4 a0 = *(const LAS f32x4*)gsp, a1 = *(const LAS f32x4*)(gsp + 4), b0 = *(const LAS f32x4*)shp, b1 = *(const LAS f32x4*)(shp + 4);
                    const float gs[8] = {a0.x, a0.y, a0.z, a0.w, a1.x, a1.y, a1.z, a1.w}, sh[8] = {b0.x, b0.y, b0.z, b0.w, b1.x, b1.y, b1.z, b1.w};
#pragma unroll
                    for (int h = 0; h < 4; ++h) { float hv[8];
#pragma unroll
                        for (int e = 0; e < 8; ++e) hv[e] = v[h][j][e] * rstd[h] * gs[e] + sh[e];
                        *(v4u*)(hout + ((size_t)tile * 256 + r + h) * DM + 8 * lane + 512 * j) = pack8(hv); } }
            }
        }
    }
}

__device__ __forceinline__ void attn_phase(LAS unsigned char* lds, const bf16* PROJ, bf16* CONCAT, const float* sinks) {
    int tid_ = threadIdx.x; asm volatile("" : "+v"(tid_)); const int tid = tid_, lane = tid & 63, wave = tid >> 6, fr = lane & 15, fq = lane >> 4;
    LAS bf16* Ks = (LAS bf16*)lds;
    LAS bf16* Vt = (LAS bf16*)(lds + 36864);
    v4u kv[4], vv[4];
#define ATT_LOAD_KV(uu) do { const int kh_ = (uu) & 1, n_ = ((uu) >> 1) & 63, b_ = (uu) >> 7; const long rb_ = (long)b_ * SEQ + n_ * 128 - 128; \
        _Pragma("unroll") for (int i = 0; i < 4; ++i) { const int kj = lane + 64 * i; kv[i] = (v4u){0u, 0u, 0u, 0u}; vv[i] = (v4u){0u, 0u, 0u, 0u}; \
            if (n_ > 0 || kj >= 128) { const bf16* p = PROJ + (size_t)(rb_ + kj) * INW + kh_ * 64 + wave * 8; kv[i] = *(const v4u*)(p + 512); vv[i] = *(const v4u*)(p + 640); } } } while (0)
    if ((int)blockIdx.x < NB * 64 * 2) ATT_LOAD_KV((int)blockIdx.x);
    for (int u = blockIdx.x; u < NB * 64 * 2; u += gridDim.x) {
        const int kh = u & 1, n = (u >> 1) & 63, b = u >> 7;
        const int g = wave >> 1, h = kh * 4 + g;
        const size_t qrow0 = (size_t)b * SEQ + n * 128 + (wave & 1) * 64 + fr;
        bf16x8 qf[4][2];
#pragma unroll
        for (int i = 0; i < 4; ++i) { const bf16* qp = PROJ + (qrow0 + 16 * i) * INW + h * 64 + 8 * fq; qf[i][0] = __builtin_nontemporal_load((const bf16x8*)qp); qf[i][1] = __builtin_nontemporal_load((const bf16x8*)(qp + 32)); }
#pragma unroll
        for (int i = 0; i < 4; ++i) { const int kj = lane + 64 * i;
            *(LAS v4u*)(Ks + kj * 72 + wave * 8) = kv[i];
#pragma unroll
            for (int e = 0; e < 4; ++e) { Vt[(wave * 8 + 2 * e) * 272 + kj] = (bf16)(vv[i][e] & 0xffffu); Vt[(wave * 8 + 2 * e + 1) * 272 + kj] = (bf16)(vv[i][e] >> 16); } }
        __syncthreads();
        if (u + (int)gridDim.x < NB * 64 * 2) ATT_LOAD_KV(u + (int)gridDim.x);
        const float sink = sinks[h];
        const int firstblk = (n == 0);
#pragma unroll
        for (int p = 0; p < 2; ++p) {
            const int q16a = (wave & 1) * 4 + 2 * p, kt0 = q16a;
            f32x4 st[2][10];
#pragma unroll
            for (int t = 0; t < 10; ++t) {
                const LAS bf16* kp = Ks + (16 * (kt0 + t) + fr) * 72 + 8 * fq;
                const bf16x8 k0 = *(const LAS bf16x8*)kp, k1 = *(const LAS bf16x8*)(kp + 32);
#pragma unroll
                for (int x = 0; x < 2; ++x) {
                    if (x + 8 - t == 9 || x + 8 - t == -1) { st[x][t] = (f32x4){-1e30f, -1e30f, -1e30f, -1e30f}; continue; }
                    f32x4 acc = (f32x4){0.f, 0.f, 0.f, 0.f};
                    acc = __builtin_amdgcn_mfma_f32_16x16x32_bf16(k0, qf[2 * p + x][0], acc, 0, 0, 0);
                    acc = __builtin_amdgcn_mfma_f32_16x16x32_bf16(k1, qf[2 * p + x][1], acc, 0, 0, 0);
                    st[x][t] = acc;
                }
            }
            float inv[2];
#pragma unroll
            for (int x = 0; x < 2; ++x) {
                float mx = -1e30f;
#pragma unroll
                for (int t = 0; t < 10; ++t) {
                    const int D = x + 8 - t;
                    if (D == 9 || D == -1) continue;
                    const bool tile_off = firstblk && (kt0 + t < 8);
#pragma unroll
                    for (int r = 0; r < 4; ++r) { const int dl = fr - 4 * fq - r;
                        bool valid = !tile_off;
                        if (D == 8) valid = valid && (dl < 0);
                        if (D == 0) valid = valid && (dl >= 0);
                        const float sv = valid ? st[x][t][r] : -1e30f; st[x][t][r] = sv; mx = fmaxf(mx, sv); }
                }
                mx = fmaxf(mx, __shfl_xor(mx, 16)); mx = fmaxf(mx, __shfl_xor(mx, 32)); mx = fmaxf(mx, sink);
                const float mb = mx * LOG2E;
                float lsum = 0.f;
#pragma unroll
                for (int t = 0; t < 10; ++t) {
                    const int D = x + 8 - t;
                    if (D == 9 || D == -1) { st[x][t] = (f32x4){0.f, 0.f, 0.f, 0.f}; continue; }
#pragma unroll
                    for (int r = 0; r < 4; ++r) { const float pe = __builtin_amdgcn_exp2f(st[x][t][r] * LOG2E - mb); st[x][t][r] = pe; lsum += pe; }
                }
                lsum += __shfl_xor(lsum, 16); lsum += __shfl_xor(lsum, 32); lsum += __builtin_amdgcn_exp2f(sink * LOG2E - mb);
                inv[x] = 1.0f / lsum;
            }
            f32x4 ot[2][4];
#pragma unroll
            for (int x = 0; x < 2; ++x)
#pragma unroll
                for (int dt = 0; dt < 4; ++dt) ot[x][dt] = (f32x4){0.f, 0.f, 0.f, 0.f};
#pragma unroll
            for (int s2 = 0; s2 < 5; ++s2) {
                bf16x8 pf[2];
#pragma unroll
                for (int x = 0; x < 2; ++x) { v4u pw; pw.x = pk2(st[x][2 * s2][0], st[x][2 * s2][1]); pw.y = pk2(st[x][2 * s2][2], st[x][2 * s2][3]);
                    pw.z = pk2(st[x][2 * s2 + 1][0], st[x][2 * s2 + 1][1]); pw.w = pk2(st[x][2 * s2 + 1][2], st[x][2 * s2 + 1][3]); pf[x] = __builtin_bit_cast(bf16x8, pw); }
#pragma unroll
                for (int dt = 0; dt < 4; ++dt) {
                    const LAS bf16* vp = Vt + (16 * dt + fr) * 272 + 16 * (kt0 + 2 * s2) + 4 * fq;
                    const v2u lo = *(const LAS v2u*)vp, hi = *(const LAS v2u*)(vp + 16);
                    const bf16x8 vf = __builtin_bit_cast(bf16x8, (v4u){lo.x, lo.y, hi.x, hi.y});
#pragma unroll
                    for (int x = 0; x < 2; ++x) ot[x][dt] = __builtin_amdgcn_mfma_f32_16x16x32_bf16(vf, pf[x], ot[x][dt], 0, 0, 0);
                }
            }
#pragma unroll
            for (int x = 0; x < 2; ++x) {
                bf16* op = CONCAT + (qrow0 + 16 * (2 * p + x)) * DM + h * 64 + 4 * fq;
#pragma unroll
                for (int dt = 0; dt < 4; ++dt) *(v2u*)(op + 16 * dt) = (v2u){pk2(ot[x][dt][0] * inv[x], ot[x][dt][1] * inv[x]), pk2(ot[x][dt][2] * inv[x], ot[x][dt][3] * inv[x])};
            }
        }
        __syncthreads();
    }
#undef ATT_LOAD_KV
}

constexpr int PL_US = 136;
template <int W> __device__ __forceinline__ void pool_load(const bf16* PROJ, int gi, int tt, int lane, v4u (&raw)[8]) {
    const size_t t0 = (size_t)tt * 16; const int s0 = (int)(t0 & (SEQ - 1));
    const int ch = lane & 15, rs = lane >> 4;
#pragma unroll
    for (int i = 0; i < 8; ++i) { const int r = rs + 4 * i;
        raw[i] = (v4u){0u, 0u, 0u, 0u};
        if (4 * i + 3 >= 17 - W) { if (s0 - 16 + r >= 0) raw[i] = *(const v4u*)(PROJ + (t0 - 16 + r) * INW + 768 + gi * 128 + ch * 8); } }
}
template <int W> __device__ __forceinline__ void pool_compute(bf16* CONCAT, const LAS bf16* wl, LAS bf16* ust, const float* pscale, int gi, int tt, int lane, const v4u (&raw)[8]) {
    const int fr = lane & 15, fq = lane >> 4;
    const size_t t0 = (size_t)tt * 16; const int s0 = (int)(t0 & (SEQ - 1));
    {
        const int ch = lane & 15, rs = lane >> 4;
#pragma unroll
        for (int i = 0; i < 8; ++i) { const int r = rs + 4 * i; if (4 * i + 3 >= 17 - W) *(LAS v4u*)(ust + r * PL_US + ch * 8) = raw[i]; }
    }
    const int s = s0 + fr;
    const float invc = 1.0f / (float)((s + 1 < W) ? (s + 1) : W);
    bf16x8 pf[4];
#pragma unroll
    for (int ks = 0; ks < 4; ++ks) {
        const LAS bf16* up = ust + (16 + fr) * PL_US + 32 * ks + 8 * fq;
        float sum[8];
        const v4u cur = *(const LAS v4u*)up;
#pragma unroll
        for (int e = 0; e < 4; ++e) { sum[2 * e] = bf_lo(cur[e]); sum[2 * e + 1] = bf_hi(cur[e]); }
#pragma unroll
        for (int j = 1; j < W; ++j) { const v4u rw = *(const LAS v4u*)(up - j * PL_US);
#pragma unroll
            for (int e = 0; e < 4; ++e) { sum[2 * e] += bf_lo(rw[e]); sum[2 * e + 1] += bf_hi(rw[e]); } }
        v4u o;
#pragma unroll
        for (int e = 0; e < 4; ++e) o[e] = pk2(sum[2 * e] * invc - bf_lo(cur[e]), sum[2 * e + 1] * invc - bf_hi(cur[e]));
        pf[ks] = __builtin_bit_cast(bf16x8, o);
    }
    const size_t R = t0 + fr;
#pragma unroll
    for (int nt = 0; nt < 8; ++nt) {
        f32x4 acc = (f32x4){0.f, 0.f, 0.f, 0.f};
        const LAS bf16* wp = wl + (16 * nt + fr) * PL_US + 8 * fq;
#pragma unroll
        for (int ks = 0; ks < 4; ++ks) acc = __builtin_amdgcn_mfma_f32_16x16x32_bf16(*(const LAS bf16x8*)(wp + 32 * ks), pf[ks], acc, 0, 0, 0);
        const int d = gi * 128 + 16 * nt + 4 * fq;
        const f32x4 sc = *(const f32x4*)(pscale + d);
        *(v2u*)(CONCAT + R * DM + 512 + d) = (v2u){pk2(acc[0] * sc.x, acc[1] * sc.y), pk2(acc[2] * sc.z, acc[3] * sc.w)};
    }
}
template <int W> __device__ __forceinline__ void pool_group(const bf16* PROJ, bf16* CONCAT, const LAS bf16* wl, LAS bf16* ust, const float* pscale, int gi, int gw, int ngw, int lane) {
    v4u ra[8], rb[8];
    int tt = gw;
    if (tt < T / 16) pool_load<W>(PROJ, gi, tt, lane, ra);
    while (tt < T / 16) {
        const int tn = tt + ngw;
        if (tn < T / 16) pool_load<W>(PROJ, gi, tn, lane, rb);
        pool_compute<W>(CONCAT, wl, ust, pscale, gi, tt, lane, ra);
        tt = tn;
        if (tt >= T / 16) break;
        const int tn2 = tt + ngw;
        if (tn2 < T / 16) pool_load<W>(PROJ, gi, tn2, lane, ra);
        pool_compute<W>(CONCAT, wl, ust, pscale, gi, tt, lane, rb);
        tt = tn2;
    }
}
__device__ __forceinline__ void pool_phase(LAS unsigned char* lds, const bf16* PROJ, bf16* CONCAT, const bf16* PWT, const float* pscale) {
    int tid_ = threadIdx.x; asm volatile("" : "+v"(tid_)); const int tid = tid_, lane = tid & 63, wave = tid >> 6;
    LAS bf16* wl = (LAS bf16*)lds;
    LAS bf16* ust = (LAS bf16*)(lds + 36864 + wave * 8704);
    const int gw = blockIdx.x * 8 + wave, ngw = gridDim.x * 8;
#pragma unroll 1
    for (int gi = 0; gi < 4; ++gi) {
        __syncthreads();
        { const int row = tid >> 2, q = tid & 3; const bf16* src = PWT + ((size_t)gi * 128 + row) * 128 + q * 32;
#pragma unroll
          for (int e = 0; e < 4; ++e) *(LAS v4u*)(wl + row * PL_US + q * 32 + e * 8) = *(const v4u*)(src + e * 8); }
        __syncthreads();
        if (gi == 0) pool_group<2>(PROJ, CONCAT, wl, ust, pscale, gi, gw, ngw, lane);
        else if (gi == 1) pool_group<4>(PROJ, CONCAT, wl, ust, pscale, gi, gw, ngw, lane);
        else if (gi == 2) pool_group<8>(PROJ, CONCAT, wl, ust, pscale, gi, gw, ngw, lane);
        else pool_group<16>(PROJ, CONCAT, wl, ust, pscale, gi, gw, ngw, lane);
    }
    __syncthreads();
}

#ifndef REP_P
#define REP_P 1
#endif
#ifndef REP_G
#define REP_G 1
#endif
#ifndef REP_R
#define REP_R 1
#endif
#ifndef REP_G
#define REP_G 1
#endif
#ifndef REP_IN
#define REP_IN REP_G
#endif
#ifndef REP_GU
#define REP_GU REP_G
#endif
#ifndef REP_DN
#define REP_DN REP_G
#endif
#ifndef REP_PL
#define REP_PL 1
#endif
#ifndef REP_A
#define REP_A 1
#endif
__global__ void __launch_bounds__(512, 2) fwd_kernel(Args a) {
    extern __shared__ __attribute__((aligned(16))) unsigned char lds_raw[];
    cg::grid_group grid = cg::this_grid();
    LAS unsigned char* lds = (LAS unsigned char*)lds_raw;
    unsigned char* ws = a.ws;
    bf16* H = (bf16*)(ws + WS_H); bf16* MIX = (bf16*)(ws + WS_MIX); bf16* PROJ = (bf16*)(ws + WS_PROJ);
    bf16* CONCAT = (bf16*)(ws + WS_CONCAT); bf16* ACT = (bf16*)(ws + WS_ACT);
    const float* cs = (const float*)(ws + WS_CS); bf16* XA = (bf16*)(ws + WS_XA); bf16* XB = (bf16*)(ws + WS_XB);
    volatile LAS unsigned* MISC = (volatile LAS unsigned*)(lds + RING_BYTES + 64);
    if (threadIdx.x == 0) { MISC[0] = 0u; MISC[1] = 0u; }
    __syncthreads();
    XcdBarrier bar = xcd_barrier_post((unsigned*)ws, MISC);
#define SEAM() xcd_barrier(bar)

    for (int rep = 0; rep < REP_P; ++rep) prologue(a, lds);
    if (a.ws == nullptr) grid.sync();
    SEAM();
    for (int rep = 0; rep < REP_R; ++rep) rowwise_phase(a, lds, true, false, true, false, 2, a.x, nullptr, nullptr, XB, H, 0, 0, nullptr, 0, 0, 1, a.g_pre_mix);
    mod_finalize(a);
    SEAM();
#pragma unroll 1
    for (int l = 0; l < DEPTH; ++l) {
        unsigned char* wl = ws + WS_W + (size_t)l * W_LAYER;
        for (int rep = 0; rep < REP_IN; ++rep) {
            pg8::Gemm g{H, (const bf16*)(wl + W_IN), T, INW, DM}; pg8::StaticOrder S; S.init(T, INW, gridDim.x, blockIdx.x);
            pg8::EpiInProj E{PROJ, a.b_in + l * INW, cs};
            pg8::gemm_phase<pg8::EpiInProj, pg8::StaticOrder, true, true>(lds, g, S, E);
        }
        SEAM();
        for (int rep = 0; rep < REP_A; ++rep) attn_phase(lds, PROJ, CONCAT, a.sinks + l * 8);
        for (int rep = 0; rep < REP_PL; ++rep) pool_phase(lds, PROJ, CONCAT, (const bf16*)(wl + W_PW), a.pool_scale + l * 512);
        SEAM();
        for (int rep = 0; rep < REP_G; ++rep) {
            pg8::Gemm g{CONCAT, (const bf16*)(wl + W_OUT), T, DM, DM}; pg8::StaticOrder S; S.init(T, DM, gridDim.x, blockIdx.x);
            pg8::EpiBf16<0> E{MIX, DM, nullptr, 0, 0, 1.f};
            pg8::gemm_phase<pg8::EpiBf16<0>, pg8::StaticOrder, true, true>(lds, g, S, E);
        }
        SEAM();
        for (int rep = 0; rep < REP_R; ++rep) rowwise_phase(a, lds, false, true, true, true, 2, XB, MIX, nullptr, XA, H, l, 2, a.g_post_mix + l * DM, l, 3, 4, a.g_pre_ffn + l * DM);
        SEAM();
#if defined(PROBE_HOT)
#pragma unroll 1
        for (int rep = 0; rep < 2; ++rep) {
            pg8::Gemm g{H, (const bf16*)(wl + W_GU), T, 2 * DFF, rep == 0 ? PROBE_HOT_K : DM}; pg8::DualOrder S; S.so.init(T, 2 * DFF, gridDim.x, blockIdx.x); S.c = blockIdx.x; S.rounds = 22; S.hot = (rep == 0);
            pg8::EpiSwiGLU E{rep == 0 ? MIX : ACT};
            pg8::gemm_phase<pg8::EpiSwiGLU, pg8::DualOrder, true, true>(lds, g, S, E);
            if (rep == 0) SEAM();
        }
#else
        for (int rep = 0; rep < REP_GU; ++rep) {
            pg8::Gemm g{H, (const bf16*)(wl + W_GU), T, 2 * DFF, DM}; pg8::StaticOrder S; S.init(T, 2 * DFF, gridDim.x, blockIdx.x);
            pg8::EpiSwiGLU E{ACT};
            pg8::gemm_phase<pg8::EpiSwiGLU, pg8::StaticOrder, true, true>(lds, g, S, E);
        }
#endif
        SEAM();
        for (int rep = 0; rep < REP_DN; ++rep) {
            pg8::Gemm g{ACT, (const bf16*)(wl + W_DN), T, DM, DFF}; pg8::StaticOrder S; S.init(T, DM, gridDim.x, blockIdx.x);
            pg8::EpiBf16<0> E{MIX, DM, nullptr, 0, 0, 1.f};
            pg8::gemm_phase<pg8::EpiBf16<0>, pg8::StaticOrder, true, true>(lds, g, S, E);
        }
        SEAM();
        const bool more = (l + 1 < DEPTH);
        for (int rep = 0; rep < REP_R; ++rep) rowwise_phase(a, lds, false, true, more, true, more ? 2 : 1, XA, MIX, a.out, XB, H, l, 5, a.g_post_ffn + l * DM, l + 1, 0, 1, a.g_pre_mix + (more ? (l + 1) * DM : 0));
        if (more) SEAM();
    }
}

extern "C" void kernel_launch(void* const* d_in, const int* in_sizes, int n_in, void* d_out, int out_size, void* d_ws, size_t ws_size, hipStream_t stream) {
    static int grid_blocks = 0;
    if (grid_blocks == 0) {
        if (n_in != 18 || out_size != T * DM || ws_size < WS_END) { fprintf(stderr, "kernel_launch: unexpected shapes (n_in %d, out %d, ws %zu)\n", n_in, out_size, ws_size); grid_blocks = -1; return; }
        int dev = 0, cus = 0, per_cu = 0;
        hipGetDevice(&dev);
        hipDeviceGetAttribute(&cus, hipDeviceAttributeMultiprocessorCount, dev);
        if (hipFuncSetAttribute((const void*)fwd_kernel, hipFuncAttributeMaxDynamicSharedMemorySize, LDS_BYTES) != hipSuccess) { fprintf(stderr, "kernel_launch: hipFuncSetAttribute failed\n"); grid_blocks = -1; return; }
        if (hipOccupancyMaxActiveBlocksPerMultiprocessor(&per_cu, (const void*)fwd_kernel, 512, LDS_BYTES) != hipSuccess || per_cu < 1) { fprintf(stderr, "kernel_launch: occupancy query gave %d\n", per_cu); per_cu = 1; }
        (void)hipGetLastError();
        grid_blocks = cus * per_cu;
    }
    if (grid_blocks < 0) return;
    if (hipMemsetAsync(d_ws, 0, 65536, stream) != hipSuccess) { fprintf(stderr, "kernel_launch: memset failed\n"); return; }
    Args a{};
    a.x = (const float*)d_in[0]; a.c = (const float*)d_in[1]; a.pos = (const int*)d_in[2]; a.ada_w = (const float*)d_in[3]; a.ada_b = (const float*)d_in[4];
    a.w_in = (const float*)d_in[5]; a.b_in = (const float*)d_in[6]; a.sinks = (const float*)d_in[7]; a.pool_w = (const float*)d_in[8]; a.pool_scale = (const float*)d_in[9];
    a.w_out = (const float*)d_in[10]; a.w_gate = (const float*)d_in[11]; a.w_up = (const float*)d_in[12]; a.w_down = (const float*)d_in[13];
    a.g_pre_mix = (const float*)d_in[14]; a.g_post_mix = (const float*)d_in[15]; a.g_pre_ffn = (const float*)d_in[16]; a.g_post_ffn = (const float*)d_in[17];
    a.out = (float*)d_out; a.ws = (unsigned char*)d_ws;
    void* args[] = {&a};
    hipError_t e = hipLaunchCooperativeKernel((const void*)fwd_kernel, dim3(grid_blocks), dim3(512), args, LDS_BYTES, stream);
    if (e != hipSuccess) fprintf(stderr, "cooperative launch failed: %s (grid %d)\n", hipGetErrorString(e), grid_blocks);
}
```

```cpp
#include <hip/hip_runtime.h>
#include <hip/hip_cooperative_groups.h>
#include <cstdio>
#include <cstdint>
namespace cg = cooperative_groups;
#define LAS __attribute__((address_space(3)))
namespace pg8 {
#define PG8_LAS __attribute__((address_space(3)))
typedef unsigned short bf16_t;
typedef short bf16x8 __attribute__((ext_vector_type(8)));
typedef float f32x4 __attribute__((ext_vector_type(4)));
typedef unsigned u32x4 __attribute__((ext_vector_type(4)));
constexpr int BM = 256, BK = 64, HALF = 128, HTB = HALF * BK * 2  , STAGE_BYTES = 8 * HTB, NXCD = 8, WGM = 8;

__host__ __device__ __forceinline__ int lds_byte(int r, int c) { const int st = (r >> 4) * 2 + (c >> 5), rr = r & 15, cc = c & 31, ob = rr * 64 + cc * 2; return st * 1024 + (ob ^ (((ob >> 9) & 1) << 5)); }
__host__ __device__ __forceinline__ void stage_rc(int b, int& R, int& C) { const int st = b / 1024, sb = b % 1024, swz = sb ^ (((sb >> 9) & 1) << 5); R = (st >> 1) * 16 + swz / 64; C = (st & 1) * 32 + (swz % 64) / 2; }
__host__ __device__ __forceinline__ int perm32(int rho) { const int n = rho >> 4, i = rho & 15; return 8 * (i >> 2) + 4 * n + (i & 3); }

struct Unit { int pm, pn; };
struct Gemm { const bf16_t* A; const bf16_t* Bt; int M, N, K; };

struct StaticOrder {
    int nM, nN, nwg, G, c;
    __host__ __device__ void init(int M, int N, int G_, int c_) { nM = M / BM; nN = N / BM; nwg = nM * nN; G = G_; c = c_; }
    __host__ __device__ bool next(int i, Unit& u) const {
        const long L = (long)i * G + c; if (L >= nwg) return false;
        int wgid = (int)L; { const int q = nwg / NXCD, r = nwg % NXCD, xcd = wgid % NXCD, off = wgid / NXCD; wgid = (xcd < r ? xcd * (q + 1) : r * (q + 1) + (xcd - r) * q) + off; }
        const int nig = WGM * nN, gid = wgid / nig, fm = gid * WGM, gsz = (nM - fm) < WGM ? (nM - fm) : WGM;
        u.pm = fm + ((wgid % nig) % gsz); u.pn = (wgid % nig) / gsz; return true;
    }
    __device__ __forceinline__ void a_ready(const Unit&) const {}
    __device__ __forceinline__ void done(const Unit&) const {}
};

__device__ __forceinline__ unsigned cvt_pk_bf16(float lo, float hi) { unsigned r; asm volatile("v_cvt_pk_bf16_f32 %0, %1, %2" : "=v"(r) : "v"(lo), "v"(hi)); return r; }
typedef float f32x2 __attribute__((ext_vector_type(2)));
__device__ __forceinline__ f32x2 gelu_pk(f32x2 v) {
    const f32x2 av = __builtin_elementwise_abs(v), d = av * 0.2316418882f + 1.0f;
    f32x2 t; t.x = __builtin_amdgcn_rcpf(d.x); t.y = __builtin_amdgcn_rcpf(d.y);
    f32x2 q = t * 0.5307027145f + (-0.7265760135f); q = q * t + 0.7107068705f; q = q * t + (-0.142248368f); q = q * t + 0.127414796f; q = q * t;
    const f32x2 s = (v * v) * (-0.72134752044f);
    f32x2 e; e.x = __builtin_amdgcn_exp2f(s.x); e.y = __builtin_amdgcn_exp2f(s.y);
    const f32x2 m = v * (q * e), r = v - m;
    f32x2 o; o.x = v.x < 0.f ? m.x : r.x; o.y = v.y < 0.f ? m.y : r.y; return o;
}

template <int ACT  > struct EpiBf16 {
    static constexpr bool PERM = true, AFTER_DRAIN = false; static_assert(ACT == 0 || ACT == 1, "EpiBf16: ACT is 0 (none) or 1 (gelu_pk)");
    bf16_t* O; int ldc; const float* bias; int split_cols; size_t split_stride; float scale0;
    __device__ __forceinline__ void operator()(const f32x4 (&acc)[2][2][4][2], const Unit& u, int wr, int wc, int fr, int fq) const {
        const int row0 = u.pm * BM + wr * 64 + fr; int colt = u.pn * BM; bf16_t* base = O;
        float sc = 1.f; if (split_cols) { const int t = colt / split_cols; base += (size_t)t * split_stride; colt -= t * split_cols; if (t == 0) sc = scale0; }
        const int col0 = colt + wc * 32 + 8 * fq, bcol0 = u.pn * BM + wc * 32 + 8 * fq;
        f32x4 bv[2][2];
#pragma unroll
        for (int bj = 0; bj < 2; ++bj)
#pragma unroll
            for (int n = 0; n < 2; ++n) bv[bj][n] = bias ? *(const f32x4*)(bias + bcol0 + bj * HALF + 4 * n) : (f32x4){0.f, 0.f, 0.f, 0.f};
#pragma unroll
        for (int ai = 0; ai < 2; ++ai)
#pragma unroll
            for (int m = 0; m < 4; ++m) { bf16_t* rowp = base + (size_t)(row0 + ai * HALF + m * 16) * ldc + col0;
#pragma unroll
                for (int bj = 0; bj < 2; ++bj) { f32x4 v0 = acc[ai][bj][m][0] + bv[bj][0], v1 = acc[ai][bj][m][1] + bv[bj][1];
                    if (ACT == 1) { f32x2 a = gelu_pk((f32x2){v0[0], v0[1]}), b = gelu_pk((f32x2){v0[2], v0[3]}), c = gelu_pk((f32x2){v1[0], v1[1]}), d = gelu_pk((f32x2){v1[2], v1[3]});
                        v0 = (f32x4){a.x, a.y, b.x, b.y}; v1 = (f32x4){c.x, c.y, d.x, d.y}; }
                    v0 = v0 * sc; v1 = v1 * sc; u32x4 w; w.x = cvt_pk_bf16(v0[0], v0[1]); w.y = cvt_pk_bf16(v0[2], v0[3]); w.z = cvt_pk_bf16(v1[0], v1[1]); w.w = cvt_pk_bf16(v1[2], v1[3]);
                    *(u32x4*)(rowp + bj * HALF) = w; } }
    }
};
template <class Epi, class Sched, bool ALIGN_EPI = false, bool SP2 = false, int A_AUX = 0  >
__device__ __forceinline__ void gemm_phase(PG8_LAS unsigned char* lds, const Gemm g, const Sched& S, const Epi& E) {
    int tid_ = threadIdx.x; asm volatile("" : "+v"(tid_)); const int tid = tid_, wid = __builtin_amdgcn_readfirstlane(tid >> 6), lane = tid & 63, wr = wid >> 2, wc = wid & 3, fr = lane & 15, fq = lane >> 4;
    const int K = g.K, nt = K / BK;
    unsigned voffA[2], voffB[2];
#pragma unroll
    for (int i = 0; i < 2; ++i) { int R, C; stage_rc(tid * 16 + i * 8192, R, C); const int Rb = Epi::PERM ? ((R & ~31) + perm32(R & 31)) : R;
        voffA[i] = (unsigned)(R * K + C) * 2u; voffB[i] = (unsigned)(Rb * K + C) * 2u; }
    const size_t kstep = (size_t)(BK * 2);
    const size_t hstep = (size_t)HALF * K * 2;
    const size_t tstep = 2 * hstep;
    const unsigned ldsw = (unsigned)wid * 1024u;
    const int aoff = lds_byte(wr * 64 + fr, fq * 8), boff = lds_byte(wc * 32 + fr, fq * 8);
#define PG8_SA(b, h) (((b) * 2 + (h)) * HTB)
#define PG8_SB(b, h) ((4 + (b) * 2 + (h)) * HTB)
#define PG8_STAGE(bufoff, gbase, voff) do { _Pragma("unroll") for (int _i = 0; _i < 2; ++_i) \
        __builtin_amdgcn_global_load_lds((const unsigned*)((const char*)(gbase) + (voff)[_i]), (PG8_LAS unsigned*)(lds + (bufoff) + ldsw + _i * 8192), 16, 0, 0); } while (0)
#define PG8_STAGEA(bufoff, gbase, voff) do { _Pragma("unroll") for (int _i = 0; _i < 2; ++_i) \
        __builtin_amdgcn_global_load_lds((const unsigned*)((const char*)(gbase) + (voff)[_i]), (PG8_LAS unsigned*)(lds + (bufoff) + ldsw + _i * 8192), 16, 0, A_AUX); } while (0)
#define PG8_LDA(dst, b, h) do { _Pragma("unroll") for (int m = 0; m < 4; ++m) _Pragma("unroll") for (int k = 0; k < 2; ++k) dst[m][k] = *(const PG8_LAS bf16x8*)(lds + PG8_SA(b, h) + aoff + m * 2048 + k * 1024); } while (0)
#define PG8_LDB(dst, b, h) do { _Pragma("unroll") for (int n = 0; n < 2; ++n) _Pragma("unroll") for (int k = 0; k < 2; ++k) dst[n][k] = *(const PG8_LAS bf16x8*)(lds + PG8_SB(b, h) + boff + n * 2048 + k * 1024); } while (0)
#define PG8_MMA(ai, bj, At, Bt) do { __builtin_amdgcn_s_setprio(1); _Pragma("unroll") for (int m = 0; m < 4; ++m) _Pragma("unroll") for (int n = 0; n < 2; ++n) _Pragma("unroll") for (int k = 0; k < 2; ++k) \
        acc[ai][bj][m][n] = __builtin_amdgcn_mfma_f32_16x16x32_bf16(Bt[n][k], At[m][k], acc[ai][bj][m][n], 0, 0, 0); __builtin_amdgcn_s_setprio(0); } while (0)
#define PG8_WAIT_V(n) asm volatile("s_waitcnt vmcnt(" #n ")" ::: "memory")
#define PG8_WAIT_L(n) asm volatile("s_waitcnt lgkmcnt(" #n ")" ::: "memory")
#define PG8_BAR __builtin_amdgcn_s_barrier()
#define PG8_SCHED __builtin_amdgcn_sched_barrier(0)
    Unit cur, nxt; int ui = 0;
    if (!S.next(0, cur)) return;
    f32x4 acc[2][2][4][2];
#pragma unroll
    for (int a = 0; a < 2; ++a)
#pragma unroll
        for (int b = 0; b < 2; ++b)
#pragma unroll
            for (int m = 0; m < 4; ++m)
#pragma unroll
                for (int n = 0; n < 2; ++n) acc[a][b][m][n] = (f32x4){0.f, 0.f, 0.f, 0.f};
    bf16x8 At[4][2], B0[2][2], B1[2][2];
    const char* cA = (const char*)g.A + (size_t)cur.pm * tstep; const char* cB = (const char*)g.Bt + (size_t)cur.pn * tstep;
    S.a_ready(cur);
    if constexpr (SP2) {
        PG8_STAGE(PG8_SB(0, 0), cB, voffB); PG8_STAGE(PG8_SB(0, 1), cB + hstep, voffB); PG8_STAGEA(PG8_SA(0, 0), cA, voffA); PG8_STAGEA(PG8_SA(0, 1), cA + hstep, voffA);
        if (wr == 1) PG8_BAR;
        PG8_WAIT_V(2); PG8_BAR;
        PG8_STAGE(PG8_SB(1, 0), cB + kstep, voffB); PG8_STAGEA(PG8_SA(1, 0), cA + kstep, voffA); PG8_STAGE(PG8_SB(1, 1), cB + hstep + kstep, voffB);
        PG8_WAIT_V(6); PG8_BAR;
    } else {
        PG8_STAGE(PG8_SB(0, 0), cB, voffB); PG8_STAGEA(PG8_SA(0, 0), cA, voffA); PG8_STAGE(PG8_SB(0, 1), cB + hstep, voffB); PG8_STAGEA(PG8_SA(0, 1), cA + hstep, voffA);
        if (wr == 1) PG8_BAR;
        PG8_WAIT_V(4); PG8_BAR;
        PG8_STAGE(PG8_SB(1, 0), cB + kstep, voffB); PG8_STAGEA(PG8_SA(1, 0), cA + kstep, voffA); PG8_STAGE(PG8_SB(1, 1), cB + hstep + kstep, voffB);
        PG8_WAIT_V(6); PG8_BAR;
    }
    for (;;) {
        const bool has_next = S.next(ui + 1, nxt);
        const char* nA = has_next ? (const char*)g.A + (size_t)nxt.pm * tstep : cA; const char* nB = has_next ? (const char*)g.Bt + (size_t)nxt.pn * tstep : cB;
        for (int t = 0; t < nt; t += 2) {
            const bool last = (t == nt - 2);
            const char* a1 = cA + (size_t)(t + 1) * kstep;
            const char* a2 = last ? nA : cA + (size_t)(t + 2) * kstep; const char* b2 = last ? nB : cB + (size_t)(t + 2) * kstep;
            const char* a3 = a2 + kstep; const char* b3 = b2 + kstep;
            if (last && has_next) S.a_ready(nxt);
            if constexpr (SP2) {
            PG8_LDB(B0, 0, 0); PG8_LDB(B1, 0, 1); PG8_SCHED; PG8_LDA(At, 0, 0); PG8_STAGEA(PG8_SA(1, 1), a1 + hstep, voffA);
            PG8_WAIT_V(8); PG8_WAIT_L(0); PG8_BAR; PG8_MMA(0, 0, At, B0); PG8_MMA(0, 1, At, B1); PG8_BAR; PG8_SCHED;
            PG8_LDA(At, 0, 1); PG8_STAGE(PG8_SB(0, 0), b2, voffB); PG8_STAGE(PG8_SB(0, 1), b2 + hstep, voffB); PG8_STAGEA(PG8_SA(0, 0), a2, voffA);
            PG8_WAIT_V(8); PG8_WAIT_L(0); PG8_BAR; PG8_MMA(1, 0, At, B0); PG8_MMA(1, 1, At, B1); PG8_BAR; PG8_SCHED;
            PG8_LDB(B0, 1, 0); PG8_LDB(B1, 1, 1); PG8_SCHED; PG8_LDA(At, 1, 0); PG8_STAGEA(PG8_SA(0, 1), a2 + hstep, voffA);
            PG8_WAIT_V(8); PG8_WAIT_L(0); PG8_BAR; PG8_MMA(0, 0, At, B0); PG8_MMA(0, 1, At, B1); PG8_BAR; PG8_SCHED;
            PG8_LDA(At, 1, 1); PG8_STAGE(PG8_SB(1, 0), b3, voffB); PG8_STAGE(PG8_SB(1, 1), b3 + hstep, voffB); PG8_STAGEA(PG8_SA(1, 0), a3, voffA);
            PG8_WAIT_V(8); PG8_WAIT_L(0); PG8_BAR; PG8_MMA(1, 0, At, B0); PG8_MMA(1, 1, At, B1); PG8_BAR; PG8_SCHED;
            } else {
            PG8_LDB(B0, 0, 0); PG8_SCHED; PG8_LDA(At, 0, 0); PG8_STAGEA(PG8_SA(1, 1), a1 + hstep, voffA);
            PG8_WAIT_L(8); PG8_BAR; PG8_WAIT_L(0); PG8_MMA(0, 0, At, B0); PG8_BAR; PG8_SCHED;
            PG8_LDB(B1, 0, 1); PG8_STAGE(PG8_SB(0, 0), b2, voffB);
            PG8_BAR; PG8_WAIT_L(0); PG8_MMA(0, 1, At, B1); PG8_BAR;
            PG8_LDA(At, 0, 1); PG8_STAGEA(PG8_SA(0, 0), a2, voffA);
            PG8_BAR; PG8_WAIT_L(0); PG8_MMA(1, 0, At, B0); PG8_BAR; PG8_SCHED;
            PG8_STAGE(PG8_SB(0, 1), b2 + hstep, voffB);
            PG8_WAIT_V(6); PG8_BAR; PG8_MMA(1, 1, At, B1); PG8_BAR;
            PG8_LDB(B0, 1, 0); PG8_SCHED; PG8_LDA(At, 1, 0); PG8_STAGEA(PG8_SA(0, 1), a2 + hstep, voffA);
            PG8_WAIT_L(8); PG8_BAR; PG8_WAIT_L(0); PG8_MMA(0, 0, At, B0); PG8_BAR; PG8_SCHED;
            PG8_LDB(B1, 1, 1); PG8_STAGE(PG8_SB(1, 0), b3, voffB);
            PG8_BAR; PG8_WAIT_L(0); PG8_MMA(0, 1, At, B1); PG8_BAR;
            PG8_LDA(At, 1, 1); PG8_STAGEA(PG8_SA(1, 0), a3, voffA);
            PG8_BAR; PG8_WAIT_L(0); PG8_MMA(1, 0, At, B0); PG8_BAR; PG8_SCHED;
            PG8_STAGE(PG8_SB(1, 1), b3 + hstep, voffB);
            PG8_WAIT_V(6); PG8_BAR; PG8_MMA(1, 1, At, B1); PG8_BAR;
            }
        }
        if constexpr (ALIGN_EPI) { if (wr == 0) PG8_BAR; }
        if constexpr (!Epi::AFTER_DRAIN) { E(acc, cur, wr, wc, fr, fq); S.done(cur); }
        if (!has_next) break;
#pragma unroll
        for (int a = 0; a < 2; ++a)
#pragma unroll
            for (int b = 0; b < 2; ++b)
#pragma unroll
                for (int m = 0; m < 4; ++m)
#pragma unroll
                    for (int n = 0; n < 2; ++n) acc[a][b][m][n] = (f32x4){0.f, 0.f, 0.f, 0.f};
        cur = nxt; cA = nA; cB = nB; ++ui;
        if constexpr (ALIGN_EPI) { if (wr == 1) PG8_BAR; }
    }
    PG8_WAIT_V(0);
    if constexpr (!ALIGN_EPI) { if (wr == 0) PG8_BAR; }
    PG8_BAR;
    if constexpr (Epi::AFTER_DRAIN) { E.fused(acc, cur, wr, wc, fr, fq, lds, wid, lane); S.done(cur); }
#undef PG8_SA
#undef PG8_SB
#undef PG8_STAGE
#undef PG8_STAGEA
#undef PG8_LDA
#undef PG8_LDB
#undef PG8_MMA
#undef PG8_WAIT_V
#undef PG8_WAIT_L
#undef PG8_BAR
#undef PG8_SCHED
}
}
#define XB_TMO      128
#define XB_XCNT(j)  (256  + 64 * (j))
#define XB_XSUB(j)  (1280 + 64 * (j))
#define XB_XGEN(j)  (2304 + 64 * (j))
#define XB_TOP      3328
#define XB_TOPGEN   3392
#define XCD_BAR_WORDS 3456
#define XB_SPIN_CAP (1u << 18)

__device__ __forceinline__ unsigned xb_ld(unsigned* p)              { return __hip_atomic_load(p, __ATOMIC_RELAXED, __HIP_MEMORY_SCOPE_AGENT); }
__device__ __forceinline__ unsigned xb_add(unsigned* p, unsigned v) { return __hip_atomic_fetch_add(p, v, __ATOMIC_RELAXED, __HIP_MEMORY_SCOPE_AGENT); }
__device__ __forceinline__ unsigned xb_xcc_id() { return (unsigned)__builtin_amdgcn_s_getreg((3 << 11) | 20) & 0xFu; }
#define XB_SPIN(cond, bar) do { unsigned _sp = 0; while (cond) { __builtin_amdgcn_s_sleep(1); \
    if ((++_sp & 255u) == 0u) { if (xb_ld(&(bar)[XB_TMO])) break; if (_sp > XB_SPIN_CAP) { atomicAdd(&(bar)[XB_TMO], 1u); break; } } } } while (0)

struct XcdBarrier {
    unsigned* bar; unsigned x;
    volatile LAS unsigned* st;
};

__device__ __forceinline__ XcdBarrier xcd_barrier_post(unsigned* bar, volatile LAS unsigned* st) {
    XcdBarrier b; b.bar = bar; b.x = xb_xcc_id(); b.st = st;
    if (threadIdx.x == 0) (void)xb_add(&bar[XB_XCNT(b.x)], 1u);
    return b;
}
__device__ __forceinline__ void xcd_barrier_complete(unsigned* bar, unsigned x, unsigned& nloc, unsigned& nx) {
    const unsigned G = gridDim.x * gridDim.y * gridDim.z;
    unsigned sum, cnt, mine, sp = 0u;
    for (;;) {
        sum = 0u; cnt = 0u; mine = 0u;
#pragma unroll
        for (unsigned j = 0; j < 16; ++j) { const unsigned c = xb_ld(&bar[XB_XCNT(j)]); sum += c; cnt += (c > 0u) ? 1u : 0u; mine = (j == x) ? c : mine; }
        if (sum == G) break;
        __builtin_amdgcn_s_sleep(1);
        if ((++sp & 255u) == 0u) { if (xb_ld(&bar[XB_TMO])) break; if (sp > XB_SPIN_CAP) { atomicAdd(&bar[XB_TMO], 1u); break; } }
    }
    nloc = mine > 0u ? mine : 1u; nx = cnt > 0u ? cnt : 1u;
}

__device__ __forceinline__ void xcd_barrier(const XcdBarrier& b) {
    asm volatile("s_waitcnt vmcnt(0)" ::: "memory");
    __syncthreads();
    if (threadIdx.x == 0) {
        unsigned* bar = b.bar;
        __builtin_amdgcn_s_waitcnt(0);
        unsigned nloc = b.st[0], nx = b.st[1];
        if (nloc == 0u) { xcd_barrier_complete(bar, b.x, nloc, nx); b.st[0] = nloc; b.st[1] = nx; }
        const unsigned old = xb_add(&bar[XB_XSUB(b.x)], 1u);
        const unsigned gen = old / nloc;
        if (old + 1u == (gen + 1u) * nloc) {
            __builtin_amdgcn_fence(__ATOMIC_RELEASE, "agent");
            asm volatile("s_waitcnt vmcnt(0)" ::: "memory");
            const unsigned og = xb_add(&bar[XB_TOP], 1u);
            const unsigned tg = og / nx;
            if (og + 1u == (tg + 1u) * nx) xb_add(&bar[XB_TOPGEN], 1u);
            else XB_SPIN(xb_ld(&bar[XB_TOPGEN]) == tg, bar);
            __builtin_amdgcn_fence(__ATOMIC_ACQUIRE, "agent");
            xb_add(&bar[XB_XGEN(b.x)], 1u);
            asm volatile("s_waitcnt vmcnt(0)" ::: "memory");
        } else {
            XB_SPIN(xb_ld(&bar[XB_XGEN(b.x)]) == gen, bar);
            __builtin_amdgcn_fence(__ATOMIC_ACQUIRE, "agent");
            asm volatile("s_waitcnt vmcnt(0)" ::: "memory");
        }
    }
    __syncthreads();
}

constexpr int NB = 8, SEQ = 8192, DM = 1024, DEPTH = 2;
constexpr int T = NB * SEQ;
constexpr int INW = 1280, DFF = 2816, NMODW = 6 * DM;
constexpr int KCH = 32;
constexpr float EPS = 1e-6f;
constexpr float LOG2E = 1.4426950408889634f;

#define LAS __attribute__((address_space(3)))
typedef unsigned short bf16;
typedef unsigned v4u __attribute__((ext_vector_type(4)));
typedef unsigned v2u __attribute__((ext_vector_type(2)));
typedef float f32x4 __attribute__((ext_vector_type(4)));
typedef short bf16x8 __attribute__((ext_vector_type(8)));

constexpr size_t MiB = 1u << 20;
constexpr size_t WS_MODP = 640 * MiB;
constexpr size_t WS_MODF = 8 * MiB;
constexpr size_t WS_CS = 9 * MiB;
constexpr size_t WS_W = 16 * MiB, W_LAYER = 24 * MiB;
constexpr size_t W_IN = 0, W_OUT = 3 * MiB, W_GU = 5 * MiB, W_DN = 16 * MiB, W_PW = 22 * MiB;
constexpr size_t WS_H = 64 * MiB;
constexpr size_t WS_MIX = 192 * MiB;
constexpr size_t WS_PROJ = 320 * MiB;
constexpr size_t WS_CONCAT = 480 * MiB;
constexpr size_t WS_ACT = 320 * MiB;
constexpr size_t WS_XA = 672 * MiB;
constexpr size_t WS_XB = 800 * MiB;
constexpr size_t WS_END = 928 * MiB;

constexpr int RING_BYTES = 131072;
constexpr int LDS_BYTES = 147456;

struct Args {
    const float* x; const float* c; const int* pos; const float* ada_w; const float* ada_b; const float* w_in; const float* b_in;
    const float* sinks; const float* pool_w; const float* pool_scale; const float* w_out; const float* w_gate; const float* w_up;
    const float* w_down; const float* g_pre_mix; const float* g_post_mix; const float* g_pre_ffn; const float* g_post_ffn;
    float* out; unsigned char* ws;
};

__device__ __constant__ double c_inv_freq[8] = {1.0, 0.19392274474868576, 0.03760603093086393, 0.007292664737217109,
                                                0.001414213562373095, 0.0002742481756762073, 5.318295896944988e-05, 1.031338537721246e-05};

__device__ __forceinline__ unsigned pk2(float lo, float hi) { return pg8::cvt_pk_bf16(lo, hi); }
__device__ __forceinline__ float bf_lo(unsigned w) { return __uint_as_float(w << 16); }
__device__ __forceinline__ float bf_hi(unsigned w) { return __uint_as_float(w & 0xffff0000u); }
__device__ __forceinline__ float wave_sum(float v) {
#pragma unroll
    for (int o = 1; o < 64; o <<= 1) v += __shfl_xor(v, o);
    return v;
}

namespace pg8 {
struct EpiInProj {
    static constexpr bool PERM = true, AFTER_DRAIN = false;
    bf16_t* O; const float* bias; const float* cs;
    __device__ __forceinline__ void operator()(const f32x4 (&acc)[2][2][4][2], const Unit& u, int wr, int wc, int fr, int fq) const {
        const int row0 = u.pm * BM + wr * 64 + fr; const int colt = u.pn * BM; const int col0 = colt + wc * 32 + 8 * fq;
        f32x4 bv[2][2];
#pragma unroll
        for (int bj = 0; bj < 2; ++bj)
#pragma unroll
            for (int n = 0; n < 2; ++n) bv[bj][n] = *(const f32x4*)(bias + col0 + bj * HALF + 4 * n);
        const bool rot_wave = (colt < 640) && ((wc & 1) == 0);
#pragma unroll
        for (int ai = 0; ai < 2; ++ai)
#pragma unroll
        for (int mh = 0; mh < 2; ++mh) {
            f32x4 cc[2][4];
#pragma unroll
            for (int mm = 0; mm < 2; ++mm)
#pragma unroll
                for (int q = 0; q < 4; ++q) cc[mm][q] = (f32x4){1.f, 1.f, 1.f, 1.f};
            if (rot_wave && fq < 2) {
#pragma unroll
                for (int mm = 0; mm < 2; ++mm) { const float* cr = cs + (size_t)(row0 + ai * HALF + (2 * mh + mm) * 16) * 16;
#pragma unroll
                    for (int q = 0; q < 4; ++q) cc[mm][q] = *(const f32x4*)(cr + 4 * q); }
            }
#pragma unroll
            for (int mm = 0; mm < 2; ++mm) {
                const int m = 2 * mh + mm;
                const int row = row0 + ai * HALF + m * 16;
                bf16_t* rowp = O + (size_t)row * INW + col0;
#pragma unroll
                for (int bj = 0; bj < 2; ++bj) {
                    f32x4 v0 = acc[ai][bj][m][0] + bv[bj][0], v1 = acc[ai][bj][m][1] + bv[bj][1];
                    const int cb = colt + bj * HALF;
                    if (rot_wave && cb < 640) {
                        f32x4 p0, p1;
#pragma unroll
                        for (int e = 0; e < 4; ++e) { p0[e] = __shfl_xor(v0[e], 16); p1[e] = __shfl_xor(v1[e], 16); }
                        if (fq == 0) { v0 = v0 * cc[mm][0] - p0 * cc[mm][2]; v1 = v1 * cc[mm][1] - p1 * cc[mm][3]; }
                        else if (fq == 1) { v0 = v0 * cc[mm][0] + p0 * cc[mm][2]; v1 = v1 * cc[mm][1] + p1 * cc[mm][3]; }
                    }
                    if (cb < 512) { v0 = v0 * 0.125f; v1 = v1 * 0.125f; }
                    u32x4 w; w.x = cvt_pk_bf16(v0[0], v0[1]); w.y = cvt_pk_bf16(v0[2], v0[3]); w.z = cvt_pk_bf16(v1[0], v1[1]); w.w = cvt_pk_bf16(v1[2], v1[3]);
                    *(u32x4*)(rowp + bj * HALF) = w;
                }
            }
        }
    }
};
struct EpiSwiGLU {
    static constexpr bool PERM = true, AFTER_DRAIN = false;
    bf16_t* O;
    __device__ __forceinline__ void operator()(const f32x4 (&acc)[2][2][4][2], const Unit& u, int wr, int wc, int fr, int fq) const {
        typedef float f32x2 __attribute__((ext_vector_type(2)));
        const int row0 = u.pm * BM + wr * 64 + fr; const int col0 = u.pn * HALF + wc * 32 + 8 * fq;
#pragma unroll
        for (int ai = 0; ai < 2; ++ai)
#pragma unroll
            for (int m = 0; m < 4; ++m) {
                bf16_t* rowp = O + (size_t)(row0 + ai * HALF + m * 16) * DFF + col0;
                f32x2 G[4], U[4], t[4], r[4];
#pragma unroll
                for (int n = 0; n < 2; ++n) { G[2 * n] = (f32x2){acc[ai][0][m][n][0], acc[ai][0][m][n][1]}; G[2 * n + 1] = (f32x2){acc[ai][0][m][n][2], acc[ai][0][m][n][3]};
                                              U[2 * n] = (f32x2){acc[ai][1][m][n][0], acc[ai][1][m][n][1]}; U[2 * n + 1] = (f32x2){acc[ai][1][m][n][2], acc[ai][1][m][n][3]}; }
#pragma unroll
                for (int q = 0; q < 4; ++q) { t[q].x = __builtin_amdgcn_exp2f(G[q].x); t[q].y = __builtin_amdgcn_exp2f(G[q].y); }
#pragma unroll
                for (int q = 0; q < 4; ++q) { t[q] = t[q] + 1.0f; r[q] = G[q] * U[q]; }
#pragma unroll
                for (int q = 0; q < 4; ++q) { t[q].x = __builtin_amdgcn_rcpf(t[q].x); t[q].y = __builtin_amdgcn_rcpf(t[q].y); }
#pragma unroll
                for (int q = 0; q < 4; ++q) r[q] = r[q] * t[q];
                u32x4 w; w.x = cvt_pk_bf16(r[0].x, r[0].y); w.y = cvt_pk_bf16(r[1].x, r[1].y); w.z = cvt_pk_bf16(r[2].x, r[2].y); w.w = cvt_pk_bf16(r[3].x, r[3].y);
                *(u32x4*)rowp = w;
            }
    }
};
struct DualOrder {
    StaticOrder so; int c, rounds, hot;
    __device__ bool next(int i, Unit& u) const { if (hot) { if (i >= rounds) return false; u.pm = (c % 8) * 2 + ((c / 8) & 1); u.pn = ((c / 8) >> 1) & 3; return true; } return so.next(i, u); }
    __device__ __forceinline__ void a_ready(const Unit&) const {}
    __device__ __forceinline__ void done(const Unit&) const {}
};
}

__device__ __forceinline__ void transpose_item(const float* W, int K, int N, bf16* WT, int drow0, LAS float* scr, int k0, int n0, int lane, float wscale = 1.0f) {
#pragma unroll
    for (int ih = 0; ih < 32; ih += 16) {
        float tv[16];
#pragma unroll
        for (int i = 0; i < 16; ++i) tv[i] = __builtin_nontemporal_load(W + (size_t)(k0 + 2 * (ih + i) + (lane >> 5)) * N + n0 + (lane & 31));
#pragma unroll
        for (int i = 0; i < 16; ++i) scr[(2 * (ih + i) + (lane >> 5)) * 33 + (lane & 31)] = tv[i] * wscale;
    }
    asm volatile("s_waitcnt lgkmcnt(0)" ::: "memory");
    const int c = lane & 7;
#pragma unroll
    for (int j = 0; j < 4; ++j) { const int n = (lane >> 3) + 8 * j; const LAS float* s = scr + (8 * c) * 33 + n;
        v4u o; o.x = pk2(s[0 * 33], s[1 * 33]); o.y = pk2(s[2 * 33], s[3 * 33]); o.z = pk2(s[4 * 33], s[5 * 33]); o.w = pk2(s[6 * 33], s[7 * 33]);
        *(v4u*)(WT + (size_t)(drow0 + n) * K + k0 + 8 * c) = o; }
    asm volatile("s_waitcnt lgkmcnt(0)" ::: "memory");
}

__device__ __forceinline__ void prologue(const Args& a, LAS unsigned char* lds) {
    int tid_ = threadIdx.x; asm volatile("" : "+v"(tid_)); const int tid = tid_, lane = tid & 63, wave = tid >> 6;
    unsigned char* ws = a.ws;
    __syncthreads();
    {
        LAS float* sc = (LAS float*)lds;
        for (int i = tid; i < NB * DM; i += 512) { const float v = a.c[i]; sc[i] = v / (1.0f + __expf(-v)); }
        __syncthreads();
        float* modp = (float*)(ws + WS_MODP);
        for (int item = blockIdx.x; item < DEPTH * KCH * 12; item += gridDim.x) {
            const int l = item / (KCH * 12), r = item % (KCH * 12), kc = r / 12, cb = r % 12, n = cb * 512 + tid;
            constexpr int KPI = DM / KCH;
            const float* w = a.ada_w + ((size_t)l * DM + kc * KPI) * NMODW + n;
            float acc[8];
#pragma unroll
            for (int b = 0; b < 8; ++b) acc[b] = 0.f;
#pragma unroll 1
            for (int kh = 0; kh < KPI; kh += 16) {
                float wv[16];
#pragma unroll
                for (int k = 0; k < 16; ++k) wv[k] = __builtin_nontemporal_load(w + (size_t)(kh + k) * NMODW);
#pragma unroll
                for (int k = 0; k < 16; ++k) {
                    const LAS float* sp = sc + kc * KPI + kh + k;
#pragma unroll
                    for (int b = 0; b < 8; ++b) acc[b] += sp[b * DM] * wv[k];
                    if ((k & 3) == 3) asm volatile("" ::: "memory");
                }
            }
#pragma unroll
            for (int b = 0; b < 8; ++b) modp[((size_t)(l * KCH + kc) * 8 + b) * NMODW + n] = acc[b];
        }
        __syncthreads();
    }
    {
        float* cs = (float*)(ws + WS_CS);
        for (int idx = blockIdx.x * 512 + tid; idx < T * 8; idx += gridDim.x * 512) {
            const int row = idx >> 3, j = idx & 7;
            const double rev = (double)a.pos[row] * c_inv_freq[j] * 0.15915494309189535;
            const float fr = (float)(rev - floor(rev));
            cs[(size_t)row * 16 + j] = __builtin_amdgcn_cosf(fr);
            cs[(size_t)row * 16 + 8 + j] = __builtin_amdgcn_sinf(fr);
        }
    }
    {
        LAS float* scr = (LAS float*)(lds + wave * 16384);
        const int gw = blockIdx.x * 8 + wave, ngw = gridDim.x * 8;
        constexpr int I_IN = 16 * 40, I_OUT = 16 * 32, I_G = 16 * 88, I_D = 44 * 32, I_P = 4 * 8;
        constexpr int PER_L = I_IN + I_OUT + 2 * I_G + I_D + I_P;
        for (int it = gw; it < DEPTH * PER_L; it += ngw) {
            const int l = it / PER_L; int r = it % PER_L;
            unsigned char* wl = ws + WS_W + (size_t)l * W_LAYER;
            if (r < I_IN) { const int kb = r / 40, nb = r % 40; transpose_item(a.w_in + (size_t)l * DM * INW, DM, INW, (bf16*)(wl + W_IN), 32 * nb, scr, 64 * kb, 32 * nb, lane); continue; } r -= I_IN;
            if (r < I_OUT) { const int kb = r / 32, nb = r % 32; transpose_item(a.w_out + (size_t)l * DM * DM, DM, DM, (bf16*)(wl + W_OUT), 32 * nb, scr, 64 * kb, 32 * nb, lane); continue; } r -= I_OUT;
            if (r < 2 * I_G) { const int up = r >= I_G; if (up) r -= I_G; const int kb = r / 88, nb = r % 88, n0 = 32 * nb;
                transpose_item((up ? a.w_up : a.w_gate) + (size_t)l * DM * DFF, DM, DFF, (bf16*)(wl + W_GU), 256 * (n0 >> 7) + (n0 & 127) + (up ? 128 : 0), scr, 64 * kb, n0, lane, up ? -0.6931471805599453f : -1.4426950408889634f); continue; } r -= 2 * I_G;
            if (r < I_D) { const int kb = r / 32, nb = r % 32; transpose_item(a.w_down + (size_t)l * DFF * DM, DFF, DM, (bf16*)(wl + W_DN), 32 * nb, scr, 64 * kb, 32 * nb, lane); continue; } r -= I_D;
            { const int gi = r / 8, q = r % 8, kb = q / 4, nb = q % 4;
              transpose_item(a.pool_w + ((size_t)l * 4 + gi) * 128 * 128, 128, 128, (bf16*)(wl + W_PW) + (size_t)gi * 128 * 128, 32 * nb, scr, 64 * kb, 32 * nb, lane); }
        }
    }
}

__device__ __forceinline__ float mod_val(const Args& a, int l, int b, int idx, int col) {
    const float* modp = (const float*)(a.ws + WS_MODP);
    const int n = idx * DM + col;
    float s = a.ada_b[l * NMODW + n];
#pragma unroll
    for (int kc = 0; kc < KCH; ++kc) s += modp[((size_t)(l * KCH + kc) * 8 + b) * NMODW + n];
    return s;
}
__device__ __forceinline__ float mod_fin(const Args& a, int l, int b, int idx, int col) {
    return ((const float*)(a.ws + WS_MODF))[((size_t)(l * 8 + b)) * NMODW + idx * DM + col];
}
__device__ __forceinline__ void mod_finalize(const Args& a) {
    float* modf = (float*)(a.ws + WS_MODF);
    for (int i = blockIdx.x * 512 + threadIdx.x; i < DEPTH * 8 * NMODW; i += gridDim.x * 512) {
        const int l = i / (8 * NMODW), r = i % (8 * NMODW), b = r / NMODW, n = r % NMODW;
        modf[i] = mod_val(a, l, b, n / DM, n % DM);
    }
}
__device__ __forceinline__ void unpack8(const v4u w, float (&f)[8]) {
#pragma unroll
    for (int e = 0; e < 4; ++e) { f[2 * e] = bf_lo(w[e]); f[2 * e + 1] = bf_hi(w[e]); }
}
__device__ __forceinline__ v4u pack8(const float (&f)[8]) { return (v4u){pk2(f[0], f[1]), pk2(f[2], f[3]), pk2(f[4], f[5]), pk2(f[6], f[7])}; }
__device__ __forceinline__ void rowwise_phase(const Args& a, LAS unsigned char* lds, bool from_partials, bool has_y, bool has_h, bool xin_bf, int xout_mode,
        const void* xin, const bf16* y, float* xout, bf16* xoutb, bf16* hout,
        int l_y, int gate_idx, const float* g_post, int l_h, int shift_idx, int scale_idx, const float* g_pre) {
    int tid_ = threadIdx.x; asm volatile("" : "+v"(tid_)); const int tid = tid_, lane = tid & 63, wave = tid >> 6;
    LAS float* vec = (LAS float*)lds;
    for (int tile = blockIdx.x; tile < T / 256; tile += gridDim.x) {
        const int b = tile / (SEQ / 256);
        __syncthreads();
        for (int col = tid; col < DM; col += 512) {
            if (from_partials) {
                if (has_y) vec[col] = mod_val(a, l_y, b, gate_idx, col) * g_post[col];
                if (has_h) { vec[DM + col] = g_pre[col] * (1.0f + mod_val(a, l_h, b, scale_idx, col)); vec[2 * DM + col] = mod_val(a, l_h, b, shift_idx, col); }
            } else {
                if (has_y) vec[col] = mod_fin(a, l_y, b, gate_idx, col) * g_post[col];
                if (has_h) { vec[DM + col] = g_pre[col] * (1.0f + mod_fin(a, l_h, b, scale_idx, col)); vec[2 * DM + col] = mod_fin(a, l_h, b, shift_idx, col); }
            }
        }
        __syncthreads();
#pragma unroll 1
        for (int r = wave * 4; r < 256; r += 32) {
            float v[4][2][8]; v4u yv[4][2];
#pragma unroll
            for (int h = 0; h < 4; ++h)
#pragma unroll
                for (int j = 0; j < 2; ++j) { const size_t off = ((size_t)tile * 256 + r + h) * DM + 8 * lane + 512 * j;
                    if (xin_bf) unpack8(__builtin_nontemporal_load((const v4u*)((const bf16*)xin + off)), v[h][j]);
                    else { const f32x4 p0 = __builtin_nontemporal_load((const f32x4*)((const float*)xin + off)), p1 = __builtin_nontemporal_load((const f32x4*)((const float*)xin + off + 4));
                        v[h][j][0] = p0.x; v[h][j][1] = p0.y; v[h][j][2] = p0.z; v[h][j][3] = p0.w; v[h][j][4] = p1.x; v[h][j][5] = p1.y; v[h][j][6] = p1.z; v[h][j][7] = p1.w; }
                    yv[h][j] = has_y ? __builtin_nontemporal_load((const v4u*)(y + off)) : (v4u){0u, 0u, 0u, 0u}; }
            if (has_y) {
                float rstd[4];
#pragma unroll
                for (int h = 0; h < 4; ++h) { float ss = 0.f;
#pragma unroll
                    for (int j = 0; j < 2; ++j) { float yf[8]; unpack8(yv[h][j], yf);
#pragma unroll
                        for (int e = 0; e < 8; ++e) ss += yf[e] * yf[e]; }
                    rstd[h] = __builtin_amdgcn_rsqf(wave_sum(ss) * (1.0f / DM) + EPS); }
#pragma unroll
                for (int j = 0; j < 2; ++j) { const LAS float* gpp = vec + 8 * lane + 512 * j; const f32x4 g0 = *(const LAS f32x4*)gpp, g1 = *(const LAS f32x4*)(gpp + 4);
                    const float gp[8] = {g0.x, g0.y, g0.z, g0.w, g1.x, g1.y, g1.z, g1.w};
#pragma unroll
                    for (int h = 0; h < 4; ++h) { float yf[8]; unpack8(yv[h][j], yf);
#pragma unroll
                        for (int e = 0; e < 8; ++e) v[h][j][e] += gp[e] * (yf[e] * rstd[h]); } }
            }
            if (xout_mode == 1) {
#pragma unroll
                for (int h = 0; h < 4; ++h)
#pragma unroll
                    for (int j = 0; j < 2; ++j) { float* o = xout + ((size_t)tile * 256 + r + h) * DM + 8 * lane + 512 * j;
                        __builtin_nontemporal_store((f32x4){v[h][j][0], v[h][j][1], v[h][j][2], v[h][j][3]}, (f32x4*)o); __builtin_nontemporal_store((f32x4){v[h][j][4], v[h][j][5], v[h][j][6], v[h][j][7]}, (f32x4*)(o + 4)); }
            } else if (xout_mode == 2) {
#pragma unroll
                for (int h = 0; h < 4; ++h)
#pragma unroll
                    for (int j = 0; j < 2; ++j) { const v4u w = pack8(v[h][j]);
                        __builtin_nontemporal_store(w, (v4u*)(xoutb + ((size_t)tile * 256 + r + h) * DM + 8 * lane + 512 * j));
                        unpack8(w, v[h][j]); }
            }
            if (has_h) {
                float rstd[4];
#pragma unroll
                for (int h = 0; h < 4; ++h) { float ss = 0.f;
#pragma unroll
                    for (int j = 0; j < 2; ++j)
#pragma unroll
                        for (int e = 0; e < 8; ++e) ss += v[h][j][e] * v[h][j][e];
                    rstd[h] = __builtin_amdgcn_rsqf(wave_sum(ss) * (1.0f / DM) + EPS); }
#pragma unroll
                for (int j = 0; j < 2; ++j) { const LAS float* gsp = vec + DM + 8 * lane + 512 * j; const LAS float* shp = vec + 2 * DM + 8 * lane + 512 * j;
                    const f32x4 a0 = *(const LAS f32x4*)gsp, a1 = *(const LAS f32x4*)(gsp + 4), b0 = *(const LAS f32x4*)shp, b1 = *(const LAS f32x4*)(shp + 4);
                    const float gs[8] = {a0.x, a0.y, a0.z, a0.w, a1.x, a1.y, a1.z, a1.w}, sh[8] = {b0.x, b0.y, b0.z, b0.w, b1.x, b1.y, b1.z, b1.w};
#pragma unroll
                    for (int h = 0; h < 4; ++h) { float hv[8];
#pragma unroll
                        for (int e = 0; e < 8; ++e) hv[e] = v[h][j][e] * rstd[h] * gs[e] + sh[e];
                        *(v4u*)(hout + ((size_t)tile * 256 + r + h) * DM + 8 * lane + 512 * j) = pack8(hv); } }
            }
        }
    }
}

__device__ __forceinline__ void attn_phase(LAS unsigned char* lds, const bf16* PROJ, bf16* CONCAT, const float* sinks) {
    int tid_ = threadIdx.x; asm volatile("" : "+v"(tid_)); const int tid = tid_, lane = tid & 63, wave = tid >> 6, fr = lane & 15, fq = lane >> 4;
    LAS bf16* Ks = (LAS bf16*)lds;
    LAS bf16* Vt = (LAS bf16*)(lds + 36864);
    v4u kv[4], vv[4];
#define ATT_LOAD_KV(uu) do { const int kh_ = (uu) & 1, n_ = ((uu) >> 1) & 63, b_ = (uu) >> 7; const long rb_ = (long)b_ * SEQ + n_ * 128 - 128; \
        _Pragma("unroll") for (int i = 0; i < 4; ++i) { const int kj = lane + 64 * i; kv[i] = (v4u){0u, 0u, 0u, 0u}; vv[i] = (v4u){0u, 0u, 0u, 0u}; \
            if (n_ > 0 || kj >= 128) { const bf16* p = PROJ + (size_t)(rb_ + kj) * INW + kh_ * 64 + wave * 8; kv[i] = *(const v4u*)(p + 512); vv[i] = *(const v4u*)(p + 640); } } } while (0)
    if ((int)blockIdx.x < NB * 64 * 2) ATT_LOAD_KV((int)blockIdx.x);
    for (int u = blockIdx.x; u < NB * 64 * 2; u += gridDim.x) {
        const int kh = u & 1, n = (u >> 1) & 63, b = u >> 7;
        const int g = wave >> 1, h = kh * 4 + g;
        const size_t qrow0 = (size_t)b * SEQ + n * 128 + (wave & 1) * 64 + fr;
        bf16x8 qf[4][2];
#pragma unroll
        for (int i = 0; i < 4; ++i) { const bf16* qp = PROJ + (qrow0 + 16 * i) * INW + h * 64 + 8 * fq; qf[i][0] = __builtin_nontemporal_load((const bf16x8*)qp); qf[i][1] = __builtin_nontemporal_load((const bf16x8*)(qp + 32)); }
#pragma unroll
        for (int i = 0; i < 4; ++i) { const int kj = lane + 64 * i;
            *(LAS v4u*)(Ks + kj * 72 + wave * 8) = kv[i];
#pragma unroll
            for (int e = 0; e < 4; ++e) { Vt[(wave * 8 + 2 * e) * 272 + kj] = (bf16)(vv[i][e] & 0xffffu); Vt[(wave * 8 + 2 * e + 1) * 272 + kj] = (bf16)(vv[i][e] >> 16); } }
        __syncthreads();
        if (u + (int)gridDim.x < NB * 64 * 2) ATT_LOAD_KV(u + (int)gridDim.x);
        const float sink = sinks[h];
        const int firstblk = (n == 0);
#pragma unroll
        for (int p = 0; p < 2; ++p) {
            const int q16a = (wave & 1) * 4 + 2 * p, kt0 = q16a;
            f32x4 st[2][10];
#pragma unroll
            for (int t = 0; t < 10; ++t) {
                const LAS bf16* kp = Ks + (16 * (kt0 + t) + fr) * 72 + 8 * fq;
                const bf16x8 k0 = *(const LAS bf16x8*)kp, k1 = *(const LAS bf16x8*)(kp + 32);
#pragma unroll
                for (int x = 0; x < 2; ++x) {
                    if (x + 8 - t == 9 || x + 8 - t == -1) { st[x][t] = (f32x4){-1e30f, -1e30f, -1e30f, -1e30f}; continue; }
                    f32x4 acc = (f32x4){0.f, 0.f, 0.f, 0.f};
                    acc = __builtin_amdgcn_mfma_f32_16x16x32_bf16(k0, qf[2 * p + x][0], acc, 0, 0, 0);
                    acc = __builtin_amdgcn_mfma_f32_16x16x32_bf16(k1, qf[2 * p + x][1], acc, 0, 0, 0);
                    st[x][t] = acc;
                }
            }
            float inv[2];
#pragma unroll
            for (int x = 0; x < 2; ++x) {
                float mx = -1e30f;
#pragma unroll
                for (int t = 0; t < 10; ++t) {
                    const int D = x + 8 - t;
                    if (D == 9 || D == -1) continue;
                    const bool tile_off = firstblk && (kt0 + t < 8);
#pragma unroll
                    for (int r = 0; r < 4; ++r) { const int dl = fr - 4 * fq - r;
                        bool valid = !tile_off;
                        if (D == 8) valid = valid && (dl < 0);
                        if (D == 0) valid = valid && (dl >= 0);
                        const float sv = valid ? st[x][t][r] : -1e30f; st[x][t][r] = sv; mx = fmaxf(mx, sv); }
                }
                mx = fmaxf(mx, __shfl_xor(mx, 16)); mx = fmaxf(mx, __shfl_xor(mx, 32)); mx = fmaxf(mx, sink);
                const float mb = mx * LOG2E;
                float lsum = 0.f;
#pragma unroll
                for (int t = 0; t < 10; ++t) {
                    const int D = x + 8 - t;
                    if (D == 9 || D == -1) { st[x][t] = (f32x4){0.f, 0.f, 0.f, 0.f}; continue; }
#pragma unroll
                    for (int r = 0; r < 4; ++r) { const float pe = __builtin_amdgcn_exp2f(st[x][t][r] * LOG2E - mb); st[x][t][r] = pe; lsum += pe; }
                }
                lsum += __shfl_xor(lsum, 16); lsum += __shfl_xor(lsum, 32); lsum += __builtin_amdgcn_exp2f(sink * LOG2E - mb);
                inv[x] = 1.0f / lsum;
            }
            f32x4 ot[2][4];
#pragma unroll
            for (int x = 0; x < 2; ++x)
#pragma unroll
                for (int dt = 0; dt < 4; ++dt) ot[x][dt] = (f32x4){0.f, 0.f, 0.f, 0.f};
#pragma unroll
            for (int s2 = 0; s2 < 5; ++s2) {
                bf16x8 pf[2];
#pragma unroll
                for (int x = 0; x < 2; ++x) { v4u pw; pw.x = pk2(st[x][2 * s2][0], st[x][2 * s2][1]); pw.y = pk2(st[x][2 * s2][2], st[x][2 * s2][3]);
                    pw.z = pk2(st[x][2 * s2 + 1][0], st[x][2 * s2 + 1][1]); pw.w = pk2(st[x][2 * s2 + 1][2], st[x][2 * s2 + 1][3]); pf[x] = __builtin_bit_cast(bf16x8, pw); }
#pragma unroll
                for (int dt = 0; dt < 4; ++dt) {
                    const LAS bf16* vp = Vt + (16 * dt + fr) * 272 + 16 * (kt0 + 2 * s2) + 4 * fq;
                    const v2u lo = *(const LAS v2u*)vp, hi = *(const LAS v2u*)(vp + 16);
                    const bf16x8 vf = __builtin_bit_cast(bf16x8, (v4u){lo.x, lo.y, hi.x, hi.y});
#pragma unroll
                    for (int x = 0; x < 2; ++x) ot[x][dt] = __builtin_amdgcn_mfma_f32_16x16x32_bf16(vf, pf[x], ot[x][dt], 0, 0, 0);
                }
            }
#pragma unroll
            for (int x = 0; x < 2; ++x) {
                bf16* op = CONCAT + (qrow0 + 16 * (2 * p + x)) * DM + h * 64 + 4 * fq;
#pragma unroll
                for (int dt = 0; dt < 4; ++dt) *(v2u*)(op + 16 * dt) = (v2u){pk2(ot[x][dt][0] * inv[x], ot[x][dt][1] * inv[x]), pk2(ot[x][dt][2] * inv[x], ot[x][dt][3] * inv[x])};
            }
        }
        __syncthreads();
    }
#undef ATT_LOAD_KV
}

constexpr int PL_US = 136;
template <int W> __device__ __forceinline__ void pool_load(const bf16* PROJ, int gi, int tt, int lane, v4u (&raw)[8]) {
    const size_t t0 = (size_t)tt * 16; const int s0 = (int)(t0 & (SEQ - 1));
    const int ch = lane & 15, rs = lane >> 4;
#pragma unroll
    for (int i = 0; i < 8; ++i) { const int r = rs + 4 * i;
        raw[i] = (v4u){0u, 0u, 0u, 0u};
        if (4 * i + 3 >= 17 - W) { if (s0 - 16 + r >= 0) raw[i] = *(const v4u*)(PROJ + (t0 - 16 + r) * INW + 768 + gi * 128 + ch * 8); } }
}
typedef short v4i16_t __attribute__((ext_vector_type(4)));
__device__ __forceinline__ v2u lds_tr(const LAS bf16* p) { return __builtin_bit_cast(v2u, __builtin_amdgcn_ds_read_tr16_b64_v4i16((LAS v4i16_t*)p)); }
template <int W> __device__ __forceinline__ void pool_compute(bf16* CONCAT, const LAS bf16* wl, LAS bf16* ust, const float* pscale, int gi, int tt, int lane, const v4u (&raw)[8]) {
    const int fr = lane & 15, fq = lane >> 4;
    const size_t t0 = (size_t)tt * 16; const int s0 = (int)(t0 & (SEQ - 1));
    {
        const int ch = lane & 15, rs = lane >> 4;
#pragma unroll
        for (int i = 0; i < 8; ++i) { const int r = rs + 4 * i; if (4 * i + 3 >= 17 - W) *(LAS v4u*)(ust + r * PL_US + ch * 8) = raw[i]; }
    }
    const int s = s0 + fr;
    const int cnt = (s + 1 < W) ? (s + 1) : W;
    const float invc = 1.0f / (float)cnt;
    bf16x8 band;
    { float bv[8];
#pragma unroll
      for (int j = 0; j < 8; ++j) { const int rel = 8 * fq + j - 16 - fr;
          bv[j] = ((rel > -W && rel <= 0) ? 1.0f : 0.0f) - ((rel == 0) ? (float)cnt : 0.0f); }
      band = __builtin_bit_cast(bf16x8, (v4u){pk2(bv[0], bv[1]), pk2(bv[2], bv[3]), pk2(bv[4], bv[5]), pk2(bv[6], bv[7])}); }
    f32x4 pl[8];
    const LAS bf16* trp = ust + (8 * fq + ((lane & 15) >> 2)) * PL_US + 4 * (lane & 3);
#pragma unroll
    for (int a = 0; a < 8; ++a) {
        const v2u lo = lds_tr(trp + 16 * a), hi = lds_tr(trp + 4 * PL_US + 16 * a);
        const bf16x8 ua = __builtin_bit_cast(bf16x8, (v4u){lo.x, lo.y, hi.x, hi.y});
        pl[a] = __builtin_amdgcn_mfma_f32_16x16x32_bf16(ua, band, (f32x4){0.f, 0.f, 0.f, 0.f}, 0, 0, 0);
    }
    bf16x8 pf[4];
#pragma unroll
    for (int ks = 0; ks < 4; ++ks)
        pf[ks] = __builtin_bit_cast(bf16x8, (v4u){pk2(pl[2 * ks][0] * invc, pl[2 * ks][1] * invc), pk2(pl[2 * ks][2] * invc, pl[2 * ks][3] * invc),
                                                  pk2(pl[2 * ks + 1][0] * invc, pl[2 * ks + 1][1] * invc), pk2(pl[2 * ks + 1][2] * invc, pl[2 * ks + 1][3] * invc)});
    const size_t R = t0 + fr;
#pragma unroll
    for (int nt = 0; nt < 8; ++nt) {
        f32x4 acc = (f32x4){0.f, 0.f, 0.f, 0.f};
        const LAS bf16* wp = wl + (16 * nt + fr) * PL_US + 4 * fq;
#pragma unroll
        for (int ks = 0; ks < 4; ++ks) { const v2u lo = *(const LAS v2u*)(wp + 32 * ks), hi = *(const LAS v2u*)(wp + 32 * ks + 16);
            acc = __builtin_amdgcn_mfma_f32_16x16x32_bf16(__builtin_bit_cast(bf16x8, (v4u){lo.x, lo.y, hi.x, hi.y}), pf[ks], acc, 0, 0, 0); }
        const int d = gi * 128 + 16 * nt + 4 * fq;
        const f32x4 sc = *(const f32x4*)(pscale + d);
        *(v2u*)(CONCAT + R * DM + 512 + d) = (v2u){pk2(acc[0] * sc.x, acc[1] * sc.y), pk2(acc[2] * sc.z, acc[3] * sc.w)};
    }
}
template <int W> __device__ __forceinline__ void pool_group(const bf16* PROJ, bf16* CONCAT, const LAS bf16* wl, LAS bf16* ust, const float* pscale, int gi, int gw, int ngw, int lane) {
    v4u ra[8], rb[8];
    {
        const int ch = lane & 15, rs = lane >> 4;
#pragma unroll
        for (int i = 0; i < 8; ++i) if (!(4 * i + 3 >= 17 - W)) *(LAS v4u*)(ust + (rs + 4 * i) * PL_US + ch * 8) = (v4u){0u, 0u, 0u, 0u};
    }
    int tt = gw;
    if (tt < T / 16) pool_load<W>(PROJ, gi, tt, lane, ra);
    while (tt < T / 16) {
        const int tn = tt + ngw;
        if (tn < T / 16) pool_load<W>(PROJ, gi, tn, lane, rb);
        pool_compute<W>(CONCAT, wl, ust, pscale, gi, tt, lane, ra);
        tt = tn;
        if (tt >= T / 16) break;
        const int tn2 = tt + ngw;
        if (tn2 < T / 16) pool_load<W>(PROJ, gi, tn2, lane, ra);
        pool_compute<W>(CONCAT, wl, ust, pscale, gi, tt, lane, rb);
        tt = tn2;
    }
}
__device__ __forceinline__ void pool_phase(LAS unsigned char* lds, const bf16* PROJ, bf16* CONCAT, const bf16* PWT, const float* pscale) {
    int tid_ = threadIdx.x; asm volatile("" : "+v"(tid_)); const int tid = tid_, lane = tid & 63, wave = tid >> 6;
    LAS bf16* wl = (LAS bf16*)lds;
    LAS bf16* ust = (LAS bf16*)(lds + 36864 + wave * 8704);
    const int gw = blockIdx.x * 8 + wave, ngw = gridDim.x * 8;
#pragma unroll 1
    for (int gi = 0; gi < 4; ++gi) {
        __syncthreads();
        { const int row = tid >> 2, q = tid & 3; const bf16* src = PWT + ((size_t)gi * 128 + row) * 128 + q * 32;
#pragma unroll
          for (int e = 0; e < 4; ++e) *(LAS v4u*)(wl + row * PL_US + q * 32 + e * 8) = *(const v4u*)(src + e * 8); }
        __syncthreads();
        if (gi == 0) pool_group<2>(PROJ, CONCAT, wl, ust, pscale, gi, gw, ngw, lane);
        else if (gi == 1) pool_group<4>(PROJ, CONCAT, wl, ust, pscale, gi, gw, ngw, lane);
        else if (gi == 2) pool_group<8>(PROJ, CONCAT, wl, ust, pscale, gi, gw, ngw, lane);
        else pool_group<16>(PROJ, CONCAT, wl, ust, pscale, gi, gw, ngw, lane);
    }
    __syncthreads();
}

#ifndef REP_P
#define REP_P 1
#endif
#ifndef REP_G
#define REP_G 1
#endif
#ifndef REP_R
#define REP_R 1
#endif
#ifndef REP_G
#define REP_G 1
#endif
#ifndef REP_IN
#define REP_IN REP_G
#endif
#ifndef REP_GU
#define REP_GU REP_G
#endif
#ifndef REP_DN
#define REP_DN REP_G
#endif
#ifndef REP_PL
#define REP_PL 1
#endif
#ifndef REP_A
#define REP_A 1
#endif
__global__ void __launch_bounds__(512, 2) fwd_kernel(Args a) {
    extern __shared__ __attribute__((aligned(16))) unsigned char lds_raw[];
    cg::grid_group grid = cg::this_grid();
    LAS unsigned char* lds = (LAS unsigned char*)lds_raw;
    unsigned char* ws = a.ws;
    bf16* H = (bf16*)(ws + WS_H); bf16* MIX = (bf16*)(ws + WS_MIX); bf16* PROJ = (bf16*)(ws + WS_PROJ);
    bf16* CONCAT = (bf16*)(ws + WS_CONCAT); bf16* ACT = (bf16*)(ws + WS_ACT);
    const float* cs = (const float*)(ws + WS_CS); bf16* XA = (bf16*)(ws + WS_XA); bf16* XB = (bf16*)(ws + WS_XB);
    volatile LAS unsigned* MISC = (volatile LAS unsigned*)(lds + RING_BYTES + 64);
    if (threadIdx.x == 0) { MISC[0] = 0u; MISC[1] = 0u; }
    __syncthreads();
    XcdBarrier bar = xcd_barrier_post((unsigned*)ws, MISC);
#define SEAM() xcd_barrier(bar)

    for (int rep = 0; rep < REP_P; ++rep) prologue(a, lds);
    if (a.ws == nullptr) grid.sync();
    SEAM();
    for (int rep = 0; rep < REP_R; ++rep) rowwise_phase(a, lds, true, false, true, false, 2, a.x, nullptr, nullptr, XB, H, 0, 0, nullptr, 0, 0, 1, a.g_pre_mix);
    mod_finalize(a);
    SEAM();
#pragma unroll 1
    for (int l = 0; l < DEPTH; ++l) {
        unsigned char* wl = ws + WS_W + (size_t)l * W_LAYER;
        for (int rep = 0; rep < REP_IN; ++rep) {
            pg8::Gemm g{H, (const bf16*)(wl + W_IN), T, INW, DM}; pg8::StaticOrder S; S.init(T, INW, gridDim.x, blockIdx.x);
            pg8::EpiInProj E{PROJ, a.b_in + l * INW, cs};
            pg8::gemm_phase<pg8::EpiInProj, pg8::StaticOrder, true, true>(lds, g, S, E);
        }
        SEAM();
        for (int rep = 0; rep < REP_A; ++rep) attn_phase(lds, PROJ, CONCAT, a.sinks + l * 8);
        for (int rep = 0; rep < REP_PL; ++rep) pool_phase(lds, PROJ, CONCAT, (const bf16*)(wl + W_PW), a.pool_scale + l * 512);
        SEAM();
        for (int rep = 0; rep < REP_G; ++rep) {
            pg8::Gemm g{CONCAT, (const bf16*)(wl + W_OUT), T, DM, DM}; pg8::StaticOrder S; S.init(T, DM, gridDim.x, blockIdx.x);
            pg8::EpiBf16<0> E{MIX, DM, nullptr, 0, 0, 1.f};
            pg8::gemm_phase<pg8::EpiBf16<0>, pg8::StaticOrder, true, true>(lds, g, S, E);
        }
        SEAM();
        for (int rep = 0; rep < REP_R; ++rep) rowwise_phase(a, lds, false, true, true, true, 2, XB, MIX, nullptr, XA, H, l, 2, a.g_post_mix + l * DM, l, 3, 4, a.g_pre_ffn + l * DM);
        SEAM();
#if defined(PROBE_HOT)
#pragma unroll 1
        for (int rep = 0; rep < 2; ++rep) {
            pg8::Gemm g{H, (const bf16*)(wl + W_GU), T, 2 * DFF, rep == 0 ? PROBE_HOT_K : DM}; pg8::DualOrder S; S.so.init(T, 2 * DFF, gridDim.x, blockIdx.x); S.c = blockIdx.x; S.rounds = 22; S.hot = (rep == 0);
            pg8::EpiSwiGLU E{rep == 0 ? MIX : ACT};
            pg8::gemm_phase<pg8::EpiSwiGLU, pg8::DualOrder, true, true>(lds, g, S, E);
            if (rep == 0) SEAM();
        }
#else
        for (int rep = 0; rep < REP_GU; ++rep) {
            pg8::Gemm g{H, (const bf16*)(wl + W_GU), T, 2 * DFF, DM}; pg8::StaticOrder S; S.init(T, 2 * DFF, gridDim.x, blockIdx.x);
            pg8::EpiSwiGLU E{ACT};
            pg8::gemm_phase<pg8::EpiSwiGLU, pg8::StaticOrder, true, true>(lds, g, S, E);
        }
#endif
        SEAM();
        for (int rep = 0; rep < REP_DN; ++rep) {
            pg8::Gemm g{ACT, (const bf16*)(wl + W_DN), T, DM, DFF}; pg8::StaticOrder S; S.init(T, DM, gridDim.x, blockIdx.x);
            pg8::EpiBf16<0> E{MIX, DM, nullptr, 0, 0, 1.f};
            pg8::gemm_phase<pg8::EpiBf16<0>, pg8::StaticOrder, true, true>(lds, g, S, E);
        }
        SEAM();
        const bool more = (l + 1 < DEPTH);
        for (int rep = 0; rep < REP_R; ++rep) rowwise_phase(a, lds, false, true, more, true, more ? 2 : 1, XA, MIX, a.out, XB, H, l, 5, a.g_post_ffn + l * DM, l + 1, 0, 1, a.g_pre_mix + (more ? (l + 1) * DM : 0));
        if (more) SEAM();
    }
}

extern "C" void kernel_launch(void* const* d_in, const int* in_sizes, int n_in, void* d_out, int out_size, void* d_ws, size_t ws_size, hipStream_t stream) {
    static int grid_blocks = 0;
    if (grid_blocks == 0) {
        if (n_in != 18 || out_size != T * DM || ws_size < WS_END) { fprintf(stderr, "kernel_launch: unexpected shapes (n_in %d, out %d, ws %zu)\n", n_in, out_size, ws_size); grid_blocks = -1; return; }
        int dev = 0, cus = 0, per_cu = 0;
        hipGetDevice(&dev);
        hipDeviceGetAttribute(&cus, hipDeviceAttributeMultiprocessorCount, dev);
        if (hipFuncSetAttribute((const void*)fwd_kernel, hipFuncAttributeMaxDynamicSharedMemorySize, LDS_BYTES) != hipSuccess) { fprintf(stderr, "kernel_launch: hipFuncSetAttribute failed\n"); grid_blocks = -1; return; }
        if (hipOccupancyMaxActiveBlocksPerMultiprocessor(&per_cu, (const void*)fwd_kernel, 512, LDS_BYTES) != hipSuccess || per_cu < 1) { fprintf(stderr, "kernel_launch: occupancy query gave %d\n", per_cu); per_cu = 1; }
        (void)hipGetLastError();
        grid_blocks = cus * per_cu;
    }
    if (grid_blocks < 0) return;
    if (hipMemsetAsync(d_ws, 0, 65536, stream) != hipSuccess) { fprintf(stderr, "kernel_launch: memset failed\n"); return; }
    Args a{};
    a.x = (const float*)d_in[0]; a.c = (const float*)d_in[1]; a.pos = (const int*)d_in[2]; a.ada_w = (const float*)d_in[3]; a.ada_b = (const float*)d_in[4];
    a.w_in = (const float*)d_in[5]; a.b_in = (const float*)d_in[6]; a.sinks = (const float*)d_in[7]; a.pool_w = (const float*)d_in[8]; a.pool_scale = (const float*)d_in[9];
    a.w_out = (const float*)d_in[10]; a.w_gate = (const float*)d_in[11]; a.w_up = (const float*)d_in[12]; a.w_down = (const float*)d_in[13];
    a.g_pre_mix = (const float*)d_in[14]; a.g_post_mix = (const float*)d_in[15]; a.g_pre_ffn = (const float*)d_in[16]; a.g_post_ffn = (const float*)d_in[17];
    a.out = (float*)d_out; a.ws = (unsigned char*)d_ws;
    void* args[] = {&a};
    hipError_t e = hipLaunchCooperativeKernel((const void*)fwd_kernel, dim3(grid_blocks), dim3(512), args, LDS_BYTES, stream);
    if (e != hipSuccess) fprintf(stderr, "cooperative launch failed: %s (grid %d)\n", hipGetErrorString(e), grid_blocks);
}
```

```cpp
#include <hip/hip_runtime.h>
#include <hip/hip_cooperative_groups.h>
#include <cstdio>
#include <cstdint>
namespace cg = cooperative_groups;
#define LAS __attribute__((address_space(3)))
namespace pg8 {
#define PG8_LAS __attribute__((address_space(3)))
typedef unsigned short bf16_t;
typedef short bf16x8 __attribute__((ext_vector_type(8)));
typedef float f32x4 __attribute__((ext_vector_type(4)));
typedef unsigned u32x4 __attribute__((ext_vector_type(4)));
constexpr int BM = 256, BK = 64, HALF = 128, HTB = HALF * BK * 2  , STAGE_BYTES = 8 * HTB, NXCD = 8, WGM = 8;

__host__ __device__ __forceinline__ int lds_byte(int r, int c) { const int st = (r >> 4) * 2 + (c >> 5), rr = r & 15, cc = c & 31, ob = rr * 64 + cc * 2; return st * 1024 + (ob ^ (((ob >> 9) & 1) << 5)); }
__host__ __device__ __forceinline__ void stage_rc(int b, int& R, int& C) { const int st = b / 1024, sb = b % 1024, swz = sb ^ (((sb >> 9) & 1) << 5); R = (st >> 1) * 16 + swz / 64; C = (st & 1) * 32 + (swz % 64) / 2; }
__host__ __device__ __forceinline__ int perm32(int rho) { const int n = rho >> 4, i = rho & 15; return 8 * (i >> 2) + 4 * n + (i & 3); }

struct Unit { int pm, pn; };
struct Gemm { const bf16_t* A; const bf16_t* Bt; int M, N, K; };

struct StaticOrder {
    int nM, nN, nwg, G, c;
    __host__ __device__ void init(int M, int N, int G_, int c_) { nM = M / BM; nN = N / BM; nwg = nM * nN; G = G_; c = c_; }
    __host__ __device__ bool next(int i, Unit& u) const {
        const long L = (long)i * G + c; if (L >= nwg) return false;
        int wgid = (int)L; { const int q = nwg / NXCD, r = nwg % NXCD, xcd = wgid % NXCD, off = wgid / NXCD; wgid = (xcd < r ? xcd * (q + 1) : r * (q + 1) + (xcd - r) * q) + off; }
        const int nig = WGM * nN, gid = wgid / nig, fm = gid * WGM, gsz = (nM - fm) < WGM ? (nM - fm) : WGM;
        u.pm = fm + ((wgid % nig) % gsz); u.pn = (wgid % nig) / gsz; return true;
    }
    __device__ __forceinline__ void a_ready(const Unit&) const {}
    __device__ __forceinline__ void done(const Unit&) const {}
};

__device__ __forceinline__ unsigned cvt_pk_bf16(float lo, float hi) { unsigned r; asm volatile("v_cvt_pk_bf16_f32 %0, %1, %2" : "=v"(r) : "v"(lo), "v"(hi)); return r; }
typedef float f32x2 __attribute__((ext_vector_type(2)));
__device__ __forceinline__ f32x2 gelu_pk(f32x2 v) {
    const f32x2 av = __builtin_elementwise_abs(v), d = av * 0.2316418882f + 1.0f;
    f32x2 t; t.x = __builtin_amdgcn_rcpf(d.x); t.y = __builtin_amdgcn_rcpf(d.y);
    f32x2 q = t * 0.5307027145f + (-0.7265760135f); q = q * t + 0.7107068705f; q = q * t + (-0.142248368f); q = q * t + 0.127414796f; q = q * t;
    const f32x2 s = (v * v) * (-0.72134752044f);
    f32x2 e; e.x = __builtin_amdgcn_exp2f(s.x); e.y = __builtin_amdgcn_exp2f(s.y);
    const f32x2 m = v * (q * e), r = v - m;
    f32x2 o; o.x = v.x < 0.f ? m.x : r.x; o.y = v.y < 0.f ? m.y : r.y; return o;
}

template <int ACT  > struct EpiBf16 {
    static constexpr bool PERM = true, AFTER_DRAIN = false; static_assert(ACT == 0 || ACT == 1, "EpiBf16: ACT is 0 (none) or 1 (gelu_pk)");
    bf16_t* O; int ldc; const float* bias; int split_cols; size_t split_stride; float scale0;
    __device__ __forceinline__ void operator()(const f32x4 (&acc)[2][2][4][2], const Unit& u, int wr, int wc, int fr, int fq) const {
        const int row0 = u.pm * BM + wr * 64 + fr; int colt = u.pn * BM; bf16_t* base = O;
        float sc = 1.f; if (split_cols) { const int t = colt / split_cols; base += (size_t)t * split_stride; colt -= t * split_cols; if (t == 0) sc = scale0; }
        const int col0 = colt + wc * 32 + 8 * fq, bcol0 = u.pn * BM + wc * 32 + 8 * fq;
        f32x4 bv[2][2];
#pragma unroll
        for (int bj = 0; bj < 2; ++bj)
#pragma unroll
            for (int n = 0; n < 2; ++n) bv[bj][n] = bias ? *(const f32x4*)(bias + bcol0 + bj * HALF + 4 * n) : (f32x4){0.f, 0.f, 0.f, 0.f};
#pragma unroll
        for (int ai = 0; ai < 2; ++ai)
#pragma unroll
            for (int m = 0; m < 4; ++m) { bf16_t* rowp = base + (size_t)(row0 + ai * HALF + m * 16) * ldc + col0;
#pragma unroll
                for (int bj = 0; bj < 2; ++bj) { f32x4 v0 = acc[ai][bj][m][0] + bv[bj][0], v1 = acc[ai][bj][m][1] + bv[bj][1];
                    if (ACT == 1) { f32x2 a = gelu_pk((f32x2){v0[0], v0[1]}), b = gelu_pk((f32x2){v0[2], v0[3]}), c = gelu_pk((f32x2){v1[0], v1[1]}), d = gelu_pk((f32x2){v1[2], v1[3]});
                        v0 = (f32x4){a.x, a.y, b.x, b.y}; v1 = (f32x4){c.x, c.y, d.x, d.y}; }
                    v0 = v0 * sc; v1 = v1 * sc; u32x4 w; w.x = cvt_pk_bf16(v0[0], v0[1]); w.y = cvt_pk_bf16(v0[2], v0[3]); w.z = cvt_pk_bf16(v1[0], v1[1]); w.w = cvt_pk_bf16(v1[2], v1[3]);
                    *(u32x4*)(rowp + bj * HALF) = w; } }
    }
};
template <class Epi, class Sched, bool ALIGN_EPI = false, bool SP2 = false, int A_AUX = 0  >
__device__ __forceinline__ void gemm_phase(PG8_LAS unsigned char* lds, const Gemm g, const Sched& S, const Epi& E) {
    int tid_ = threadIdx.x; asm volatile("" : "+v"(tid_)); const int tid = tid_, wid = __builtin_amdgcn_readfirstlane(tid >> 6), lane = tid & 63, wr = wid >> 2, wc = wid & 3, fr = lane & 15, fq = lane >> 4;
    const int K = g.K, nt = K / BK;
    unsigned voffA[2], voffB[2];
#pragma unroll
    for (int i = 0; i < 2; ++i) { int R, C; stage_rc(tid * 16 + i * 8192, R, C); const int Rb = Epi::PERM ? ((R & ~31) + perm32(R & 31)) : R;
        voffA[i] = (unsigned)(R * K + C) * 2u; voffB[i] = (unsigned)(Rb * K + C) * 2u; }
    const size_t kstep = (size_t)(BK * 2);
    const size_t hstep = (size_t)HALF * K * 2;
    const size_t tstep = 2 * hstep;
    const unsigned ldsw = (unsigned)wid * 1024u;
    const int aoff = lds_byte(wr * 64 + fr, fq * 8), boff = lds_byte(wc * 32 + fr, fq * 8);
#define PG8_SA(b, h) (((b) * 2 + (h)) * HTB)
#define PG8_SB(b, h) ((4 + (b) * 2 + (h)) * HTB)
#define PG8_STAGE(bufoff, gbase, voff) do { _Pragma("unroll") for (int _i = 0; _i < 2; ++_i) \
        __builtin_amdgcn_global_load_lds((const unsigned*)((const char*)(gbase) + (voff)[_i]), (PG8_LAS unsigned*)(lds + (bufoff) + ldsw + _i * 8192), 16, 0, 0); } while (0)
#define PG8_STAGEA(bufoff, gbase, voff) do { _Pragma("unroll") for (int _i = 0; _i < 2; ++_i) \
        __builtin_amdgcn_global_load_lds((const unsigned*)((const char*)(gbase) + (voff)[_i]), (PG8_LAS unsigned*)(lds + (bufoff) + ldsw + _i * 8192), 16, 0, A_AUX); } while (0)
#define PG8_LDA(dst, b, h) do { _Pragma("unroll") for (int m = 0; m < 4; ++m) _Pragma("unroll") for (int k = 0; k < 2; ++k) dst[m][k] = *(const PG8_LAS bf16x8*)(lds + PG8_SA(b, h) + aoff + m * 2048 + k * 1024); } while (0)
#define PG8_LDB(dst, b, h) do { _Pragma("unroll") for (int n = 0; n < 2; ++n) _Pragma("unroll") for (int k = 0; k < 2; ++k) dst[n][k] = *(const PG8_LAS bf16x8*)(lds + PG8_SB(b, h) + boff + n * 2048 + k * 1024); } while (0)
#define PG8_MMA(ai, bj, At, Bt) do { __builtin_amdgcn_s_setprio(1); _Pragma("unroll") for (int m = 0; m < 4; ++m) _Pragma("unroll") for (int n = 0; n < 2; ++n) _Pragma("unroll") for (int k = 0; k < 2; ++k) \
        acc[ai][bj][m][n] = __builtin_amdgcn_mfma_f32_16x16x32_bf16(Bt[n][k], At[m][k], acc[ai][bj][m][n], 0, 0, 0); __builtin_amdgcn_s_setprio(0); } while (0)
#define PG8_WAIT_V(n) asm volatile("s_waitcnt vmcnt(" #n ")" ::: "memory")
#define PG8_WAIT_L(n) asm volatile("s_waitcnt lgkmcnt(" #n ")" ::: "memory")
#define PG8_BAR __builtin_amdgcn_s_barrier()
#define PG8_SCHED __builtin_amdgcn_sched_barrier(0)
    Unit cur, nxt; int ui = 0;
    if (!S.next(0, cur)) return;
    f32x4 acc[2][2][4][2];
#pragma unroll
    for (int a = 0; a < 2; ++a)
#pragma unroll
        for (int b = 0; b < 2; ++b)
#pragma unroll
            for (int m = 0; m < 4; ++m)
#pragma unroll
                for (int n = 0; n < 2; ++n) acc[a][b][m][n] = (f32x4){0.f, 0.f, 0.f, 0.f};
    bf16x8 At[4][2], B0[2][2], B1[2][2];
    const char* cA = (const char*)g.A + (size_t)cur.pm * tstep; const char* cB = (const char*)g.Bt + (size_t)cur.pn * tstep;
    S.a_ready(cur);
    if constexpr (SP2) {
        PG8_STAGE(PG8_SB(0, 0), cB, voffB); PG8_STAGE(PG8_SB(0, 1), cB + hstep, voffB); PG8_STAGEA(PG8_SA(0, 0), cA, voffA); PG8_STAGEA(PG8_SA(0, 1), cA + hstep, voffA);
        if (wr == 1) PG8_BAR;
        PG8_WAIT_V(2); PG8_BAR;
        PG8_STAGE(PG8_SB(1, 0), cB + kstep, voffB); PG8_STAGEA(PG8_SA(1, 0), cA + kstep, voffA); PG8_STAGE(PG8_SB(1, 1), cB + hstep + kstep, voffB);
        PG8_WAIT_V(6); PG8_BAR;
    } else {
        PG8_STAGE(PG8_SB(0, 0), cB, voffB); PG8_STAGEA(PG8_SA(0, 0), cA, voffA); PG8_STAGE(PG8_SB(0, 1), cB + hstep, voffB); PG8_STAGEA(PG8_SA(0, 1), cA + hstep, voffA);
        if (wr == 1) PG8_BAR;
        PG8_WAIT_V(4); PG8_BAR;
        PG8_STAGE(PG8_SB(1, 0), cB + kstep, voffB); PG8_STAGEA(PG8_SA(1, 0), cA + kstep, voffA); PG8_STAGE(PG8_SB(1, 1), cB + hstep + kstep, voffB);
        PG8_WAIT_V(6); PG8_BAR;
    }
    for (;;) {
        const bool has_next = S.next(ui + 1, nxt);
        const char* nA = has_next ? (const char*)g.A + (size_t)nxt.pm * tstep : cA; const char* nB = has_next ? (const char*)g.Bt + (size_t)nxt.pn * tstep : cB;
        for (int t = 0; t < nt; t += 2) {
            const bool last = (t == nt - 2);
            const char* a1 = cA + (size_t)(t + 1) * kstep;
            const char* a2 = last ? nA : cA + (size_t)(t + 2) * kstep; const char* b2 = last ? nB : cB + (size_t)(t + 2) * kstep;
            const char* a3 = a2 + kstep; const char* b3 = b2 + kstep;
            if (last && has_next) S.a_ready(nxt);
            if constexpr (SP2) {
            PG8_LDB(B0, 0, 0); PG8_LDB(B1, 0, 1); PG8_SCHED; PG8_LDA(At, 0, 0); PG8_STAGEA(PG8_SA(1, 1), a1 + hstep, voffA);
            PG8_WAIT_V(8); PG8_WAIT_L(0); PG8_BAR; PG8_MMA(0, 0, At, B0); PG8_MMA(0, 1, At, B1); PG8_BAR; PG8_SCHED;
            PG8_LDA(At, 0, 1); PG8_STAGE(PG8_SB(0, 0), b2, voffB); PG8_STAGE(PG8_SB(0, 1), b2 + hstep, voffB); PG8_STAGEA(PG8_SA(0, 0), a2, voffA);
            PG8_WAIT_V(8); PG8_WAIT_L(0); PG8_BAR; PG8_MMA(1, 0, At, B0); PG8_MMA(1, 1, At, B1); PG8_BAR; PG8_SCHED;
            PG8_LDB(B0, 1, 0); PG8_LDB(B1, 1, 1); PG8_SCHED; PG8_LDA(At, 1, 0); PG8_STAGEA(PG8_SA(0, 1), a2 + hstep, voffA);
            PG8_WAIT_V(8); PG8_WAIT_L(0); PG8_BAR; PG8_MMA(0, 0, At, B0); PG8_MMA(0, 1, At, B1); PG8_BAR; PG8_SCHED;
            PG8_LDA(At, 1, 1); PG8_STAGE(PG8_SB(1, 0), b3, voffB); PG8_STAGE(PG8_SB(1, 1), b3 + hstep, voffB); PG8_STAGEA(PG8_SA(1, 0), a3, voffA);
            PG8_WAIT_V(8); PG8_WAIT_L(0); PG8_BAR; PG8_MMA(1, 0, At, B0); PG8_MMA(1, 1, At, B1); PG8_BAR; PG8_SCHED;
            } else {
            PG8_LDB(B0, 0, 0); PG8_SCHED; PG8_LDA(At, 0, 0); PG8_STAGEA(PG8_SA(1, 1), a1 + hstep, voffA);
            PG8_WAIT_L(8); PG8_BAR; PG8_WAIT_L(0); PG8_MMA(0, 0, At, B0); PG8_BAR; PG8_SCHED;
            PG8_LDB(B1, 0, 1); PG8_STAGE(PG8_SB(0, 0), b2, voffB);
            PG8_BAR; PG8_WAIT_L(0); PG8_MMA(0, 1, At, B1); PG8_BAR;
            PG8_LDA(At, 0, 1); PG8_STAGEA(PG8_SA(0, 0), a2, voffA);
            PG8_BAR; PG8_WAIT_L(0); PG8_MMA(1, 0, At, B0); PG8_BAR; PG8_SCHED;
            PG8_STAGE(PG8_SB(0, 1), b2 + hstep, voffB);
            PG8_WAIT_V(6); PG8_BAR; PG8_MMA(1, 1, At, B1); PG8_BAR;
            PG8_LDB(B0, 1, 0); PG8_SCHED; PG8_LDA(At, 1, 0); PG8_STAGEA(PG8_SA(0, 1), a2 + hstep, voffA);
            PG8_WAIT_L(8); PG8_BAR; PG8_WAIT_L(0); PG8_MMA(0, 0, At, B0); PG8_BAR; PG8_SCHED;
            PG8_LDB(B1, 1, 1); PG8_STAGE(PG8_SB(1, 0), b3, voffB);
            PG8_BAR; PG8_WAIT_L(0); PG8_MMA(0, 1, At, B1); PG8_BAR;
            PG8_LDA(At, 1, 1); PG8_STAGEA(PG8_SA(1, 0), a3, voffA);
            PG8_BAR; PG8_WAIT_L(0); PG8_MMA(1, 0, At, B0); PG8_BAR; PG8_SCHED;
            PG8_STAGE(PG8_SB(1, 1), b3 + hstep, voffB);
            PG8_WAIT_V(6); PG8_BAR; PG8_MMA(1, 1, At, B1); PG8_BAR;
            }
        }
        if constexpr (ALIGN_EPI) { if (wr == 0) PG8_BAR; }
        if constexpr (!Epi::AFTER_DRAIN) { E(acc, cur, wr, wc, fr, fq); S.done(cur); }
        if (!has_next) break;
#pragma unroll
        for (int a = 0; a < 2; ++a)
#pragma unroll
            for (int b = 0; b < 2; ++b)
#pragma unroll
                for (int m = 0; m < 4; ++m)
#pragma unroll
                    for (int n = 0; n < 2; ++n) acc[a][b][m][n] = (f32x4){0.f, 0.f, 0.f, 0.f};
        cur = nxt; cA = nA; cB = nB; ++ui;
        if constexpr (ALIGN_EPI) { if (wr == 1) PG8_BAR; }
    }
    PG8_WAIT_V(0);
    if constexpr (!ALIGN_EPI) { if (wr == 0) PG8_BAR; }
    PG8_BAR;
    if constexpr (Epi::AFTER_DRAIN) { E.fused(acc, cur, wr, wc, fr, fq, lds, wid, lane); S.done(cur); }
#undef PG8_SA
#undef PG8_SB
#undef PG8_STAGE
#undef PG8_STAGEA
#undef PG8_LDA
#undef PG8_LDB
#undef PG8_MMA
#undef PG8_WAIT_V
#undef PG8_WAIT_L
#undef PG8_BAR
#undef PG8_SCHED
}
}
#define XB_TMO      128
#define XB_XCNT(j)  (256  + 64 * (j))
#define XB_XSUB(j)  (1280 + 64 * (j))
#define XB_XGEN(j)  (2304 + 64 * (j))
#define XB_TOP      3328
#define XB_TOPGEN   3392
#define XCD_BAR_WORDS 3456
#define XB_SPIN_CAP (1u << 18)

__device__ __forceinline__ unsigned xb_ld(unsigned* p)              { return __hip_atomic_load(p, __ATOMIC_RELAXED, __HIP_MEMORY_SCOPE_AGENT); }
__device__ __forceinline__ unsigned xb_add(unsigned* p, unsigned v) { return __hip_atomic_fetch_add(p, v, __ATOMIC_RELAXED, __HIP_MEMORY_SCOPE_AGENT); }
__device__ __forceinline__ unsigned xb_xcc_id() { return (unsigned)__builtin_amdgcn_s_getreg((3 << 11) | 20) & 0xFu; }
#define XB_SPIN(cond, bar) do { unsigned _sp = 0; while (cond) { __builtin_amdgcn_s_sleep(1); \
    if ((++_sp & 255u) == 0u) { if (xb_ld(&(bar)[XB_TMO])) break; if (_sp > XB_SPIN_CAP) { atomicAdd(&(bar)[XB_TMO], 1u); break; } } } } while (0)

struct XcdBarrier {
    unsigned* bar; unsigned x;
    volatile LAS unsigned* st;
};

__device__ __forceinline__ XcdBarrier xcd_barrier_post(unsigned* bar, volatile LAS unsigned* st) {
    XcdBarrier b; b.bar = bar; b.x = xb_xcc_id(); b.st = st;
    if (threadIdx.x == 0) (void)xb_add(&bar[XB_XCNT(b.x)], 1u);
    return b;
}
__device__ __forceinline__ void xcd_barrier_complete(unsigned* bar, unsigned x, unsigned& nloc, unsigned& nx) {
    const unsigned G = gridDim.x * gridDim.y * gridDim.z;
    unsigned sum, cnt, mine, sp = 0u;
    for (;;) {
        sum = 0u; cnt = 0u; mine = 0u;
#pragma unroll
        for (unsigned j = 0; j < 16; ++j) { const unsigned c = xb_ld(&bar[XB_XCNT(j)]); sum += c; cnt += (c > 0u) ? 1u : 0u; mine = (j == x) ? c : mine; }
        if (sum == G) break;
        __builtin_amdgcn_s_sleep(1);
        if ((++sp & 255u) == 0u) { if (xb_ld(&bar[XB_TMO])) break; if (sp > XB_SPIN_CAP) { atomicAdd(&bar[XB_TMO], 1u); break; } }
    }
    nloc = mine > 0u ? mine : 1u; nx = cnt > 0u ? cnt : 1u;
}

__device__ __forceinline__ void xcd_barrier(const XcdBarrier& b) {
    asm volatile("s_waitcnt vmcnt(0)" ::: "memory");
    __syncthreads();
    if (threadIdx.x == 0) {
        unsigned* bar = b.bar;
        __builtin_amdgcn_s_waitcnt(0);
        unsigned nloc = b.st[0], nx = b.st[1];
        if (nloc == 0u) { xcd_barrier_complete(bar, b.x, nloc, nx); b.st[0] = nloc; b.st[1] = nx; }
        const unsigned old = xb_add(&bar[XB_XSUB(b.x)], 1u);
        const unsigned gen = old / nloc;
        if (old + 1u == (gen + 1u) * nloc) {
            __builtin_amdgcn_fence(__ATOMIC_RELEASE, "agent");
            asm volatile("s_waitcnt vmcnt(0)" ::: "memory");
            const unsigned og = xb_add(&bar[XB_TOP], 1u);
            const unsigned tg = og / nx;
            if (og + 1u == (tg + 1u) * nx) xb_add(&bar[XB_TOPGEN], 1u);
            else XB_SPIN(xb_ld(&bar[XB_TOPGEN]) == tg, bar);
            __builtin_amdgcn_fence(__ATOMIC_ACQUIRE, "agent");
            xb_add(&bar[XB_XGEN(b.x)], 1u);
            asm volatile("s_waitcnt vmcnt(0)" ::: "memory");
        } else {
            XB_SPIN(xb_ld(&bar[XB_XGEN(b.x)]) == gen, bar);
            __builtin_amdgcn_fence(__ATOMIC_ACQUIRE, "agent");
            asm volatile("s_waitcnt vmcnt(0)" ::: "memory");
        }
    }
    __syncthreads();
}

constexpr int NB = 8, SEQ = 8192, DM = 1024, DEPTH = 2;
constexpr int T = NB * SEQ;
constexpr int INW = 1280, DFF = 2816, NMODW = 6 * DM;
constexpr int KCH = 32;
constexpr float EPS = 1e-6f;
constexpr float LOG2E = 1.4426950408889634f;

#define LAS __attribute__((address_space(3)))
typedef unsigned short bf16;
typedef unsigned v4u __attribute__((ext_vector_type(4)));
typedef unsigned v2u __attribute__((ext_vector_type(2)));
typedef float f32x4 __attribute__((ext_vector_type(4)));
typedef short bf16x8 __attribute__((ext_vector_type(8)));

constexpr size_t MiB = 1u << 20;
constexpr size_t WS_MODP = 640 * MiB;
constexpr size_t WS_MODF = 8 * MiB;
constexpr size_t WS_CS = 9 * MiB;
constexpr size_t WS_W = 16 * MiB, W_LAYER = 24 * MiB;
constexpr size_t W_IN = 0, W_OUT = 3 * MiB, W_GU = 5 * MiB, W_DN = 16 * MiB, W_PW = 22 * MiB;
constexpr size_t WS_H = 64 * MiB;
constexpr size_t WS_MIX = 192 * MiB;
constexpr size_t WS_PROJ = 320 * MiB;
constexpr size_t WS_CONCAT = 480 * MiB;
constexpr size_t WS_ACT = 320 * MiB;
constexpr size_t WS_XA = 672 * MiB;
constexpr size_t WS_XB = 800 * MiB;
constexpr size_t WS_END = 928 * MiB;

constexpr int RING_BYTES = 131072;
constexpr int LDS_BYTES = 147456;

struct Args {
    const float* x; const float* c; const int* pos; const float* ada_w; const float* ada_b; const float* w_in; const float* b_in;
    const float* sinks; const float* pool_w; const float* pool_scale; const float* w_out; const float* w_gate; const float* w_up;
    const float* w_down; const float* g_pre_mix; const float* g_post_mix; const float* g_pre_ffn; const float* g_post_ffn;
    float* out; unsigned char* ws;
};

__device__ __constant__ double c_inv_freq[8] = {1.0, 0.19392274474868576, 0.03760603093086393, 0.007292664737217109,
                                                0.001414213562373095, 0.0002742481756762073, 5.318295896944988e-05, 1.031338537721246e-05};

__device__ __forceinline__ unsigned pk2(float lo, float hi) { return pg8::cvt_pk_bf16(lo, hi); }
__device__ __forceinline__ float bf_lo(unsigned w) { return __uint_as_float(w << 16); }
__device__ __forceinline__ float bf_hi(unsigned w) { return __uint_as_float(w & 0xffff0000u); }
__device__ __forceinline__ float wave_sum(float v) {
#pragma unroll
    for (int o = 1; o < 64; o <<= 1) v += __shfl_xor(v, o);
    return v;
}

namespace pg8 {
struct EpiInProj {
    static constexpr bool PERM = true, AFTER_DRAIN = false;
    bf16_t* O; const float* bias; const float* cs;
    __device__ __forceinline__ void operator()(const f32x4 (&acc)[2][2][4][2], const Unit& u, int wr, int wc, int fr, int fq) const {
        const int row0 = u.pm * BM + wr * 64 + fr; const int colt = u.pn * BM; const int col0 = colt + wc * 32 + 8 * fq;
        f32x4 bv[2][2];
#pragma unroll
        for (int bj = 0; bj < 2; ++bj)
#pragma unroll
            for (int n = 0; n < 2; ++n) bv[bj][n] = *(const f32x4*)(bias + col0 + bj * HALF + 4 * n);
        const bool rot_wave = (colt < 640) && ((wc & 1) == 0);
#pragma unroll
        for (int ai = 0; ai < 2; ++ai)
#pragma unroll
        for (int mh = 0; mh < 2; ++mh) {
            f32x4 cc[2][4];
#pragma unroll
            for (int mm = 0; mm < 2; ++mm)
#pragma unroll
                for (int q = 0; q < 4; ++q) cc[mm][q] = (f32x4){1.f, 1.f, 1.f, 1.f};
            if (rot_wave && fq < 2) {
#pragma unroll
                for (int mm = 0; mm < 2; ++mm) { const float* cr = cs + (size_t)(row0 + ai * HALF + (2 * mh + mm) * 16) * 16;
#pragma unroll
                    for (int q = 0; q < 4; ++q) cc[mm][q] = *(const f32x4*)(cr + 4 * q); }
            }
#pragma unroll
            for (int mm = 0; mm < 2; ++mm) {
                const int m = 2 * mh + mm;
                const int row = row0 + ai * HALF + m * 16;
                bf16_t* rowp = O + (size_t)row * INW + col0;
#pragma unroll
                for (int bj = 0; bj < 2; ++bj) {
                    f32x4 v0 = acc[ai][bj][m][0] + bv[bj][0], v1 = acc[ai][bj][m][1] + bv[bj][1];
                    const int cb = colt + bj * HALF;
                    if (rot_wave && cb < 640) {
                        f32x4 p0, p1;
#pragma unroll
                        for (int e = 0; e < 4; ++e) { p0[e] = __shfl_xor(v0[e], 16); p1[e] = __shfl_xor(v1[e], 16); }
                        if (fq == 0) { v0 = v0 * cc[mm][0] - p0 * cc[mm][2]; v1 = v1 * cc[mm][1] - p1 * cc[mm][3]; }
                        else if (fq == 1) { v0 = v0 * cc[mm][0] + p0 * cc[mm][2]; v1 = v1 * cc[mm][1] + p1 * cc[mm][3]; }
                    }
                    if (cb < 512) { v0 = v0 * 0.125f; v1 = v1 * 0.125f; }
                    u32x4 w; w.x = cvt_pk_bf16(v0[0], v0[1]); w.y = cvt_pk_bf16(v0[2], v0[3]); w.z = cvt_pk_bf16(v1[0], v1[1]); w.w = cvt_pk_bf16(v1[2], v1[3]);
                    *(u32x4*)(rowp + bj * HALF) = w;
                }
            }
        }
    }
};
struct EpiSwiGLU {
    static constexpr bool PERM = true, AFTER_DRAIN = false;
    bf16_t* O;
    __device__ __forceinline__ void operator()(const f32x4 (&acc)[2][2][4][2], const Unit& u, int wr, int wc, int fr, int fq) const {
        typedef float f32x2 __attribute__((ext_vector_type(2)));
        const int row0 = u.pm * BM + wr * 64 + fr; const int col0 = u.pn * HALF + wc * 32 + 8 * fq;
#pragma unroll
        for (int ai = 0; ai < 2; ++ai)
#pragma unroll
            for (int m = 0; m < 4; ++m) {
                bf16_t* rowp = O + (size_t)(row0 + ai * HALF + m * 16) * DFF + col0;
                f32x2 G[4], U[4], t[4], r[4];
#pragma unroll
                for (int n = 0; n < 2; ++n) { G[2 * n] = (f32x2){acc[ai][0][m][n][0], acc[ai][0][m][n][1]}; G[2 * n + 1] = (f32x2){acc[ai][0][m][n][2], acc[ai][0][m][n][3]};
                                              U[2 * n] = (f32x2){acc[ai][1][m][n][0], acc[ai][1][m][n][1]}; U[2 * n + 1] = (f32x2){acc[ai][1][m][n][2], acc[ai][1][m][n][3]}; }
#pragma unroll
                for (int q = 0; q < 4; ++q) { t[q].x = __builtin_amdgcn_exp2f(G[q].x); t[q].y = __builtin_amdgcn_exp2f(G[q].y); }
#pragma unroll
                for (int q = 0; q < 4; ++q) { t[q] = t[q] + 1.0f; r[q] = G[q] * U[q]; }
#pragma unroll
                for (int q = 0; q < 4; ++q) { t[q].x = __builtin_amdgcn_rcpf(t[q].x); t[q].y = __builtin_amdgcn_rcpf(t[q].y); }
#pragma unroll
                for (int q = 0; q < 4; ++q) r[q] = r[q] * t[q];
                u32x4 w; w.x = cvt_pk_bf16(r[0].x, r[0].y); w.y = cvt_pk_bf16(r[1].x, r[1].y); w.z = cvt_pk_bf16(r[2].x, r[2].y); w.w = cvt_pk_bf16(r[3].x, r[3].y);
                *(u32x4*)rowp = w;
            }
    }
};
struct DualOrder {
    StaticOrder so; int c, rounds, hot;
    __device__ bool next(int i, Unit& u) const { if (hot) { if (i >= rounds) return false; u.pm = (c % 8) * 2 + ((c / 8) & 1); u.pn = ((c / 8) >> 1) & 3; return true; } return so.next(i, u); }
    __device__ __forceinline__ void a_ready(const Unit&) const {}
    __device__ __forceinline__ void done(const Unit&) const {}
};
}

__device__ __forceinline__ void transpose_item(const float* W, int K, int N, bf16* WT, int drow0, LAS float* scr, int k0, int n0, int lane, float wscale = 1.0f) {
#pragma unroll
    for (int ih = 0; ih < 32; ih += 16) {
        float tv[16];
#pragma unroll
        for (int i = 0; i < 16; ++i) tv[i] = __builtin_nontemporal_load(W + (size_t)(k0 + 2 * (ih + i) + (lane >> 5)) * N + n0 + (lane & 31));
#pragma unroll
        for (int i = 0; i < 16; ++i) scr[(2 * (ih + i) + (lane >> 5)) * 33 + (lane & 31)] = tv[i] * wscale;
    }
    asm volatile("s_waitcnt lgkmcnt(0)" ::: "memory");
    const int c = lane & 7;
#pragma unroll
    for (int j = 0; j < 4; ++j) { const int n = (lane >> 3) + 8 * j; const LAS float* s = scr + (8 * c) * 33 + n;
        v4u o; o.x = pk2(s[0 * 33], s[1 * 33]); o.y = pk2(s[2 * 33], s[3 * 33]); o.z = pk2(s[4 * 33], s[5 * 33]); o.w = pk2(s[6 * 33], s[7 * 33]);
        *(v4u*)(WT + (size_t)(drow0 + n) * K + k0 + 8 * c) = o; }
    asm volatile("s_waitcnt lgkmcnt(0)" ::: "memory");
}

__device__ __forceinline__ void prologue(const Args& a, LAS unsigned char* lds) {
    int tid_ = threadIdx.x; asm volatile("" : "+v"(tid_)); const int tid = tid_, lane = tid & 63, wave = tid >> 6;
    unsigned char* ws = a.ws;
    __syncthreads();
    {
        LAS float* sc = (LAS float*)lds;
        for (int i = tid; i < NB * DM; i += 512) { const float v = a.c[i]; sc[i] = v / (1.0f + __expf(-v)); }
        __syncthreads();
        float* modp = (float*)(ws + WS_MODP);
        for (int item = blockIdx.x; item < DEPTH * KCH * 12; item += gridDim.x) {
            const int l = item / (KCH * 12), r = item % (KCH * 12), kc = r / 12, cb = r % 12, n = cb * 512 + tid;
            constexpr int KPI = DM / KCH;
            const float* w = a.ada_w + ((size_t)l * DM + kc * KPI) * NMODW + n;
            float acc[8];
#pragma unroll
            for (int b = 0; b < 8; ++b) acc[b] = 0.f;
#pragma unroll 1
            for (int kh = 0; kh < KPI; kh += 16) {
                float wv[16];
#pragma unroll
                for (int k = 0; k < 16; ++k) wv[k] = __builtin_nontemporal_load(w + (size_t)(kh + k) * NMODW);
#pragma unroll
                for (int k = 0; k < 16; ++k) {
                    const LAS float* sp = sc + kc * KPI + kh + k;
#pragma unroll
                    for (int b = 0; b < 8; ++b) acc[b] += sp[b * DM] * wv[k];
                    if ((k & 3) == 3) asm volatile("" ::: "memory");
                }
            }
#pragma unroll
            for (int b = 0; b < 8; ++b) modp[((size_t)(l * KCH + kc) * 8 + b) * NMODW + n] = acc[b];
        }
        __syncthreads();
    }
    {
        float* cs = (float*)(ws + WS_CS);
        for (int idx = blockIdx.x * 512 + tid; idx < T * 8; idx += gridDim.x * 512) {
            const int row = idx >> 3, j = idx & 7;
            const double rev = (double)a.pos[row] * c_inv_freq[j] * 0.15915494309189535;
            const float fr = (float)(rev - floor(rev));
            cs[(size_t)row * 16 + j] = __builtin_amdgcn_cosf(fr);
            cs[(size_t)row * 16 + 8 + j] = __builtin_amdgcn_sinf(fr);
        }
    }
    {
        LAS float* scr = (LAS float*)(lds + wave * 16384);
        const int gw = blockIdx.x * 8 + wave, ngw = gridDim.x * 8;
        constexpr int I_IN = 16 * 40, I_OUT = 16 * 32, I_G = 16 * 88, I_D = 44 * 32, I_P = 4 * 8;
        constexpr int PER_L = I_IN + I_OUT + 2 * I_G + I_D + I_P;
        for (int it = gw; it < DEPTH * PER_L; it += ngw) {
            const int l = it / PER_L; int r = it % PER_L;
            unsigned char* wl = ws + WS_W + (size_t)l * W_LAYER;
            if (r < I_IN) { const int kb = r / 40, nb = r % 40; transpose_item(a.w_in + (size_t)l * DM * INW, DM, INW, (bf16*)(wl + W_IN), 32 * nb, scr, 64 * kb, 32 * nb, lane); continue; } r -= I_IN;
            if (r < I_OUT) { const int kb = r / 32, nb = r % 32; transpose_item(a.w_out + (size_t)l * DM * DM, DM, DM, (bf16*)(wl + W_OUT), 32 * nb, scr, 64 * kb, 32 * nb, lane); continue; } r -= I_OUT;
            if (r < 2 * I_G) { const int up = r >= I_G; if (up) r -= I_G; const int kb = r / 88, nb = r % 88, n0 = 32 * nb;
                transpose_item((up ? a.w_up : a.w_gate) + (size_t)l * DM * DFF, DM, DFF, (bf16*)(wl + W_GU), 256 * (n0 >> 7) + (n0 & 127) + (up ? 128 : 0), scr, 64 * kb, n0, lane, up ? -0.6931471805599453f : -1.4426950408889634f); continue; } r -= 2 * I_G;
            if (r < I_D) { const int kb = r / 32, nb = r % 32; transpose_item(a.w_down + (size_t)l * DFF * DM, DFF, DM, (bf16*)(wl + W_DN), 32 * nb, scr, 64 * kb, 32 * nb, lane); continue; } r -= I_D;
            { const int gi = r / 8, q = r % 8, kb = q / 4, nb = q % 4;
              transpose_item(a.pool_w + ((size_t)l * 4 + gi) * 128 * 128, 128, 128, (bf16*)(wl + W_PW) + (size_t)gi * 128 * 128, 32 * nb, scr, 64 * kb, 32 * nb, lane); }
        }
    }
}

__device__ __forceinline__ float mod_val(const Args& a, int l, int b, int idx, int col) {
    const float* modp = (const float*)(a.ws + WS_MODP);
    const int n = idx * DM + col;
    float s = a.ada_b[l * NMODW + n];
#pragma unroll
    for (int kc = 0; kc < KCH; ++kc) s += modp[((size_t)(l * KCH + kc) * 8 + b) * NMODW + n];
    return s;
}
__device__ __forceinline__ float mod_fin(const Args& a, int l, int b, int idx, int col) {
    return ((const float*)(a.ws + WS_MODF))[((size_t)(l * 8 + b)) * NMODW + idx * DM + col];
}
__device__ __forceinline__ void mod_finalize(const Args& a) {
    float* modf = (float*)(a.ws + WS_MODF);
    for (int i = blockIdx.x * 512 + threadIdx.x; i < DEPTH * 8 * NMODW; i += gridDim.x * 512) {
        const int l = i / (8 * NMODW), r = i % (8 * NMODW), b = r / NMODW, n = r % NMODW;
        modf[i] = mod_val(a, l, b, n / DM, n % DM);
    }
}
__device__ __forceinline__ void unpack8(const v4u w, float (&f)[8]) {
#pragma unroll
    for (int e = 0; e < 4; ++e) { f[2 * e] = bf_lo(w[e]); f[2 * e + 1] = bf_hi(w[e]); }
}
__device__ __forceinline__ v4u pack8(const float (&f)[8]) { return (v4u){pk2(f[0], f[1]), pk2(f[2], f[3]), pk2(f[4], f[5]), pk2(f[6], f[7])}; }
__device__ __forceinline__ void rowwise_phase(const Args& a, LAS unsigned char* lds, bool from_partials, bool has_y, bool has_h, bool xin_bf, int xout_mode,
        const void* xin, const bf16* y, float* xout, bf16* xoutb, bf16* hout,
        int l_y, int gate_idx, const float* g_post, int l_h, int shift_idx, int scale_idx, const float* g_pre) {
    int tid_ = threadIdx.x; asm volatile("" : "+v"(tid_)); const int tid = tid_, lane = tid & 63, wave = tid >> 6;
    LAS float* vec = (LAS float*)lds;
    for (int tile = blockIdx.x; tile < T / 256; tile += gridDim.x) {
        const int b = tile / (SEQ / 256);
        __syncthreads();
        for (int col = tid; col < DM; col += 512) {
            if (from_partials) {
                if (has_y) vec[col] = mod_val(a, l_y, b, gate_idx, col) * g_post[col];
                if (has_h) { vec[DM + col] = g_pre[col] * (1.0f + mod_val(a, l_h, b, scale_idx, col)); vec[2 * DM + col] = mod_val(a, l_h, b, shift_idx, col); }
            } else {
                if (has_y) vec[col] = mod_fin(a, l_y, b, gate_idx, col) * g_post[col];
                if (has_h) { vec[DM + col] = g_pre[col] * (1.0f + mod_fin(a, l_h, b, scale_idx, col)); vec[2 * DM + col] = mod_fin(a, l_h, b, shift_idx, col); }
            }
        }
        __syncthreads();
#pragma unroll 1
        for (int r = wave * 4; r < 256; r += 32) {
            float v[4][2][8]; v4u yv[4][2];
#pragma unroll
            for (int h = 0; h < 4; ++h)
#pragma unroll
                for (int j = 0; j < 2; ++j) { const size_t off = ((size_t)tile * 256 + r + h) * DM + 8 * lane + 512 * j;
                    if (xin_bf) unpack8(__builtin_nontemporal_load((const v4u*)((const bf16*)xin + off)), v[h][j]);
                    else { const f32x4 p0 = __builtin_nontemporal_load((const f32x4*)((const float*)xin + off)), p1 = __builtin_nontemporal_load((const f32x4*)((const float*)xin + off + 4));
                        v[h][j][0] = p0.x; v[h][j][1] = p0.y; v[h][j][2] = p0.z; v[h][j][3] = p0.w; v[h][j][4] = p1.x; v[h][j][5] = p1.y; v[h][j][6] = p1.z; v[h][j][7] = p1.w; }
                    yv[h][j] = has_y ? __builtin_nontemporal_load((const v4u*)(y + off)) : (v4u){0u, 0u, 0u, 0u}; }
            if (has_y) {
                float rstd[4];
#pragma unroll
                for (int h = 0; h < 4; ++h) { float ss = 0.f;
#pragma unroll
                    for (int j = 0; j < 2; ++j) { float yf[8]; unpack8(yv[h][j], yf);
#pragma unroll
                        for (int e = 0; e < 8; ++e) ss += yf[e] * yf[e]; }
                    rstd[h] = __builtin_amdgcn_rsqf(wave_sum(ss) * (1.0f / DM) + EPS); }
#pragma unroll
                for (int j = 0; j < 2; ++j) { const LAS float* gpp = vec + 8 * lane + 512 * j; const f32x4 g0 = *(const LAS f32x4*)gpp, g1 = *(const LAS f32x4*)(gpp + 4);
                    const float gp[8] = {g0.x, g0.y, g0.z, g0.w, g1.x, g1.y, g1.z, g1.w};
#pragma unroll
                    for (int h = 0; h < 4; ++h) { float yf[8]; unpack8(yv[h][j], yf);
#pragma unroll
                        for (int e = 0; e < 8; ++e) v[h][j][e] += gp[e] * (yf[e] * rstd[h]); } }
            }
            if (xout_mode == 1) {
#pragma unroll
                for (int h = 0; h < 4; ++h)
#pragma unroll
                    for (int j = 0; j < 2; ++j) { float* o = xout + ((size_t)tile * 256 + r + h) * DM + 8 * lane + 512 * j;
                        __builtin_nontemporal_store((f32x4){v[h][j][0], v[h][j][1], v[h][j][2], v[h][j][3]}, (f32x4*)o); __builtin_nontemporal_store((f32x4){v[h][j][4], v[h][j][5], v[h][j][6], v[h][j][7]}, (f32x4*)(o + 4)); }
            } else if (xout_mode == 2) {
#pragma unroll
                for (int h = 0; h < 4; ++h)
#pragma unroll
                    for (int j = 0; j < 2; ++j) { const v4u w = pack8(v[h][j]);
                        __builtin_nontemporal_store(w, (v4u*)(xoutb + ((size_t)tile * 256 + r + h) * DM + 8 * lane + 512 * j));
                        unpack8(w, v[h][j]); }
            }
            if (has_h) {
                float rstd[4];
#pragma unroll
                for (int h = 0; h < 4; ++h) { float ss = 0.f;
#pragma unroll
                    for (int j = 0; j < 2; ++j)
#pragma unroll
                        for (int e = 0; e < 8; ++e) ss += v[h][j][e] * v[h][j][e];
                    rstd[h] = __builtin_amdgcn_rsqf(wave_sum(ss) * (1.0f / DM) + EPS); }
#pragma unroll
                for (int j = 0; j < 2; ++j) { const LAS float* gsp = vec + DM + 8 * lane + 512 * j; const LAS float* shp = vec + 2 * DM + 8 * lane + 512 * j;
                    const f32x4 a0 = *(const LAS f32x4*)gsp, a1 = *(const LAS f32x4*)(gsp + 4), b0 = *(const LAS f32x4*)shp, b1 = *(const LAS f32x4*)(shp + 4);
                    const float gs[8] = {a0.x, a0.y, a0.z, a0.w, a1.x, a1.y, a1.z, a1.w}, sh[8] = {b0.x, b0.y, b0.z, b0.w, b1.x, b1.y, b1.z, b1.w};
#pragma unroll
                    for (int h = 0; h < 4; ++h) { float hv[8];
#pragma unroll
                        for (int e = 0; e < 8; ++e) hv[e] = v[h][j][e] * rstd[h] * gs[e] + sh[e];
                        *(v4u*)(hout + ((size_t)tile * 256 + r + h) * DM + 8 * lane + 512 * j) = pack8(hv); } }
            }
        }
    }
}

__device__ __forceinline__ void attn_phase(LAS unsigned char* lds, const bf16* PROJ, bf16* CONCAT, const float* sinks) {
    int tid_ = threadIdx.x; asm volatile("" : "+v"(tid_)); const int tid = tid_, lane = tid & 63, wave = tid >> 6, fr = lane & 15, fq = lane >> 4;
    LAS bf16* Ks = (LAS bf16*)lds;
    LAS bf16* Vt = (LAS bf16*)(lds + 36864);
    v4u kv[4], vv[4];
#define ATT_LOAD_KV(uu) do { const int kh_ = (uu) & 1, n_ = ((uu) >> 1) & 63, b_ = (uu) >> 7; const long rb_ = (long)b_ * SEQ + n_ * 128 - 128; \
        _Pragma("unroll") for (int i = 0; i < 4; ++i) { const int kj = lane + 64 * i; kv[i] = (v4u){0u, 0u, 0u, 0u}; vv[i] = (v4u){0u, 0u, 0u, 0u}; \
            if (n_ > 0 || kj >= 128) { const bf16* p = PROJ + (size_t)(rb_ + kj) * INW + kh_ * 64 + wave * 8; kv[i] = *(const v4u*)(p + 512); vv[i] = *(const v4u*)(p + 640); } } } while (0)
    if ((int)blockIdx.x < NB * 64 * 2) ATT_LOAD_KV((int)blockIdx.x);
    for (int u = blockIdx.x; u < NB * 64 * 2; u += gridDim.x) {
        const int kh = u & 1, n = (u >> 1) & 63, b = u >> 7;
        const int g = wave >> 1, h = kh * 4 + g;
        const size_t qrow0 = (size_t)b * SEQ + n * 128 + (wave & 1) * 64 + fr;
        bf16x8 qf[4][2];
#pragma unroll
        for (int i = 0; i < 4; ++i) { const bf16* qp = PROJ + (qrow0 + 16 * i) * INW + h * 64 + 8 * fq; qf[i][0] = __builtin_nontemporal_load((const bf16x8*)qp); qf[i][1] = __builtin_nontemporal_load((const bf16x8*)(qp + 32)); }
#pragma unroll
        for (int i = 0; i < 4; ++i) { const int kj = lane + 64 * i;
            *(LAS v4u*)(Ks + kj * 72 + wave * 8) = kv[i];
#pragma unroll
            for (int e = 0; e < 4; ++e) { Vt[(wave * 8 + 2 * e) * 272 + kj] = (bf16)(vv[i][e] & 0xffffu); Vt[(wave * 8 + 2 * e + 1) * 272 + kj] = (bf16)(vv[i][e] >> 16); } }
        __syncthreads();
        if (u + (int)gridDim.x < NB * 64 * 2) ATT_LOAD_KV(u + (int)gridDim.x);
        const float sink = sinks[h];
        const int firstblk = (n == 0);
#pragma unroll
        for (int p = 0; p < 2; ++p) {
            const int q16a = (wave & 1) * 4 + 2 * p, kt0 = q16a;
            f32x4 st[2][10];
#pragma unroll
            for (int t = 0; t < 10; ++t) {
                const LAS bf16* kp = Ks + (16 * (kt0 + t) + fr) * 72 + 8 * fq;
                const bf16x8 k0 = *(const LAS bf16x8*)kp, k1 = *(const LAS bf16x8*)(kp + 32);
#pragma unroll
                for (int x = 0; x < 2; ++x) {
                    if (x + 8 - t == 9 || x + 8 - t == -1) { st[x][t] = (f32x4){-1e30f, -1e30f, -1e30f, -1e30f}; continue; }
                    f32x4 acc = (f32x4){0.f, 0.f, 0.f, 0.f};
                    acc = __builtin_amdgcn_mfma_f32_16x16x32_bf16(k0, qf[2 * p + x][0], acc, 0, 0, 0);
                    acc = __builtin_amdgcn_mfma_f32_16x16x32_bf16(k1, qf[2 * p + x][1], acc, 0, 0, 0);
                    st[x][t] = acc;
                }
            }
            float inv[2];
#pragma unroll
            for (int x = 0; x < 2; ++x) {
                float mx = -1e30f;
#pragma unroll
                for (int t = 0; t < 10; ++t) {
                    const int D = x + 8 - t;
                    if (D == 9 || D == -1) continue;
                    const bool tile_off = firstblk && (kt0 + t < 8);
#pragma unroll
                    for (int r = 0; r < 4; ++r) { const int dl = fr - 4 * fq - r;
                        bool valid = !tile_off;
                        if (D == 8) valid = valid && (dl < 0);
                        if (D == 0) valid = valid && (dl >= 0);
                        const float sv = valid ? st[x][t][r] : -1e30f; st[x][t][r] = sv; mx = fmaxf(mx, sv); }
                }
                mx = fmaxf(mx, __shfl_xor(mx, 16)); mx = fmaxf(mx, __shfl_xor(mx, 32)); mx = fmaxf(mx, sink);
                const float mb = mx * LOG2E;
                float lsum = 0.f;
#pragma unroll
                for (int t = 0; t < 10; ++t) {
                    const int D = x + 8 - t;
                    if (D == 9 || D == -1) { st[x][t] = (f32x4){0.f, 0.f, 0.f, 0.f}; continue; }
#pragma unroll
                    for (int r = 0; r < 4; ++r) { const float pe = __builtin_amdgcn_exp2f(st[x][t][r] * LOG2E - mb); st[x][t][r] = pe; lsum += pe; }
                }
                lsum += __shfl_xor(lsum, 16); lsum += __shfl_xor(lsum, 32); lsum += __builtin_amdgcn_exp2f(sink * LOG2E - mb);
                inv[x] = 1.0f / lsum;
            }
            f32x4 ot[2][4];
#pragma unroll
            for (int x = 0; x < 2; ++x)
#pragma unroll
                for (int dt = 0; dt < 4; ++dt) ot[x][dt] = (f32x4){0.f, 0.f, 0.f, 0.f};
#pragma unroll
            for (int s2 = 0; s2 < 5; ++s2) {
                bf16x8 pf[2];
#pragma unroll
                for (int x = 0; x < 2; ++x) { v4u pw; pw.x = pk2(st[x][2 * s2][0], st[x][2 * s2][1]); pw.y = pk2(st[x][2 * s2][2], st[x][2 * s2][3]);
                    pw.z = pk2(st[x][2 * s2 + 1][0], st[x][2 * s2 + 1][1]); pw.w = pk2(st[x][2 * s2 + 1][2], st[x][2 * s2 + 1][3]); pf[x] = __builtin_bit_cast(bf16x8, pw); }
#pragma unroll
                for (int dt = 0; dt < 4; ++dt) {
                    const LAS bf16* vp = Vt + (16 * dt + fr) * 272 + 16 * (kt0 + 2 * s2) + 4 * fq;
                    const v2u lo = *(const LAS v2u*)vp, hi = *(const LAS v2u*)(vp + 16);
                    const bf16x8 vf = __builtin_bit_cast(bf16x8, (v4u){lo.x, lo.y, hi.x, hi.y});
#pragma unroll
                    for (int x = 0; x < 2; ++x) ot[x][dt] = __builtin_amdgcn_mfma_f32_16x16x32_bf16(vf, pf[x], ot[x][dt], 0, 0, 0);
                }
            }
#pragma unroll
            for (int x = 0; x < 2; ++x) {
                LAS bf16* stg = (LAS bf16*)(lds + 71680) + (wave * 2 + x) * (16 * 72);
#pragma unroll
                for (int dt = 0; dt < 4; ++dt) *(LAS v2u*)(stg + fr * 72 + 16 * dt + 4 * fq) = (v2u){pk2(ot[x][dt][0] * inv[x], ot[x][dt][1] * inv[x]), pk2(ot[x][dt][2] * inv[x], ot[x][dt][3] * inv[x])};
                bf16* op = CONCAT + (qrow0 - fr + 16 * (2 * p + x)) * DM + h * 64;
#pragma unroll
                for (int i = 0; i < 2; ++i) { const int row = 8 * i + (lane >> 3), chn = lane & 7;
                    *(v4u*)(op + (size_t)row * DM + chn * 8) = *(const LAS v4u*)(stg + row * 72 + chn * 8); }
            }
        }
        __syncthreads();
    }
#undef ATT_LOAD_KV
}

constexpr int PL_US = 136;
template <int W> __device__ __forceinline__ void pool_load(const bf16* PROJ, int gi, int tt, int lane, v4u (&raw)[8]) {
    const size_t t0 = (size_t)tt * 16; const int s0 = (int)(t0 & (SEQ - 1));
    const int ch = lane & 15, rs = lane >> 4;
#pragma unroll
    for (int i = 0; i < 8; ++i) { const int r = rs + 4 * i;
        raw[i] = (v4u){0u, 0u, 0u, 0u};
        if (4 * i + 3 >= 17 - W) { if (s0 - 16 + r >= 0) raw[i] = *(const v4u*)(PROJ + (t0 - 16 + r) * INW + 768 + gi * 128 + ch * 8); } }
}
typedef short v4i16_t __attribute__((ext_vector_type(4)));
__device__ __forceinline__ v2u lds_tr(const LAS bf16* p) { return __builtin_bit_cast(v2u, __builtin_amdgcn_ds_read_tr16_b64_v4i16((LAS v4i16_t*)p)); }
template <int W> __device__ __forceinline__ void pool_compute(bf16* CONCAT, const LAS bf16* wl, LAS bf16* ust, const float* pscale, int gi, int tt, int lane, const v4u (&raw)[8]) {
    const int fr = lane & 15, fq = lane >> 4;
    const size_t t0 = (size_t)tt * 16; const int s0 = (int)(t0 & (SEQ - 1));
    {
        const int ch = lane & 15, rs = lane >> 4;
#pragma unroll
        for (int i = 0; i < 8; ++i) { const int r = rs + 4 * i; if (4 * i + 3 >= 17 - W) *(LAS v4u*)(ust + r * PL_US + ch * 8) = raw[i]; }
    }
    const int s = s0 + fr;
    const int cnt = (s + 1 < W) ? (s + 1) : W;
    const float invc = 1.0f / (float)cnt;
    bf16x8 band;
    { float bv[8];
#pragma unroll
      for (int j = 0; j < 8; ++j) { const int rel = 8 * fq + j - 16 - fr;
          bv[j] = ((rel > -W && rel <= 0) ? 1.0f : 0.0f) - ((rel == 0) ? (float)cnt : 0.0f); }
      band = __builtin_bit_cast(bf16x8, (v4u){pk2(bv[0], bv[1]), pk2(bv[2], bv[3]), pk2(bv[4], bv[5]), pk2(bv[6], bv[7])}); }
    f32x4 pl[8];
    const LAS bf16* trp = ust + (8 * fq + ((lane & 15) >> 2)) * PL_US + 4 * (lane & 3);
#pragma unroll
    for (int a = 0; a < 8; ++a) {
        const v2u lo = lds_tr(trp + 16 * a), hi = lds_tr(trp + 4 * PL_US + 16 * a);
        const bf16x8 ua = __builtin_bit_cast(bf16x8, (v4u){lo.x, lo.y, hi.x, hi.y});
        pl[a] = __builtin_amdgcn_mfma_f32_16x16x32_bf16(ua, band, (f32x4){0.f, 0.f, 0.f, 0.f}, 0, 0, 0);
    }
    bf16x8 pf[4];
#pragma unroll
    for (int ks = 0; ks < 4; ++ks)
        pf[ks] = __builtin_bit_cast(bf16x8, (v4u){pk2(pl[2 * ks][0] * invc, pl[2 * ks][1] * invc), pk2(pl[2 * ks][2] * invc, pl[2 * ks][3] * invc),
                                                  pk2(pl[2 * ks + 1][0] * invc, pl[2 * ks + 1][1] * invc), pk2(pl[2 * ks + 1][2] * invc, pl[2 * ks + 1][3] * invc)});
#pragma unroll
    for (int nt = 0; nt < 8; ++nt) {
        f32x4 acc = (f32x4){0.f, 0.f, 0.f, 0.f};
        const LAS bf16* wp = wl + (16 * nt + fr) * PL_US + 4 * fq;
#pragma unroll
        for (int ks = 0; ks < 4; ++ks) { const v2u lo = *(const LAS v2u*)(wp + 32 * ks), hi = *(const LAS v2u*)(wp + 32 * ks + 16);
            acc = __builtin_amdgcn_mfma_f32_16x16x32_bf16(__builtin_bit_cast(bf16x8, (v4u){lo.x, lo.y, hi.x, hi.y}), pf[ks], acc, 0, 0, 0); }
        const int d = gi * 128 + 16 * nt + 4 * fq;
        const f32x4 sc = *(const f32x4*)(pscale + d);
        *(LAS v2u*)(ust + fr * PL_US + 16 * nt + 4 * fq) = (v2u){pk2(acc[0] * sc.x, acc[1] * sc.y), pk2(acc[2] * sc.z, acc[3] * sc.w)};
    }
#pragma unroll
    for (int i = 0; i < 4; ++i) { const int row = 4 * i + (lane >> 4), chn = lane & 15;
        const v4u w = *(const LAS v4u*)(ust + row * PL_US + chn * 8);
        *(v4u*)(CONCAT + (t0 + row) * DM + 512 + gi * 128 + chn * 8) = w; }
}
template <int W> __device__ __forceinline__ void pool_group(const bf16* PROJ, bf16* CONCAT, const LAS bf16* wl, LAS bf16* ust, const float* pscale, int gi, int gw, int ngw, int lane) {
    v4u ra[8], rb[8];
    {
        const int ch = lane & 15, rs = lane >> 4;
#pragma unroll
        for (int i = 0; i < 8; ++i) if (!(4 * i + 3 >= 17 - W)) *(LAS v4u*)(ust + (rs + 4 * i) * PL_US + ch * 8) = (v4u){0u, 0u, 0u, 0u};
    }
    int tt = gw;
    if (tt < T / 16) pool_load<W>(PROJ, gi, tt, lane, ra);
    while (tt < T / 16) {
        const int tn = tt + ngw;
        if (tn < T / 16) pool_load<W>(PROJ, gi, tn, lane, rb);
        pool_compute<W>(CONCAT, wl, ust, pscale, gi, tt, lane, ra);
        tt = tn;
        if (tt >= T / 16) break;
        const int tn2 = tt + ngw;
        if (tn2 < T / 16) pool_load<W>(PROJ, gi, tn2, lane, ra);
        pool_compute<W>(CONCAT, wl, ust, pscale, gi, tt, lane, rb);
        tt = tn2;
    }
}
__device__ __forceinline__ void pool_phase(LAS unsigned char* lds, const bf16* PROJ, bf16* CONCAT, const bf16* PWT, const float* pscale) {
    int tid_ = threadIdx.x; asm volatile("" : "+v"(tid_)); const int tid = tid_, lane = tid & 63, wave = tid >> 6;
    LAS bf16* wl = (LAS bf16*)lds;
    LAS bf16* ust = (LAS bf16*)(lds + 36864 + wave * 8704);
    const int gw = blockIdx.x * 8 + wave, ngw = gridDim.x * 8;
#pragma unroll 1
    for (int gi = 0; gi < 4; ++gi) {
        __syncthreads();
        { const int row = tid >> 2, q = tid & 3; const bf16* src = PWT + ((size_t)gi * 128 + row) * 128 + q * 32;
#pragma unroll
          for (int e = 0; e < 4; ++e) *(LAS v4u*)(wl + row * PL_US + q * 32 + e * 8) = *(const v4u*)(src + e * 8); }
        __syncthreads();
        if (gi == 0) pool_group<2>(PROJ, CONCAT, wl, ust, pscale, gi, gw, ngw, lane);
        else if (gi == 1) pool_group<4>(PROJ, CONCAT, wl, ust, pscale, gi, gw, ngw, lane);
        else if (gi == 2) pool_group<8>(PROJ, CONCAT, wl, ust, pscale, gi, gw, ngw, lane);
        else pool_group<16>(PROJ, CONCAT, wl, ust, pscale, gi, gw, ngw, lane);
    }
    __syncthreads();
}

#ifndef REP_P
#define REP_P 1
#endif
#ifndef REP_G
#define REP_G 1
#endif
#ifndef REP_R
#define REP_R 1
#endif
#ifndef REP_G
#define REP_G 1
#endif
#ifndef REP_IN
#define REP_IN REP_G
#endif
#ifndef REP_GU
#define REP_GU REP_G
#endif
#ifndef REP_DN
#define REP_DN REP_G
#endif
#ifndef REP_PL
#define REP_PL 1
#endif
#ifndef REP_A
#define REP_A 1
#endif
__global__ void __launch_bounds__(512, 2) fwd_kernel(Args a) {
    extern __shared__ __attribute__((aligned(16))) unsigned char lds_raw[];
    cg::grid_group grid = cg::this_grid();
    LAS unsigned char* lds = (LAS unsigned char*)lds_raw;
    unsigned char* ws = a.ws;
    bf16* H = (bf16*)(ws + WS_H); bf16* MIX = (bf16*)(ws + WS_MIX); bf16* PROJ = (bf16*)(ws + WS_PROJ);
    bf16* CONCAT = (bf16*)(ws + WS_CONCAT); bf16* ACT = (bf16*)(ws + WS_ACT);
    const float* cs = (const float*)(ws + WS_CS); bf16* XA = (bf16*)(ws + WS_XA); bf16* XB = (bf16*)(ws + WS_XB);
    volatile LAS unsigned* MISC = (volatile LAS unsigned*)(lds + RING_BYTES + 64);
    if (threadIdx.x == 0) { MISC[0] = 0u; MISC[1] = 0u; }
    __syncthreads();
    XcdBarrier bar = xcd_barrier_post((unsigned*)ws, MISC);
#define SEAM() xcd_barrier(bar)

    for (int rep = 0; rep < REP_P; ++rep) prologue(a, lds);
    if (a.ws == nullptr) grid.sync();
    SEAM();
    for (int rep = 0; rep < REP_R; ++rep) rowwise_phase(a, lds, true, false, true, false, 2, a.x, nullptr, nullptr, XB, H, 0, 0, nullptr, 0, 0, 1, a.g_pre_mix);
    mod_finalize(a);
    SEAM();
#pragma unroll 1
    for (int l = 0; l < DEPTH; ++l) {
        unsigned char* wl = ws + WS_W + (size_t)l * W_LAYER;
        for (int rep = 0; rep < REP_IN; ++rep) {
            pg8::Gemm g{H, (const bf16*)(wl + W_IN), T, INW, DM}; pg8::StaticOrder S; S.init(T, INW, gridDim.x, blockIdx.x);
            pg8::EpiInProj E{PROJ, a.b_in + l * INW, cs};
            pg8::gemm_phase<pg8::EpiInProj, pg8::StaticOrder, true, true>(lds, g, S, E);
        }
        SEAM();
        for (int rep = 0; rep < REP_A; ++rep) attn_phase(lds, PROJ, CONCAT, a.sinks + l * 8);
        for (int rep = 0; rep < REP_PL; ++rep) pool_phase(lds, PROJ, CONCAT, (const bf16*)(wl + W_PW), a.pool_scale + l * 512);
        SEAM();
        for (int rep = 0; rep < REP_G; ++rep) {
            pg8::Gemm g{CONCAT, (const bf16*)(wl + W_OUT), T, DM, DM}; pg8::StaticOrder S; S.init(T, DM, gridDim.x, blockIdx.x);
            pg8::EpiBf16<0> E{MIX, DM, nullptr, 0, 0, 1.f};
            pg8::gemm_phase<pg8::EpiBf16<0>, pg8::StaticOrder, true, true>(lds, g, S, E);
        }
        SEAM();
        for (int rep = 0; rep < REP_R; ++rep) rowwise_phase(a, lds, false, true, true, true, 2, XB, MIX, nullptr, XA, H, l, 2, a.g_post_mix + l * DM, l, 3, 4, a.g_pre_ffn + l * DM);
        SEAM();
#if defined(PROBE_HOT)
#pragma unroll 1
        for (int rep = 0; rep < 2; ++rep) {
            pg8::Gemm g{H, (const bf16*)(wl + W_GU), T, 2 * DFF, rep == 0 ? PROBE_HOT_K : DM}; pg8::DualOrder S; S.so.init(T, 2 * DFF, gridDim.x, blockIdx.x); S.c = blockIdx.x; S.rounds = 22; S.hot = (rep == 0);
            pg8::EpiSwiGLU E{rep == 0 ? MIX : ACT};
            pg8::gemm_phase<pg8::EpiSwiGLU, pg8::DualOrder, true, true>(lds, g, S, E);
            if (rep == 0) SEAM();
        }
#else
        for (int rep = 0; rep < REP_GU; ++rep) {
            pg8::Gemm g{H, (const bf16*)(wl + W_GU), T, 2 * DFF, DM}; pg8::StaticOrder S; S.init(T, 2 * DFF, gridDim.x, blockIdx.x);
            pg8::EpiSwiGLU E{ACT};
            pg8::gemm_phase<pg8::EpiSwiGLU, pg8::StaticOrder, true, true>(lds, g, S, E);
        }
#endif
        SEAM();
        for (int rep = 0; rep < REP_DN; ++rep) {
            pg8::Gemm g{ACT, (const bf16*)(wl + W_DN), T, DM, DFF}; pg8::StaticOrder S; S.init(T, DM, gridDim.x, blockIdx.x);
            pg8::EpiBf16<0> E{MIX, DM, nullptr, 0, 0, 1.f};
            pg8::gemm_phase<pg8::EpiBf16<0>, pg8::StaticOrder, true, true>(lds, g, S, E);
        }
        SEAM();
        const bool more = (l + 1 < DEPTH);
        for (int rep = 0; rep < REP_R; ++rep) rowwise_phase(a, lds, false, true, more, true, more ? 2 : 1, XA, MIX, a.out, XB, H, l, 5, a.g_post_ffn + l * DM, l + 1, 0, 1, a.g_pre_mix + (more ? (l + 1) * DM : 0));
        if (more) SEAM();
    }
}

extern "C" void kernel_launch(void* const* d_in, const int* in_sizes, int n_in, void* d_out, int out_size, void* d_ws, size_t ws_size, hipStream_t stream) {
    static int grid_blocks = 0;
    if (grid_blocks == 0) {
        if (n_in != 18 || out_size != T * DM || ws_size < WS_END) { fprintf(stderr, "kernel_launch: unexpected shapes (n_in %d, out %d, ws %zu)\n", n_in, out_size, ws_size); grid_blocks = -1; return; }
        int dev = 0, cus = 0, per_cu = 0;
        hipGetDevice(&dev);
        hipDeviceGetAttribute(&cus, hipDeviceAttributeMultiprocessorCount, dev);
        if (hipFuncSetAttribute((const void*)fwd_kernel, hipFuncAttributeMaxDynamicSharedMemorySize, LDS_BYTES) != hipSuccess) { fprintf(stderr, "kernel_launch: hipFuncSetAttribute failed\n"); grid_blocks = -1; return; }
        if (hipOccupancyMaxActiveBlocksPerMultiprocessor(&per_cu, (const void*)fwd_kernel, 512, LDS_BYTES) != hipSuccess || per_cu < 1) { fprintf(stderr, "kernel_launch: occupancy query gave %d\n", per_cu); per_cu = 1; }
        (void)hipGetLastError();
        grid_blocks = cus * per_cu;
    }
    if (grid_blocks < 0) return;
    if (hipMemsetAsync(d_ws, 0, 65536, stream) != hipSuccess) { fprintf(stderr, "kernel_launch: memset failed\n"); return; }
    Args a{};
    a.x = (const float*)d_in[0]; a.c = (const float*)d_in[1]; a.pos = (const int*)d_in[2]; a.ada_w = (const float*)d_in[3]; a.ada_b = (const float*)d_in[4];
    a.w_in = (const float*)d_in[5]; a.b_in = (const float*)d_in[6]; a.sinks = (const float*)d_in[7]; a.pool_w = (const float*)d_in[8]; a.pool_scale = (const float*)d_in[9];
    a.w_out = (const float*)d_in[10]; a.w_gate = (const float*)d_in[11]; a.w_up = (const float*)d_in[12]; a.w_down = (const float*)d_in[13];
    a.g_pre_mix = (const float*)d_in[14]; a.g_post_mix = (const float*)d_in[15]; a.g_pre_ffn = (const float*)d_in[16]; a.g_post_ffn = (const float*)d_in[17];
    a.out = (float*)d_out; a.ws = (unsigned char*)d_ws;
    void* args[] = {&a};
    hipError_t e = hipLaunchCooperativeKernel((const void*)fwd_kernel, dim3(grid_blocks), dim3(512), args, LDS_BYTES, stream);
    if (e != hipSuccess) fprintf(stderr, "cooperative launch failed: %s (grid %d)\n", hipGetErrorString(e), grid_blocks);
}
```

```cpp
#include <hip/hip_runtime.h>
#include <hip/hip_cooperative_groups.h>
#include <cstdio>
#include <cstdint>
namespace cg = cooperative_groups;
#define LAS __attribute__((address_space(3)))
namespace pg8 {
#define PG8_LAS __attribute__((address_space(3)))
typedef unsigned short bf16_t;
typedef short bf16x8 __attribute__((ext_vector_type(8)));
typedef float f32x4 __attribute__((ext_vector_type(4)));
typedef unsigned u32x4 __attribute__((ext_vector_type(4)));
constexpr int BM = 256, BK = 64, HALF = 128, HTB = HALF * BK * 2  , STAGE_BYTES = 8 * HTB, NXCD = 8, WGM = 8;

__host__ __device__ __forceinline__ int lds_byte(int r, int c) { const int st = (r >> 4) * 2 + (c >> 5), rr = r & 15, cc = c & 31, ob = rr * 64 + cc * 2; return st * 1024 + (ob ^ (((ob >> 9) & 1) << 5)); }
__host__ __device__ __forceinline__ void stage_rc(int b, int& R, int& C) { const int st = b / 1024, sb = b % 1024, swz = sb ^ (((sb >> 9) & 1) << 5); R = (st >> 1) * 16 + swz / 64; C = (st & 1) * 32 + (swz % 64) / 2; }
__host__ __device__ __forceinline__ int perm32(int rho) { const int n = rho >> 4, i = rho & 15; return 8 * (i >> 2) + 4 * n + (i & 3); }

struct Unit { int pm, pn; };
struct Gemm { const bf16_t* A; const bf16_t* Bt; int M, N, K; };

struct StaticOrder {
    int nM, nN, nwg, G, c;
    __host__ __device__ void init(int M, int N, int G_, int c_) { nM = M / BM; nN = N / BM; nwg = nM * nN; G = G_; c = c_; }
    __host__ __device__ bool next(int i, Unit& u) const {
        const long L = (long)i * G + c; if (L >= nwg) return false;
        int wgid = (int)L; { const int q = nwg / NXCD, r = nwg % NXCD, xcd = wgid % NXCD, off = wgid / NXCD; wgid = (xcd < r ? xcd * (q + 1) : r * (q + 1) + (xcd - r) * q) + off; }
        const int nig = WGM * nN, gid = wgid / nig, fm = gid * WGM, gsz = (nM - fm) < WGM ? (nM - fm) : WGM;
        u.pm = fm + ((wgid % nig) % gsz); u.pn = (wgid % nig) / gsz; return true;
    }
    __device__ __forceinline__ void a_ready(const Unit&) const {}
    __device__ __forceinline__ void done(const Unit&) const {}
};

__device__ __forceinline__ unsigned cvt_pk_bf16(float lo, float hi) { unsigned r; asm volatile("v_cvt_pk_bf16_f32 %0, %1, %2" : "=v"(r) : "v"(lo), "v"(hi)); return r; }
typedef float f32x2 __attribute__((ext_vector_type(2)));
__device__ __forceinline__ f32x2 gelu_pk(f32x2 v) {
    const f32x2 av = __builtin_elementwise_abs(v), d = av * 0.2316418882f + 1.0f;
    f32x2 t; t.x = __builtin_amdgcn_rcpf(d.x); t.y = __builtin_amdgcn_rcpf(d.y);
    f32x2 q = t * 0.5307027145f + (-0.7265760135f); q = q * t + 0.7107068705f; q = q * t + (-0.142248368f); q = q * t + 0.127414796f; q = q * t;
    const f32x2 s = (v * v) * (-0.72134752044f);
    f32x2 e; e.x = __builtin_amdgcn_exp2f(s.x); e.y = __builtin_amdgcn_exp2f(s.y);
    const f32x2 m = v * (q * e), r = v - m;
    f32x2 o; o.x = v.x < 0.f ? m.x : r.x; o.y = v.y < 0.f ? m.y : r.y; return o;
}

template <int ACT  > struct EpiBf16 {
    static constexpr bool PERM = true, AFTER_DRAIN = false; static_assert(ACT == 0 || ACT == 1, "EpiBf16: ACT is 0 (none) or 1 (gelu_pk)");
    bf16_t* O; int ldc; const float* bias; int split_cols; size_t split_stride; float scale0;
    __device__ __forceinline__ void operator()(const f32x4 (&acc)[2][2][4][2], const Unit& u, int wr, int wc, int fr, int fq) const {
        const int row0 = u.pm * BM + wr * 64 + fr; int colt = u.pn * BM; bf16_t* base = O;
        float sc = 1.f; if (split_cols) { const int t = colt / split_cols; base += (size_t)t * split_stride; colt -= t * split_cols; if (t == 0) sc = scale0; }
        const int col0 = colt + wc * 32 + 8 * fq, bcol0 = u.pn * BM + wc * 32 + 8 * fq;
        f32x4 bv[2][2];
#pragma unroll
        for (int bj = 0; bj < 2; ++bj)
#pragma unroll
            for (int n = 0; n < 2; ++n) bv[bj][n] = bias ? *(const f32x4*)(bias + bcol0 + bj * HALF + 4 * n) : (f32x4){0.f, 0.f, 0.f, 0.f};
#pragma unroll
        for (int ai = 0; ai < 2; ++ai)
#pragma unroll
            for (int m = 0; m < 4; ++m) { bf16_t* rowp = base + (size_t)(row0 + ai * HALF + m * 16) * ldc + col0;
#pragma unroll
                for (int bj = 0; bj < 2; ++bj) { f32x4 v0 = acc[ai][bj][m][0] + bv[bj][0], v1 = acc[ai][bj][m][1] + bv[bj][1];
                    if (ACT == 1) { f32x2 a = gelu_pk((f32x2){v0[0], v0[1]}), b = gelu_pk((f32x2){v0[2], v0[3]}), c = gelu_pk((f32x2){v1[0], v1[1]}), d = gelu_pk((f32x2){v1[2], v1[3]});
                        v0 = (f32x4){a.x, a.y, b.x, b.y}; v1 = (f32x4){c.x, c.y, d.x, d.y}; }
                    v0 = v0 * sc; v1 = v1 * sc; u32x4 w; w.x = cvt_pk_bf16(v0[0], v0[1]); w.y = cvt_pk_bf16(v0[2], v0[3]); w.z = cvt_pk_bf16(v1[0], v1[1]); w.w = cvt_pk_bf16(v1[2], v1[3]);
                    *(u32x4*)(rowp + bj * HALF) = w; } }
    }
};
template <class Epi, class Sched, bool ALIGN_EPI = false, bool SP2 = false, int A_AUX = 0  >
__device__ __forceinline__ void gemm_phase(PG8_LAS unsigned char* lds, const Gemm g, const Sched& S, const Epi& E) {
    int tid_ = threadIdx.x; asm volatile("" : "+v"(tid_)); const int tid = tid_, wid = __builtin_amdgcn_readfirstlane(tid >> 6), lane = tid & 63, wr = wid >> 2, wc = wid & 3, fr = lane & 15, fq = lane >> 4;
    const int K = g.K, nt = K / BK;
    unsigned voffA[2], voffB[2];
#pragma unroll
    for (int i = 0; i < 2; ++i) { int R, C; stage_rc(tid * 16 + i * 8192, R, C); const int Rb = Epi::PERM ? ((R & ~31) + perm32(R & 31)) : R;
        voffA[i] = (unsigned)(R * K + C) * 2u; voffB[i] = (unsigned)(Rb * K + C) * 2u; }
    const size_t kstep = (size_t)(BK * 2);
    const size_t hstep = (size_t)HALF * K * 2;
    const size_t tstep = 2 * hstep;
    const unsigned ldsw = (unsigned)wid * 1024u;
    const int aoff = lds_byte(wr * 64 + fr, fq * 8), boff = lds_byte(wc * 32 + fr, fq * 8);
#define PG8_SA(b, h) (((b) * 2 + (h)) * HTB)
#define PG8_SB(b, h) ((4 + (b) * 2 + (h)) * HTB)
#define PG8_STAGE(bufoff, gbase, voff) do { _Pragma("unroll") for (int _i = 0; _i < 2; ++_i) \
        __builtin_amdgcn_global_load_lds((const unsigned*)((const char*)(gbase) + (voff)[_i]), (PG8_LAS unsigned*)(lds + (bufoff) + ldsw + _i * 8192), 16, 0, 0); } while (0)
#define PG8_STAGEA(bufoff, gbase, voff) do { _Pragma("unroll") for (int _i = 0; _i < 2; ++_i) \
        __builtin_amdgcn_global_load_lds((const unsigned*)((const char*)(gbase) + (voff)[_i]), (PG8_LAS unsigned*)(lds + (bufoff) + ldsw + _i * 8192), 16, 0, A_AUX); } while (0)
#define PG8_LDA(dst, b, h) do { _Pragma("unroll") for (int m = 0; m < 4; ++m) _Pragma("unroll") for (int k = 0; k < 2; ++k) dst[m][k] = *(const PG8_LAS bf16x8*)(lds + PG8_SA(b, h) + aoff + m * 2048 + k * 1024); } while (0)
#define PG8_LDB(dst, b, h) do { _Pragma("unroll") for (int n = 0; n < 2; ++n) _Pragma("unroll") for (int k = 0; k < 2; ++k) dst[n][k] = *(const PG8_LAS bf16x8*)(lds + PG8_SB(b, h) + boff + n * 2048 + k * 1024); } while (0)
#define PG8_MMA(ai, bj, At, Bt) do { __builtin_amdgcn_s_setprio(1); _Pragma("unroll") for (int m = 0; m < 4; ++m) _Pragma("unroll") for (int n = 0; n < 2; ++n) _Pragma("unroll") for (int k = 0; k < 2; ++k) \
        acc[ai][bj][m][n] = __builtin_amdgcn_mfma_f32_16x16x32_bf16(Bt[n][k], At[m][k], acc[ai][bj][m][n], 0, 0, 0); __builtin_amdgcn_s_setprio(0); } while (0)
#define PG8_WAIT_V(n) asm volatile("s_waitcnt vmcnt(" #n ")" ::: "memory")
#define PG8_WAIT_L(n) asm volatile("s_waitcnt lgkmcnt(" #n ")" ::: "memory")
#define PG8_BAR __builtin_amdgcn_s_barrier()
#define PG8_SCHED __builtin_amdgcn_sched_barrier(0)
    Unit cur, nxt; int ui = 0;
    if (!S.next(0, cur)) return;
    f32x4 acc[2][2][4][2];
#pragma unroll
    for (int a = 0; a < 2; ++a)
#pragma unroll
        for (int b = 0; b < 2; ++b)
#pragma unroll
            for (int m = 0; m < 4; ++m)
#pragma unroll
                for (int n = 0; n < 2; ++n) acc[a][b][m][n] = (f32x4){0.f, 0.f, 0.f, 0.f};
    bf16x8 At[4][2], B0[2][2], B1[2][2];
    const char* cA = (const char*)g.A + (size_t)cur.pm * tstep; const char* cB = (const char*)g.Bt + (size_t)cur.pn * tstep;
    S.a_ready(cur);
    if constexpr (SP2) {
        PG8_STAGE(PG8_SB(0, 0), cB, voffB); PG8_STAGE(PG8_SB(0, 1), cB + hstep, voffB); PG8_STAGEA(PG8_SA(0, 0), cA, voffA); PG8_STAGEA(PG8_SA(0, 1), cA + hstep, voffA);
        if (wr == 1) PG8_BAR;
        PG8_WAIT_V(2); PG8_BAR;
        PG8_STAGE(PG8_SB(1, 0), cB + kstep, voffB); PG8_STAGEA(PG8_SA(1, 0), cA + kstep, voffA); PG8_STAGE(PG8_SB(1, 1), cB + hstep + kstep, voffB);
        PG8_WAIT_V(6); PG8_BAR;
    } else {
        PG8_STAGE(PG8_SB(0, 0), cB, voffB); PG8_STAGEA(PG8_SA(0, 0), cA, voffA); PG8_STAGE(PG8_SB(0, 1), cB + hstep, voffB); PG8_STAGEA(PG8_SA(0, 1), cA + hstep, voffA);
        if (wr == 1) PG8_BAR;
        PG8_WAIT_V(4); PG8_BAR;
        PG8_STAGE(PG8_SB(1, 0), cB + kstep, voffB); PG8_STAGEA(PG8_SA(1, 0), cA + kstep, voffA); PG8_STAGE(PG8_SB(1, 1), cB + hstep + kstep, voffB);
        PG8_WAIT_V(6); PG8_BAR;
    }
    for (;;) {
        const bool has_next = S.next(ui + 1, nxt);
        const char* nA = has_next ? (const char*)g.A + (size_t)nxt.pm * tstep : cA; const char* nB = has_next ? (const char*)g.Bt + (size_t)nxt.pn * tstep : cB;
        for (int t = 0; t < nt; t += 2) {
            const bool last = (t == nt - 2);
            const char* a1 = cA + (size_t)(t + 1) * kstep;
            const char* a2 = last ? nA : cA + (size_t)(t + 2) * kstep; const char* b2 = last ? nB : cB + (size_t)(t + 2) * kstep;
            const char* a3 = a2 + kstep; const char* b3 = b2 + kstep;
            if (last && has_next) S.a_ready(nxt);
            if constexpr (SP2) {
            PG8_LDB(B0, 0, 0); PG8_LDB(B1, 0, 1); PG8_SCHED; PG8_LDA(At, 0, 0); PG8_STAGEA(PG8_SA(1, 1), a1 + hstep, voffA);
            PG8_WAIT_V(8); PG8_WAIT_L(0); PG8_BAR; PG8_MMA(0, 0, At, B0); PG8_MMA(0, 1, At, B1); PG8_BAR; PG8_SCHED;
            PG8_LDA(At, 0, 1); PG8_STAGE(PG8_SB(0, 0), b2, voffB); PG8_STAGE(PG8_SB(0, 1), b2 + hstep, voffB); PG8_STAGEA(PG8_SA(0, 0), a2, voffA);
            PG8_WAIT_V(8); PG8_WAIT_L(0); PG8_BAR; PG8_MMA(1, 0, At, B0); PG8_MMA(1, 1, At, B1); PG8_BAR; PG8_SCHED;
            PG8_LDB(B0, 1, 0); PG8_LDB(B1, 1, 1); PG8_SCHED; PG8_LDA(At, 1, 0); PG8_STAGEA(PG8_SA(0, 1), a2 + hstep, voffA);
            PG8_WAIT_V(8); PG8_WAIT_L(0); PG8_BAR; PG8_MMA(0, 0, At, B0); PG8_MMA(0, 1, At, B1); PG8_BAR; PG8_SCHED;
            PG8_LDA(At, 1, 1); PG8_STAGE(PG8_SB(1, 0), b3, voffB); PG8_STAGE(PG8_SB(1, 1), b3 + hstep, voffB); PG8_STAGEA(PG8_SA(1, 0), a3, voffA);
            PG8_WAIT_V(8); PG8_WAIT_L(0); PG8_BAR; PG8_MMA(1, 0, At, B0); PG8_MMA(1, 1, At, B1); PG8_BAR; PG8_SCHED;
            } else {
            PG8_LDB(B0, 0, 0); PG8_SCHED; PG8_LDA(At, 0, 0); PG8_STAGEA(PG8_SA(1, 1), a1 + hstep, voffA);
            PG8_WAIT_L(8); PG8_BAR; PG8_WAIT_L(0); PG8_MMA(0, 0, At, B0); PG8_BAR; PG8_SCHED;
            PG8_LDB(B1, 0, 1); PG8_STAGE(PG8_SB(0, 0), b2, voffB);
            PG8_BAR; PG8_WAIT_L(0); PG8_MMA(0, 1, At, B1); PG8_BAR;
            PG8_LDA(At, 0, 1); PG8_STAGEA(PG8_SA(0, 0), a2, voffA);
            PG8_BAR; PG8_WAIT_L(0); PG8_MMA(1, 0, At, B0); PG8_BAR; PG8_SCHED;
            PG8_STAGE(PG8_SB(0, 1), b2 + hstep, voffB);
            PG8_WAIT_V(6); PG8_BAR; PG8_MMA(1, 1, At, B1); PG8_BAR;
            PG8_LDB(B0, 1, 0); PG8_SCHED; PG8_LDA(At, 1, 0); PG8_STAGEA(PG8_SA(0, 1), a2 + hstep, voffA);
            PG8_WAIT_L(8); PG8_BAR; PG8_WAIT_L(0); PG8_MMA(0, 0, At, B0); PG8_BAR; PG8_SCHED;
            PG8_LDB(B1, 1, 1); PG8_STAGE(PG8_SB(1, 0), b3, voffB);
            PG8_BAR; PG8_WAIT_L(0); PG8_MMA(0, 1, At, B1); PG8_BAR;
            PG8_LDA(At, 1, 1); PG8_STAGEA(PG8_SA(1, 0), a3, voffA);
            PG8_BAR; PG8_WAIT_L(0); PG8_MMA(1, 0, At, B0); PG8_BAR; PG8_SCHED;
            PG8_STAGE(PG8_SB(1, 1), b3 + hstep, voffB);
            PG8_WAIT_V(6); PG8_BAR; PG8_MMA(1, 1, At, B1); PG8_BAR;
            }
        }
        if constexpr (ALIGN_EPI) { if (wr == 0) PG8_BAR; }
        if constexpr (!Epi::AFTER_DRAIN) { E(acc, cur, wr, wc, fr, fq); S.done(cur); }
        if (!has_next) break;
#pragma unroll
        for (int a = 0; a < 2; ++a)
#pragma unroll
            for (int b = 0; b < 2; ++b)
#pragma unroll
                for (int m = 0; m < 4; ++m)
#pragma unroll
                    for (int n = 0; n < 2; ++n) acc[a][b][m][n] = (f32x4){0.f, 0.f, 0.f, 0.f};
        cur = nxt; cA = nA; cB = nB; ++ui;
        if constexpr (ALIGN_EPI) { if (wr == 1) PG8_BAR; }
    }
    PG8_WAIT_V(0);
    if constexpr (!ALIGN_EPI) { if (wr == 0) PG8_BAR; }
    PG8_BAR;
    if constexpr (Epi::AFTER_DRAIN) { E.fused(acc, cur, wr, wc, fr, fq, lds, wid, lane); S.done(cur); }
#undef PG8_SA
#undef PG8_SB
#undef PG8_STAGE
#undef PG8_STAGEA
#undef PG8_LDA
#undef PG8_LDB
#undef PG8_MMA
#undef PG8_WAIT_V
#undef PG8_WAIT_L
#undef PG8_BAR
#undef PG8_SCHED
}
}
#define XB_TMO      128
#define XB_XCNT(j)  (256  + 64 * (j))
#define XB_XSUB(j)  (1280 + 64 * (j))
#define XB_XGEN(j)  (2304 + 64 * (j))
#define XB_TOP      3328
#define XB_TOPGEN   3392
#define XCD_BAR_WORDS 3456
#define XB_SPIN_CAP (1u << 18)

__device__ __forceinline__ unsigned xb_ld(unsigned* p)              { return __hip_atomic_load(p, __ATOMIC_RELAXED, __HIP_MEMORY_SCOPE_AGENT); }
__device__ __forceinline__ unsigned xb_add(unsigned* p, unsigned v) { return __hip_atomic_fetch_add(p, v, __ATOMIC_RELAXED, __HIP_MEMORY_SCOPE_AGENT); }
__device__ __forceinline__ unsigned xb_xcc_id() { return (unsigned)__builtin_amdgcn_s_getreg((3 << 11) | 20) & 0xFu; }
#define XB_SPIN(cond, bar) do { unsigned _sp = 0; while (cond) { __builtin_amdgcn_s_sleep(1); \
    if ((++_sp & 255u) == 0u) { if (xb_ld(&(bar)[XB_TMO])) break; if (_sp > XB_SPIN_CAP) { atomicAdd(&(bar)[XB_TMO], 1u); break; } } } } while (0)

struct XcdBarrier {
    unsigned* bar; unsigned x;
    volatile LAS unsigned* st;
};

__device__ __forceinline__ XcdBarrier xcd_barrier_post(unsigned* bar, volatile LAS unsigned* st) {
    XcdBarrier b; b.bar = bar; b.x = xb_xcc_id(); b.st = st;
    if (threadIdx.x == 0) (void)xb_add(&bar[XB_XCNT(b.x)], 1u);
    return b;
}
__device__ __forceinline__ void xcd_barrier_complete(unsigned* bar, unsigned x, unsigned& nloc, unsigned& nx) {
    const unsigned G = gridDim.x * gridDim.y * gridDim.z;
    unsigned sum, cnt, mine, sp = 0u;
    for (;;) {
        sum = 0u; cnt = 0u; mine = 0u;
#pragma unroll
        for (unsigned j = 0; j < 16; ++j) { const unsigned c = xb_ld(&bar[XB_XCNT(j)]); sum += c; cnt += (c > 0u) ? 1u : 0u; mine = (j == x) ? c : mine; }
        if (sum == G) break;
        __builtin_amdgcn_s_sleep(1);
        if ((++sp & 255u) == 0u) { if (xb_ld(&bar[XB_TMO])) break; if (sp > XB_SPIN_CAP) { atomicAdd(&bar[XB_TMO], 1u); break; } }
    }
    nloc = mine > 0u ? mine : 1u; nx = cnt > 0u ? cnt : 1u;
}

__device__ __forceinline__ void xcd_barrier(const XcdBarrier& b) {
    asm volatile("s_waitcnt vmcnt(0)" ::: "memory");
    __syncthreads();
    if (threadIdx.x == 0) {
        unsigned* bar = b.bar;
        __builtin_amdgcn_s_waitcnt(0);
        unsigned nloc = b.st[0], nx = b.st[1];
        if (nloc == 0u) { xcd_barrier_complete(bar, b.x, nloc, nx); b.st[0] = nloc; b.st[1] = nx; }
        const unsigned old = xb_add(&bar[XB_XSUB(b.x)], 1u);
        const unsigned gen = old / nloc;
        if (old + 1u == (gen + 1u) * nloc) {
            __builtin_amdgcn_fence(__ATOMIC_RELEASE, "agent");
            asm volatile("s_waitcnt vmcnt(0)" ::: "memory");
            const unsigned og = xb_add(&bar[XB_TOP], 1u);
            const unsigned tg = og / nx;
            if (og + 1u == (tg + 1u) * nx) xb_add(&bar[XB_TOPGEN], 1u);
            else XB_SPIN(xb_ld(&bar[XB_TOPGEN]) == tg, bar);
            __builtin_amdgcn_fence(__ATOMIC_ACQUIRE, "agent");
            xb_add(&bar[XB_XGEN(b.x)], 1u);
            asm volatile("s_waitcnt vmcnt(0)" ::: "memory");
        } else {
            XB_SPIN(xb_ld(&bar[XB_XGEN(b.x)]) == gen, bar);
            __builtin_amdgcn_fence(__ATOMIC_ACQUIRE, "agent");
            asm volatile("s_waitcnt vmcnt(0)" ::: "memory");
        }
    }
    __syncthreads();
}

constexpr int NB = 8, SEQ = 8192, DM = 1024, DEPTH = 2;
constexpr int T = NB * SEQ;
constexpr int INW = 1280, DFF = 2816, NMODW = 6 * DM;
constexpr int KCH = 32;
constexpr float EPS = 1e-6f;
constexpr float LOG2E = 1.4426950408889634f;

#define LAS __attribute__((address_space(3)))
typedef unsigned short bf16;
typedef unsigned v4u __attribute__((ext_vector_type(4)));
typedef unsigned v2u __attribute__((ext_vector_type(2)));
typedef float f32x4 __attribute__((ext_vector_type(4)));
typedef short bf16x8 __attribute__((ext_vector_type(8)));

constexpr size_t MiB = 1u << 20;
constexpr size_t WS_MODP = 640 * MiB;
constexpr size_t WS_MODF = 8 * MiB;
constexpr size_t WS_CS = 9 * MiB;
constexpr size_t WS_W = 16 * MiB, W_LAYER = 24 * MiB;
constexpr size_t W_IN = 0, W_OUT = 3 * MiB, W_GU = 5 * MiB, W_DN = 16 * MiB, W_PW = 22 * MiB;
constexpr size_t WS_H = 64 * MiB;
constexpr size_t WS_MIX = 192 * MiB;
constexpr size_t WS_PROJ = 320 * MiB;
constexpr size_t WS_CONCAT = 480 * MiB;
constexpr size_t WS_ACT = 320 * MiB;
constexpr size_t WS_XA = 672 * MiB;
constexpr size_t WS_XB = 800 * MiB;
constexpr size_t WS_END = 928 * MiB;

constexpr int RING_BYTES = 131072;
constexpr int LDS_BYTES = 147456;

struct Args {
    const float* x; const float* c; const int* pos; const float* ada_w; const float* ada_b; const float* w_in; const float* b_in;
    const float* sinks; const float* pool_w; const float* pool_scale; const float* w_out; const float* w_gate; const float* w_up;
    const float* w_down; const float* g_pre_mix; const float* g_post_mix; const float* g_pre_ffn; const float* g_post_ffn;
    float* out; unsigned char* ws;
};

__device__ __constant__ double c_inv_freq[8] = {1.0, 0.19392274474868576, 0.03760603093086393, 0.007292664737217109,
                                                0.001414213562373095, 0.0002742481756762073, 5.318295896944988e-05, 1.031338537721246e-05};

__device__ __forceinline__ unsigned pk2(float lo, float hi) { return pg8::cvt_pk_bf16(lo, hi); }
__device__ __forceinline__ float bf_lo(unsigned w) { return __uint_as_float(w << 16); }
__device__ __forceinline__ float bf_hi(unsigned w) { return __uint_as_float(w & 0xffff0000u); }
__device__ __forceinline__ float wave_sum(float v) {
#pragma unroll
    for (int o = 1; o < 64; o <<= 1) v += __shfl_xor(v, o);
    return v;
}

namespace pg8 {
struct EpiInProj {
    static constexpr bool PERM = true, AFTER_DRAIN = false;
    bf16_t* O; const float* bias; const float* cs;
    __device__ __forceinline__ void operator()(const f32x4 (&acc)[2][2][4][2], const Unit& u, int wr, int wc, int fr, int fq) const {
        const int row0 = u.pm * BM + wr * 64 + fr; const int colt = u.pn * BM; const int col0 = colt + wc * 32 + 8 * fq;
        f32x4 bv[2][2];
#pragma unroll
        for (int bj = 0; bj < 2; ++bj)
#pragma unroll
            for (int n = 0; n < 2; ++n) bv[bj][n] = *(const f32x4*)(bias + col0 + bj * HALF + 4 * n);
        const bool rot_wave = (colt < 640) && ((wc & 1) == 0);
#pragma unroll
        for (int ai = 0; ai < 2; ++ai)
#pragma unroll
        for (int mh = 0; mh < 2; ++mh) {
            f32x4 cc[2][4];
#pragma unroll
            for (int mm = 0; mm < 2; ++mm)
#pragma unroll
                for (int q = 0; q < 4; ++q) cc[mm][q] = (f32x4){1.f, 1.f, 1.f, 1.f};
            if (rot_wave && fq < 2) {
#pragma unroll
                for (int mm = 0; mm < 2; ++mm) { const float* cr = cs + (size_t)(row0 + ai * HALF + (2 * mh + mm) * 16) * 16;
#pragma unroll
                    for (int q = 0; q < 4; ++q) cc[mm][q] = *(const f32x4*)(cr + 4 * q); }
            }
#pragma unroll
            for (int mm = 0; mm < 2; ++mm) {
                const int m = 2 * mh + mm;
                const int row = row0 + ai * HALF + m * 16;
                bf16_t* rowp = O + (size_t)row * INW + col0;
#pragma unroll
                for (int bj = 0; bj < 2; ++bj) {
                    f32x4 v0 = acc[ai][bj][m][0] + bv[bj][0], v1 = acc[ai][bj][m][1] + bv[bj][1];
                    const int cb = colt + bj * HALF;
                    if (rot_wave && cb < 640) {
                        f32x4 p0, p1;
#pragma unroll
                        for (int e = 0; e < 4; ++e) { p0[e] = __shfl_xor(v0[e], 16); p1[e] = __shfl_xor(v1[e], 16); }
                        if (fq == 0) { v0 = v0 * cc[mm][0] - p0 * cc[mm][2]; v1 = v1 * cc[mm][1] - p1 * cc[mm][3]; }
                        else if (fq == 1) { v0 = v0 * cc[mm][0] + p0 * cc[mm][2]; v1 = v1 * cc[mm][1] + p1 * cc[mm][3]; }
                    }
                    if (cb < 512) { v0 = v0 * 0.125f; v1 = v1 * 0.125f; }
                    u32x4 w; w.x = cvt_pk_bf16(v0[0], v0[1]); w.y = cvt_pk_bf16(v0[2], v0[3]); w.z = cvt_pk_bf16(v1[0], v1[1]); w.w = cvt_pk_bf16(v1[2], v1[3]);
                    *(u32x4*)(rowp + bj * HALF) = w;
                }
            }
        }
    }
};
struct EpiSwiGLU {
    static constexpr bool PERM = true, AFTER_DRAIN = false;
    bf16_t* O;
    __device__ __forceinline__ void operator()(const f32x4 (&acc)[2][2][4][2], const Unit& u, int wr, int wc, int fr, int fq) const {
        typedef float f32x2 __attribute__((ext_vector_type(2)));
        const int row0 = u.pm * BM + wr * 64 + fr; const int col0 = u.pn * HALF + wc * 32 + 8 * fq;
#pragma unroll
        for (int ai = 0; ai < 2; ++ai)
#pragma unroll
            for (int m = 0; m < 4; ++m) {
                bf16_t* rowp = O + (size_t)(row0 + ai * HALF + m * 16) * DFF + col0;
                f32x2 G[4], U[4], t[4], r[4];
#pragma unroll
                for (int n = 0; n < 2; ++n) { G[2 * n] = (f32x2){acc[ai][0][m][n][0], acc[ai][0][m][n][1]}; G[2 * n + 1] = (f32x2){acc[ai][0][m][n][2], acc[ai][0][m][n][3]};
                                              U[2 * n] = (f32x2){acc[ai][1][m][n][0], acc[ai][1][m][n][1]}; U[2 * n + 1] = (f32x2){acc[ai][1][m][n][2], acc[ai][1][m][n][3]}; }
#pragma unroll
                for (int q = 0; q < 4; ++q) { t[q].x = __builtin_amdgcn_exp2f(G[q].x); t[q].y = __builtin_amdgcn_exp2f(G[q].y); }
#pragma unroll
                for (int q = 0; q < 4; ++q) { t[q] = t[q] + 1.0f; r[q] = G[q] * U[q]; }
#pragma unroll
                for (int q = 0; q < 4; ++q) { t[q].x = __builtin_amdgcn_rcpf(t[q].x); t[q].y = __builtin_amdgcn_rcpf(t[q].y); }
#pragma unroll
                for (int q = 0; q < 4; ++q) r[q] = r[q] * t[q];
                u32x4 w; w.x = cvt_pk_bf16(r[0].x, r[0].y); w.y = cvt_pk_bf16(r[1].x, r[1].y); w.z = cvt_pk_bf16(r[2].x, r[2].y); w.w = cvt_pk_bf16(r[3].x, r[3].y);
                *(u32x4*)rowp = w;
            }
    }
};
struct DualOrder {
    StaticOrder so; int c, rounds, hot;
    __device__ bool next(int i, Unit& u) const { if (hot) { if (i >= rounds) return false; u.pm = (c % 8) * 2 + ((c / 8) & 1); u.pn = ((c / 8) >> 1) & 3; return true; } return so.next(i, u); }
    __device__ __forceinline__ void a_ready(const Unit&) const {}
    __device__ __forceinline__ void done(const Unit&) const {}
};
}

__device__ __forceinline__ void transpose_item(const float* W, int K, int N, bf16* WT, int drow0, LAS float* scr, int k0, int n0, int lane, float wscale = 1.0f) {
#pragma unroll
    for (int ih = 0; ih < 32; ih += 16) {
        float tv[16];
#pragma unroll
        for (int i = 0; i < 16; ++i) tv[i] = __builtin_nontemporal_load(W + (size_t)(k0 + 2 * (ih + i) + (lane >> 5)) * N + n0 + (lane & 31));
#pragma unroll
        for (int i = 0; i < 16; ++i) scr[(2 * (ih + i) + (lane >> 5)) * 33 + (lane & 31)] = tv[i] * wscale;
    }
    asm volatile("s_waitcnt lgkmcnt(0)" ::: "memory");
    const int c = lane & 7;
#pragma unroll
    for (int j = 0; j < 4; ++j) { const int n = (lane >> 3) + 8 * j; const LAS float* s = scr + (8 * c) * 33 + n;
        v4u o; o.x = pk2(s[0 * 33], s[1 * 33]); o.y = pk2(s[2 * 33], s[3 * 33]); o.z = pk2(s[4 * 33], s[5 * 33]); o.w = pk2(s[6 * 33], s[7 * 33]);
        *(v4u*)(WT + (size_t)(drow0 + n) * K + k0 + 8 * c) = o; }
    asm volatile("s_waitcnt lgkmcnt(0)" ::: "memory");
}

__device__ __forceinline__ void prologue(const Args& a, LAS unsigned char* lds) {
    int tid_ = threadIdx.x; asm volatile("" : "+v"(tid_)); const int tid = tid_, lane = tid & 63, wave = tid >> 6;
    unsigned char* ws = a.ws;
    __syncthreads();
    {
        LAS float* sc = (LAS float*)lds;
        for (int i = tid; i < NB * DM; i += 512) { const float v = a.c[i]; sc[i] = v / (1.0f + __expf(-v)); }
        __syncthreads();
        float* modp = (float*)(ws + WS_MODP);
        for (int item = blockIdx.x; item < DEPTH * KCH * 12; item += gridDim.x) {
            const int l = item / (KCH * 12), r = item % (KCH * 12), kc = r / 12, cb = r % 12, n = cb * 512 + tid;
            constexpr int KPI = DM / KCH;
            const float* w = a.ada_w + ((size_t)l * DM + kc * KPI) * NMODW + n;
            float acc[8];
#pragma unroll
            for (int b = 0; b < 8; ++b) acc[b] = 0.f;
#pragma unroll 1
            for (int kh = 0; kh < KPI; kh += 16) {
                float wv[16];
#pragma unroll
                for (int k = 0; k < 16; ++k) wv[k] = __builtin_nontemporal_load(w + (size_t)(kh + k) * NMODW);
#pragma unroll
                for (int k = 0; k < 16; ++k) {
                    const LAS float* sp = sc + kc * KPI + kh + k;
#pragma unroll
                    for (int b = 0; b < 8; ++b) acc[b] += sp[b * DM] * wv[k];
                    if ((k & 3) == 3) asm volatile("" ::: "memory");
                }
            }
#pragma unroll
            for (int b = 0; b < 8; ++b) modp[((size_t)(l * KCH + kc) * 8 + b) * NMODW + n] = acc[b];
        }
        __syncthreads();
    }
    {
        float* cs = (float*)(ws + WS_CS);
        for (int idx = blockIdx.x * 512 + tid; idx < T * 8; idx += gridDim.x * 512) {
            const int row = idx >> 3, j = idx & 7;
            const double rev = (double)a.pos[row] * c_inv_freq[j] * 0.15915494309189535;
            const float fr = (float)(rev - floor(rev));
            cs[(size_t)row * 16 + j] = __builtin_amdgcn_cosf(fr);
            cs[(size_t)row * 16 + 8 + j] = __builtin_amdgcn_sinf(fr);
        }
    }
    {
        LAS float* scr = (LAS float*)(lds + wave * 16384);
        const int gw = blockIdx.x * 8 + wave, ngw = gridDim.x * 8;
        constexpr int I_IN = 16 * 40, I_OUT = 16 * 32, I_G = 16 * 88, I_D = 44 * 32, I_P = 4 * 8;
        constexpr int PER_L = I_IN + I_OUT + 2 * I_G + I_D + I_P;
        for (int it = gw; it < DEPTH * PER_L; it += ngw) {
            const int l = it / PER_L; int r = it % PER_L;
            unsigned char* wl = ws + WS_W + (size_t)l * W_LAYER;
            if (r < I_IN) { const int kb = r / 40, nb = r % 40; transpose_item(a.w_in + (size_t)l * DM * INW, DM, INW, (bf16*)(wl + W_IN), 32 * nb, scr, 64 * kb, 32 * nb, lane); continue; } r -= I_IN;
            if (r < I_OUT) { const int kb = r / 32, nb = r % 32; transpose_item(a.w_out + (size_t)l * DM * DM, DM, DM, (bf16*)(wl + W_OUT), 32 * nb, scr, 64 * kb, 32 * nb, lane); continue; } r -= I_OUT;
            if (r < 2 * I_G) { const int up = r >= I_G; if (up) r -= I_G; const int kb = r / 88, nb = r % 88, n0 = 32 * nb;
                transpose_item((up ? a.w_up : a.w_gate) + (size_t)l * DM * DFF, DM, DFF, (bf16*)(wl + W_GU), 256 * (n0 >> 7) + (n0 & 127) + (up ? 128 : 0), scr, 64 * kb, n0, lane, up ? -0.6931471805599453f : -1.4426950408889634f); continue; } r -= 2 * I_G;
            if (r < I_D) { const int kb = r / 32, nb = r % 32; transpose_item(a.w_down + (size_t)l * DFF * DM, DFF, DM, (bf16*)(wl + W_DN), 32 * nb, scr, 64 * kb, 32 * nb, lane); continue; } r -= I_D;
            { const int gi = r / 8, q = r % 8, kb = q / 4, nb = q % 4;
              transpose_item(a.pool_w + ((size_t)l * 4 + gi) * 128 * 128, 128, 128, (bf16*)(wl + W_PW) + (size_t)gi * 128 * 128, 32 * nb, scr, 64 * kb, 32 * nb, lane); }
        }
    }
}

__device__ __forceinline__ float mod_val(const Args& a, int l, int b, int idx, int col) {
    const float* modp = (const float*)(a.ws + WS_MODP);
    const int n = idx * DM + col;
    float s = a.ada_b[l * NMODW + n];
#pragma unroll
    for (int kc = 0; kc < KCH; ++kc) s += modp[((size_t)(l * KCH + kc) * 8 + b) * NMODW + n];
    return s;
}
__device__ __forceinline__ float mod_fin(const Args& a, int l, int b, int idx, int col) {
    return ((const float*)(a.ws + WS_MODF))[((size_t)(l * 8 + b)) * NMODW + idx * DM + col];
}
__device__ __forceinline__ void mod_finalize(const Args& a) {
    float* modf = (float*)(a.ws + WS_MODF);
    for (int i = blockIdx.x * 512 + threadIdx.x; i < DEPTH * 8 * NMODW; i += gridDim.x * 512) {
        const int l = i / (8 * NMODW), r = i % (8 * NMODW), b = r / NMODW, n = r % NMODW;
        modf[i] = mod_val(a, l, b, n / DM, n % DM);
    }
}
__device__ __forceinline__ void unpack8(const v4u w, float (&f)[8]) {
#pragma unroll
    for (int e = 0; e < 4; ++e) { f[2 * e] = bf_lo(w[e]); f[2 * e + 1] = bf_hi(w[e]); }
}
__device__ __forceinline__ v4u pack8(const float (&f)[8]) { return (v4u){pk2(f[0], f[1]), pk2(f[2], f[3]), pk2(f[4], f[5]), pk2(f[6], f[7])}; }
__device__ __forceinline__ void rowwise_phase(const Args& a, LAS unsigned char* lds, bool from_partials, bool has_y, bool has_h, bool xin_bf, int xout_mode,
        const void* xin, const bf16* y, float* xout, bf16* xoutb, bf16* hout,
        int l_y, int gate_idx, const float* g_post, int l_h, int shift_idx, int scale_idx, const float* g_pre) {
    int tid_ = threadIdx.x; asm volatile("" : "+v"(tid_)); const int tid = tid_, lane = tid & 63, wave = tid >> 6;
    LAS float* vec = (LAS float*)lds;
    for (int tile = blockIdx.x; tile < T / 256; tile += gridDim.x) {
        const int b = tile / (SEQ / 256);
        __syncthreads();
        for (int col = tid; col < DM; col += 512) {
            if (from_partials) {
                if (has_y) vec[col] = mod_val(a, l_y, b, gate_idx, col) * g_post[col];
                if (has_h) { vec[DM + col] = g_pre[col] * (1.0f + mod_val(a, l_h, b, scale_idx, col)); vec[2 * DM + col] = mod_val(a, l_h, b, shift_idx, col); }
            } else {
                if (has_y) vec[col] = mod_fin(a, l_y, b, gate_idx, col) * g_post[col];
                if (has_h) { vec[DM + col] = g_pre[col] * (1.0f + mod_fin(a, l_h, b, scale_idx, col)); vec[2 * DM + col] = mod_fin(a, l_h, b, shift_idx, col); }
            }
        }
        __syncthreads();
#pragma unroll 1
        for (int r = wave * 4; r < 256; r += 32) {
            float v[4][2][8]; v4u yv[4][2];
#pragma unroll
            for (int h = 0; h < 4; ++h)
#pragma unroll
                for (int j = 0; j < 2; ++j) { const size_t off = ((size_t)tile * 256 + r + h) * DM + 8 * lane + 512 * j;
                    if (xin_bf) unpack8(__builtin_nontemporal_load((const v4u*)((const bf16*)xin + off)), v[h][j]);
                    else { const f32x4 p0 = __builtin_nontemporal_load((const f32x4*)((const float*)xin + off)), p1 = __builtin_nontemporal_load((const f32x4*)((const float*)xin + off + 4));
                        v[h][j][0] = p0.x; v[h][j][1] = p0.y; v[h][j][2] = p0.z; v[h][j][3] = p0.w; v[h][j][4] = p1.x; v[h][j][5] = p1.y; v[h][j][6] = p1.z; v[h][j][7] = p1.w; }
                    yv[h][j] = has_y ? __builtin_nontemporal_load((const v4u*)(y + off)) : (v4u){0u, 0u, 0u, 0u}; }
            if (has_y) {
                float rstd[4];
#pragma unroll
                for (int h = 0; h < 4; ++h) { float ss = 0.f;
#pragma unroll
                    for (int j = 0; j < 2; ++j) { float yf[8]; unpack8(yv[h][j], yf);
#pragma unroll
                        for (int e = 0; e < 8; ++e) ss += yf[e] * yf[e]; }
                    rstd[h] = __builtin_amdgcn_rsqf(wave_sum(ss) * (1.0f / DM) + EPS); }
#pragma unroll
                for (int j = 0; j < 2; ++j) { const LAS float* gpp = vec + 8 * lane + 512 * j; const f32x4 g0 = *(const LAS f32x4*)gpp, g1 = *(const LAS f32x4*)(gpp + 4);
                    const float gp[8] = {g0.x, g0.y, g0.z, g0.w, g1.x, g1.y, g1.z, g1.w};
#pragma unroll
                    for (int h = 0; h < 4; ++h) { float yf[8]; unpack8(yv[h][j], yf);
#pragma unroll
                        for (int e = 0; e < 8; ++e) v[h][j][e] += gp[e] * (yf[e] * rstd[h]); } }
            }
            if (xout_mode == 1) {
#pragma unroll
                for (int h = 0; h < 4; ++h)
#pragma unroll
                    for (int j = 0; j < 2; ++j) { float* o = xout + ((size_t)tile * 256 + r + h) * DM + 8 * lane + 512 * j;
                        __builtin_nontemporal_store((f32x4){v[h][j][0], v[h][j][1], v[h][j][2], v[h][j][3]}, (f32x4*)o); __builtin_nontemporal_store((f32x4){v[h][j][4], v[h][j][5], v[h][j][6], v[h][j][7]}, (f32x4*)(o + 4)); }
            } else if (xout_mode == 2) {
#pragma unroll
                for (int h = 0; h < 4; ++h)
#pragma unroll
                    for (int j = 0; j < 2; ++j) { const v4u w = pack8(v[h][j]);
                        __builtin_nontemporal_store(w, (v4u*)(xoutb + ((size_t)tile * 256 + r + h) * DM + 8 * lane + 512 * j));
                        unpack8(w, v[h][j]); }
            }
            if (has_h) {
                float rstd[4];
#pragma unroll
                for (int h = 0; h < 4; ++h) { float ss = 0.f;
#pragma unroll
                    for (int j = 0; j < 2; ++j)
#pragma unroll
                        for (int e = 0; e < 8; ++e) ss += v[h][j][e] * v[h][j][e];
                    rstd[h] = __builtin_amdgcn_rsqf(wave_sum(ss) * (1.0f / DM) + EPS); }
#pragma unroll
                for (int j = 0; j < 2; ++j) { const LAS float* gsp = vec + DM + 8 * lane + 512 * j; const LAS float* shp = vec + 2 * DM + 8 * lane + 512 * j;
                    const f32x4 a0 = *(const LAS f32x4*)gsp, a1 = *(const LAS f32x4*)(gsp + 4), b0 = *(const LAS f32x4*)shp, b1 = *(const LAS f32x4*)(shp + 4);
                    const float gs[8] = {a0.x, a0.y, a0.z, a0.w, a1.x, a1.y, a1.z, a1.w}, sh[8] = {b0.x, b0.y, b0.z, b0.w, b1.x, b1.y, b1.z, b1.w};
#pragma unroll
                    for (int h = 0; h < 4; ++h) { float hv[8];
#pragma unroll
                        for (int e = 0; e < 8; ++e) hv[e] = v[h][j][e] * rstd[h] * gs[e] + sh[e];
                        *(v4u*)(hout + ((size_t)tile * 256 + r + h) * DM + 8 * lane + 512 * j) = pack8(hv); } }
            }
        }
    }
}

__device__ __forceinline__ void attn_phase(LAS unsigned char* lds, const bf16* PROJ, bf16* CONCAT, const float* sinks) {
    int tid_ = threadIdx.x; asm volatile("" : "+v"(tid_)); const int tid = tid_, lane = tid & 63, wave = tid >> 6, fr = lane & 15, fq = lane >> 4;
    LAS bf16* Ks = (LAS bf16*)lds;
    LAS bf16* Vt = (LAS bf16*)(lds + 36864);
    v4u kv[4], vv[4];
#define ATT_LOAD_KV(uu) do { const int kh_ = (uu) & 1, n_ = ((uu) >> 1) & 63, b_ = (uu) >> 7; const long rb_ = (long)b_ * SEQ + n_ * 128 - 128; \
        _Pragma("unroll") for (int i = 0; i < 4; ++i) { const int kj = lane + 64 * i; kv[i] = (v4u){0u, 0u, 0u, 0u}; vv[i] = (v4u){0u, 0u, 0u, 0u}; \
            if (n_ > 0 || kj >= 128) { const bf16* p = PROJ + (size_t)(rb_ + kj) * INW + kh_ * 64 + wave * 8; kv[i] = *(const v4u*)(p + 512); vv[i] = *(const v4u*)(p + 640); } } } while (0)
    if ((int)blockIdx.x < NB * 64 * 2) ATT_LOAD_KV((int)blockIdx.x);
    for (int u = blockIdx.x; u < NB * 64 * 2; u += gridDim.x) {
        const int kh = u & 1, n = (u >> 1) & 63, b = u >> 7;
        const int g = wave >> 1, h = kh * 4 + g;
        const size_t qrow0 = (size_t)b * SEQ + n * 128 + (wave & 1) * 64 + fr;
        bf16x8 qf[4][2];
#pragma unroll
        for (int i = 0; i < 4; ++i) { const bf16* qp = PROJ + (qrow0 + 16 * i) * INW + h * 64 + 8 * fq; qf[i][0] = __builtin_nontemporal_load((const bf16x8*)qp); qf[i][1] = __builtin_nontemporal_load((const bf16x8*)(qp + 32)); }
#pragma unroll
        for (int i = 0; i < 4; ++i) { const int kj = lane + 64 * i;
            *(LAS v4u*)(Ks + kj * 72 + wave * 8) = kv[i];
#pragma unroll
            for (int e = 0; e < 4; ++e) { Vt[(wave * 8 + 2 * e) * 272 + kj] = (bf16)(vv[i][e] & 0xffffu); Vt[(wave * 8 + 2 * e + 1) * 272 + kj] = (bf16)(vv[i][e] >> 16); } }
        __syncthreads();
        if (u + (int)gridDim.x < NB * 64 * 2) ATT_LOAD_KV(u + (int)gridDim.x);
        const float sink = sinks[h];
        const int firstblk = (n == 0);
#pragma unroll
        for (int p = 0; p < 2; ++p) {
            const int q16a = (wave & 1) * 4 + 2 * p, kt0 = q16a;
            f32x4 st[2][10];
#pragma unroll
            for (int t = 0; t < 10; ++t) {
                const LAS bf16* kp = Ks + (16 * (kt0 + t) + fr) * 72 + 8 * fq;
                const bf16x8 k0 = *(const LAS bf16x8*)kp, k1 = *(const LAS bf16x8*)(kp + 32);
#pragma unroll
                for (int x = 0; x < 2; ++x) {
                    if (x + 8 - t == 9 || x + 8 - t == -1) { st[x][t] = (f32x4){-1e30f, -1e30f, -1e30f, -1e30f}; continue; }
                    f32x4 acc = (f32x4){0.f, 0.f, 0.f, 0.f};
                    acc = __builtin_amdgcn_mfma_f32_16x16x32_bf16(k0, qf[2 * p + x][0], acc, 0, 0, 0);
                    acc = __builtin_amdgcn_mfma_f32_16x16x32_bf16(k1, qf[2 * p + x][1], acc, 0, 0, 0);
                    st[x][t] = acc;
                }
            }
            float inv[2];
#pragma unroll
            for (int x = 0; x < 2; ++x) {
                float mx = -1e30f;
#pragma unroll
                for (int t = 0; t < 10; ++t) {
                    const int D = x + 8 - t;
                    if (D == 9 || D == -1) continue;
                    const bool tile_off = firstblk && (kt0 + t < 8);
#pragma unroll
                    for (int r = 0; r < 4; ++r) { const int dl = fr - 4 * fq - r;
                        bool valid = !tile_off;
                        if (D == 8) valid = valid && (dl < 0);
                        if (D == 0) valid = valid && (dl >= 0);
                        const float sv = valid ? st[x][t][r] : -1e30f; st[x][t][r] = sv; mx = fmaxf(mx, sv); }
                }
                mx = fmaxf(mx, __shfl_xor(mx, 16)); mx = fmaxf(mx, __shfl_xor(mx, 32)); mx = fmaxf(mx, sink);
                const float mb = mx * LOG2E;
                float lsum = 0.f;
#pragma unroll
                for (int t = 0; t < 10; ++t) {
                    const int D = x + 8 - t;
                    if (D == 9 || D == -1) { st[x][t] = (f32x4){0.f, 0.f, 0.f, 0.f}; continue; }
#pragma unroll
                    for (int r = 0; r < 4; ++r) { const float pe = __builtin_amdgcn_exp2f(st[x][t][r] * LOG2E - mb); st[x][t][r] = pe; lsum += pe; }
                }
                lsum += __shfl_xor(lsum, 16); lsum += __shfl_xor(lsum, 32); lsum += __builtin_amdgcn_exp2f(sink * LOG2E - mb);
                inv[x] = 1.0f / lsum;
            }
            f32x4 ot[2][4];
#pragma unroll
            for (int x = 0; x < 2; ++x)
#pragma unroll
                for (int dt = 0; dt < 4; ++dt) ot[x][dt] = (f32x4){0.f, 0.f, 0.f, 0.f};
#pragma unroll
            for (int s2 = 0; s2 < 5; ++s2) {
                bf16x8 pf[2];
#pragma unroll
                for (int x = 0; x < 2; ++x) { v4u pw; pw.x = pk2(st[x][2 * s2][0], st[x][2 * s2][1]); pw.y = pk2(st[x][2 * s2][2], st[x][2 * s2][3]);
                    pw.z = pk2(st[x][2 * s2 + 1][0], st[x][2 * s2 + 1][1]); pw.w = pk2(st[x][2 * s2 + 1][2], st[x][2 * s2 + 1][3]); pf[x] = __builtin_bit_cast(bf16x8, pw); }
#pragma unroll
                for (int dt = 0; dt < 4; ++dt) {
                    const LAS bf16* vp = Vt + (16 * dt + fr) * 272 + 16 * (kt0 + 2 * s2) + 4 * fq;
                    const v2u lo = *(const LAS v2u*)vp, hi = *(const LAS v2u*)(vp + 16);
                    const bf16x8 vf = __builtin_bit_cast(bf16x8, (v4u){lo.x, lo.y, hi.x, hi.y});
#pragma unroll
                    for (int x = 0; x < 2; ++x) ot[x][dt] = __builtin_amdgcn_mfma_f32_16x16x32_bf16(vf, pf[x], ot[x][dt], 0, 0, 0);
                }
            }
#pragma unroll
            for (int x = 0; x < 2; ++x) {
                LAS bf16* stg = (LAS bf16*)(lds + 71680) + (wave * 2 + x) * (16 * 72);
#pragma unroll
                for (int dt = 0; dt < 4; ++dt) *(LAS v2u*)(stg + fr * 72 + 16 * dt + 4 * fq) = (v2u){pk2(ot[x][dt][0] * inv[x], ot[x][dt][1] * inv[x]), pk2(ot[x][dt][2] * inv[x], ot[x][dt][3] * inv[x])};
                bf16* op = CONCAT + (qrow0 - fr + 16 * (2 * p + x)) * DM + h * 64;
#pragma unroll
                for (int i = 0; i < 2; ++i) { const int row = 8 * i + (lane >> 3), chn = lane & 7;
                    *(v4u*)(op + (size_t)row * DM + chn * 8) = *(const LAS v4u*)(stg + row * 72 + chn * 8); }
            }
        }
        __syncthreads();
    }
#undef ATT_LOAD_KV
}

constexpr int PL_US = 136;
template <int W> __device__ __forceinline__ void pool_load(const bf16* PROJ, int gi, int tt, int lane, v4u (&raw)[8]) {
    const size_t t0 = (size_t)tt * 16; const int s0 = (int)(t0 & (SEQ - 1));
    const int ch = lane & 15, rs = lane >> 4;
#pragma unroll
    for (int i = 0; i < 8; ++i) { const int r = rs + 4 * i;
        raw[i] = (v4u){0u, 0u, 0u, 0u};
        if (4 * i + 3 >= 17 - W) { if (s0 - 16 + r >= 0) raw[i] = *(const v4u*)(PROJ + (t0 - 16 + r) * INW + 768 + gi * 128 + ch * 8); } }
}
typedef short v4i16_t __attribute__((ext_vector_type(4)));
__device__ __forceinline__ v2u lds_tr(const LAS bf16* p) { return __builtin_bit_cast(v2u, __builtin_amdgcn_ds_read_tr16_b64_v4i16((LAS v4i16_t*)p)); }
template <int W> __device__ __forceinline__ void pool_compute(bf16* CONCAT, const LAS bf16* wl, LAS bf16* ust, const float* pscale, int gi, int tt, int lane, const v4u (&raw)[8]) {
    const int fr = lane & 15, fq = lane >> 4;
    const size_t t0 = (size_t)tt * 16; const int s0 = (int)(t0 & (SEQ - 1));
    {
        const int ch = lane & 15, rs = lane >> 4;
#pragma unroll
        for (int i = 0; i < 8; ++i) { const int r = rs + 4 * i; if (4 * i + 3 >= 17 - W) *(LAS v4u*)(ust + r * PL_US + ch * 8) = raw[i]; }
    }
    const int s = s0 + fr;
    const int cnt = (s + 1 < W) ? (s + 1) : W;
    const float invc = 1.0f / (float)cnt;
    bf16x8 band;
    { float bv[8];
#pragma unroll
      for (int j = 0; j < 8; ++j) { const int rel = 8 * fq + j - 16 - fr;
          bv[j] = ((rel > -W && rel <= 0) ? 1.0f : 0.0f) - ((rel == 0) ? (float)cnt : 0.0f); }
      band = __builtin_bit_cast(bf16x8, (v4u){pk2(bv[0], bv[1]), pk2(bv[2], bv[3]), pk2(bv[4], bv[5]), pk2(bv[6], bv[7])}); }
    f32x4 pl[8];
    const LAS bf16* trp = ust + (8 * fq + ((lane & 15) >> 2)) * PL_US + 4 * (lane & 3);
#pragma unroll
    for (int a = 0; a < 8; ++a) {
        const v2u lo = lds_tr(trp + 16 * a), hi = lds_tr(trp + 4 * PL_US + 16 * a);
        const bf16x8 ua = __builtin_bit_cast(bf16x8, (v4u){lo.x, lo.y, hi.x, hi.y});
        pl[a] = __builtin_amdgcn_mfma_f32_16x16x32_bf16(ua, band, (f32x4){0.f, 0.f, 0.f, 0.f}, 0, 0, 0);
    }
    bf16x8 pf[4];
#pragma unroll
    for (int ks = 0; ks < 4; ++ks)
        pf[ks] = __builtin_bit_cast(bf16x8, (v4u){pk2(pl[2 * ks][0] * invc, pl[2 * ks][1] * invc), pk2(pl[2 * ks][2] * invc, pl[2 * ks][3] * invc),
                                                  pk2(pl[2 * ks + 1][0] * invc, pl[2 * ks + 1][1] * invc), pk2(pl[2 * ks + 1][2] * invc, pl[2 * ks + 1][3] * invc)});
#pragma unroll
    for (int nt = 0; nt < 8; ++nt) {
        f32x4 acc = (f32x4){0.f, 0.f, 0.f, 0.f};
        const LAS bf16* wp = wl + (16 * nt + fr) * PL_US + 4 * fq;
#pragma unroll
        for (int ks = 0; ks < 4; ++ks) { const v2u lo = *(const LAS v2u*)(wp + 32 * ks), hi = *(const LAS v2u*)(wp + 32 * ks + 16);
            acc = __builtin_amdgcn_mfma_f32_16x16x32_bf16(__builtin_bit_cast(bf16x8, (v4u){lo.x, lo.y, hi.x, hi.y}), pf[ks], acc, 0, 0, 0); }
        const int d = gi * 128 + 16 * nt + 4 * fq;
        const f32x4 sc = *(const f32x4*)(pscale + d);
        *(LAS v2u*)(ust + fr * PL_US + 16 * nt + 4 * fq) = (v2u){pk2(acc[0] * sc.x, acc[1] * sc.y), pk2(acc[2] * sc.z, acc[3] * sc.w)};
    }
#pragma unroll
    for (int i = 0; i < 4; ++i) { const int row = 4 * i + (lane >> 4), chn = lane & 15;
        const v4u w = *(const LAS v4u*)(ust + row * PL_US + chn * 8);
        *(v4u*)(CONCAT + (t0 + row) * DM + 512 + gi * 128 + chn * 8) = w; }
}
template <int W> __device__ __forceinline__ void pool_group(const bf16* PROJ, bf16* CONCAT, const LAS bf16* wl, LAS bf16* ust, const float* pscale, int gi, int gw, int ngw, int lane) {
    v4u ra[8], rb[8];
    {
        const int ch = lane & 15, rs = lane >> 4;
#pragma unroll
        for (int i = 0; i < 8; ++i) if (!(4 * i + 3 >= 17 - W)) *(LAS v4u*)(ust + (rs + 4 * i) * PL_US + ch * 8) = (v4u){0u, 0u, 0u, 0u};
    }
    int tt = gw;
    if (tt < T / 16) pool_load<W>(PROJ, gi, tt, lane, ra);
    while (tt < T / 16) {
        const int tn = tt + ngw;
        if (tn < T / 16) pool_load<W>(PROJ, gi, tn, lane, rb);
        pool_compute<W>(CONCAT, wl, ust, pscale, gi, tt, lane, ra);
        tt = tn;
        if (tt >= T / 16) break;
        const int tn2 = tt + ngw;
        if (tn2 < T / 16) pool_load<W>(PROJ, gi, tn2, lane, ra);
        pool_compute<W>(CONCAT, wl, ust, pscale, gi, tt, lane, rb);
        tt = tn2;
    }
}
__device__ __forceinline__ void pool_phase(LAS unsigned char* lds, const bf16* PROJ, bf16* CONCAT, const bf16* PWT, const float* pscale) {
    int tid_ = threadIdx.x; asm volatile("" : "+v"(tid_)); const int tid = tid_, lane = tid & 63, wave = tid >> 6;
    LAS bf16* wl = (LAS bf16*)lds;
    LAS bf16* ust = (LAS bf16*)(lds + 36864 + wave * 8704);
    const bool quad = (gridDim.x & 3) == 0;
    const int gw = quad ? (int)(blockIdx.x >> 2) * 8 + wave : (int)blockIdx.x * 8 + wave, ngw = quad ? (int)(gridDim.x >> 2) * 8 : (int)gridDim.x * 8;
#pragma unroll 1
    for (int g = 0; g < (quad ? 1 : 4); ++g) {
        const int gi = quad ? (int)(blockIdx.x & 3) : g;
        __syncthreads();
        { const int row = tid >> 2, q = tid & 3; const bf16* src = PWT + ((size_t)gi * 128 + row) * 128 + q * 32;
#pragma unroll
          for (int e = 0; e < 4; ++e) *(LAS v4u*)(wl + row * PL_US + q * 32 + e * 8) = *(const v4u*)(src + e * 8); }
        __syncthreads();
        if (gi == 0) pool_group<2>(PROJ, CONCAT, wl, ust, pscale, gi, gw, ngw, lane);
        else if (gi == 1) pool_group<4>(PROJ, CONCAT, wl, ust, pscale, gi, gw, ngw, lane);
        else if (gi == 2) pool_group<8>(PROJ, CONCAT, wl, ust, pscale, gi, gw, ngw, lane);
        else pool_group<16>(PROJ, CONCAT, wl, ust, pscale, gi, gw, ngw, lane);
    }
    __syncthreads();
}

#ifndef REP_P
#define REP_P 1
#endif
#ifndef REP_G
#define REP_G 1
#endif
#ifndef REP_R
#define REP_R 1
#endif
#ifndef REP_G
#define REP_G 1
#endif
#ifndef REP_IN
#define REP_IN REP_G
#endif
#ifndef REP_GU
#define REP_GU REP_G
#endif
#ifndef REP_DN
#define REP_DN REP_G
#endif
#ifndef REP_PL
#define REP_PL 1
#endif
#ifndef REP_A
#define REP_A 1
#endif
__global__ void __launch_bounds__(512, 2) fwd_kernel(Args a) {
    extern __shared__ __attribute__((aligned(16))) unsigned char lds_raw[];
    cg::grid_group grid = cg::this_grid();
    LAS unsigned char* lds = (LAS unsigned char*)lds_raw;
    unsigned char* ws = a.ws;
    bf16* H = (bf16*)(ws + WS_H); bf16* MIX = (bf16*)(ws + WS_MIX); bf16* PROJ = (bf16*)(ws + WS_PROJ);
    bf16* CONCAT = (bf16*)(ws + WS_CONCAT); bf16* ACT = (bf16*)(ws + WS_ACT);
    const float* cs = (const float*)(ws + WS_CS); bf16* XA = (bf16*)(ws + WS_XA); bf16* XB = (bf16*)(ws + WS_XB);
    volatile LAS unsigned* MISC = (volatile LAS unsigned*)(lds + RING_BYTES + 64);
    if (threadIdx.x == 0) { MISC[0] = 0u; MISC[1] = 0u; }
    __syncthreads();
    XcdBarrier bar = xcd_barrier_post((unsigned*)ws, MISC);
#define SEAM() xcd_barrier(bar)

    for (int rep = 0; rep < REP_P; ++rep) prologue(a, lds);
    if (a.ws == nullptr) grid.sync();
    SEAM();
    for (int rep = 0; rep < REP_R; ++rep) rowwise_phase(a, lds, true, false, true, false, 2, a.x, nullptr, nullptr, XB, H, 0, 0, nullptr, 0, 0, 1, a.g_pre_mix);
    mod_finalize(a);
    SEAM();
#pragma unroll 1
    for (int l = 0; l < DEPTH; ++l) {
        unsigned char* wl = ws + WS_W + (size_t)l * W_LAYER;
        for (int rep = 0; rep < REP_IN; ++rep) {
            pg8::Gemm g{H, (const bf16*)(wl + W_IN), T, INW, DM}; pg8::StaticOrder S; S.init(T, INW, gridDim.x, blockIdx.x);
            pg8::EpiInProj E{PROJ, a.b_in + l * INW, cs};
            pg8::gemm_phase<pg8::EpiInProj, pg8::StaticOrder, true, true>(lds, g, S, E);
        }
        SEAM();
        for (int rep = 0; rep < REP_A; ++rep) attn_phase(lds, PROJ, CONCAT, a.sinks + l * 8);
        for (int rep = 0; rep < REP_PL; ++rep) pool_phase(lds, PROJ, CONCAT, (const bf16*)(wl + W_PW), a.pool_scale + l * 512);
        SEAM();
        for (int rep = 0; rep < REP_G; ++rep) {
            pg8::Gemm g{CONCAT, (const bf16*)(wl + W_OUT), T, DM, DM}; pg8::StaticOrder S; S.init(T, DM, gridDim.x, blockIdx.x);
            pg8::EpiBf16<0> E{MIX, DM, nullptr, 0, 0, 1.f};
            pg8::gemm_phase<pg8::EpiBf16<0>, pg8::StaticOrder, true, true>(lds, g, S, E);
        }
        SEAM();
        for (int rep = 0; rep < REP_R; ++rep) rowwise_phase(a, lds, false, true, true, true, 2, XB, MIX, nullptr, XA, H, l, 2, a.g_post_mix + l * DM, l, 3, 4, a.g_pre_ffn + l * DM);
        SEAM();
#if defined(PROBE_HOT)
#pragma unroll 1
        for (int rep = 0; rep < 2; ++rep) {
            pg8::Gemm g{H, (const bf16*)(wl + W_GU), T, 2 * DFF, rep == 0 ? PROBE_HOT_K : DM}; pg8::DualOrder S; S.so.init(T, 2 * DFF, gridDim.x, blockIdx.x); S.c = blockIdx.x; S.rounds = 22; S.hot = (rep == 0);
            pg8::EpiSwiGLU E{rep == 0 ? MIX : ACT};
            pg8::gemm_phase<pg8::EpiSwiGLU, pg8::DualOrder, true, true>(lds, g, S, E);
            if (rep == 0) SEAM();
        }
#else
        for (int rep = 0; rep < REP_GU; ++rep) {
            pg8::Gemm g{H, (const bf16*)(wl + W_GU), T, 2 * DFF, DM}; pg8::StaticOrder S; S.init(T, 2 * DFF, gridDim.x, blockIdx.x);
            pg8::EpiSwiGLU E{ACT};
            pg8::gemm_phase<pg8::EpiSwiGLU, pg8::StaticOrder, true, true>(lds, g, S, E);
        }
#endif
        SEAM();
        for (int rep = 0; rep < REP_DN; ++rep) {
            pg8::Gemm g{ACT, (const bf16*)(wl + W_DN), T, DM, DFF}; pg8::StaticOrder S; S.init(T, DM, gridDim.x, blockIdx.x);
            pg8::EpiBf16<0> E{MIX, DM, nullptr, 0, 0, 1.f};
            pg8::gemm_phase<pg8::EpiBf16<0>, pg8::StaticOrder, true, true>(lds, g, S, E);
        }
        SEAM();
        const bool more = (l + 1 < DEPTH);
        for (int rep = 0; rep < REP_R; ++rep) rowwise_phase(a, lds, false, true, more, true, more ? 2 : 1, XA, MIX, a.out, XB, H, l, 5, a.g_post_ffn + l * DM, l + 1, 0, 1, a.g_pre_mix + (more ? (l + 1) * DM : 0));
        if (more) SEAM();
    }
}

extern "C" void kernel_launch(void* const* d_in, const int* in_sizes, int n_in, void* d_out, int out_size, void* d_ws, size_t ws_size, hipStream_t stream) {
    static int grid_blocks = 0;
    if (grid_blocks == 0) {
        if (n_in != 18 || out_size != T * DM || ws_size < WS_END) { fprintf(stderr, "kernel_launch: unexpected shapes (n_in %d, out %d, ws %zu)\n", n_in, out_size, ws_size); grid_blocks = -1; return; }
        int dev = 0, cus = 0, per_cu = 0;
        hipGetDevice(&dev);
        hipDeviceGetAttribute(&cus, hipDeviceAttributeMultiprocessorCount, dev);
        if (hipFuncSetAttribute((const void*)fwd_kernel, hipFuncAttributeMaxDynamicSharedMemorySize, LDS_BYTES) != hipSuccess) { fprintf(stderr, "kernel_launch: hipFuncSetAttribute failed\n"); grid_blocks = -1; return; }
        if (hipOccupancyMaxActiveBlocksPerMultiprocessor(&per_cu, (const void*)fwd_kernel, 512, LDS_BYTES) != hipSuccess || per_cu < 1) { fprintf(stderr, "kernel_launch: occupancy query gave %d\n", per_cu); per_cu = 1; }
        (void)hipGetLastError();
        grid_blocks = cus * per_cu;
    }
    if (grid_blocks < 0) return;
    if (hipMemsetAsync(d_ws, 0, 65536, stream) != hipSuccess) { fprintf(stderr, "kernel_launch: memset failed\n"); return; }
    Args a{};
    a.x = (const float*)d_in[0]; a.c = (const float*)d_in[1]; a.pos = (const int*)d_in[2]; a.ada_w = (const float*)d_in[3]; a.ada_b = (const float*)d_in[4];
    a.w_in = (const float*)d_in[5]; a.b_in = (const float*)d_in[6]; a.sinks = (const float*)d_in[7]; a.pool_w = (const float*)d_in[8]; a.pool_scale = (const float*)d_in[9];
    a.w_out = (const float*)d_in[10]; a.w_gate = (const float*)d_in[11]; a.w_up = (const float*)d_in[12]; a.w_down = (const float*)d_in[13];
    a.g_pre_mix = (const float*)d_in[14]; a.g_post_mix = (const float*)d_in[15]; a.g_pre_ffn = (const float*)d_in[16]; a.g_post_ffn = (const float*)d_in[17];
    a.out = (float*)d_out; a.ws = (unsigned char*)d_ws;
    void* args[] = {&a};
    hipError_t e = hipLaunchCooperativeKernel((const void*)fwd_kernel, dim3(grid_blocks), dim3(512), args, LDS_BYTES, stream);
    if (e != hipSuccess) fprintf(stderr, "cooperative launch failed: %s (grid %d)\n", hipGetErrorString(e), grid_blocks);
}
```

```cpp
#include <hip/hip_runtime.h>
#include <hip/hip_cooperative_groups.h>
#include <cstdio>
#include <cstdint>
namespace cg = cooperative_groups;
#define LAS __attribute__((address_space(3)))
namespace pg8 {
#define PG8_LAS __attribute__((address_space(3)))
typedef unsigned short bf16_t;
typedef short bf16x8 __attribute__((ext_vector_type(8)));
typedef float f32x4 __attribute__((ext_vector_type(4)));
typedef unsigned u32x4 __attribute__((ext_vector_type(4)));
constexpr int BM = 256, BK = 64, HALF = 128, HTB = HALF * BK * 2  , STAGE_BYTES = 8 * HTB, NXCD = 8, WGM = 8;

__host__ __device__ __forceinline__ int lds_byte(int r, int c) { const int st = (r >> 4) * 2 + (c >> 5), rr = r & 15, cc = c & 31, ob = rr * 64 + cc * 2; return st * 1024 + (ob ^ (((ob >> 9) & 1) << 5)); }
__host__ __device__ __forceinline__ void stage_rc(int b, int& R, int& C) { const int st = b / 1024, sb = b % 1024, swz = sb ^ (((sb >> 9) & 1) << 5); R = (st >> 1) * 16 + swz / 64; C = (st & 1) * 32 + (swz % 64) / 2; }
__host__ __device__ __forceinline__ int perm32(int rho) { const int n = rho >> 4, i = rho & 15; return 8 * (i >> 2) + 4 * n + (i & 3); }

struct Unit { int pm, pn; };
struct Gemm { const bf16_t* A; const bf16_t* Bt; int M, N, K; };

struct StaticOrder {
    int nM, nN, nwg, G, c;
    __host__ __device__ void init(int M, int N, int G_, int c_) { nM = M / BM; nN = N / BM; nwg = nM * nN; G = G_; c = c_; }
    __host__ __device__ bool next(int i, Unit& u) const {
        const long L = (long)i * G + c; if (L >= nwg) return false;
        int wgid = (int)L; { const int q = nwg / NXCD, r = nwg % NXCD, xcd = wgid % NXCD, off = wgid / NXCD; wgid = (xcd < r ? xcd * (q + 1) : r * (q + 1) + (xcd - r) * q) + off; }
        const int nig = WGM * nN, gid = wgid / nig, fm = gid * WGM, gsz = (nM - fm) < WGM ? (nM - fm) : WGM;
        u.pm = fm + ((wgid % nig) % gsz); u.pn = (wgid % nig) / gsz; return true;
    }
    __device__ __forceinline__ void a_ready(const Unit&) const {}
    __device__ __forceinline__ void done(const Unit&) const {}
};

__device__ __forceinline__ unsigned cvt_pk_bf16(float lo, float hi) { unsigned r; asm volatile("v_cvt_pk_bf16_f32 %0, %1, %2" : "=v"(r) : "v"(lo), "v"(hi)); return r; }
typedef float f32x2 __attribute__((ext_vector_type(2)));
__device__ __forceinline__ f32x2 gelu_pk(f32x2 v) {
    const f32x2 av = __builtin_elementwise_abs(v), d = av * 0.2316418882f + 1.0f;
    f32x2 t; t.x = __builtin_amdgcn_rcpf(d.x); t.y = __builtin_amdgcn_rcpf(d.y);
    f32x2 q = t * 0.5307027145f + (-0.7265760135f); q = q * t + 0.7107068705f; q = q * t + (-0.142248368f); q = q * t + 0.127414796f; q = q * t;
    const f32x2 s = (v * v) * (-0.72134752044f);
    f32x2 e; e.x = __builtin_amdgcn_exp2f(s.x); e.y = __builtin_amdgcn_exp2f(s.y);
    const f32x2 m = v * (q * e), r = v - m;
    f32x2 o; o.x = v.x < 0.f ? m.x : r.x; o.y = v.y < 0.f ? m.y : r.y; return o;
}

template <int ACT  > struct EpiBf16 {
    static constexpr bool PERM = true, AFTER_DRAIN = false; static_assert(ACT == 0 || ACT == 1, "EpiBf16: ACT is 0 (none) or 1 (gelu_pk)");
    bf16_t* O; int ldc; const float* bias; int split_cols; size_t split_stride; float scale0;
    __device__ __forceinline__ void operator()(const f32x4 (&acc)[2][2][4][2], const Unit& u, int wr, int wc, int fr, int fq) const {
        const int row0 = u.pm * BM + wr * 64 + fr; int colt = u.pn * BM; bf16_t* base = O;
        float sc = 1.f; if (split_cols) { const int t = colt / split_cols; base += (size_t)t * split_stride; colt -= t * split_cols; if (t == 0) sc = scale0; }
        const int col0 = colt + wc * 32 + 8 * fq, bcol0 = u.pn * BM + wc * 32 + 8 * fq;
        f32x4 bv[2][2];
#pragma unroll
        for (int bj = 0; bj < 2; ++bj)
#pragma unroll
            for (int n = 0; n < 2; ++n) bv[bj][n] = bias ? *(const f32x4*)(bias + bcol0 + bj * HALF + 4 * n) : (f32x4){0.f, 0.f, 0.f, 0.f};
#pragma unroll
        for (int ai = 0; ai < 2; ++ai)
#pragma unroll
            for (int m = 0; m < 4; ++m) { bf16_t* rowp = base + (size_t)(row0 + ai * HALF + m * 16) * ldc + col0;
#pragma unroll
                for (int bj = 0; bj < 2; ++bj) { f32x4 v0 = acc[ai][bj][m][0] + bv[bj][0], v1 = acc[ai][bj][m][1] + bv[bj][1];
                    if (ACT == 1) { f32x2 a = gelu_pk((f32x2){v0[0], v0[1]}), b = gelu_pk((f32x2){v0[2], v0[3]}), c = gelu_pk((f32x2){v1[0], v1[1]}), d = gelu_pk((f32x2){v1[2], v1[3]});
                        v0 = (f32x4){a.x, a.y, b.x, b.y}; v1 = (f32x4){c.x, c.y, d.x, d.y}; }
                    v0 = v0 * sc; v1 = v1 * sc; u32x4 w; w.x = cvt_pk_bf16(v0[0], v0[1]); w.y = cvt_pk_bf16(v0[2], v0[3]); w.z = cvt_pk_bf16(v1[0], v1[1]); w.w = cvt_pk_bf16(v1[2], v1[3]);
                    *(u32x4*)(rowp + bj * HALF) = w; } }
    }
};
template <class Epi, class Sched, bool ALIGN_EPI = false, bool SP2 = false, int A_AUX = 0  >
__device__ __forceinline__ void gemm_phase(PG8_LAS unsigned char* lds, const Gemm g, const Sched& S, const Epi& E) {
    int tid_ = threadIdx.x; asm volatile("" : "+v"(tid_)); const int tid = tid_, wid = __builtin_amdgcn_readfirstlane(tid >> 6), lane = tid & 63, wr = wid >> 2, wc = wid & 3, fr = lane & 15, fq = lane >> 4;
    const int K = g.K, nt = K / BK;
    unsigned voffA[2], voffB[2];
#pragma unroll
    for (int i = 0; i < 2; ++i) { int R, C; stage_rc(tid * 16 + i * 8192, R, C); const int Rb = Epi::PERM ? ((R & ~31) + perm32(R & 31)) : R;
        voffA[i] = (unsigned)(R * K + C) * 2u; voffB[i] = (unsigned)(Rb * K + C) * 2u; }
    const size_t kstep = (size_t)(BK * 2);
    const size_t hstep = (size_t)HALF * K * 2;
    const size_t tstep = 2 * hstep;
    const unsigned ldsw = (unsigned)wid * 1024u;
    const int aoff = lds_byte(wr * 64 + fr, fq * 8), boff = lds_byte(wc * 32 + fr, fq * 8);
#define PG8_SA(b, h) (((b) * 2 + (h)) * HTB)
#define PG8_SB(b, h) ((4 + (b) * 2 + (h)) * HTB)
#define PG8_STAGE(bufoff, gbase, voff) do { _Pragma("unroll") for (int _i = 0; _i < 2; ++_i) \
        __builtin_amdgcn_global_load_lds((const unsigned*)((const char*)(gbase) + (voff)[_i]), (PG8_LAS unsigned*)(lds + (bufoff) + ldsw + _i * 8192), 16, 0, 0); } while (0)
#define PG8_STAGEA(bufoff, gbase, voff) do { _Pragma("unroll") for (int _i = 0; _i < 2; ++_i) \
        __builtin_amdgcn_global_load_lds((const unsigned*)((const char*)(gbase) + (voff)[_i]), (PG8_LAS unsigned*)(lds + (bufoff) + ldsw + _i * 8192), 16, 0, A_AUX); } while (0)
#define PG8_LDA(dst, b, h) do { _Pragma("unroll") for (int m = 0; m < 4; ++m) _Pragma("unroll") for (int k = 0; k < 2; ++k) dst[m][k] = *(const PG8_LAS bf16x8*)(lds + PG8_SA(b, h) + aoff + m * 2048 + k * 1024); } while (0)
#define PG8_LDB(dst, b, h) do { _Pragma("unroll") for (int n = 0; n < 2; ++n) _Pragma("unroll") for (int k = 0; k < 2; ++k) dst[n][k] = *(const PG8_LAS bf16x8*)(lds + PG8_SB(b, h) + boff + n * 2048 + k * 1024); } while (0)
#define PG8_MMA(ai, bj, At, Bt) do { __builtin_amdgcn_s_setprio(1); _Pragma("unroll") for (int m = 0; m < 4; ++m) _Pragma("unroll") for (int n = 0; n < 2; ++n) _Pragma("unroll") for (int k = 0; k < 2; ++k) \
        acc[ai][bj][m][n] = __builtin_amdgcn_mfma_f32_16x16x32_bf16(Bt[n][k], At[m][k], acc[ai][bj][m][n], 0, 0, 0); __builtin_amdgcn_s_setprio(0); } while (0)
#define PG8_WAIT_V(n) asm volatile("s_waitcnt vmcnt(" #n ")" ::: "memory")
#define PG8_WAIT_L(n) asm volatile("s_waitcnt lgkmcnt(" #n ")" ::: "memory")
#define PG8_BAR __builtin_amdgcn_s_barrier()
#define PG8_SCHED __builtin_amdgcn_sched_barrier(0)
    Unit cur, nxt; int ui = 0;
    if (!S.next(0, cur)) return;
    f32x4 acc[2][2][4][2];
#pragma unroll
    for (int a = 0; a < 2; ++a)
#pragma unroll
        for (int b = 0; b < 2; ++b)
#pragma unroll
            for (int m = 0; m < 4; ++m)
#pragma unroll
                for (int n = 0; n < 2; ++n) acc[a][b][m][n] = (f32x4){0.f, 0.f, 0.f, 0.f};
    bf16x8 At[4][2], B0[2][2], B1[2][2];
    const char* cA = (const char*)g.A + (size_t)cur.pm * tstep; const char* cB = (const char*)g.Bt + (size_t)cur.pn * tstep;
    S.a_ready(cur);
    if constexpr (SP2) {
        PG8_STAGE(PG8_SB(0, 0), cB, voffB); PG8_STAGE(PG8_SB(0, 1), cB + hstep, voffB); PG8_STAGEA(PG8_SA(0, 0), cA, voffA); PG8_STAGEA(PG8_SA(0, 1), cA + hstep, voffA);
        if (wr == 1) PG8_BAR;
        PG8_WAIT_V(2); PG8_BAR;
        PG8_STAGE(PG8_SB(1, 0), cB + kstep, voffB); PG8_STAGEA(PG8_SA(1, 0), cA + kstep, voffA); PG8_STAGE(PG8_SB(1, 1), cB + hstep + kstep, voffB);
        PG8_WAIT_V(6); PG8_BAR;
    } else {
        PG8_STAGE(PG8_SB(0, 0), cB, voffB); PG8_STAGEA(PG8_SA(0, 0), cA, voffA); PG8_STAGE(PG8_SB(0, 1), cB + hstep, voffB); PG8_STAGEA(PG8_SA(0, 1), cA + hstep, voffA);
        if (wr == 1) PG8_BAR;
        PG8_WAIT_V(4); PG8_BAR;
        PG8_STAGE(PG8_SB(1, 0), cB + kstep, voffB); PG8_STAGEA(PG8_SA(1, 0), cA + kstep, voffA); PG8_STAGE(PG8_SB(1, 1), cB + hstep + kstep, voffB);
        PG8_WAIT_V(6); PG8_BAR;
    }
    for (;;) {
        const bool has_next = S.next(ui + 1, nxt);
        const char* nA = has_next ? (const char*)g.A + (size_t)nxt.pm * tstep : cA; const char* nB = has_next ? (const char*)g.Bt + (size_t)nxt.pn * tstep : cB;
        for (int t = 0; t < nt; t += 2) {
            const bool last = (t == nt - 2);
            const char* a1 = cA + (size_t)(t + 1) * kstep;
            const char* a2 = last ? nA : cA + (size_t)(t + 2) * kstep; const char* b2 = last ? nB : cB + (size_t)(t + 2) * kstep;
            const char* a3 = a2 + kstep; const char* b3 = b2 + kstep;
            if (last && has_next) S.a_ready(nxt);
            if constexpr (SP2) {
            PG8_LDB(B0, 0, 0); PG8_LDB(B1, 0, 1); PG8_SCHED; PG8_LDA(At, 0, 0); PG8_STAGEA(PG8_SA(1, 1), a1 + hstep, voffA);
            PG8_WAIT_V(8); PG8_WAIT_L(0); PG8_BAR; PG8_MMA(0, 0, At, B0); PG8_MMA(0, 1, At, B1); PG8_BAR; PG8_SCHED;
            PG8_LDA(At, 0, 1); PG8_STAGE(PG8_SB(0, 0), b2, voffB); PG8_STAGE(PG8_SB(0, 1), b2 + hstep, voffB); PG8_STAGEA(PG8_SA(0, 0), a2, voffA);
            PG8_WAIT_V(8); PG8_WAIT_L(0); PG8_BAR; PG8_MMA(1, 0, At, B0); PG8_MMA(1, 1, At, B1); PG8_BAR; PG8_SCHED;
            PG8_LDB(B0, 1, 0); PG8_LDB(B1, 1, 1); PG8_SCHED; PG8_LDA(At, 1, 0); PG8_STAGEA(PG8_SA(0, 1), a2 + hstep, voffA);
            PG8_WAIT_V(8); PG8_WAIT_L(0); PG8_BAR; PG8_MMA(0, 0, At, B0); PG8_MMA(0, 1, At, B1); PG8_BAR; PG8_SCHED;
            PG8_LDA(At, 1, 1); PG8_STAGE(PG8_SB(1, 0), b3, voffB); PG8_STAGE(PG8_SB(1, 1), b3 + hstep, voffB); PG8_STAGEA(PG8_SA(1, 0), a3, voffA);
            PG8_WAIT_V(8); PG8_WAIT_L(0); PG8_BAR; PG8_MMA(1, 0, At, B0); PG8_MMA(1, 1, At, B1); PG8_BAR; PG8_SCHED;
            } else {
            PG8_LDB(B0, 0, 0); PG8_SCHED; PG8_LDA(At, 0, 0); PG8_STAGEA(PG8_SA(1, 1), a1 + hstep, voffA);
            PG8_WAIT_L(8); PG8_BAR; PG8_WAIT_L(0); PG8_MMA(0, 0, At, B0); PG8_BAR; PG8_SCHED;
            PG8_LDB(B1, 0, 1); PG8_STAGE(PG8_SB(0, 0), b2, voffB);
            PG8_BAR; PG8_WAIT_L(0); PG8_MMA(0, 1, At, B1); PG8_BAR;
            PG8_LDA(At, 0, 1); PG8_STAGEA(PG8_SA(0, 0), a2, voffA);
            PG8_BAR; PG8_WAIT_L(0); PG8_MMA(1, 0, At, B0); PG8_BAR; PG8_SCHED;
            PG8_STAGE(PG8_SB(0, 1), b2 + hstep, voffB);
            PG8_WAIT_V(6); PG8_BAR; PG8_MMA(1, 1, At, B1); PG8_BAR;
            PG8_LDB(B0, 1, 0); PG8_SCHED; PG8_LDA(At, 1, 0); PG8_STAGEA(PG8_SA(0, 1), a2 + hstep, voffA);
            PG8_WAIT_L(8); PG8_BAR; PG8_WAIT_L(0); PG8_MMA(0, 0, At, B0); PG8_BAR; PG8_SCHED;
            PG8_LDB(B1, 1, 1); PG8_STAGE(PG8_SB(1, 0), b3, voffB);
            PG8_BAR; PG8_WAIT_L(0); PG8_MMA(0, 1, At, B1); PG8_BAR;
            PG8_LDA(At, 1, 1); PG8_STAGEA(PG8_SA(1, 0), a3, voffA);
            PG8_BAR; PG8_WAIT_L(0); PG8_MMA(1, 0, At, B0); PG8_BAR; PG8_SCHED;
            PG8_STAGE(PG8_SB(1, 1), b3 + hstep, voffB);
            PG8_WAIT_V(6); PG8_BAR; PG8_MMA(1, 1, At, B1); PG8_BAR;
            }
        }
        if constexpr (ALIGN_EPI) { if (wr == 0) PG8_BAR; }
        if constexpr (!Epi::AFTER_DRAIN) { E(acc, cur, wr, wc, fr, fq); S.done(cur); }
        if (!has_next) break;
#pragma unroll
        for (int a = 0; a < 2; ++a)
#pragma unroll
            for (int b = 0; b < 2; ++b)
#pragma unroll
                for (int m = 0; m < 4; ++m)
#pragma unroll
                    for (int n = 0; n < 2; ++n) acc[a][b][m][n] = (f32x4){0.f, 0.f, 0.f, 0.f};
        cur = nxt; cA = nA; cB = nB; ++ui;
        if constexpr (ALIGN_EPI) { if (wr == 1) PG8_BAR; }
    }
    PG8_WAIT_V(0);
    if constexpr (!ALIGN_EPI) { if (wr == 0) PG8_BAR; }
    PG8_BAR;
    if constexpr (Epi::AFTER_DRAIN) { E.fused(acc, cur, wr, wc, fr, fq, lds, wid, lane); S.done(cur); }
#undef PG8_SA
#undef PG8_SB
#undef PG8_STAGE
#undef PG8_STAGEA
#undef PG8_LDA
#undef PG8_LDB
#undef PG8_MMA
#undef PG8_WAIT_V
#undef PG8_WAIT_L
#undef PG8_BAR
#undef PG8_SCHED
}
}
#define XB_TMO      128
#define XB_XCNT(j)  (256  + 64 * (j))
#define XB_XSUB(j)  (1280 + 64 * (j))
#define XB_XGEN(j)  (2304 + 64 * (j))
#define XB_TOP      3328
#define XB_TOPGEN   3392
#define XCD_BAR_WORDS 3456
#define XB_SPIN_CAP (1u << 18)

__device__ __forceinline__ unsigned xb_ld(unsigned* p)              { return __hip_atomic_load(p, __ATOMIC_RELAXED, __HIP_MEMORY_SCOPE_AGENT); }
__device__ __forceinline__ unsigned xb_add(unsigned* p, unsigned v) { return __hip_atomic_fetch_add(p, v, __ATOMIC_RELAXED, __HIP_MEMORY_SCOPE_AGENT); }
__device__ __forceinline__ unsigned xb_xcc_id() { return (unsigned)__builtin_amdgcn_s_getreg((3 << 11) | 20) & 0xFu; }
#define XB_SPIN(cond, bar) do { unsigned _sp = 0; while (cond) { __builtin_amdgcn_s_sleep(1); \
    if ((++_sp & 255u) == 0u) { if (xb_ld(&(bar)[XB_TMO])) break; if (_sp > XB_SPIN_CAP) { atomicAdd(&(bar)[XB_TMO], 1u); break; } } } } while (0)

struct XcdBarrier {
    unsigned* bar; unsigned x;
    volatile LAS unsigned* st;
};

__device__ __forceinline__ XcdBarrier xcd_barrier_post(unsigned* bar, volatile LAS unsigned* st) {
    XcdBarrier b; b.bar = bar; b.x = xb_xcc_id(); b.st = st;
    if (threadIdx.x == 0) (void)xb_add(&bar[XB_XCNT(b.x)], 1u);
    return b;
}
__device__ __forceinline__ void xcd_barrier_complete(unsigned* bar, unsigned x, unsigned& nloc, unsigned& nx) {
    const unsigned G = gridDim.x * gridDim.y * gridDim.z;
    unsigned sum, cnt, mine, sp = 0u;
    for (;;) {
        sum = 0u; cnt = 0u; mine = 0u;
#pragma unroll
        for (unsigned j = 0; j < 16; ++j) { const unsigned c = xb_ld(&bar[XB_XCNT(j)]); sum += c; cnt += (c > 0u) ? 1u : 0u; mine = (j == x) ? c : mine; }
        if (sum == G) break;
        __builtin_amdgcn_s_sleep(1);
        if ((++sp & 255u) == 0u) { if (xb_ld(&bar[XB_TMO])) break; if (sp > XB_SPIN_CAP) { atomicAdd(&bar[XB_TMO], 1u); break; } }
    }
    nloc = mine > 0u ? mine : 1u; nx = cnt > 0u ? cnt : 1u;
}

__device__ __forceinline__ void xcd_barrier(const XcdBarrier& b) {
    asm volatile("s_waitcnt vmcnt(0)" ::: "memory");
    __syncthreads();
    if (threadIdx.x == 0) {
        unsigned* bar = b.bar;
        __builtin_amdgcn_s_waitcnt(0);
        unsigned nloc = b.st[0], nx = b.st[1];
        if (nloc == 0u) { xcd_barrier_complete(bar, b.x, nloc, nx); b.st[0] = nloc; b.st[1] = nx; }
        const unsigned old = xb_add(&bar[XB_XSUB(b.x)], 1u);
        const unsigned gen = old / nloc;
        if (old + 1u == (gen + 1u) * nloc) {
            __builtin_amdgcn_fence(__ATOMIC_RELEASE, "agent");
            asm volatile("s_waitcnt vmcnt(0)" ::: "memory");
            const unsigned og = xb_add(&bar[XB_TOP], 1u);
            const unsigned tg = og / nx;
            if (og + 1u == (tg + 1u) * nx) xb_add(&bar[XB_TOPGEN], 1u);
            else XB_SPIN(xb_ld(&bar[XB_TOPGEN]) == tg, bar);
            __builtin_amdgcn_fence(__ATOMIC_ACQUIRE, "agent");
            xb_add(&bar[XB_XGEN(b.x)], 1u);
            asm volatile("s_waitcnt vmcnt(0)" ::: "memory");
        } else {
            XB_SPIN(xb_ld(&bar[XB_XGEN(b.x)]) == gen, bar);
            __builtin_amdgcn_fence(__ATOMIC_ACQUIRE, "agent");
            asm volatile("s_waitcnt vmcnt(0)" ::: "memory");
        }
    }
    __syncthreads();
}

constexpr int NB = 8, SEQ = 8192, DM = 1024, DEPTH = 2;
constexpr int T = NB * SEQ;
constexpr int INW = 1280, DFF = 2816, NMODW = 6 * DM;
constexpr int KCH = 32;
constexpr float EPS = 1e-6f;
constexpr float LOG2E = 1.4426950408889634f;

#define LAS __attribute__((address_space(3)))
typedef unsigned short bf16;
typedef unsigned v4u __attribute__((ext_vector_type(4)));
typedef unsigned v2u __attribute__((ext_vector_type(2)));
typedef float f32x4 __attribute__((ext_vector_type(4)));
typedef short bf16x8 __attribute__((ext_vector_type(8)));

constexpr size_t MiB = 1u << 20;
constexpr size_t WS_MODP = 640 * MiB;
constexpr size_t WS_MODF = 8 * MiB;
constexpr size_t WS_CS = 9 * MiB;
constexpr size_t WS_W = 16 * MiB, W_LAYER = 24 * MiB;
constexpr size_t W_IN = 0, W_OUT = 3 * MiB, W_GU = 5 * MiB, W_DN = 16 * MiB, W_PW = 22 * MiB;
constexpr size_t WS_H = 64 * MiB;
constexpr size_t WS_MIX = 192 * MiB;
constexpr size_t WS_PROJ = 320 * MiB;
constexpr size_t WS_CONCAT = 480 * MiB;
constexpr size_t WS_ACT = 320 * MiB;
constexpr size_t WS_XA = 672 * MiB;
constexpr size_t WS_XB = 800 * MiB;
constexpr size_t WS_END = 928 * MiB;

constexpr int RING_BYTES = 131072;
constexpr int LDS_BYTES = 147456;

struct Args {
    const float* x; const float* c; const int* pos; const float* ada_w; const float* ada_b; const float* w_in; const float* b_in;
    const float* sinks; const float* pool_w; const float* pool_scale; const float* w_out; const float* w_gate; const float* w_up;
    const float* w_down; const float* g_pre_mix; const float* g_post_mix; const float* g_pre_ffn; const float* g_post_ffn;
    float* out; unsigned char* ws;
};

__device__ __constant__ double c_inv_freq[8] = {1.0, 0.19392274474868576, 0.03760603093086393, 0.007292664737217109,
                                                0.001414213562373095, 0.0002742481756762073, 5.318295896944988e-05, 1.031338537721246e-05};

__device__ __forceinline__ unsigned pk2(float lo, float hi) { return pg8::cvt_pk_bf16(lo, hi); }
__device__ __forceinline__ float bf_lo(unsigned w) { return __uint_as_float(w << 16); }
__device__ __forceinline__ float bf_hi(unsigned w) { return __uint_as_float(w & 0xffff0000u); }
__device__ __forceinline__ float wave_sum(float v) {
#pragma unroll
    for (int o = 1; o < 64; o <<= 1) v += __shfl_xor(v, o);
    return v;
}

namespace pg8 {
struct EpiInProj {
    static constexpr bool PERM = true, AFTER_DRAIN = false;
    bf16_t* O; const float* bias; const float* cs;
    __device__ __forceinline__ void operator()(const f32x4 (&acc)[2][2][4][2], const Unit& u, int wr, int wc, int fr, int fq) const {
        const int row0 = u.pm * BM + wr * 64 + fr; const int colt = u.pn * BM; const int col0 = colt + wc * 32 + 8 * fq;
        f32x4 bv[2][2];
#pragma unroll
        for (int bj = 0; bj < 2; ++bj)
#pragma unroll
            for (int n = 0; n < 2; ++n) bv[bj][n] = *(const f32x4*)(bias + col0 + bj * HALF + 4 * n);
        const bool rot_wave = (colt < 640) && ((wc & 1) == 0);
#pragma unroll
        for (int ai = 0; ai < 2; ++ai)
#pragma unroll
        for (int mh = 0; mh < 2; ++mh) {
            f32x4 cc[2][4];
#pragma unroll
            for (int mm = 0; mm < 2; ++mm)
#pragma unroll
                for (int q = 0; q < 4; ++q) cc[mm][q] = (f32x4){1.f, 1.f, 1.f, 1.f};
            if (rot_wave && fq < 2) {
#pragma unroll
                for (int mm = 0; mm < 2; ++mm) { const float* cr = cs + (size_t)(row0 + ai * HALF + (2 * mh + mm) * 16) * 16;
#pragma unroll
                    for (int q = 0; q < 4; ++q) cc[mm][q] = *(const f32x4*)(cr + 4 * q); }
            }
#pragma unroll
            for (int mm = 0; mm < 2; ++mm) {
                const int m = 2 * mh + mm;
                const int row = row0 + ai * HALF + m * 16;
                bf16_t* rowp = O + (size_t)row * INW + col0;
#pragma unroll
                for (int bj = 0; bj < 2; ++bj) {
                    f32x4 v0 = acc[ai][bj][m][0] + bv[bj][0], v1 = acc[ai][bj][m][1] + bv[bj][1];
                    const int cb = colt + bj * HALF;
                    if (rot_wave && cb < 640) {
                        f32x4 p0, p1;
#pragma unroll
                        for (int e = 0; e < 4; ++e) { p0[e] = __shfl_xor(v0[e], 16); p1[e] = __shfl_xor(v1[e], 16); }
                        if (fq == 0) { v0 = v0 * cc[mm][0] - p0 * cc[mm][2]; v1 = v1 * cc[mm][1] - p1 * cc[mm][3]; }
                        else if (fq == 1) { v0 = v0 * cc[mm][0] + p0 * cc[mm][2]; v1 = v1 * cc[mm][1] + p1 * cc[mm][3]; }
                    }
                    if (cb < 512) { v0 = v0 * 0.125f; v1 = v1 * 0.125f; }
                    u32x4 w; w.x = cvt_pk_bf16(v0[0], v0[1]); w.y = cvt_pk_bf16(v0[2], v0[3]); w.z = cvt_pk_bf16(v1[0], v1[1]); w.w = cvt_pk_bf16(v1[2], v1[3]);
                    *(u32x4*)(rowp + bj * HALF) = w;
                }
            }
        }
    }
};
struct EpiSwiGLU {
    static constexpr bool PERM = true, AFTER_DRAIN = false;
    bf16_t* O;
    __device__ __forceinline__ void operator()(const f32x4 (&acc)[2][2][4][2], const Unit& u, int wr, int wc, int fr, int fq) const {
        typedef float f32x2 __attribute__((ext_vector_type(2)));
        const int row0 = u.pm * BM + wr * 64 + fr; const int col0 = u.pn * HALF + wc * 32 + 8 * fq;
#pragma unroll
        for (int ai = 0; ai < 2; ++ai)
#pragma unroll
            for (int m = 0; m < 4; ++m) {
                bf16_t* rowp = O + (size_t)(row0 + ai * HALF + m * 16) * DFF + col0;
                f32x2 G[4], U[4], t[4], r[4];
#pragma unroll
                for (int n = 0; n < 2; ++n) { G[2 * n] = (f32x2){acc[ai][0][m][n][0], acc[ai][0][m][n][1]}; G[2 * n + 1] = (f32x2){acc[ai][0][m][n][2], acc[ai][0][m][n][3]};
                                              U[2 * n] = (f32x2){acc[ai][1][m][n][0], acc[ai][1][m][n][1]}; U[2 * n + 1] = (f32x2){acc[ai][1][m][n][2], acc[ai][1][m][n][3]}; }
#pragma unroll
                for (int q = 0; q < 4; ++q) { t[q].x = __builtin_amdgcn_exp2f(G[q].x); t[q].y = __builtin_amdgcn_exp2f(G[q].y); }
#pragma unroll
                for (int q = 0; q < 4; ++q) { t[q] = t[q] + 1.0f; r[q] = G[q] * U[q]; }
#pragma unroll
                for (int q = 0; q < 4; ++q) { t[q].x = __builtin_amdgcn_rcpf(t[q].x); t[q].y = __builtin_amdgcn_rcpf(t[q].y); }
#pragma unroll
                for (int q = 0; q < 4; ++q) r[q] = r[q] * t[q];
                u32x4 w; w.x = cvt_pk_bf16(r[0].x, r[0].y); w.y = cvt_pk_bf16(r[1].x, r[1].y); w.z = cvt_pk_bf16(r[2].x, r[2].y); w.w = cvt_pk_bf16(r[3].x, r[3].y);
                *(u32x4*)rowp = w;
            }
    }
};
struct DualOrder {
    StaticOrder so; int c, rounds, hot;
    __device__ bool next(int i, Unit& u) const { if (hot) { if (i >= rounds) return false; u.pm = (c % 8) * 2 + ((c / 8) & 1); u.pn = ((c / 8) >> 1) & 3; return true; } return so.next(i, u); }
    __device__ __forceinline__ void a_ready(const Unit&) const {}
    __device__ __forceinline__ void done(const Unit&) const {}
};
}

__device__ __forceinline__ void transpose_item(const float* W, int K, int N, bf16* WT, int drow0, LAS float* scr, int k0, int n0, int lane, float wscale = 1.0f) {
#pragma unroll
    for (int ih = 0; ih < 32; ih += 16) {
        float tv[16];
#pragma unroll
        for (int i = 0; i < 16; ++i) tv[i] = __builtin_nontemporal_load(W + (size_t)(k0 + 2 * (ih + i) + (lane >> 5)) * N + n0 + (lane & 31));
#pragma unroll
        for (int i = 0; i < 16; ++i) scr[(2 * (ih + i) + (lane >> 5)) * 33 + (lane & 31)] = tv[i] * wscale;
    }
    asm volatile("s_waitcnt lgkmcnt(0)" ::: "memory");
    const int c = lane & 7;
#pragma unroll
    for (int j = 0; j < 4; ++j) { const int n = (lane >> 3) + 8 * j; const LAS float* s = scr + (8 * c) * 33 + n;
        v4u o; o.x = pk2(s[0 * 33], s[1 * 33]); o.y = pk2(s[2 * 33], s[3 * 33]); o.z = pk2(s[4 * 33], s[5 * 33]); o.w = pk2(s[6 * 33], s[7 * 33]);
        *(v4u*)(WT + (size_t)(drow0 + n) * K + k0 + 8 * c) = o; }
    asm volatile("s_waitcnt lgkmcnt(0)" ::: "memory");
}

__device__ __forceinline__ void prologue(const Args& a, LAS unsigned char* lds) {
    int tid_ = threadIdx.x; asm volatile("" : "+v"(tid_)); const int tid = tid_, lane = tid & 63, wave = tid >> 6;
    unsigned char* ws = a.ws;
    __syncthreads();
    {
        LAS float* sc = (LAS float*)lds;
        for (int i = tid; i < NB * DM; i += 512) { const float v = a.c[i]; sc[i] = v / (1.0f + __expf(-v)); }
        __syncthreads();
        float* modp = (float*)(ws + WS_MODP);
        for (int item = blockIdx.x; item < DEPTH * KCH * 12; item += gridDim.x) {
            const int l = item / (KCH * 12), r = item % (KCH * 12), kc = r / 12, cb = r % 12, n = cb * 512 + tid;
            constexpr int KPI = DM / KCH;
            const float* w = a.ada_w + ((size_t)l * DM + kc * KPI) * NMODW + n;
            float acc[8];
#pragma unroll
            for (int b = 0; b < 8; ++b) acc[b] = 0.f;
#pragma unroll 1
            for (int kh = 0; kh < KPI; kh += 16) {
                float wv[16];
#pragma unroll
                for (int k = 0; k < 16; ++k) wv[k] = __builtin_nontemporal_load(w + (size_t)(kh + k) * NMODW);
#pragma unroll
                for (int k = 0; k < 16; ++k) {
                    const LAS float* sp = sc + kc * KPI + kh + k;
#pragma unroll
                    for (int b = 0; b < 8; ++b) acc[b] += sp[b * DM] * wv[k];
                    if ((k & 3) == 3) asm volatile("" ::: "memory");
                }
            }
#pragma unroll
            for (int b = 0; b < 8; ++b) modp[((size_t)(l * KCH + kc) * 8 + b) * NMODW + n] = acc[b];
        }
        __syncthreads();
    }
    {
        float* cs = (float*)(ws + WS_CS);
        for (int idx = blockIdx.x * 512 + tid; idx < T * 8; idx += gridDim.x * 512) {
            const int row = idx >> 3, j = idx & 7;
            const double rev = (double)a.pos[row] * c_inv_freq[j] * 0.15915494309189535;
            const float fr = (float)(rev - floor(rev));
            cs[(size_t)row * 16 + j] = __builtin_amdgcn_cosf(fr);
            cs[(size_t)row * 16 + 8 + j] = __builtin_amdgcn_sinf(fr);
        }
    }
    {
        LAS float* scr = (LAS float*)(lds + wave * 16384);
        const int gw = blockIdx.x * 8 + wave, ngw = gridDim.x * 8;
        constexpr int I_IN = 16 * 40, I_OUT = 16 * 32, I_G = 16 * 88, I_D = 44 * 32, I_P = 4 * 8;
        constexpr int PER_L = I_IN + I_OUT + 2 * I_G + I_D + I_P;
        for (int it = gw; it < DEPTH * PER_L; it += ngw) {
            const int l = it / PER_L; int r = it % PER_L;
            unsigned char* wl = ws + WS_W + (size_t)l * W_LAYER;
            if (r < I_IN) { const int kb = r / 40, nb = r % 40; transpose_item(a.w_in + (size_t)l * DM * INW, DM, INW, (bf16*)(wl + W_IN), 32 * nb, scr, 64 * kb, 32 * nb, lane); continue; } r -= I_IN;
            if (r < I_OUT) { const int kb = r / 32, nb = r % 32; transpose_item(a.w_out + (size_t)l * DM * DM, DM, DM, (bf16*)(wl + W_OUT), 32 * nb, scr, 64 * kb, 32 * nb, lane); continue; } r -= I_OUT;
            if (r < 2 * I_G) { const int up = r >= I_G; if (up) r -= I_G; const int kb = r / 88, nb = r % 88, n0 = 32 * nb;
                transpose_item((up ? a.w_up : a.w_gate) + (size_t)l * DM * DFF, DM, DFF, (bf16*)(wl + W_GU), 256 * (n0 >> 7) + (n0 & 127) + (up ? 128 : 0), scr, 64 * kb, n0, lane, up ? -0.6931471805599453f : -1.4426950408889634f); continue; } r -= 2 * I_G;
            if (r < I_D) { const int kb = r / 32, nb = r % 32; transpose_item(a.w_down + (size_t)l * DFF * DM, DFF, DM, (bf16*)(wl + W_DN), 32 * nb, scr, 64 * kb, 32 * nb, lane); continue; } r -= I_D;
            { const int gi = r / 8, q = r % 8, kb = q / 4, nb = q % 4;
              transpose_item(a.pool_w + ((size_t)l * 4 + gi) * 128 * 128, 128, 128, (bf16*)(wl + W_PW) + (size_t)gi * 128 * 128, 32 * nb, scr, 64 * kb, 32 * nb, lane); }
        }
    }
}

__device__ __forceinline__ float mod_val(const Args& a, int l, int b, int idx, int col) {
    const float* modp = (const float*)(a.ws + WS_MODP);
    const int n = idx * DM + col;
    float s = a.ada_b[l * NMODW + n];
#pragma unroll
    for (int kc = 0; kc < KCH; ++kc) s += modp[((size_t)(l * KCH + kc) * 8 + b) * NMODW + n];
    return s;
}
__device__ __forceinline__ float mod_fin(const Args& a, int l, int b, int idx, int col) {
    return ((const float*)(a.ws + WS_MODF))[((size_t)(l * 8 + b)) * NMODW + idx * DM + col];
}
__device__ __forceinline__ void mod_finalize(const Args& a) {
    float* modf = (float*)(a.ws + WS_MODF);
    for (int i = blockIdx.x * 512 + threadIdx.x; i < DEPTH * 8 * NMODW; i += gridDim.x * 512) {
        const int l = i / (8 * NMODW), r = i % (8 * NMODW), b = r / NMODW, n = r % NMODW;
        modf[i] = mod_val(a, l, b, n / DM, n % DM);
    }
}
__device__ __forceinline__ void unpack8(const v4u w, float (&f)[8]) {
#pragma unroll
    for (int e = 0; e < 4; ++e) { f[2 * e] = bf_lo(w[e]); f[2 * e + 1] = bf_hi(w[e]); }
}
__device__ __forceinline__ v4u pack8(const float (&f)[8]) { return (v4u){pk2(f[0], f[1]), pk2(f[2], f[3]), pk2(f[4], f[5]), pk2(f[6], f[7])}; }
__device__ __forceinline__ void rowwise_phase(const Args& a, LAS unsigned char* lds, bool from_partials, bool has_y, bool has_h, bool xin_bf, int xout_mode,
        const void* xin, const bf16* y, float* xout, bf16* xoutb, bf16* hout,
        int l_y, int gate_idx, const float* g_post, int l_h, int shift_idx, int scale_idx, const float* g_pre) {
    int tid_ = threadIdx.x; asm volatile("" : "+v"(tid_)); const int tid = tid_, lane = tid & 63, wave = tid >> 6;
    LAS float* vec = (LAS float*)lds;
    for (int tile = blockIdx.x; tile < T / 256; tile += gridDim.x) {
        const int b = tile / (SEQ / 256);
        __syncthreads();
        for (int col = tid; col < DM; col += 512) {
            if (from_partials) {
                if (has_y) vec[col] = mod_val(a, l_y, b, gate_idx, col) * g_post[col];
                if (has_h) { vec[DM + col] = g_pre[col] * (1.0f + mod_val(a, l_h, b, scale_idx, col)); vec[2 * DM + col] = mod_val(a, l_h, b, shift_idx, col); }
            } else {
                if (has_y) vec[col] = mod_fin(a, l_y, b, gate_idx, col) * g_post[col];
                if (has_h) { vec[DM + col] = g_pre[col] * (1.0f + mod_fin(a, l_h, b, scale_idx, col)); vec[2 * DM + col] = mod_fin(a, l_h, b, shift_idx, col); }
            }
        }
        __syncthreads();
#pragma unroll 1
        for (int r = wave * 4; r < 256; r += 32) {
            float v[4][2][8]; v4u yv[4][2];
#pragma unroll
            for (int h = 0; h < 4; ++h)
#pragma unroll
                for (int j = 0; j < 2; ++j) { const size_t off = ((size_t)tile * 256 + r + h) * DM + 8 * lane + 512 * j;
                    if (xin_bf) unpack8(__builtin_nontemporal_load((const v4u*)((const bf16*)xin + off)), v[h][j]);
                    else { const f32x4 p0 = __builtin_nontemporal_load((const f32x4*)((const float*)xin + off)), p1 = __builtin_nontemporal_load((const f32x4*)((const float*)xin + off + 4));
                        v[h][j][0] = p0.x; v[h][j][1] = p0.y; v[h][j][2] = p0.z; v[h][j][3] = p0.w; v[h][j][4] = p1.x; v[h][j][5] = p1.y; v[h][j][6] = p1.z; v[h][j][7] = p1.w; }
                    yv[h][j] = has_y ? __builtin_nontemporal_load((const v4u*)(y + off)) : (v4u){0u, 0u, 0u, 0u}; }
            if (has_y) {
                float rstd[4];
#pragma unroll
                for (int h = 0; h < 4; ++h) { float ss = 0.f;
#pragma unroll
                    for (int j = 0; j < 2; ++j) { float yf[8]; unpack8(yv[h][j], yf);
#pragma unroll
                        for (int e = 0; e < 8; ++e) ss += yf[e] * yf[e]; }
                    rstd[h] = __builtin_amdgcn_rsqf(wave_sum(ss) * (1.0f / DM) + EPS); }
#pragma unroll
                for (int j = 0; j < 2; ++j) { const LAS float* gpp = vec + 8 * lane + 512 * j; const f32x4 g0 = *(const LAS f32x4*)gpp, g1 = *(const LAS f32x4*)(gpp + 4);
                    const float gp[8] = {g0.x, g0.y, g0.z, g0.w, g1.x, g1.y, g1.z, g1.w};
#pragma unroll
                    for (int h = 0; h < 4; ++h) { float yf[8]; unpack8(yv[h][j], yf);
#pragma unroll
                        for (int e = 0; e < 8; ++e) v[h][j][e] += gp[e] * (yf[e] * rstd[h]); } }
            }
            if (xout_mode == 1) {
#pragma unroll
                for (int h = 0; h < 4; ++h)
#pragma unroll
                    for (int j = 0; j < 2; ++j) { float* o = xout + ((size_t)tile * 256 + r + h) * DM + 8 * lane + 512 * j;
                        __builtin_nontemporal_store((f32x4){v[h][j][0], v[h][j][1], v[h][j][2], v[h][j][3]}, (f32x4*)o); __builtin_nontemporal_store((f32x4){v[h][j][4], v[h][j][5], v[h][j][6], v[h][j][7]}, (f32x4*)(o + 4)); }
            } else if (xout_mode == 2) {
#pragma unroll
                for (int h = 0; h < 4; ++h)
#pragma unroll
                    for (int j = 0; j < 2; ++j) { const v4u w = pack8(v[h][j]);
                        __builtin_nontemporal_store(w, (v4u*)(xoutb + ((size_t)tile * 256 + r + h) * DM + 8 * lane + 512 * j));
                        unpack8(w, v[h][j]); }
            }
            if (has_h) {
                float rstd[4];
#pragma unroll
                for (int h = 0; h < 4; ++h) { float ss = 0.f;
#pragma unroll
                    for (int j = 0; j < 2; ++j)
#pragma unroll
                        for (int e = 0; e < 8; ++e) ss += v[h][j][e] * v[h][j][e];
                    rstd[h] = __builtin_amdgcn_rsqf(wave_sum(ss) * (1.0f / DM) + EPS); }
#pragma unroll
                for (int j = 0; j < 2; ++j) { const LAS float* gsp = vec + DM + 8 * lane + 512 * j; const LAS float* shp = vec + 2 * DM + 8 * lane + 512 * j;
                    const f32x4 a0 = *(const LAS f32x4*)gsp, a1 = *(const LAS f32x4*)(gsp + 4), b0 = *(const LAS f32x4*)shp, b1 = *(const LAS f32x4*)(shp + 4);
                    const float gs[8] = {a0.x, a0.y, a0.z, a0.w, a1.x, a1.y, a1.z, a1.w}, sh[8] = {b0.x, b0.y, b0.z, b0.w, b1.x, b1.y, b1.z, b1.w};
#pragma unroll
                    for (int h = 0; h < 4; ++h) { float hv[8];
#pragma unroll
                        for (int e = 0; e < 8; ++e) hv[e] = v[h][j][e] * rstd[h] * gs[e] + sh[e];
                        *(v4u*)(hout + ((size_t)tile * 256 + r + h) * DM + 8 * lane + 512 * j) = pack8(hv); } }
            }
        }
    }
}

typedef short v4i16a_t __attribute__((ext_vector_type(4)));
__device__ __forceinline__ v2u lds_tr_a(const LAS bf16* p) { return __builtin_bit_cast(v2u, __builtin_amdgcn_ds_read_tr16_b64_v4i16((LAS v4i16a_t*)p)); }
__device__ __forceinline__ void attn_phase(LAS unsigned char* lds, const bf16* PROJ, bf16* CONCAT, const float* sinks) {
    int tid_ = threadIdx.x; asm volatile("" : "+v"(tid_)); const int tid = tid_, lane = tid & 63, wave = tid >> 6, fr = lane & 15, fq = lane >> 4;
    LAS bf16* Ks = (LAS bf16*)lds;
    LAS bf16* Vs = (LAS bf16*)(lds + 36864);
    v4u kv[4], vv[4];
#define ATT_LOAD_KV(uu) do { const int kh_ = (uu) & 1, n_ = ((uu) >> 1) & 63, b_ = (uu) >> 7; const long rb_ = (long)b_ * SEQ + n_ * 128 - 128; \
        _Pragma("unroll") for (int i = 0; i < 4; ++i) { const int kj = lane + 64 * i; kv[i] = (v4u){0u, 0u, 0u, 0u}; vv[i] = (v4u){0u, 0u, 0u, 0u}; \
            if (n_ > 0 || kj >= 128) { const bf16* p = PROJ + (size_t)(rb_ + kj) * INW + kh_ * 64 + wave * 8; kv[i] = *(const v4u*)(p + 512); vv[i] = *(const v4u*)(p + 640); } } } while (0)
    bf16x8 qf[4][2];
#define ATT_LOAD_Q(uu) do { const int kh_ = (uu) & 1, n_ = ((uu) >> 1) & 63, b_ = (uu) >> 7; const size_t qr_ = (size_t)b_ * SEQ + n_ * 128 + (wave & 1) * 64 + fr; \
        _Pragma("unroll") for (int i = 0; i < 4; ++i) { const bf16* qp = PROJ + (qr_ + 16 * i) * INW + (kh_ * 4 + (wave >> 1)) * 64 + 8 * fq; \
            qf[i][0] = __builtin_nontemporal_load((const bf16x8*)qp); qf[i][1] = __builtin_nontemporal_load((const bf16x8*)(qp + 32)); } } while (0)
    if ((int)blockIdx.x < NB * 64 * 2) { ATT_LOAD_KV((int)blockIdx.x); ATT_LOAD_Q((int)blockIdx.x); }
    for (int u = blockIdx.x; u < NB * 64 * 2; u += gridDim.x) {
        const int kh = u & 1, n = (u >> 1) & 63, b = u >> 7;
        const int g = wave >> 1, h = kh * 4 + g;
        const size_t qrow0 = (size_t)b * SEQ + n * 128 + (wave & 1) * 64 + fr;
#pragma unroll
        for (int i = 0; i < 4; ++i) { const int kj = lane + 64 * i;
            *(LAS v4u*)(Ks + kj * 72 + wave * 8) = kv[i];
            *(LAS v4u*)(Vs + kj * 72 + wave * 8) = vv[i]; }
        __syncthreads();
        if (u + (int)gridDim.x < NB * 64 * 2) ATT_LOAD_KV(u + (int)gridDim.x);
        const float sink = sinks[h];
        const int firstblk = (n == 0);
#pragma unroll
        for (int p = 0; p < 2; ++p) {
            const int q16a = (wave & 1) * 4 + 2 * p, kt0 = q16a;
            f32x4 st[2][10];
            bf16x8 kfr[10][2];
            const LAS bf16* kp0 = Ks + (16 * kt0 + fr) * 72 + 8 * fq;
#define ATT_LDK(t) do { kfr[t][0] = *(const LAS bf16x8*)(kp0 + (t) * 16 * 72); kfr[t][1] = *(const LAS bf16x8*)(kp0 + (t) * 16 * 72 + 32); } while (0)
            ATT_LDK(0);
#pragma unroll
            for (int t = 0; t < 10; ++t) {
                if (t + 1 < 10) ATT_LDK(t + 1);
#pragma unroll
                for (int x = 0; x < 2; ++x) {
                    if (x + 8 - t == 9 || x + 8 - t == -1) { st[x][t] = (f32x4){-1e30f, -1e30f, -1e30f, -1e30f}; continue; }
                    f32x4 acc = (f32x4){0.f, 0.f, 0.f, 0.f};
                    acc = __builtin_amdgcn_mfma_f32_16x16x32_bf16(kfr[t][0], qf[2 * p + x][0], acc, 0, 0, 0);
                    acc = __builtin_amdgcn_mfma_f32_16x16x32_bf16(kfr[t][1], qf[2 * p + x][1], acc, 0, 0, 0);
                    st[x][t] = acc;
                }
            }
#undef ATT_LDK
            float inv[2];
#pragma unroll
            for (int x = 0; x < 2; ++x) {
                float mx = -1e30f;
#pragma unroll
                for (int t = 0; t < 10; ++t) {
                    const int D = x + 8 - t;
                    if (D == 9 || D == -1) continue;
                    const bool tile_off = firstblk && (kt0 + t < 8);
#pragma unroll
                    for (int r = 0; r < 4; ++r) { const int dl = fr - 4 * fq - r;
                        bool valid = !tile_off;
                        if (D == 8) valid = valid && (dl < 0);
                        if (D == 0) valid = valid && (dl >= 0);
                        const float sv = valid ? st[x][t][r] : -1e30f; st[x][t][r] = sv; mx = fmaxf(mx, sv); }
                }
                mx = fmaxf(mx, __shfl_xor(mx, 16)); mx = fmaxf(mx, __shfl_xor(mx, 32)); mx = fmaxf(mx, sink);
                const float mb = mx * LOG2E;
                float lsum = 0.f;
#pragma unroll
                for (int t = 0; t < 10; ++t) {
                    const int D = x + 8 - t;
                    if (D == 9 || D == -1) { st[x][t] = (f32x4){0.f, 0.f, 0.f, 0.f}; continue; }
#pragma unroll
                    for (int r = 0; r < 4; ++r) { const float pe = __builtin_amdgcn_exp2f(st[x][t][r] * LOG2E - mb); st[x][t][r] = pe; lsum += pe; }
                }
                lsum += __shfl_xor(lsum, 16); lsum += __shfl_xor(lsum, 32); lsum += __builtin_amdgcn_exp2f(sink * LOG2E - mb);
                inv[x] = 1.0f / lsum;
            }
            f32x4 ot[2][4];
#pragma unroll
            for (int x = 0; x < 2; ++x)
#pragma unroll
                for (int dt = 0; dt < 4; ++dt) ot[x][dt] = (f32x4){0.f, 0.f, 0.f, 0.f};
            const LAS bf16* vp0 = Vs + (16 * kt0 + 4 * fq + (fr >> 2)) * 72 + 4 * (fr & 3);
            v2u vlo[5][4], vhi[5][4];
#define ATT_LDV(s) do { _Pragma("unroll") for (int dt = 0; dt < 4; ++dt) { vlo[s][dt] = lds_tr_a(vp0 + (s) * 32 * 72 + 16 * dt); vhi[s][dt] = lds_tr_a(vp0 + (s) * 32 * 72 + 16 * 72 + 16 * dt); } } while (0)
#pragma unroll
            for (int s2 = 0; s2 < 5; ++s2) {
                ATT_LDV(s2);
                bf16x8 pf[2];
#pragma unroll
                for (int x = 0; x < 2; ++x) { v4u pw; pw.x = pk2(st[x][2 * s2][0], st[x][2 * s2][1]); pw.y = pk2(st[x][2 * s2][2], st[x][2 * s2][3]);
                    pw.z = pk2(st[x][2 * s2 + 1][0], st[x][2 * s2 + 1][1]); pw.w = pk2(st[x][2 * s2 + 1][2], st[x][2 * s2 + 1][3]); pf[x] = __builtin_bit_cast(bf16x8, pw); }
#pragma unroll
                for (int dt = 0; dt < 4; ++dt) {
                    const bf16x8 vf = __builtin_bit_cast(bf16x8, (v4u){vlo[s2][dt].x, vlo[s2][dt].y, vhi[s2][dt].x, vhi[s2][dt].y});
#pragma unroll
                    for (int x = 0; x < 2; ++x) ot[x][dt] = __builtin_amdgcn_mfma_f32_16x16x32_bf16(vf, pf[x], ot[x][dt], 0, 0, 0);
                }
            }
#undef ATT_LDV
#pragma unroll
            for (int x = 0; x < 2; ++x) {
                LAS bf16* stg = (LAS bf16*)(lds + 73728) + (wave * 2 + x) * (16 * 72);
#pragma unroll
                for (int dt = 0; dt < 4; ++dt) *(LAS v2u*)(stg + fr * 72 + 16 * dt + 4 * fq) = (v2u){pk2(ot[x][dt][0] * inv[x], ot[x][dt][1] * inv[x]), pk2(ot[x][dt][2] * inv[x], ot[x][dt][3] * inv[x])};
                bf16* op = CONCAT + (qrow0 - fr + 16 * (2 * p + x)) * DM + h * 64;
#pragma unroll
                for (int i = 0; i < 2; ++i) { const int row = 8 * i + (lane >> 3), chn = lane & 7;
                    *(v4u*)(op + (size_t)row * DM + chn * 8) = *(const LAS v4u*)(stg + row * 72 + chn * 8); }
            }
        }
        if (u + (int)gridDim.x < NB * 64 * 2) ATT_LOAD_Q(u + (int)gridDim.x);
        __syncthreads();
    }
#undef ATT_LOAD_KV
#undef ATT_LOAD_Q
}

constexpr int PL_US = 136;
template <int W> __device__ __forceinline__ void pool_load(const bf16* PROJ, int gi, int tt, int lane, v4u (&raw)[8]) {
    const size_t t0 = (size_t)tt * 16; const int s0 = (int)(t0 & (SEQ - 1));
    const int ch = lane & 15, rs = lane >> 4;
#pragma unroll
    for (int i = 0; i < 8; ++i) { const int r = rs + 4 * i;
        raw[i] = (v4u){0u, 0u, 0u, 0u};
        if (4 * i + 3 >= 17 - W) { if (s0 - 16 + r >= 0) raw[i] = *(const v4u*)(PROJ + (t0 - 16 + r) * INW + 768 + gi * 128 + ch * 8); } }
}
typedef short v4i16_t __attribute__((ext_vector_type(4)));
__device__ __forceinline__ v2u lds_tr(const LAS bf16* p) { return __builtin_bit_cast(v2u, __builtin_amdgcn_ds_read_tr16_b64_v4i16((LAS v4i16_t*)p)); }
template <int W> __device__ __forceinline__ void pool_compute(bf16* CONCAT, const LAS bf16* wl, LAS bf16* ust, const float* pscale, int gi, int tt, int lane, const v4u (&raw)[8]) {
    const int fr = lane & 15, fq = lane >> 4;
    const size_t t0 = (size_t)tt * 16; const int s0 = (int)(t0 & (SEQ - 1));
    {
        const int ch = lane & 15, rs = lane >> 4;
#pragma unroll
        for (int i = 0; i < 8; ++i) { const int r = rs + 4 * i; if (4 * i + 3 >= 17 - W) *(LAS v4u*)(ust + r * PL_US + ch * 8) = raw[i]; }
    }
    const int s = s0 + fr;
    const int cnt = (s + 1 < W) ? (s + 1) : W;
    const float invc = 1.0f / (float)cnt;
    bf16x8 band;
    { float bv[8];
#pragma unroll
      for (int j = 0; j < 8; ++j) { const int rel = 8 * fq + j - 16 - fr;
          bv[j] = ((rel > -W && rel <= 0) ? 1.0f : 0.0f) - ((rel == 0) ? (float)cnt : 0.0f); }
      band = __builtin_bit_cast(bf16x8, (v4u){pk2(bv[0], bv[1]), pk2(bv[2], bv[3]), pk2(bv[4], bv[5]), pk2(bv[6], bv[7])}); }
    f32x4 pl[8];
    const LAS bf16* trp = ust + (8 * fq + ((lane & 15) >> 2)) * PL_US + 4 * (lane & 3);
#pragma unroll
    for (int a = 0; a < 8; ++a) {
        const v2u lo = lds_tr(trp + 16 * a), hi = lds_tr(trp + 4 * PL_US + 16 * a);
        const bf16x8 ua = __builtin_bit_cast(bf16x8, (v4u){lo.x, lo.y, hi.x, hi.y});
        pl[a] = __builtin_amdgcn_mfma_f32_16x16x32_bf16(ua, band, (f32x4){0.f, 0.f, 0.f, 0.f}, 0, 0, 0);
    }
    bf16x8 pf[4];
#pragma unroll
    for (int ks = 0; ks < 4; ++ks)
        pf[ks] = __builtin_bit_cast(bf16x8, (v4u){pk2(pl[2 * ks][0] * invc, pl[2 * ks][1] * invc), pk2(pl[2 * ks][2] * invc, pl[2 * ks][3] * invc),
                                                  pk2(pl[2 * ks + 1][0] * invc, pl[2 * ks + 1][1] * invc), pk2(pl[2 * ks + 1][2] * invc, pl[2 * ks + 1][3] * invc)});
#pragma unroll
    for (int nt = 0; nt < 8; ++nt) {
        f32x4 acc = (f32x4){0.f, 0.f, 0.f, 0.f};
        const LAS bf16* wp = wl + (16 * nt + fr) * PL_US + 4 * fq;
#pragma unroll
        for (int ks = 0; ks < 4; ++ks) { const v2u lo = *(const LAS v2u*)(wp + 32 * ks), hi = *(const LAS v2u*)(wp + 32 * ks + 16);
            acc = __builtin_amdgcn_mfma_f32_16x16x32_bf16(__builtin_bit_cast(bf16x8, (v4u){lo.x, lo.y, hi.x, hi.y}), pf[ks], acc, 0, 0, 0); }
        const int d = gi * 128 + 16 * nt + 4 * fq;
        const f32x4 sc = *(const f32x4*)(pscale + d);
        *(LAS v2u*)(ust + fr * PL_US + 16 * nt + 4 * fq) = (v2u){pk2(acc[0] * sc.x, acc[1] * sc.y), pk2(acc[2] * sc.z, acc[3] * sc.w)};
    }
#pragma unroll
    for (int i = 0; i < 4; ++i) { const int row = 4 * i + (lane >> 4), chn = lane & 15;
        const v4u w = *(const LAS v4u*)(ust + row * PL_US + chn * 8);
        *(v4u*)(CONCAT + (t0 + row) * DM + 512 + gi * 128 + chn * 8) = w; }
}
template <int W> __device__ __forceinline__ void pool_group(const bf16* PROJ, bf16* CONCAT, const LAS bf16* wl, LAS bf16* ust, const float* pscale, int gi, int gw, int ngw, int lane) {
    v4u ra[8], rb[8];
    {
        const int ch = lane & 15, rs = lane >> 4;
#pragma unroll
        for (int i = 0; i < 8; ++i) if (!(4 * i + 3 >= 17 - W)) *(LAS v4u*)(ust + (rs + 4 * i) * PL_US + ch * 8) = (v4u){0u, 0u, 0u, 0u};
    }
    int tt = gw;
    if (tt < T / 16) pool_load<W>(PROJ, gi, tt, lane, ra);
    while (tt < T / 16) {
        const int tn = tt + ngw;
        if (tn < T / 16) pool_load<W>(PROJ, gi, tn, lane, rb);
        pool_compute<W>(CONCAT, wl, ust, pscale, gi, tt, lane, ra);
        tt = tn;
        if (tt >= T / 16) break;
        const int tn2 = tt + ngw;
        if (tn2 < T / 16) pool_load<W>(PROJ, gi, tn2, lane, ra);
        pool_compute<W>(CONCAT, wl, ust, pscale, gi, tt, lane, rb);
        tt = tn2;
    }
}
__device__ __forceinline__ void pool_phase(LAS unsigned char* lds, const bf16* PROJ, bf16* CONCAT, const bf16* PWT, const float* pscale) {
    int tid_ = threadIdx.x; asm volatile("" : "+v"(tid_)); const int tid = tid_, lane = tid & 63, wave = tid >> 6;
    LAS bf16* wl = (LAS bf16*)lds;
    LAS bf16* ust = (LAS bf16*)(lds + 36864 + wave * 8704);
    const bool quad = (gridDim.x & 3) == 0;
    const int gw = quad ? (int)(blockIdx.x >> 2) * 8 + wave : (int)blockIdx.x * 8 + wave, ngw = quad ? (int)(gridDim.x >> 2) * 8 : (int)gridDim.x * 8;
#pragma unroll 1
    for (int g = 0; g < (quad ? 1 : 4); ++g) {
        const int gi = quad ? (int)(blockIdx.x & 3) : g;
        __syncthreads();
        { const int row = tid >> 2, q = tid & 3; const bf16* src = PWT + ((size_t)gi * 128 + row) * 128 + q * 32;
#pragma unroll
          for (int e = 0; e < 4; ++e) *(LAS v4u*)(wl + row * PL_US + q * 32 + e * 8) = *(const v4u*)(src + e * 8); }
        __syncthreads();
        if (gi == 0) pool_group<2>(PROJ, CONCAT, wl, ust, pscale, gi, gw, ngw, lane);
        else if (gi == 1) pool_group<4>(PROJ, CONCAT, wl, ust, pscale, gi, gw, ngw, lane);
        else if (gi == 2) pool_group<8>(PROJ, CONCAT, wl, ust, pscale, gi, gw, ngw, lane);
        else pool_group<16>(PROJ, CONCAT, wl, ust, pscale, gi, gw, ngw, lane);
    }
    __syncthreads();
}

#ifndef REP_P
#define REP_P 1
#endif
#ifndef REP_G
#define REP_G 1
#endif
#ifndef REP_R
#define REP_R 1
#endif
#ifndef REP_G
#define REP_G 1
#endif
#ifndef REP_IN
#define REP_IN REP_G
#endif
#ifndef REP_GU
#define REP_GU REP_G
#endif
#ifndef REP_DN
#define REP_DN REP_G
#endif
#ifndef REP_PL
#define REP_PL 1
#endif
#ifndef REP_A
#define REP_A 1
#endif
__global__ void __launch_bounds__(512, 2) fwd_kernel(Args a) {
    extern __shared__ __attribute__((aligned(16))) unsigned char lds_raw[];
    cg::grid_group grid = cg::this_grid();
    LAS unsigned char* lds = (LAS unsigned char*)lds_raw;
    unsigned char* ws = a.ws;
    bf16* H = (bf16*)(ws + WS_H); bf16* MIX = (bf16*)(ws + WS_MIX); bf16* PROJ = (bf16*)(ws + WS_PROJ);
    bf16* CONCAT = (bf16*)(ws + WS_CONCAT); bf16* ACT = (bf16*)(ws + WS_ACT);
    const float* cs = (const float*)(ws + WS_CS); bf16* XA = (bf16*)(ws + WS_XA); bf16* XB = (bf16*)(ws + WS_XB);
    volatile LAS unsigned* MISC = (volatile LAS unsigned*)(lds + RING_BYTES + 64);
    if (threadIdx.x == 0) { MISC[0] = 0u; MISC[1] = 0u; }
    __syncthreads();
    XcdBarrier bar = xcd_barrier_post((unsigned*)ws, MISC);
#define SEAM() xcd_barrier(bar)

    for (int rep = 0; rep < REP_P; ++rep) prologue(a, lds);
    if (a.ws == nullptr) grid.sync();
    SEAM();
    for (int rep = 0; rep < REP_R; ++rep) rowwise_phase(a, lds, true, false, true, false, 2, a.x, nullptr, nullptr, XB, H, 0, 0, nullptr, 0, 0, 1, a.g_pre_mix);
    mod_finalize(a);
    SEAM();
#pragma unroll 1
    for (int l = 0; l < DEPTH; ++l) {
        unsigned char* wl = ws + WS_W + (size_t)l * W_LAYER;
        for (int rep = 0; rep < REP_IN; ++rep) {
            pg8::Gemm g{H, (const bf16*)(wl + W_IN), T, INW, DM}; pg8::StaticOrder S; S.init(T, INW, gridDim.x, blockIdx.x);
            pg8::EpiInProj E{PROJ, a.b_in + l * INW, cs};
            pg8::gemm_phase<pg8::EpiInProj, pg8::StaticOrder, true, true>(lds, g, S, E);
        }
        SEAM();
        for (int rep = 0; rep < REP_A; ++rep) attn_phase(lds, PROJ, CONCAT, a.sinks + l * 8);
        for (int rep = 0; rep < REP_PL; ++rep) pool_phase(lds, PROJ, CONCAT, (const bf16*)(wl + W_PW), a.pool_scale + l * 512);
        SEAM();
        for (int rep = 0; rep < REP_G; ++rep) {
            pg8::Gemm g{CONCAT, (const bf16*)(wl + W_OUT), T, DM, DM}; pg8::StaticOrder S; S.init(T, DM, gridDim.x, blockIdx.x);
            pg8::EpiBf16<0> E{MIX, DM, nullptr, 0, 0, 1.f};
            pg8::gemm_phase<pg8::EpiBf16<0>, pg8::StaticOrder, true, true>(lds, g, S, E);
        }
        SEAM();
        for (int rep = 0; rep < REP_R; ++rep) rowwise_phase(a, lds, false, true, true, true, 2, XB, MIX, nullptr, XA, H, l, 2, a.g_post_mix + l * DM, l, 3, 4, a.g_pre_ffn + l * DM);
        SEAM();
#if defined(PROBE_HOT)
#pragma unroll 1
        for (int rep = 0; rep < 2; ++rep) {
            pg8::Gemm g{H, (const bf16*)(wl + W_GU), T, 2 * DFF, rep == 0 ? PROBE_HOT_K : DM}; pg8::DualOrder S; S.so.init(T, 2 * DFF, gridDim.x, blockIdx.x); S.c = blockIdx.x; S.rounds = 22; S.hot = (rep == 0);
            pg8::EpiSwiGLU E{rep == 0 ? MIX : ACT};
            pg8::gemm_phase<pg8::EpiSwiGLU, pg8::DualOrder, true, true>(lds, g, S, E);
            if (rep == 0) SEAM();
        }
#else
        for (int rep = 0; rep < REP_GU; ++rep) {
            pg8::Gemm g{H, (const bf16*)(wl + W_GU), T, 2 * DFF, DM}; pg8::StaticOrder S; S.init(T, 2 * DFF, gridDim.x, blockIdx.x);
            pg8::EpiSwiGLU E{ACT};
            pg8::gemm_phase<pg8::EpiSwiGLU, pg8::StaticOrder, true, true>(lds, g, S, E);
        }
#endif
        SEAM();
        for (int rep = 0; rep < REP_DN; ++rep) {
            pg8::Gemm g{ACT, (const bf16*)(wl + W_DN), T, DM, DFF}; pg8::StaticOrder S; S.init(T, DM, gridDim.x, blockIdx.x);
            pg8::EpiBf16<0> E{MIX, DM, nullptr, 0, 0, 1.f};
            pg8::gemm_phase<pg8::EpiBf16<0>, pg8::StaticOrder, true, true>(lds, g, S, E);
        }
        SEAM();
        const bool more = (l + 1 < DEPTH);
        for (int rep = 0; rep < REP_R; ++rep) rowwise_phase(a, lds, false, true, more, true, more ? 2 : 1, XA, MIX, a.out, XB, H, l, 5, a.g_post_ffn + l * DM, l + 1, 0, 1, a.g_pre_mix + (more ? (l + 1) * DM : 0));
        if (more) SEAM();
    }
}

extern "C" void kernel_launch(void* const* d_in, const int* in_sizes, int n_in, void* d_out, int out_size, void* d_ws, size_t ws_size, hipStream_t stream) {
    static int grid_blocks = 0;
    if (grid_blocks == 0) {
        if (n_in != 18 || out_size != T * DM || ws_size < WS_END) { fprintf(stderr, "kernel_launch: unexpected shapes (n_in %d, out %d, ws %zu)\n", n_in, out_size, ws_size); grid_blocks = -1; return; }
        int dev = 0, cus = 0, per_cu = 0;
        hipGetDevice(&dev);
        hipDeviceGetAttribute(&cus, hipDeviceAttributeMultiprocessorCount, dev);
        if (hipFuncSetAttribute((const void*)fwd_kernel, hipFuncAttributeMaxDynamicSharedMemorySize, LDS_BYTES) != hipSuccess) { fprintf(stderr, "kernel_launch: hipFuncSetAttribute failed\n"); grid_blocks = -1; return; }
        if (hipOccupancyMaxActiveBlocksPerMultiprocessor(&per_cu, (const void*)fwd_kernel, 512, LDS_BYTES) != hipSuccess || per_cu < 1) { fprintf(stderr, "kernel_launch: occupancy query gave %d\n", per_cu); per_cu = 1; }
        (void)hipGetLastError();
        grid_blocks = cus * per_cu;
    }
    if (grid_blocks < 0) return;
    if (hipMemsetAsync(d_ws, 0, 65536, stream) != hipSuccess) { fprintf(stderr, "kernel_launch: memset failed\n"); return; }
    Args a{};
    a.x = (const float*)d_in[0]; a.c = (const float*)d_in[1]; a.pos = (const int*)d_in[2]; a.ada_w = (const float*)d_in[3]; a.ada_b = (const float*)d_in[4];
    a.w_in = (const float*)d_in[5]; a.b_in = (const float*)d_in[6]; a.sinks = (const float*)d_in[7]; a.pool_w = (const float*)d_in[8]; a.pool_scale = (const float*)d_in[9];
    a.w_out = (const float*)d_in[10]; a.w_gate = (const float*)d_in[11]; a.w_up = (const float*)d_in[12]; a.w_down = (const float*)d_in[13];
    a.g_pre_mix = (const float*)d_in[14]; a.g_post_mix = (const float*)d_in[15]; a.g_pre_ffn = (const float*)d_in[16]; a.g_post_ffn = (const float*)d_in[17];
    a.out = (float*)d_out; a.ws = (unsigned char*)d_ws;
    void* args[] = {&a};
    hipError_t e = hipLaunchCooperativeKernel((const void*)fwd_kernel, dim3(grid_blocks), dim3(512), args, LDS_BYTES, stream);
    if (e != hipSuccess) fprintf(stderr, "cooperative launch failed: %s (grid %d)\n", hipGetErrorString(e), grid_blocks);
}
```

```cpp
#include <hip/hip_runtime.h>
#include <hip/hip_cooperative_groups.h>
#include <cstdio>
#include <cstdint>
namespace cg = cooperative_groups;
#define LAS __attribute__((address_space(3)))
namespace pg8 {
#define PG8_LAS __attribute__((address_space(3)))
typedef unsigned short bf16_t;
typedef short bf16x8 __attribute__((ext_vector_type(8)));
typedef float f32x4 __attribute__((ext_vector_type(4)));
typedef unsigned u32x4 __attribute__((ext_vector_type(4)));
constexpr int BM = 256, BK = 64, HALF = 128, HTB = HALF * BK * 2  , STAGE_BYTES = 8 * HTB, NXCD = 8, WGM = 8;

__host__ __device__ __forceinline__ int lds_byte(int r, int c) { const int st = (r >> 4) * 2 + (c >> 5), rr = r & 15, cc = c & 31, ob = rr * 64 + cc * 2; return st * 1024 + (ob ^ (((ob >> 9) & 1) << 5)); }
__host__ __device__ __forceinline__ void stage_rc(int b, int& R, int& C) { const int st = b / 1024, sb = b % 1024, swz = sb ^ (((sb >> 9) & 1) << 5); R = (st >> 1) * 16 + swz / 64; C = (st & 1) * 32 + (swz % 64) / 2; }
__host__ __device__ __forceinline__ int perm32(int rho) { const int n = rho >> 4, i = rho & 15; return 8 * (i >> 2) + 4 * n + (i & 3); }

struct Unit { int pm, pn; };
struct Gemm { const bf16_t* A; const bf16_t* Bt; int M, N, K; };

struct StaticOrder {
    int nM, nN, nwg, G, c, rev;
    __host__ __device__ void init(int M, int N, int G_, int c_, int rev_ = 0) { nM = M / BM; nN = N / BM; nwg = nM * nN; G = G_; c = c_; rev = rev_; }
    __host__ __device__ bool next(int i, Unit& u) const {
        const long L = (long)i * G + c; if (L >= nwg) return false;
        int wgid = (int)L; { const int q = nwg / NXCD, r = nwg % NXCD, xcd = wgid % NXCD, off = wgid / NXCD; wgid = (xcd < r ? xcd * (q + 1) : r * (q + 1) + (xcd - r) * q) + off; }
        const int nig = WGM * nN, gid = wgid / nig, fm = gid * WGM, gsz = (nM - fm) < WGM ? (nM - fm) : WGM;
        u.pm = fm + ((wgid % nig) % gsz); u.pn = (wgid % nig) / gsz; if (rev) u.pm = nM - 1 - u.pm; return true;
    }
    __device__ __forceinline__ void a_ready(const Unit&) const {}
    __device__ __forceinline__ void done(const Unit&) const {}
};

__device__ __forceinline__ unsigned cvt_pk_bf16(float lo, float hi) { unsigned r; asm volatile("v_cvt_pk_bf16_f32 %0, %1, %2" : "=v"(r) : "v"(lo), "v"(hi)); return r; }
typedef float f32x2 __attribute__((ext_vector_type(2)));
__device__ __forceinline__ f32x2 gelu_pk(f32x2 v) {
    const f32x2 av = __builtin_elementwise_abs(v), d = av * 0.2316418882f + 1.0f;
    f32x2 t; t.x = __builtin_amdgcn_rcpf(d.x); t.y = __builtin_amdgcn_rcpf(d.y);
    f32x2 q = t * 0.5307027145f + (-0.7265760135f); q = q * t + 0.7107068705f; q = q * t + (-0.142248368f); q = q * t + 0.127414796f; q = q * t;
    const f32x2 s = (v * v) * (-0.72134752044f);
    f32x2 e; e.x = __builtin_amdgcn_exp2f(s.x); e.y = __builtin_amdgcn_exp2f(s.y);
    const f32x2 m = v * (q * e), r = v - m;
    f32x2 o; o.x = v.x < 0.f ? m.x : r.x; o.y = v.y < 0.f ? m.y : r.y; return o;
}

template <int ACT  > struct EpiBf16 {
    static constexpr bool PERM = true, AFTER_DRAIN = false; static_assert(ACT == 0 || ACT == 1, "EpiBf16: ACT is 0 (none) or 1 (gelu_pk)");
    bf16_t* O; int ldc; const float* bias; int split_cols; size_t split_stride; float scale0;
    __device__ __forceinline__ void operator()(const f32x4 (&acc)[2][2][4][2], const Unit& u, int wr, int wc, int fr, int fq) const {
        const int row0 = u.pm * BM + wr * 64 + fr; int colt = u.pn * BM; bf16_t* base = O;
        float sc = 1.f; if (split_cols) { const int t = colt / split_cols; base += (size_t)t * split_stride; colt -= t * split_cols; if (t == 0) sc = scale0; }
        const int col0 = colt + wc * 32 + 8 * fq, bcol0 = u.pn * BM + wc * 32 + 8 * fq;
        f32x4 bv[2][2];
#pragma unroll
        for (int bj = 0; bj < 2; ++bj)
#pragma unroll
            for (int n = 0; n < 2; ++n) bv[bj][n] = bias ? *(const f32x4*)(bias + bcol0 + bj * HALF + 4 * n) : (f32x4){0.f, 0.f, 0.f, 0.f};
#pragma unroll
        for (int ai = 0; ai < 2; ++ai)
#pragma unroll
            for (int m = 0; m < 4; ++m) { bf16_t* rowp = base + (size_t)(row0 + ai * HALF + m * 16) * ldc + col0;
#pragma unroll
                for (int bj = 0; bj < 2; ++bj) { f32x4 v0 = acc[ai][bj][m][0] + bv[bj][0], v1 = acc[ai][bj][m][1] + bv[bj][1];
                    if (ACT == 1) { f32x2 a = gelu_pk((f32x2){v0[0], v0[1]}), b = gelu_pk((f32x2){v0[2], v0[3]}), c = gelu_pk((f32x2){v1[0], v1[1]}), d = gelu_pk((f32x2){v1[2], v1[3]});
                        v0 = (f32x4){a.x, a.y, b.x, b.y}; v1 = (f32x4){c.x, c.y, d.x, d.y}; }
                    v0 = v0 * sc; v1 = v1 * sc; u32x4 w; w.x = cvt_pk_bf16(v0[0], v0[1]); w.y = cvt_pk_bf16(v0[2], v0[3]); w.z = cvt_pk_bf16(v1[0], v1[1]); w.w = cvt_pk_bf16(v1[2], v1[3]);
                    *(u32x4*)(rowp + bj * HALF) = w; } }
    }
};
template <class Epi, class Sched, bool ALIGN_EPI = false, bool SP2 = false, int A_AUX = 0  >
__device__ __forceinline__ void gemm_phase(PG8_LAS unsigned char* lds, const Gemm g, const Sched& S, const Epi& E) {
    int tid_ = threadIdx.x; asm volatile("" : "+v"(tid_)); const int tid = tid_, wid = __builtin_amdgcn_readfirstlane(tid >> 6), lane = tid & 63, wr = wid >> 2, wc = wid & 3, fr = lane & 15, fq = lane >> 4;
    const int K = g.K, nt = K / BK;
    unsigned voffA[2], voffB[2];
#pragma unroll
    for (int i = 0; i < 2; ++i) { int R, C; stage_rc(tid * 16 + i * 8192, R, C); const int Rb = Epi::PERM ? ((R & ~31) + perm32(R & 31)) : R;
        voffA[i] = (unsigned)(R * K + C) * 2u; voffB[i] = (unsigned)(Rb * K + C) * 2u; }
    const size_t kstep = (size_t)(BK * 2);
    const size_t hstep = (size_t)HALF * K * 2;
    const size_t tstep = 2 * hstep;
    const unsigned ldsw = (unsigned)wid * 1024u;
    const int aoff = lds_byte(wr * 64 + fr, fq * 8), boff = lds_byte(wc * 32 + fr, fq * 8);
#define PG8_SA(b, h) (((b) * 2 + (h)) * HTB)
#define PG8_SB(b, h) ((4 + (b) * 2 + (h)) * HTB)
#define PG8_STAGE(bufoff, gbase, voff) do { _Pragma("unroll") for (int _i = 0; _i < 2; ++_i) \
        __builtin_amdgcn_global_load_lds((const unsigned*)((const char*)(gbase) + (voff)[_i]), (PG8_LAS unsigned*)(lds + (bufoff) + ldsw + _i * 8192), 16, 0, 0); } while (0)
#define PG8_STAGEA(bufoff, gbase, voff) do { _Pragma("unroll") for (int _i = 0; _i < 2; ++_i) \
        __builtin_amdgcn_global_load_lds((const unsigned*)((const char*)(gbase) + (voff)[_i]), (PG8_LAS unsigned*)(lds + (bufoff) + ldsw + _i * 8192), 16, 0, A_AUX); } while (0)
#define PG8_LDA(dst, b, h) do { _Pragma("unroll") for (int m = 0; m < 4; ++m) _Pragma("unroll") for (int k = 0; k < 2; ++k) dst[m][k] = *(const PG8_LAS bf16x8*)(lds + PG8_SA(b, h) + aoff + m * 2048 + k * 1024); } while (0)
#define PG8_LDB(dst, b, h) do { _Pragma("unroll") for (int n = 0; n < 2; ++n) _Pragma("unroll") for (int k = 0; k < 2; ++k) dst[n][k] = *(const PG8_LAS bf16x8*)(lds + PG8_SB(b, h) + boff + n * 2048 + k * 1024); } while (0)
#define PG8_MMA(ai, bj, At, Bt) do { __builtin_amdgcn_s_setprio(1); _Pragma("unroll") for (int m = 0; m < 4; ++m) _Pragma("unroll") for (int n = 0; n < 2; ++n) _Pragma("unroll") for (int k = 0; k < 2; ++k) \
        acc[ai][bj][m][n] = __builtin_amdgcn_mfma_f32_16x16x32_bf16(Bt[n][k], At[m][k], acc[ai][bj][m][n], 0, 0, 0); __builtin_amdgcn_s_setprio(0); } while (0)
#define PG8_WAIT_V(n) asm volatile("s_waitcnt vmcnt(" #n ")" ::: "memory")
#define PG8_WAIT_L(n) asm volatile("s_waitcnt lgkmcnt(" #n ")" ::: "memory")
#define PG8_BAR __builtin_amdgcn_s_barrier()
#define PG8_SCHED __builtin_amdgcn_sched_barrier(0)
    Unit cur, nxt; int ui = 0;
    if (!S.next(0, cur)) return;
    f32x4 acc[2][2][4][2];
#pragma unroll
    for (int a = 0; a < 2; ++a)
#pragma unroll
        for (int b = 0; b < 2; ++b)
#pragma unroll
            for (int m = 0; m < 4; ++m)
#pragma unroll
                for (int n = 0; n < 2; ++n) acc[a][b][m][n] = (f32x4){0.f, 0.f, 0.f, 0.f};
    bf16x8 At[4][2], B0[2][2], B1[2][2];
    const char* cA = (const char*)g.A + (size_t)cur.pm * tstep; const char* cB = (const char*)g.Bt + (size_t)cur.pn * tstep;
    S.a_ready(cur);
    if constexpr (SP2) {
        PG8_STAGE(PG8_SB(0, 0), cB, voffB); PG8_STAGE(PG8_SB(0, 1), cB + hstep, voffB); PG8_STAGEA(PG8_SA(0, 0), cA, voffA); PG8_STAGEA(PG8_SA(0, 1), cA + hstep, voffA);
        if (wr == 1) PG8_BAR;
        PG8_WAIT_V(2); PG8_BAR;
        PG8_STAGE(PG8_SB(1, 0), cB + kstep, voffB); PG8_STAGEA(PG8_SA(1, 0), cA + kstep, voffA); PG8_STAGE(PG8_SB(1, 1), cB + hstep + kstep, voffB);
        PG8_WAIT_V(6); PG8_BAR;
    } else {
        PG8_STAGE(PG8_SB(0, 0), cB, voffB); PG8_STAGEA(PG8_SA(0, 0), cA, voffA); PG8_STAGE(PG8_SB(0, 1), cB + hstep, voffB); PG8_STAGEA(PG8_SA(0, 1), cA + hstep, voffA);
        if (wr == 1) PG8_BAR;
        PG8_WAIT_V(4); PG8_BAR;
        PG8_STAGE(PG8_SB(1, 0), cB + kstep, voffB); PG8_STAGEA(PG8_SA(1, 0), cA + kstep, voffA); PG8_STAGE(PG8_SB(1, 1), cB + hstep + kstep, voffB);
        PG8_WAIT_V(6); PG8_BAR;
    }
    for (;;) {
        const bool has_next = S.next(ui + 1, nxt);
        const char* nA = has_next ? (const char*)g.A + (size_t)nxt.pm * tstep : cA; const char* nB = has_next ? (const char*)g.Bt + (size_t)nxt.pn * tstep : cB;
        for (int t = 0; t < nt; t += 2) {
            const bool last = (t == nt - 2);
            const char* a1 = cA + (size_t)(t + 1) * kstep;
            const char* a2 = last ? nA : cA + (size_t)(t + 2) * kstep; const char* b2 = last ? nB : cB + (size_t)(t + 2) * kstep;
            const char* a3 = a2 + kstep; const char* b3 = b2 + kstep;
            if (last && has_next) S.a_ready(nxt);
            if constexpr (SP2) {
            PG8_LDB(B0, 0, 0); PG8_LDB(B1, 0, 1); PG8_SCHED; PG8_LDA(At, 0, 0); PG8_STAGEA(PG8_SA(1, 1), a1 + hstep, voffA);
            PG8_WAIT_V(8); PG8_WAIT_L(0); PG8_BAR; PG8_MMA(0, 0, At, B0); PG8_MMA(0, 1, At, B1); PG8_BAR; PG8_SCHED;
            PG8_LDA(At, 0, 1); PG8_STAGE(PG8_SB(0, 0), b2, voffB); PG8_STAGE(PG8_SB(0, 1), b2 + hstep, voffB); PG8_STAGEA(PG8_SA(0, 0), a2, voffA);
            PG8_WAIT_V(8); PG8_WAIT_L(0); PG8_BAR; PG8_MMA(1, 0, At, B0); PG8_MMA(1, 1, At, B1); PG8_BAR; PG8_SCHED;
            PG8_LDB(B0, 1, 0); PG8_LDB(B1, 1, 1); PG8_SCHED; PG8_LDA(At, 1, 0); PG8_STAGEA(PG8_SA(0, 1), a2 + hstep, voffA);
            PG8_WAIT_V(8); PG8_WAIT_L(0); PG8_BAR; PG8_MMA(0, 0, At, B0); PG8_MMA(0, 1, At, B1); PG8_BAR; PG8_SCHED;
            PG8_LDA(At, 1, 1); PG8_STAGE(PG8_SB(1, 0), b3, voffB); PG8_STAGE(PG8_SB(1, 1), b3 + hstep, voffB); PG8_STAGEA(PG8_SA(1, 0), a3, voffA);
            PG8_WAIT_V(8); PG8_WAIT_L(0); PG8_BAR; PG8_MMA(1, 0, At, B0); PG8_MMA(1, 1, At, B1); PG8_BAR; PG8_SCHED;
            } else {
            PG8_LDB(B0, 0, 0); PG8_SCHED; PG8_LDA(At, 0, 0); PG8_STAGEA(PG8_SA(1, 1), a1 + hstep, voffA);
            PG8_WAIT_L(8); PG8_BAR; PG8_WAIT_L(0); PG8_MMA(0, 0, At, B0); PG8_BAR; PG8_SCHED;
            PG8_LDB(B1, 0, 1); PG8_STAGE(PG8_SB(0, 0), b2, voffB);
            PG8_BAR; PG8_WAIT_L(0); PG8_MMA(0, 1, At, B1); PG8_BAR;
            PG8_LDA(At, 0, 1); PG8_STAGEA(PG8_SA(0, 0), a2, voffA);
            PG8_BAR; PG8_WAIT_L(0); PG8_MMA(1, 0, At, B0); PG8_BAR; PG8_SCHED;
            PG8_STAGE(PG8_SB(0, 1), b2 + hstep, voffB);
            PG8_WAIT_V(6); PG8_BAR; PG8_MMA(1, 1, At, B1); PG8_BAR;
            PG8_LDB(B0, 1, 0); PG8_SCHED; PG8_LDA(At, 1, 0); PG8_STAGEA(PG8_SA(0, 1), a2 + hstep, voffA);
            PG8_WAIT_L(8); PG8_BAR; PG8_WAIT_L(0); PG8_MMA(0, 0, At, B0); PG8_BAR; PG8_SCHED;
            PG8_LDB(B1, 1, 1); PG8_STAGE(PG8_SB(1, 0), b3, voffB);
            PG8_BAR; PG8_WAIT_L(0); PG8_MMA(0, 1, At, B1); PG8_BAR;
            PG8_LDA(At, 1, 1); PG8_STAGEA(PG8_SA(1, 0), a3, voffA);
            PG8_BAR; PG8_WAIT_L(0); PG8_MMA(1, 0, At, B0); PG8_BAR; PG8_SCHED;
            PG8_STAGE(PG8_SB(1, 1), b3 + hstep, voffB);
            PG8_WAIT_V(6); PG8_BAR; PG8_MMA(1, 1, At, B1); PG8_BAR;
            }
        }
        if constexpr (ALIGN_EPI) { if (wr == 0) PG8_BAR; }
        if constexpr (!Epi::AFTER_DRAIN) { E(acc, cur, wr, wc, fr, fq); S.done(cur); }
        if (!has_next) break;
#pragma unroll
        for (int a = 0; a < 2; ++a)
#pragma unroll
            for (int b = 0; b < 2; ++b)
#pragma unroll
                for (int m = 0; m < 4; ++m)
#pragma unroll
                    for (int n = 0; n < 2; ++n) acc[a][b][m][n] = (f32x4){0.f, 0.f, 0.f, 0.f};
        cur = nxt; cA = nA; cB = nB; ++ui;
        if constexpr (ALIGN_EPI) { if (wr == 1) PG8_BAR; }
    }
    PG8_WAIT_V(0);
    if constexpr (!ALIGN_EPI) { if (wr == 0) PG8_BAR; }
    PG8_BAR;
    if constexpr (Epi::AFTER_DRAIN) { E.fused(acc, cur, wr, wc, fr, fq, lds, wid, lane); S.done(cur); }
#undef PG8_SA
#undef PG8_SB
#undef PG8_STAGE
#undef PG8_STAGEA
#undef PG8_LDA
#undef PG8_LDB
#undef PG8_MMA
#undef PG8_WAIT_V
#undef PG8_WAIT_L
#undef PG8_BAR
#undef PG8_SCHED
}
}
#define XB_TMO      128
#define XB_XCNT(j)  (256  + 64 * (j))
#define XB_XSUB(j)  (1280 + 64 * (j))
#define XB_XGEN(j)  (2304 + 64 * (j))
#define XB_TOP      3328
#define XB_TOPGEN   3392
#define XCD_BAR_WORDS 3456
#define XB_SPIN_CAP (1u << 18)

__device__ __forceinline__ unsigned xb_ld(unsigned* p)              { return __hip_atomic_load(p, __ATOMIC_RELAXED, __HIP_MEMORY_SCOPE_AGENT); }
__device__ __forceinline__ unsigned xb_add(unsigned* p, unsigned v) { return __hip_atomic_fetch_add(p, v, __ATOMIC_RELAXED, __HIP_MEMORY_SCOPE_AGENT); }
__device__ __forceinline__ unsigned xb_xcc_id() { return (unsigned)__builtin_amdgcn_s_getreg((3 << 11) | 20) & 0xFu; }
#define XB_SPIN(cond, bar) do { unsigned _sp = 0; while (cond) { __builtin_amdgcn_s_sleep(1); \
    if ((++_sp & 255u) == 0u) { if (xb_ld(&(bar)[XB_TMO])) break; if (_sp > XB_SPIN_CAP) { atomicAdd(&(bar)[XB_TMO], 1u); break; } } } } while (0)

struct XcdBarrier {
    unsigned* bar; unsigned x;
    volatile LAS unsigned* st;
};

__device__ __forceinline__ XcdBarrier xcd_barrier_post(unsigned* bar, volatile LAS unsigned* st) {
    XcdBarrier b; b.bar = bar; b.x = xb_xcc_id(); b.st = st;
    if (threadIdx.x == 0) (void)xb_add(&bar[XB_XCNT(b.x)], 1u);
    return b;
}
__device__ __forceinline__ void xcd_barrier_complete(unsigned* bar, unsigned x, unsigned& nloc, unsigned& nx) {
    const unsigned G = gridDim.x * gridDim.y * gridDim.z;
    unsigned sum, cnt, mine, sp = 0u;
    for (;;) {
        sum = 0u; cnt = 0u; mine = 0u;
#pragma unroll
        for (unsigned j = 0; j < 16; ++j) { const unsigned c = xb_ld(&bar[XB_XCNT(j)]); sum += c; cnt += (c > 0u) ? 1u : 0u; mine = (j == x) ? c : mine; }
        if (sum == G) break;
        __builtin_amdgcn_s_sleep(1);
        if ((++sp & 255u) == 0u) { if (xb_ld(&bar[XB_TMO])) break; if (sp > XB_SPIN_CAP) { atomicAdd(&bar[XB_TMO], 1u); break; } }
    }
    nloc = mine > 0u ? mine : 1u; nx = cnt > 0u ? cnt : 1u;
}

__device__ __forceinline__ void xcd_barrier(const XcdBarrier& b) {
    asm volatile("s_waitcnt vmcnt(0)" ::: "memory");
    __syncthreads();
    if (threadIdx.x == 0) {
        unsigned* bar = b.bar;
        __builtin_amdgcn_s_waitcnt(0);
        unsigned nloc = b.st[0], nx = b.st[1];
        if (nloc == 0u) { xcd_barrier_complete(bar, b.x, nloc, nx); b.st[0] = nloc; b.st[1] = nx; }
        const unsigned old = xb_add(&bar[XB_XSUB(b.x)], 1u);
        const unsigned gen = old / nloc;
        if (old + 1u == (gen + 1u) * nloc) {
            __builtin_amdgcn_fence(__ATOMIC_RELEASE, "agent");
            asm volatile("s_waitcnt vmcnt(0)" ::: "memory");
            const unsigned og = xb_add(&bar[XB_TOP], 1u);
            const unsigned tg = og / nx;
            if (og + 1u == (tg + 1u) * nx) xb_add(&bar[XB_TOPGEN], 1u);
            else XB_SPIN(xb_ld(&bar[XB_TOPGEN]) == tg, bar);
            __builtin_amdgcn_fence(__ATOMIC_ACQUIRE, "agent");
            xb_add(&bar[XB_XGEN(b.x)], 1u);
            asm volatile("s_waitcnt vmcnt(0)" ::: "memory");
        } else {
            XB_SPIN(xb_ld(&bar[XB_XGEN(b.x)]) == gen, bar);
            __builtin_amdgcn_fence(__ATOMIC_ACQUIRE, "agent");
            asm volatile("s_waitcnt vmcnt(0)" ::: "memory");
        }
    }
    __syncthreads();
}

constexpr int NB = 8, SEQ = 8192, DM = 1024, DEPTH = 2;
constexpr int T = NB * SEQ;
constexpr int INW = 1280, DFF = 2816, NMODW = 6 * DM;
constexpr int KCH = 32;
constexpr float EPS = 1e-6f;
constexpr float LOG2E = 1.4426950408889634f;

#define LAS __attribute__((address_space(3)))
typedef unsigned short bf16;
typedef unsigned v4u __attribute__((ext_vector_type(4)));
typedef unsigned v2u __attribute__((ext_vector_type(2)));
typedef float f32x4 __attribute__((ext_vector_type(4)));
typedef short bf16x8 __attribute__((ext_vector_type(8)));

constexpr size_t MiB = 1u << 20;
constexpr size_t WS_MODP = 640 * MiB;
constexpr size_t WS_MODF = 8 * MiB;
constexpr size_t WS_CS = 9 * MiB;
constexpr size_t WS_W = 16 * MiB, W_LAYER = 24 * MiB;
constexpr size_t W_IN = 0, W_OUT = 3 * MiB, W_GU = 5 * MiB, W_DN = 16 * MiB, W_PW = 22 * MiB;
constexpr size_t WS_H = 64 * MiB;
constexpr size_t WS_MIX = 192 * MiB;
constexpr size_t WS_PROJ = 320 * MiB;
constexpr size_t WS_CONCAT = 480 * MiB;
constexpr size_t WS_ACT = 320 * MiB;
constexpr size_t WS_XA = 672 * MiB;
constexpr size_t WS_XB = 800 * MiB;
constexpr size_t WS_END = 928 * MiB;

constexpr int RING_BYTES = 131072;
constexpr int LDS_BYTES = 147456;

struct Args {
    const float* x; const float* c; const int* pos; const float* ada_w; const float* ada_b; const float* w_in; const float* b_in;
    const float* sinks; const float* pool_w; const float* pool_scale; const float* w_out; const float* w_gate; const float* w_up;
    const float* w_down; const float* g_pre_mix; const float* g_post_mix; const float* g_pre_ffn; const float* g_post_ffn;
    float* out; unsigned char* ws;
};

__device__ __constant__ double c_inv_freq[8] = {1.0, 0.19392274474868576, 0.03760603093086393, 0.007292664737217109,
                                                0.001414213562373095, 0.0002742481756762073, 5.318295896944988e-05, 1.031338537721246e-05};

__device__ __forceinline__ unsigned pk2(float lo, float hi) { return pg8::cvt_pk_bf16(lo, hi); }
__device__ __forceinline__ float bf_lo(unsigned w) { return __uint_as_float(w << 16); }
__device__ __forceinline__ float bf_hi(unsigned w) { return __uint_as_float(w & 0xffff0000u); }
__device__ __forceinline__ float wave_sum(float v) {
#pragma unroll
    for (int o = 1; o < 64; o <<= 1) v += __shfl_xor(v, o);
    return v;
}

namespace pg8 {
struct EpiInProj {
    static constexpr bool PERM = true, AFTER_DRAIN = false;
    bf16_t* O; const float* bias; const float* cs;
    __device__ __forceinline__ void operator()(const f32x4 (&acc)[2][2][4][2], const Unit& u, int wr, int wc, int fr, int fq) const {
        const int row0 = u.pm * BM + wr * 64 + fr; const int colt = u.pn * BM; const int col0 = colt + wc * 32 + 8 * fq;
        f32x4 bv[2][2];
#pragma unroll
        for (int bj = 0; bj < 2; ++bj)
#pragma unroll
            for (int n = 0; n < 2; ++n) bv[bj][n] = *(const f32x4*)(bias + col0 + bj * HALF + 4 * n);
        const bool rot_wave = (colt < 640) && ((wc & 1) == 0);
#pragma unroll
        for (int ai = 0; ai < 2; ++ai)
#pragma unroll
        for (int mh = 0; mh < 2; ++mh) {
            f32x4 cc[2][4];
#pragma unroll
            for (int mm = 0; mm < 2; ++mm)
#pragma unroll
                for (int q = 0; q < 4; ++q) cc[mm][q] = (f32x4){1.f, 1.f, 1.f, 1.f};
            if (rot_wave && fq < 2) {
#pragma unroll
                for (int mm = 0; mm < 2; ++mm) { const float* cr = cs + (size_t)(row0 + ai * HALF + (2 * mh + mm) * 16) * 16;
#pragma unroll
                    for (int q = 0; q < 4; ++q) cc[mm][q] = *(const f32x4*)(cr + 4 * q); }
            }
#pragma unroll
            for (int mm = 0; mm < 2; ++mm) {
                const int m = 2 * mh + mm;
                const int row = row0 + ai * HALF + m * 16;
                bf16_t* rowp = O + (size_t)row * INW + col0;
#pragma unroll
                for (int bj = 0; bj < 2; ++bj) {
                    f32x4 v0 = acc[ai][bj][m][0] + bv[bj][0], v1 = acc[ai][bj][m][1] + bv[bj][1];
                    const int cb = colt + bj * HALF;
                    if (rot_wave && cb < 640) {
                        f32x4 p0, p1;
#pragma unroll
                        for (int e = 0; e < 4; ++e) { p0[e] = __shfl_xor(v0[e], 16); p1[e] = __shfl_xor(v1[e], 16); }
                        if (fq == 0) { v0 = v0 * cc[mm][0] - p0 * cc[mm][2]; v1 = v1 * cc[mm][1] - p1 * cc[mm][3]; }
                        else if (fq == 1) { v0 = v0 * cc[mm][0] + p0 * cc[mm][2]; v1 = v1 * cc[mm][1] + p1 * cc[mm][3]; }
                    }
                    if (cb < 512) { v0 = v0 * 0.125f; v1 = v1 * 0.125f; }
                    u32x4 w; w.x = cvt_pk_bf16(v0[0], v0[1]); w.y = cvt_pk_bf16(v0[2], v0[3]); w.z = cvt_pk_bf16(v1[0], v1[1]); w.w = cvt_pk_bf16(v1[2], v1[3]);
                    *(u32x4*)(rowp + bj * HALF) = w;
                }
            }
        }
    }
};
struct EpiSwiGLU {
    static constexpr bool PERM = true, AFTER_DRAIN = false;
    bf16_t* O;
    __device__ __forceinline__ void operator()(const f32x4 (&acc)[2][2][4][2], const Unit& u, int wr, int wc, int fr, int fq) const {
        typedef float f32x2 __attribute__((ext_vector_type(2)));
        const int row0 = u.pm * BM + wr * 64 + fr; const int col0 = u.pn * HALF + wc * 32 + 8 * fq;
#pragma unroll
        for (int ai = 0; ai < 2; ++ai)
#pragma unroll
            for (int m = 0; m < 4; ++m) {
                bf16_t* rowp = O + (size_t)(row0 + ai * HALF + m * 16) * DFF + col0;
                f32x2 G[4], U[4], t[4], r[4];
#pragma unroll
                for (int n = 0; n < 2; ++n) { G[2 * n] = (f32x2){acc[ai][0][m][n][0], acc[ai][0][m][n][1]}; G[2 * n + 1] = (f32x2){acc[ai][0][m][n][2], acc[ai][0][m][n][3]};
                                              U[2 * n] = (f32x2){acc[ai][1][m][n][0], acc[ai][1][m][n][1]}; U[2 * n + 1] = (f32x2){acc[ai][1][m][n][2], acc[ai][1][m][n][3]}; }
#pragma unroll
                for (int q = 0; q < 4; ++q) { t[q].x = __builtin_amdgcn_exp2f(G[q].x); t[q].y = __builtin_amdgcn_exp2f(G[q].y); }
#pragma unroll
                for (int q = 0; q < 4; ++q) { t[q] = t[q] + 1.0f; r[q] = G[q] * U[q]; }
#pragma unroll
                for (int q = 0; q < 4; ++q) { t[q].x = __builtin_amdgcn_rcpf(t[q].x); t[q].y = __builtin_amdgcn_rcpf(t[q].y); }
#pragma unroll
                for (int q = 0; q < 4; ++q) r[q] = r[q] * t[q];
                u32x4 w; w.x = cvt_pk_bf16(r[0].x, r[0].y); w.y = cvt_pk_bf16(r[1].x, r[1].y); w.z = cvt_pk_bf16(r[2].x, r[2].y); w.w = cvt_pk_bf16(r[3].x, r[3].y);
                *(u32x4*)rowp = w;
            }
    }
};
struct DualOrder {
    StaticOrder so; int c, rounds, hot;
    __device__ bool next(int i, Unit& u) const { if (hot) { if (i >= rounds) return false; u.pm = (c % 8) * 2 + ((c / 8) & 1); u.pn = ((c / 8) >> 1) & 3; return true; } return so.next(i, u); }
    __device__ __forceinline__ void a_ready(const Unit&) const {}
    __device__ __forceinline__ void done(const Unit&) const {}
};
}

__device__ __forceinline__ void transpose_item(const float* W, int K, int N, bf16* WT, int drow0, LAS float* scr, int k0, int n0, int lane, float wscale = 1.0f) {
#pragma unroll
    for (int ih = 0; ih < 32; ih += 16) {
        float tv[16];
#pragma unroll
        for (int i = 0; i < 16; ++i) tv[i] = __builtin_nontemporal_load(W + (size_t)(k0 + 2 * (ih + i) + (lane >> 5)) * N + n0 + (lane & 31));
#pragma unroll
        for (int i = 0; i < 16; ++i) scr[(2 * (ih + i) + (lane >> 5)) * 33 + (lane & 31)] = tv[i] * wscale;
    }
    asm volatile("s_waitcnt lgkmcnt(0)" ::: "memory");
    const int c = lane & 7;
#pragma unroll
    for (int j = 0; j < 4; ++j) { const int n = (lane >> 3) + 8 * j; const LAS float* s = scr + (8 * c) * 33 + n;
        v4u o; o.x = pk2(s[0 * 33], s[1 * 33]); o.y = pk2(s[2 * 33], s[3 * 33]); o.z = pk2(s[4 * 33], s[5 * 33]); o.w = pk2(s[6 * 33], s[7 * 33]);
        *(v4u*)(WT + (size_t)(drow0 + n) * K + k0 + 8 * c) = o; }
    asm volatile("s_waitcnt lgkmcnt(0)" ::: "memory");
}

__device__ __forceinline__ void prologue(const Args& a, LAS unsigned char* lds) {
    int tid_ = threadIdx.x; asm volatile("" : "+v"(tid_)); const int tid = tid_, lane = tid & 63, wave = tid >> 6;
    unsigned char* ws = a.ws;
    __syncthreads();
    {
        LAS float* sc = (LAS float*)lds;
        for (int i = tid; i < NB * DM; i += 512) { const float v = a.c[i]; sc[i] = v / (1.0f + __expf(-v)); }
        __syncthreads();
        float* modp = (float*)(ws + WS_MODP);
        for (int item = blockIdx.x; item < DEPTH * KCH * 12; item += gridDim.x) {
            const int l = item / (KCH * 12), r = item % (KCH * 12), kc = r / 12, cb = r % 12, n = cb * 512 + tid;
            constexpr int KPI = DM / KCH;
            const float* w = a.ada_w + ((size_t)l * DM + kc * KPI) * NMODW + n;
            float acc[8];
#pragma unroll
            for (int b = 0; b < 8; ++b) acc[b] = 0.f;
#pragma unroll 1
            for (int kh = 0; kh < KPI; kh += 16) {
                float wv[16];
#pragma unroll
                for (int k = 0; k < 16; ++k) wv[k] = __builtin_nontemporal_load(w + (size_t)(kh + k) * NMODW);
#pragma unroll
                for (int k = 0; k < 16; ++k) {
                    const LAS float* sp = sc + kc * KPI + kh + k;
#pragma unroll
                    for (int b = 0; b < 8; ++b) acc[b] += sp[b * DM] * wv[k];
                    if ((k & 3) == 3) asm volatile("" ::: "memory");
                }
            }
#pragma unroll
            for (int b = 0; b < 8; ++b) modp[((size_t)(l * KCH + kc) * 8 + b) * NMODW + n] = acc[b];
        }
        __syncthreads();
    }
    {
        float* cs = (float*)(ws + WS_CS);
        for (int idx = blockIdx.x * 512 + tid; idx < T * 8; idx += gridDim.x * 512) {
            const int row = idx >> 3, j = idx & 7;
            const double rev = (double)a.pos[row] * c_inv_freq[j] * 0.15915494309189535;
            const float fr = (float)(rev - floor(rev));
            cs[(size_t)row * 16 + j] = __builtin_amdgcn_cosf(fr);
            cs[(size_t)row * 16 + 8 + j] = __builtin_amdgcn_sinf(fr);
        }
    }
    {
        LAS float* scr = (LAS float*)(lds + wave * 16384);
        const int gw = blockIdx.x * 8 + wave, ngw = gridDim.x * 8;
        constexpr int I_IN = 16 * 40, I_OUT = 16 * 32, I_G = 16 * 88, I_D = 44 * 32, I_P = 4 * 8;
        constexpr int PER_L = I_IN + I_OUT + 2 * I_G + I_D + I_P;
        for (int it = gw; it < DEPTH * PER_L; it += ngw) {
            const int l = it / PER_L; int r = it % PER_L;
            unsigned char* wl = ws + WS_W + (size_t)l * W_LAYER;
            if (r < I_IN) { const int kb = r / 40, nb = r % 40; transpose_item(a.w_in + (size_t)l * DM * INW, DM, INW, (bf16*)(wl + W_IN), 32 * nb, scr, 64 * kb, 32 * nb, lane); continue; } r -= I_IN;
            if (r < I_OUT) { const int kb = r / 32, nb = r % 32; transpose_item(a.w_out + (size_t)l * DM * DM, DM, DM, (bf16*)(wl + W_OUT), 32 * nb, scr, 64 * kb, 32 * nb, lane); continue; } r -= I_OUT;
            if (r < 2 * I_G) { const int up = r >= I_G; if (up) r -= I_G; const int kb = r / 88, nb = r % 88, n0 = 32 * nb;
                transpose_item((up ? a.w_up : a.w_gate) + (size_t)l * DM * DFF, DM, DFF, (bf16*)(wl + W_GU), 256 * (n0 >> 7) + (n0 & 127) + (up ? 128 : 0), scr, 64 * kb, n0, lane, up ? -0.6931471805599453f : -1.4426950408889634f); continue; } r -= 2 * I_G;
            if (r < I_D) { const int kb = r / 32, nb = r % 32; transpose_item(a.w_down + (size_t)l * DFF * DM, DFF, DM, (bf16*)(wl + W_DN), 32 * nb, scr, 64 * kb, 32 * nb, lane); continue; } r -= I_D;
            { const int gi = r / 8, q = r % 8, kb = q / 4, nb = q % 4;
              transpose_item(a.pool_w + ((size_t)l * 4 + gi) * 128 * 128, 128, 128, (bf16*)(wl + W_PW) + (size_t)gi * 128 * 128, 32 * nb, scr, 64 * kb, 32 * nb, lane); }
        }
    }
}

__device__ __forceinline__ float mod_val(const Args& a, int l, int b, int idx, int col) {
    const float* modp = (const float*)(a.ws + WS_MODP);
    const int n = idx * DM + col;
    float s = a.ada_b[l * NMODW + n];
#pragma unroll
    for (int kc = 0; kc < KCH; ++kc) s += modp[((size_t)(l * KCH + kc) * 8 + b) * NMODW + n];
    return s;
}
__device__ __forceinline__ float mod_fin(const Args& a, int l, int b, int idx, int col) {
    return ((const float*)(a.ws + WS_MODF))[((size_t)(l * 8 + b)) * NMODW + idx * DM + col];
}
__device__ __forceinline__ void mod_finalize(const Args& a) {
    float* modf = (float*)(a.ws + WS_MODF);
    for (int i = blockIdx.x * 512 + threadIdx.x; i < DEPTH * 8 * NMODW; i += gridDim.x * 512) {
        const int l = i / (8 * NMODW), r = i % (8 * NMODW), b = r / NMODW, n = r % NMODW;
        modf[i] = mod_val(a, l, b, n / DM, n % DM);
    }
}
__device__ __forceinline__ void unpack8(const v4u w, float (&f)[8]) {
#pragma unroll
    for (int e = 0; e < 4; ++e) { f[2 * e] = bf_lo(w[e]); f[2 * e + 1] = bf_hi(w[e]); }
}
__device__ __forceinline__ v4u pack8(const float (&f)[8]) { return (v4u){pk2(f[0], f[1]), pk2(f[2], f[3]), pk2(f[4], f[5]), pk2(f[6], f[7])}; }
__device__ __forceinline__ void rowwise_phase(const Args& a, LAS unsigned char* lds, bool from_partials, bool has_y, bool has_h, bool xin_bf, int xout_mode,
        const void* xin, const bf16* y, float* xout, bf16* xoutb, bf16* hout,
        int l_y, int gate_idx, const float* g_post, int l_h, int shift_idx, int scale_idx, const float* g_pre) {
    int tid_ = threadIdx.x; asm volatile("" : "+v"(tid_)); const int tid = tid_, lane = tid & 63, wave = tid >> 6;
    LAS float* vec = (LAS float*)lds;
    for (int tile = blockIdx.x; tile < T / 256; tile += gridDim.x) {
        const int b = tile / (SEQ / 256);
        __syncthreads();
        for (int col = tid; col < DM; col += 512) {
            if (from_partials) {
                if (has_y) vec[col] = mod_val(a, l_y, b, gate_idx, col) * g_post[col];
                if (has_h) { vec[DM + col] = g_pre[col] * (1.0f + mod_val(a, l_h, b, scale_idx, col)); vec[2 * DM + col] = mod_val(a, l_h, b, shift_idx, col); }
            } else {
                if (has_y) vec[col] = mod_fin(a, l_y, b, gate_idx, col) * g_post[col];
                if (has_h) { vec[DM + col] = g_pre[col] * (1.0f + mod_fin(a, l_h, b, scale_idx, col)); vec[2 * DM + col] = mod_fin(a, l_h, b, shift_idx, col); }
            }
        }
        __syncthreads();
#pragma unroll 1
        for (int r = wave * 4; r < 256; r += 32) {
            float v[4][2][8]; v4u yv[4][2];
#pragma unroll
            for (int h = 0; h < 4; ++h)
#pragma unroll
                for (int j = 0; j < 2; ++j) { const size_t off = ((size_t)tile * 256 + r + h) * DM + 8 * lane + 512 * j;
                    if (xin_bf) unpack8(__builtin_nontemporal_load((const v4u*)((const bf16*)xin + off)), v[h][j]);
                    else { const f32x4 p0 = __builtin_nontemporal_load((const f32x4*)((const float*)xin + off)), p1 = __builtin_nontemporal_load((const f32x4*)((const float*)xin + off + 4));
                        v[h][j][0] = p0.x; v[h][j][1] = p0.y; v[h][j][2] = p0.z; v[h][j][3] = p0.w; v[h][j][4] = p1.x; v[h][j][5] = p1.y; v[h][j][6] = p1.z; v[h][j][7] = p1.w; }
                    yv[h][j] = has_y ? __builtin_nontemporal_load((const v4u*)(y + off)) : (v4u){0u, 0u, 0u, 0u}; }
            if (has_y) {
                float rstd[4];
#pragma unroll
                for (int h = 0; h < 4; ++h) { float ss = 0.f;
#pragma unroll
                    for (int j = 0; j < 2; ++j) { float yf[8]; unpack8(yv[h][j], yf);
#pragma unroll
                        for (int e = 0; e < 8; ++e) ss += yf[e] * yf[e]; }
                    rstd[h] = __builtin_amdgcn_rsqf(wave_sum(ss) * (1.0f / DM) + EPS); }
#pragma unroll
                for (int j = 0; j < 2; ++j) { const LAS float* gpp = vec + 8 * lane + 512 * j; const f32x4 g0 = *(const LAS f32x4*)gpp, g1 = *(const LAS f32x4*)(gpp + 4);
                    const float gp[8] = {g0.x, g0.y, g0.z, g0.w, g1.x, g1.y, g1.z, g1.w};
#pragma unroll
                    for (int h = 0; h < 4; ++h) { float yf[8]; unpack8(yv[h][j], yf);
#pragma unroll
                        for (int e = 0; e < 8; ++e) v[h][j][e] += gp[e] * (yf[e] * rstd[h]); } }
            }
            if (xout_mode == 1) {
#pragma unroll
                for (int h = 0; h < 4; ++h)
#pragma unroll
                    for (int j = 0; j < 2; ++j) { float* o = xout + ((size_t)tile * 256 + r + h) * DM + 8 * lane + 512 * j;
                        __builtin_nontemporal_store((f32x4){v[h][j][0], v[h][j][1], v[h][j][2], v[h][j][3]}, (f32x4*)o); __builtin_nontemporal_store((f32x4){v[h][j][4], v[h][j][5], v[h][j][6], v[h][j][7]}, (f32x4*)(o + 4)); }
            } else if (xout_mode == 2) {
#pragma unroll
                for (int h = 0; h < 4; ++h)
#pragma unroll
                    for (int j = 0; j < 2; ++j) { const v4u w = pack8(v[h][j]);
                        __builtin_nontemporal_store(w, (v4u*)(xoutb + ((size_t)tile * 256 + r + h) * DM + 8 * lane + 512 * j));
                        unpack8(w, v[h][j]); }
            }
            if (has_h) {
                float rstd[4];
#pragma unroll
                for (int h = 0; h < 4; ++h) { float ss = 0.f;
#pragma unroll
                    for (int j = 0; j < 2; ++j)
#pragma unroll
                        for (int e = 0; e < 8; ++e) ss += v[h][j][e] * v[h][j][e];
                    rstd[h] = __builtin_amdgcn_rsqf(wave_sum(ss) * (1.0f / DM) + EPS); }
#pragma unroll
                for (int j = 0; j < 2; ++j) { const LAS float* gsp = vec + DM + 8 * lane + 512 * j; const LAS float* shp = vec + 2 * DM + 8 * lane + 512 * j;
                    const f32x4 a0 = *(const LAS f32x4*)gsp, a1 = *(const LAS f32x4*)(gsp + 4), b0 = *(const LAS f32x4*)shp, b1 = *(const LAS f32x4*)(shp + 4);
                    const float gs[8] = {a0.x, a0.y, a0.z, a0.w, a1.x, a1.y, a1.z, a1.w}, sh[8] = {b0.x, b0.y, b0.z, b0.w, b1.x, b1.y, b1.z, b1.w};
#pragma unroll
                    for (int h = 0; h < 4; ++h) { float hv[8];
#pragma unroll
                        for (int e = 0; e < 8; ++e) hv[e] = v[h][j][e] * rstd[h] * gs[e] + sh[e];
                        *(v4u*)(hout + ((size_t)tile * 256 + r + h) * DM + 8 * lane + 512 * j) = pack8(hv); } }
            }
        }
    }
}

typedef short v4i16a_t __attribute__((ext_vector_type(4)));
__device__ __forceinline__ v2u lds_tr_a(const LAS bf16* p) { return __builtin_bit_cast(v2u, __builtin_amdgcn_ds_read_tr16_b64_v4i16((LAS v4i16a_t*)p)); }
__device__ __forceinline__ void attn_phase(LAS unsigned char* lds, const bf16* PROJ, bf16* CONCAT, const float* sinks) {
    int tid_ = threadIdx.x; asm volatile("" : "+v"(tid_)); const int tid = tid_, lane = tid & 63, wave = tid >> 6, fr = lane & 15, fq = lane >> 4;
    LAS bf16* Ks = (LAS bf16*)lds;
    LAS bf16* Vs = (LAS bf16*)(lds + 36864);
    v4u kv[4], vv[4];
#define ATT_LOAD_KV(uu) do { const int kh_ = (uu) & 1, n_ = ((uu) >> 1) & 63, b_ = (uu) >> 7; const long rb_ = (long)b_ * SEQ + n_ * 128 - 128; \
        _Pragma("unroll") for (int i = 0; i < 4; ++i) { const int kj = lane + 64 * i; kv[i] = (v4u){0u, 0u, 0u, 0u}; vv[i] = (v4u){0u, 0u, 0u, 0u}; \
            if (n_ > 0 || kj >= 128) { const bf16* p = PROJ + (size_t)(rb_ + kj) * INW + kh_ * 64 + wave * 8; kv[i] = *(const v4u*)(p + 512); vv[i] = *(const v4u*)(p + 640); } } } while (0)
    bf16x8 qf[4][2];
#define ATT_LOAD_Q(uu) do { const int kh_ = (uu) & 1, n_ = ((uu) >> 1) & 63, b_ = (uu) >> 7; const size_t qr_ = (size_t)b_ * SEQ + n_ * 128 + (wave & 1) * 64 + fr; \
        _Pragma("unroll") for (int i = 0; i < 4; ++i) { const bf16* qp = PROJ + (qr_ + 16 * i) * INW + (kh_ * 4 + (wave >> 1)) * 64 + 8 * fq; \
            qf[i][0] = __builtin_nontemporal_load((const bf16x8*)qp); qf[i][1] = __builtin_nontemporal_load((const bf16x8*)(qp + 32)); } } while (0)
    if ((int)blockIdx.x < NB * 64 * 2) { ATT_LOAD_KV((int)blockIdx.x); ATT_LOAD_Q((int)blockIdx.x); }
    for (int u = blockIdx.x; u < NB * 64 * 2; u += gridDim.x) {
        const int kh = u & 1, n = (u >> 1) & 63, b = u >> 7;
        const int g = wave >> 1, h = kh * 4 + g;
        const size_t qrow0 = (size_t)b * SEQ + n * 128 + (wave & 1) * 64 + fr;
#pragma unroll
        for (int i = 0; i < 4; ++i) { const int kj = lane + 64 * i;
            *(LAS v4u*)(Ks + kj * 72 + wave * 8) = kv[i];
            *(LAS v4u*)(Vs + kj * 72 + wave * 8) = vv[i]; }
        __syncthreads();
        if (u + (int)gridDim.x < NB * 64 * 2) ATT_LOAD_KV(u + (int)gridDim.x);
        const float sink = sinks[h];
        const int firstblk = (n == 0);
#pragma unroll
        for (int p = 0; p < 2; ++p) {
            const int q16a = (wave & 1) * 4 + 2 * p, kt0 = q16a;
            f32x4 st[2][10];
            bf16x8 kfr[10][2];
            const LAS bf16* kp0 = Ks + (16 * kt0 + fr) * 72 + 8 * fq;
#define ATT_LDK(t) do { kfr[t][0] = *(const LAS bf16x8*)(kp0 + (t) * 16 * 72); kfr[t][1] = *(const LAS bf16x8*)(kp0 + (t) * 16 * 72 + 32); } while (0)
            ATT_LDK(0);
#pragma unroll
            for (int t = 0; t < 10; ++t) {
                if (t + 1 < 10) ATT_LDK(t + 1);
#pragma unroll
                for (int x = 0; x < 2; ++x) {
                    if (x + 8 - t == 9 || x + 8 - t == -1) { st[x][t] = (f32x4){-1e30f, -1e30f, -1e30f, -1e30f}; continue; }
                    f32x4 acc = (f32x4){0.f, 0.f, 0.f, 0.f};
                    acc = __builtin_amdgcn_mfma_f32_16x16x32_bf16(kfr[t][0], qf[2 * p + x][0], acc, 0, 0, 0);
                    acc = __builtin_amdgcn_mfma_f32_16x16x32_bf16(kfr[t][1], qf[2 * p + x][1], acc, 0, 0, 0);
                    st[x][t] = acc;
                }
            }
#undef ATT_LDK
            float inv[2];
#pragma unroll
            for (int x = 0; x < 2; ++x) {
                float mx = -1e30f;
#pragma unroll
                for (int t = 0; t < 10; ++t) {
                    const int D = x + 8 - t;
                    if (D == 9 || D == -1) continue;
                    const bool tile_off = firstblk && (kt0 + t < 8);
#pragma unroll
                    for (int r = 0; r < 4; ++r) { const int dl = fr - 4 * fq - r;
                        bool valid = !tile_off;
                        if (D == 8) valid = valid && (dl < 0);
                        if (D == 0) valid = valid && (dl >= 0);
                        const float sv = valid ? st[x][t][r] : -1e30f; st[x][t][r] = sv; mx = fmaxf(mx, sv); }
                }
                mx = fmaxf(mx, __shfl_xor(mx, 16)); mx = fmaxf(mx, __shfl_xor(mx, 32)); mx = fmaxf(mx, sink);
                const float mb = mx * LOG2E;
                float lsum = 0.f;
#pragma unroll
                for (int t = 0; t < 10; ++t) {
                    const int D = x + 8 - t;
                    if (D == 9 || D == -1) { st[x][t] = (f32x4){0.f, 0.f, 0.f, 0.f}; continue; }
#pragma unroll
                    for (int r = 0; r < 4; ++r) { const float pe = __builtin_amdgcn_exp2f(st[x][t][r] * LOG2E - mb); st[x][t][r] = pe; lsum += pe; }
                }
                lsum += __shfl_xor(lsum, 16); lsum += __shfl_xor(lsum, 32); lsum += __builtin_amdgcn_exp2f(sink * LOG2E - mb);
                inv[x] = 1.0f / lsum;
            }
            f32x4 ot[2][4];
#pragma unroll
            for (int x = 0; x < 2; ++x)
#pragma unroll
                for (int dt = 0; dt < 4; ++dt) ot[x][dt] = (f32x4){0.f, 0.f, 0.f, 0.f};
            const LAS bf16* vp0 = Vs + (16 * kt0 + 4 * fq + (fr >> 2)) * 72 + 4 * (fr & 3);
            v2u vlo[5][4], vhi[5][4];
#define ATT_LDV(s) do { _Pragma("unroll") for (int dt = 0; dt < 4; ++dt) { vlo[s][dt] = lds_tr_a(vp0 + (s) * 32 * 72 + 16 * dt); vhi[s][dt] = lds_tr_a(vp0 + (s) * 32 * 72 + 16 * 72 + 16 * dt); } } while (0)
#pragma unroll
            for (int s2 = 0; s2 < 5; ++s2) {
                ATT_LDV(s2);
                bf16x8 pf[2];
#pragma unroll
                for (int x = 0; x < 2; ++x) { v4u pw; pw.x = pk2(st[x][2 * s2][0], st[x][2 * s2][1]); pw.y = pk2(st[x][2 * s2][2], st[x][2 * s2][3]);
                    pw.z = pk2(st[x][2 * s2 + 1][0], st[x][2 * s2 + 1][1]); pw.w = pk2(st[x][2 * s2 + 1][2], st[x][2 * s2 + 1][3]); pf[x] = __builtin_bit_cast(bf16x8, pw); }
#pragma unroll
                for (int dt = 0; dt < 4; ++dt) {
                    const bf16x8 vf = __builtin_bit_cast(bf16x8, (v4u){vlo[s2][dt].x, vlo[s2][dt].y, vhi[s2][dt].x, vhi[s2][dt].y});
#pragma unroll
                    for (int x = 0; x < 2; ++x) ot[x][dt] = __builtin_amdgcn_mfma_f32_16x16x32_bf16(vf, pf[x], ot[x][dt], 0, 0, 0);
                }
            }
#undef ATT_LDV
#pragma unroll
            for (int x = 0; x < 2; ++x) {
                LAS bf16* stg = (LAS bf16*)(lds + 73728) + (wave * 2 + x) * (16 * 72);
#pragma unroll
                for (int dt = 0; dt < 4; ++dt) *(LAS v2u*)(stg + fr * 72 + 16 * dt + 4 * fq) = (v2u){pk2(ot[x][dt][0] * inv[x], ot[x][dt][1] * inv[x]), pk2(ot[x][dt][2] * inv[x], ot[x][dt][3] * inv[x])};
                bf16* op = CONCAT + (qrow0 - fr + 16 * (2 * p + x)) * DM + h * 64;
#pragma unroll
                for (int i = 0; i < 2; ++i) { const int row = 8 * i + (lane >> 3), chn = lane & 7;
                    *(v4u*)(op + (size_t)row * DM + chn * 8) = *(const LAS v4u*)(stg + row * 72 + chn * 8); }
            }
        }
        if (u + (int)gridDim.x < NB * 64 * 2) ATT_LOAD_Q(u + (int)gridDim.x);
        __syncthreads();
    }
#undef ATT_LOAD_KV
#undef ATT_LOAD_Q
}

constexpr int PL_US = 136;
template <int W> __device__ __forceinline__ void pool_load(const bf16* PROJ, int gi, int tt, int lane, v4u (&raw)[8]) {
    const size_t t0 = (size_t)tt * 16; const int s0 = (int)(t0 & (SEQ - 1));
    const int ch = lane & 15, rs = lane >> 4;
#pragma unroll
    for (int i = 0; i < 8; ++i) { const int r = rs + 4 * i;
        raw[i] = (v4u){0u, 0u, 0u, 0u};
        if (4 * i + 3 >= 17 - W) { if (s0 - 16 + r >= 0) raw[i] = *(const v4u*)(PROJ + (t0 - 16 + r) * INW + 768 + gi * 128 + ch * 8); } }
}
typedef short v4i16_t __attribute__((ext_vector_type(4)));
__device__ __forceinline__ v2u lds_tr(const LAS bf16* p) { return __builtin_bit_cast(v2u, __builtin_amdgcn_ds_read_tr16_b64_v4i16((LAS v4i16_t*)p)); }
template <int W> __device__ __forceinline__ void pool_compute(bf16* CONCAT, const LAS bf16* wl, LAS bf16* ust, const float* pscale, int gi, int tt, int lane, const v4u (&raw)[8]) {
    const int fr = lane & 15, fq = lane >> 4;
    const size_t t0 = (size_t)tt * 16; const int s0 = (int)(t0 & (SEQ - 1));
    {
        const int ch = lane & 15, rs = lane >> 4;
#pragma unroll
        for (int i = 0; i < 8; ++i) { const int r = rs + 4 * i; if (4 * i + 3 >= 17 - W) *(LAS v4u*)(ust + r * PL_US + ch * 8) = raw[i]; }
    }
    const int s = s0 + fr;
    const int cnt = (s + 1 < W) ? (s + 1) : W;
    const float invc = 1.0f / (float)cnt;
    bf16x8 band;
    { float bv[8];
#pragma unroll
      for (int j = 0; j < 8; ++j) { const int rel = 8 * fq + j - 16 - fr;
          bv[j] = ((rel > -W && rel <= 0) ? 1.0f : 0.0f) - ((rel == 0) ? (float)cnt : 0.0f); }
      band = __builtin_bit_cast(bf16x8, (v4u){pk2(bv[0], bv[1]), pk2(bv[2], bv[3]), pk2(bv[4], bv[5]), pk2(bv[6], bv[7])}); }
    f32x4 pl[8];
    const LAS bf16* trp = ust + (8 * fq + ((lane & 15) >> 2)) * PL_US + 4 * (lane & 3);
#pragma unroll
    for (int a = 0; a < 8; ++a) {
        const v2u lo = lds_tr(trp + 16 * a), hi = lds_tr(trp + 4 * PL_US + 16 * a);
        const bf16x8 ua = __builtin_bit_cast(bf16x8, (v4u){lo.x, lo.y, hi.x, hi.y});
        pl[a] = __builtin_amdgcn_mfma_f32_16x16x32_bf16(ua, band, (f32x4){0.f, 0.f, 0.f, 0.f}, 0, 0, 0);
    }
    bf16x8 pf[4];
#pragma unroll
    for (int ks = 0; ks < 4; ++ks)
        pf[ks] = __builtin_bit_cast(bf16x8, (v4u){pk2(pl[2 * ks][0] * invc, pl[2 * ks][1] * invc), pk2(pl[2 * ks][2] * invc, pl[2 * ks][3] * invc),
                                                  pk2(pl[2 * ks + 1][0] * invc, pl[2 * ks + 1][1] * invc), pk2(pl[2 * ks + 1][2] * invc, pl[2 * ks + 1][3] * invc)});
#pragma unroll
    for (int nt = 0; nt < 8; ++nt) {
        f32x4 acc = (f32x4){0.f, 0.f, 0.f, 0.f};
        const LAS bf16* wp = wl + (16 * nt + fr) * PL_US + 4 * fq;
#pragma unroll
        for (int ks = 0; ks < 4; ++ks) { const v2u lo = *(const LAS v2u*)(wp + 32 * ks), hi = *(const LAS v2u*)(wp + 32 * ks + 16);
            acc = __builtin_amdgcn_mfma_f32_16x16x32_bf16(__builtin_bit_cast(bf16x8, (v4u){lo.x, lo.y, hi.x, hi.y}), pf[ks], acc, 0, 0, 0); }
        const int d = gi * 128 + 16 * nt + 4 * fq;
        const f32x4 sc = *(const f32x4*)(pscale + d);
        *(LAS v2u*)(ust + fr * PL_US + 16 * nt + 4 * fq) = (v2u){pk2(acc[0] * sc.x, acc[1] * sc.y), pk2(acc[2] * sc.z, acc[3] * sc.w)};
    }
#pragma unroll
    for (int i = 0; i < 4; ++i) { const int row = 4 * i + (lane >> 4), chn = lane & 15;
        const v4u w = *(const LAS v4u*)(ust + row * PL_US + chn * 8);
        *(v4u*)(CONCAT + (t0 + row) * DM + 512 + gi * 128 + chn * 8) = w; }
}
template <int W> __device__ __forceinline__ void pool_group(const bf16* PROJ, bf16* CONCAT, const LAS bf16* wl, LAS bf16* ust, const float* pscale, int gi, int gw, int ngw, int lane) {
    v4u ra[8], rb[8];
    {
        const int ch = lane & 15, rs = lane >> 4;
#pragma unroll
        for (int i = 0; i < 8; ++i) if (!(4 * i + 3 >= 17 - W)) *(LAS v4u*)(ust + (rs + 4 * i) * PL_US + ch * 8) = (v4u){0u, 0u, 0u, 0u};
    }
    int tt = gw;
    if (tt < T / 16) pool_load<W>(PROJ, gi, tt, lane, ra);
    while (tt < T / 16) {
        const int tn = tt + ngw;
        if (tn < T / 16) pool_load<W>(PROJ, gi, tn, lane, rb);
        pool_compute<W>(CONCAT, wl, ust, pscale, gi, tt, lane, ra);
        tt = tn;
        if (tt >= T / 16) break;
        const int tn2 = tt + ngw;
        if (tn2 < T / 16) pool_load<W>(PROJ, gi, tn2, lane, ra);
        pool_compute<W>(CONCAT, wl, ust, pscale, gi, tt, lane, rb);
        tt = tn2;
    }
}
__device__ __forceinline__ void pool_phase(LAS unsigned char* lds, const bf16* PROJ, bf16* CONCAT, const bf16* PWT, const float* pscale) {
    int tid_ = threadIdx.x; asm volatile("" : "+v"(tid_)); const int tid = tid_, lane = tid & 63, wave = tid >> 6;
    LAS bf16* wl = (LAS bf16*)lds;
    LAS bf16* ust = (LAS bf16*)(lds + 36864 + wave * 8704);
    const bool quad = (gridDim.x & 3) == 0;
    const int gw = quad ? (int)(blockIdx.x >> 2) * 8 + wave : (int)blockIdx.x * 8 + wave, ngw = quad ? (int)(gridDim.x >> 2) * 8 : (int)gridDim.x * 8;
#pragma unroll 1
    for (int g = 0; g < (quad ? 1 : 4); ++g) {
        const int gi = quad ? (int)(blockIdx.x & 3) : g;
        __syncthreads();
        { const int row = tid >> 2, q = tid & 3; const bf16* src = PWT + ((size_t)gi * 128 + row) * 128 + q * 32;
#pragma unroll
          for (int e = 0; e < 4; ++e) *(LAS v4u*)(wl + row * PL_US + q * 32 + e * 8) = *(const v4u*)(src + e * 8); }
        __syncthreads();
        if (gi == 0) pool_group<2>(PROJ, CONCAT, wl, ust, pscale, gi, gw, ngw, lane);
        else if (gi == 1) pool_group<4>(PROJ, CONCAT, wl, ust, pscale, gi, gw, ngw, lane);
        else if (gi == 2) pool_group<8>(PROJ, CONCAT, wl, ust, pscale, gi, gw, ngw, lane);
        else pool_group<16>(PROJ, CONCAT, wl, ust, pscale, gi, gw, ngw, lane);
    }
    __syncthreads();
}

#ifndef REP_P
#define REP_P 1
#endif
#ifndef REP_G
#define REP_G 1
#endif
#ifndef REP_R
#define REP_R 1
#endif
#ifndef REP_G
#define REP_G 1
#endif
#ifndef REP_IN
#define REP_IN REP_G
#endif
#ifndef REP_GU
#define REP_GU REP_G
#endif
#ifndef REP_DN
#define REP_DN REP_G
#endif
#ifndef REP_PL
#define REP_PL 1
#endif
#ifndef REP_A
#define REP_A 1
#endif
__global__ void __launch_bounds__(512, 2) fwd_kernel(Args a) {
    extern __shared__ __attribute__((aligned(16))) unsigned char lds_raw[];
    cg::grid_group grid = cg::this_grid();
    LAS unsigned char* lds = (LAS unsigned char*)lds_raw;
    unsigned char* ws = a.ws;
    bf16* H = (bf16*)(ws + WS_H); bf16* MIX = (bf16*)(ws + WS_MIX); bf16* PROJ = (bf16*)(ws + WS_PROJ);
    bf16* CONCAT = (bf16*)(ws + WS_CONCAT); bf16* ACT = (bf16*)(ws + WS_ACT);
    const float* cs = (const float*)(ws + WS_CS); bf16* XA = (bf16*)(ws + WS_XA); bf16* XB = (bf16*)(ws + WS_XB);
    volatile LAS unsigned* MISC = (volatile LAS unsigned*)(lds + RING_BYTES + 64);
    if (threadIdx.x == 0) { MISC[0] = 0u; MISC[1] = 0u; }
    __syncthreads();
    XcdBarrier bar = xcd_barrier_post((unsigned*)ws, MISC);
#define SEAM() xcd_barrier(bar)

    for (int rep = 0; rep < REP_P; ++rep) prologue(a, lds);
    if (a.ws == nullptr) grid.sync();
    SEAM();
    for (int rep = 0; rep < REP_R; ++rep) rowwise_phase(a, lds, true, false, true, false, 2, a.x, nullptr, nullptr, XB, H, 0, 0, nullptr, 0, 0, 1, a.g_pre_mix);
    mod_finalize(a);
    SEAM();
#pragma unroll 1
    for (int l = 0; l < DEPTH; ++l) {
        unsigned char* wl = ws + WS_W + (size_t)l * W_LAYER;
        for (int rep = 0; rep < REP_IN; ++rep) {
            pg8::Gemm g{H, (const bf16*)(wl + W_IN), T, INW, DM}; pg8::StaticOrder S; S.init(T, INW, gridDim.x, blockIdx.x);
            pg8::EpiInProj E{PROJ, a.b_in + l * INW, cs};
            pg8::gemm_phase<pg8::EpiInProj, pg8::StaticOrder, true, true>(lds, g, S, E);
        }
        SEAM();
        for (int rep = 0; rep < REP_A; ++rep) attn_phase(lds, PROJ, CONCAT, a.sinks + l * 8);
        for (int rep = 0; rep < REP_PL; ++rep) pool_phase(lds, PROJ, CONCAT, (const bf16*)(wl + W_PW), a.pool_scale + l * 512);
        SEAM();
        for (int rep = 0; rep < REP_G; ++rep) {
            pg8::Gemm g{CONCAT, (const bf16*)(wl + W_OUT), T, DM, DM}; pg8::StaticOrder S; S.init(T, DM, gridDim.x, blockIdx.x);
            pg8::EpiBf16<0> E{MIX, DM, nullptr, 0, 0, 1.f};
            pg8::gemm_phase<pg8::EpiBf16<0>, pg8::StaticOrder, true, true>(lds, g, S, E);
        }
        SEAM();
        for (int rep = 0; rep < REP_R; ++rep) rowwise_phase(a, lds, false, true, true, true, 2, XB, MIX, nullptr, XA, H, l, 2, a.g_post_mix + l * DM, l, 3, 4, a.g_pre_ffn + l * DM);
        SEAM();
#if defined(PROBE_HOT)
#pragma unroll 1
        for (int rep = 0; rep < 2; ++rep) {
            pg8::Gemm g{H, (const bf16*)(wl + W_GU), T, 2 * DFF, rep == 0 ? PROBE_HOT_K : DM}; pg8::DualOrder S; S.so.init(T, 2 * DFF, gridDim.x, blockIdx.x); S.c = blockIdx.x; S.rounds = 22; S.hot = (rep == 0);
            pg8::EpiSwiGLU E{rep == 0 ? MIX : ACT};
            pg8::gemm_phase<pg8::EpiSwiGLU, pg8::DualOrder, true, true>(lds, g, S, E);
            if (rep == 0) SEAM();
        }
#else
        for (int rep = 0; rep < REP_GU; ++rep) {
            pg8::Gemm g{H, (const bf16*)(wl + W_GU), T, 2 * DFF, DM}; pg8::StaticOrder S; S.init(T, 2 * DFF, gridDim.x, blockIdx.x);
            pg8::EpiSwiGLU E{ACT};
            pg8::gemm_phase<pg8::EpiSwiGLU, pg8::StaticOrder, true, true>(lds, g, S, E);
        }
#endif
        SEAM();
        for (int rep = 0; rep < REP_DN; ++rep) {
            pg8::Gemm g{ACT, (const bf16*)(wl + W_DN), T, DM, DFF}; pg8::StaticOrder S; S.init(T, DM, gridDim.x, blockIdx.x, 1);
            pg8::EpiBf16<0> E{MIX, DM, nullptr, 0, 0, 1.f};
            pg8::gemm_phase<pg8::EpiBf16<0>, pg8::StaticOrder, true, true>(lds, g, S, E);
        }
        SEAM();
        const bool more = (l + 1 < DEPTH);
        for (int rep = 0; rep < REP_R; ++rep) rowwise_phase(a, lds, false, true, more, true, more ? 2 : 1, XA, MIX, a.out, XB, H, l, 5, a.g_post_ffn + l * DM, l + 1, 0, 1, a.g_pre_mix + (more ? (l + 1) * DM : 0));
        if (more) SEAM();
    }
}

extern "C" void kernel_launch(void* const* d_in, const int* in_sizes, int n_in, void* d_out, int out_size, void* d_ws, size_t ws_size, hipStream_t stream) {
    static int grid_blocks = 0;
    if (grid_blocks == 0) {
        if (n_in != 18 || out_size != T * DM || ws_size < WS_END) { fprintf(stderr, "kernel_launch: unexpected shapes (n_in %d, out %d, ws %zu)\n", n_in, out_size, ws_size); grid_blocks = -1; return; }
        int dev = 0, cus = 0, per_cu = 0;
        hipGetDevice(&dev);
        hipDeviceGetAttribute(&cus, hipDeviceAttributeMultiprocessorCount, dev);
        if (hipFuncSetAttribute((const void*)fwd_kernel, hipFuncAttributeMaxDynamicSharedMemorySize, LDS_BYTES) != hipSuccess) { fprintf(stderr, "kernel_launch: hipFuncSetAttribute failed\n"); grid_blocks = -1; return; }
        if (hipOccupancyMaxActiveBlocksPerMultiprocessor(&per_cu, (const void*)fwd_kernel, 512, LDS_BYTES) != hipSuccess || per_cu < 1) { fprintf(stderr, "kernel_launch: occupancy query gave %d\n", per_cu); per_cu = 1; }
        (void)hipGetLastError();
        grid_blocks = cus * per_cu;
    }
    if (grid_blocks < 0) return;
    if (hipMemsetAsync(d_ws, 0, 65536, stream) != hipSuccess) { fprintf(stderr, "kernel_launch: memset failed\n"); return; }
    Args a{};
    a.x = (const float*)d_in[0]; a.c = (const float*)d_in[1]; a.pos = (const int*)d_in[2]; a.ada_w = (const float*)d_in[3]; a.ada_b = (const float*)d_in[4];
    a.w_in = (const float*)d_in[5]; a.b_in = (const float*)d_in[6]; a.sinks = (const float*)d_in[7]; a.pool_w = (const float*)d_in[8]; a.pool_scale = (const float*)d_in[9];
    a.w_out = (const float*)d_in[10]; a.w_gate = (const float*)d_in[11]; a.w_up = (const float*)d_in[12]; a.w_down = (const float*)d_in[13];
    a.g_pre_mix = (const float*)d_in[14]; a.g_post_mix = (const float*)d_in[15]; a.g_pre_ffn = (const float*)d_in[16]; a.g_post_ffn = (const float*)d_in[17];
    a.out = (float*)d_out; a.ws = (unsigned char*)d_ws;
    void* args[] = {&a};
    hipError_t e = hipLaunchCooperativeKernel((const void*)fwd_kernel, dim3(grid_blocks), dim3(512), args, LDS_BYTES, stream);
    if (e != hipSuccess) fprintf(stderr, "cooperative launch failed: %s (grid %d)\n", hipGetErrorString(e), grid_blocks);
}
```

```cpp
#include <hip/hip_runtime.h>
#include <hip/hip_cooperative_groups.h>
#include <cstdio>
#include <cstdint>
namespace cg = cooperative_groups;
#define LAS __attribute__((address_space(3)))
namespace pg8 {
#define PG8_LAS __attribute__((address_space(3)))
typedef unsigned short bf16_t;
typedef short bf16x8 __attribute__((ext_vector_type(8)));
typedef float f32x4 __attribute__((ext_vector_type(4)));
typedef unsigned u32x4 __attribute__((ext_vector_type(4)));
constexpr int BM = 256, BK = 64, HALF = 128, HTB = HALF * BK * 2  , STAGE_BYTES = 8 * HTB, NXCD = 8, WGM = 4;

__host__ __device__ __forceinline__ int lds_byte(int r, int c) { const int st = (r >> 4) * 2 + (c >> 5), rr = r & 15, cc = c & 31, ob = rr * 64 + cc * 2; return st * 1024 + (ob ^ (((ob >> 9) & 1) << 5)); }
__host__ __device__ __forceinline__ void stage_rc(int b, int& R, int& C) { const int st = b / 1024, sb = b % 1024, swz = sb ^ (((sb >> 9) & 1) << 5); R = (st >> 1) * 16 + swz / 64; C = (st & 1) * 32 + (swz % 64) / 2; }
__host__ __device__ __forceinline__ int perm32(int rho) { const int n = rho >> 4, i = rho & 15; return 8 * (i >> 2) + 4 * n + (i & 3); }

struct Unit { int pm, pn; };
struct Gemm { const bf16_t* A; const bf16_t* Bt; int M, N, K; };

struct StaticOrder {
    int nM, nN, nwg, G, c, rev;
    __host__ __device__ void init(int M, int N, int G_, int c_, int rev_ = 0) { nM = M / BM; nN = N / BM; nwg = nM * nN; G = G_; c = c_; rev = rev_; }
    __host__ __device__ bool next(int i, Unit& u) const {
        const long L = (long)i * G + c; if (L >= nwg) return false;
        int wgid = (int)L; { const int q = nwg / NXCD, r = nwg % NXCD, xcd = wgid % NXCD, off = wgid / NXCD; wgid = (xcd < r ? xcd * (q + 1) : r * (q + 1) + (xcd - r) * q) + off; }
        const int nig = WGM * nN, gid = wgid / nig, fm = gid * WGM, gsz = (nM - fm) < WGM ? (nM - fm) : WGM;
        u.pm = fm + ((wgid % nig) % gsz); u.pn = (wgid % nig) / gsz; if (rev) u.pm = nM - 1 - u.pm; return true;
    }
    __device__ __forceinline__ void a_ready(const Unit&) const {}
    __device__ __forceinline__ void done(const Unit&) const {}
};

__device__ __forceinline__ unsigned cvt_pk_bf16(float lo, float hi) { unsigned r; asm volatile("v_cvt_pk_bf16_f32 %0, %1, %2" : "=v"(r) : "v"(lo), "v"(hi)); return r; }
typedef float f32x2 __attribute__((ext_vector_type(2)));
__device__ __forceinline__ f32x2 gelu_pk(f32x2 v) {
    const f32x2 av = __builtin_elementwise_abs(v), d = av * 0.2316418882f + 1.0f;
    f32x2 t; t.x = __builtin_amdgcn_rcpf(d.x); t.y = __builtin_amdgcn_rcpf(d.y);
    f32x2 q = t * 0.5307027145f + (-0.7265760135f); q = q * t + 0.7107068705f; q = q * t + (-0.142248368f); q = q * t + 0.127414796f; q = q * t;
    const f32x2 s = (v * v) * (-0.72134752044f);
    f32x2 e; e.x = __builtin_amdgcn_exp2f(s.x); e.y = __builtin_amdgcn_exp2f(s.y);
    const f32x2 m = v * (q * e), r = v - m;
    f32x2 o; o.x = v.x < 0.f ? m.x : r.x; o.y = v.y < 0.f ? m.y : r.y; return o;
}

template <int ACT  > struct EpiBf16 {
    static constexpr bool PERM = true, AFTER_DRAIN = false; static_assert(ACT == 0 || ACT == 1, "EpiBf16: ACT is 0 (none) or 1 (gelu_pk)");
    bf16_t* O; int ldc; const float* bias; int split_cols; size_t split_stride; float scale0;
    __device__ __forceinline__ void operator()(const f32x4 (&acc)[2][2][4][2], const Unit& u, int wr, int wc, int fr, int fq) const {
        const int row0 = u.pm * BM + wr * 64 + fr; int colt = u.pn * BM; bf16_t* base = O;
        float sc = 1.f; if (split_cols) { const int t = colt / split_cols; base += (size_t)t * split_stride; colt -= t * split_cols; if (t == 0) sc = scale0; }
        const int col0 = colt + wc * 32 + 8 * fq, bcol0 = u.pn * BM + wc * 32 + 8 * fq;
        f32x4 bv[2][2];
#pragma unroll
        for (int bj = 0; bj < 2; ++bj)
#pragma unroll
            for (int n = 0; n < 2; ++n) bv[bj][n] = bias ? *(const f32x4*)(bias + bcol0 + bj * HALF + 4 * n) : (f32x4){0.f, 0.f, 0.f, 0.f};
#pragma unroll
        for (int ai = 0; ai < 2; ++ai)
#pragma unroll
            for (int m = 0; m < 4; ++m) { bf16_t* rowp = base + (size_t)(row0 + ai * HALF + m * 16) * ldc + col0;
#pragma unroll
                for (int bj = 0; bj < 2; ++bj) { f32x4 v0 = acc[ai][bj][m][0] + bv[bj][0], v1 = acc[ai][bj][m][1] + bv[bj][1];
                    if (ACT == 1) { f32x2 a = gelu_pk((f32x2){v0[0], v0[1]}), b = gelu_pk((f32x2){v0[2], v0[3]}), c = gelu_pk((f32x2){v1[0], v1[1]}), d = gelu_pk((f32x2){v1[2], v1[3]});
                        v0 = (f32x4){a.x, a.y, b.x, b.y}; v1 = (f32x4){c.x, c.y, d.x, d.y}; }
                    v0 = v0 * sc; v1 = v1 * sc; u32x4 w; w.x = cvt_pk_bf16(v0[0], v0[1]); w.y = cvt_pk_bf16(v0[2], v0[3]); w.z = cvt_pk_bf16(v1[0], v1[1]); w.w = cvt_pk_bf16(v1[2], v1[3]);
                    *(u32x4*)(rowp + bj * HALF) = w; } }
    }
};
template <class Epi, class Sched, bool ALIGN_EPI = false, bool SP2 = false, int A_AUX = 0  >
__device__ __forceinline__ void gemm_phase(PG8_LAS unsigned char* lds, const Gemm g, const Sched& S, const Epi& E) {
    int tid_ = threadIdx.x; asm volatile("" : "+v"(tid_)); const int tid = tid_, wid = __builtin_amdgcn_readfirstlane(tid >> 6), lane = tid & 63, wr = wid >> 2, wc = wid & 3, fr = lane & 15, fq = lane >> 4;
    const int K = g.K, nt = K / BK;
    unsigned voffA[2], voffB[2];
#pragma unroll
    for (int i = 0; i < 2; ++i) { int R, C; stage_rc(tid * 16 + i * 8192, R, C); const int Rb = Epi::PERM ? ((R & ~31) + perm32(R & 31)) : R;
        voffA[i] = (unsigned)(R * K + C) * 2u; voffB[i] = (unsigned)(Rb * K + C) * 2u; }
    const size_t kstep = (size_t)(BK * 2);
    const size_t hstep = (size_t)HALF * K * 2;
    const size_t tstep = 2 * hstep;
    const unsigned ldsw = (unsigned)wid * 1024u;
    const int aoff = lds_byte(wr * 64 + fr, fq * 8), boff = lds_byte(wc * 32 + fr, fq * 8);
#define PG8_SA(b, h) (((b) * 2 + (h)) * HTB)
#define PG8_SB(b, h) ((4 + (b) * 2 + (h)) * HTB)
#define PG8_STAGE(bufoff, gbase, voff) do { _Pragma("unroll") for (int _i = 0; _i < 2; ++_i) \
        __builtin_amdgcn_global_load_lds((const unsigned*)((const char*)(gbase) + (voff)[_i]), (PG8_LAS unsigned*)(lds + (bufoff) + ldsw + _i * 8192), 16, 0, 0); } while (0)
#define PG8_STAGEA(bufoff, gbase, voff) do { _Pragma("unroll") for (int _i = 0; _i < 2; ++_i) \
        __builtin_amdgcn_global_load_lds((const unsigned*)((const char*)(gbase) + (voff)[_i]), (PG8_LAS unsigned*)(lds + (bufoff) + ldsw + _i * 8192), 16, 0, A_AUX); } while (0)
#define PG8_LDA(dst, b, h) do { _Pragma("unroll") for (int m = 0; m < 4; ++m) _Pragma("unroll") for (int k = 0; k < 2; ++k) dst[m][k] = *(const PG8_LAS bf16x8*)(lds + PG8_SA(b, h) + aoff + m * 2048 + k * 1024); } while (0)
#define PG8_LDB(dst, b, h) do { _Pragma("unroll") for (int n = 0; n < 2; ++n) _Pragma("unroll") for (int k = 0; k < 2; ++k) dst[n][k] = *(const PG8_LAS bf16x8*)(lds + PG8_SB(b, h) + boff + n * 2048 + k * 1024); } while (0)
#define PG8_MMA(ai, bj, At, Bt) do { __builtin_amdgcn_s_setprio(1); _Pragma("unroll") for (int m = 0; m < 4; ++m) _Pragma("unroll") for (int n = 0; n < 2; ++n) _Pragma("unroll") for (int k = 0; k < 2; ++k) \
        acc[ai][bj][m][n] = __builtin_amdgcn_mfma_f32_16x16x32_bf16(Bt[n][k], At[m][k], acc[ai][bj][m][n], 0, 0, 0); __builtin_amdgcn_s_setprio(0); } while (0)
#define PG8_WAIT_V(n) asm volatile("s_waitcnt vmcnt(" #n ")" ::: "memory")
#define PG8_WAIT_L(n) asm volatile("s_waitcnt lgkmcnt(" #n ")" ::: "memory")
#define PG8_BAR __builtin_amdgcn_s_barrier()
#define PG8_SCHED __builtin_amdgcn_sched_barrier(0)
    Unit cur, nxt; int ui = 0;
    if (!S.next(0, cur)) return;
    f32x4 acc[2][2][4][2];
#pragma unroll
    for (int a = 0; a < 2; ++a)
#pragma unroll
        for (int b = 0; b < 2; ++b)
#pragma unroll
            for (int m = 0; m < 4; ++m)
#pragma unroll
                for (int n = 0; n < 2; ++n) acc[a][b][m][n] = (f32x4){0.f, 0.f, 0.f, 0.f};
    bf16x8 At[4][2], B0[2][2], B1[2][2];
    const char* cA = (const char*)g.A + (size_t)cur.pm * tstep; const char* cB = (const char*)g.Bt + (size_t)cur.pn * tstep;
    S.a_ready(cur);
    if constexpr (SP2) {
        PG8_STAGE(PG8_SB(0, 0), cB, voffB); PG8_STAGE(PG8_SB(0, 1), cB + hstep, voffB); PG8_STAGEA(PG8_SA(0, 0), cA, voffA); PG8_STAGEA(PG8_SA(0, 1), cA + hstep, voffA);
        if (wr == 1) PG8_BAR;
        PG8_WAIT_V(2); PG8_BAR;
        PG8_STAGE(PG8_SB(1, 0), cB + kstep, voffB); PG8_STAGEA(PG8_SA(1, 0), cA + kstep, voffA); PG8_STAGE(PG8_SB(1, 1), cB + hstep + kstep, voffB);
        PG8_WAIT_V(6); PG8_BAR;
    } else {
        PG8_STAGE(PG8_SB(0, 0), cB, voffB); PG8_STAGEA(PG8_SA(0, 0), cA, voffA); PG8_STAGE(PG8_SB(0, 1), cB + hstep, voffB); PG8_STAGEA(PG8_SA(0, 1), cA + hstep, voffA);
        if (wr == 1) PG8_BAR;
        PG8_WAIT_V(4); PG8_BAR;
        PG8_STAGE(PG8_SB(1, 0), cB + kstep, voffB); PG8_STAGEA(PG8_SA(1, 0), cA + kstep, voffA); PG8_STAGE(PG8_SB(1, 1), cB + hstep + kstep, voffB);
        PG8_WAIT_V(6); PG8_BAR;
    }
    for (;;) {
        const bool has_next = S.next(ui + 1, nxt);
        const char* nA = has_next ? (const char*)g.A + (size_t)nxt.pm * tstep : cA; const char* nB = has_next ? (const char*)g.Bt + (size_t)nxt.pn * tstep : cB;
        for (int t = 0; t < nt; t += 2) {
            const bool last = (t == nt - 2);
            const char* a1 = cA + (size_t)(t + 1) * kstep;
            const char* a2 = last ? nA : cA + (size_t)(t + 2) * kstep; const char* b2 = last ? nB : cB + (size_t)(t + 2) * kstep;
            const char* a3 = a2 + kstep; const char* b3 = b2 + kstep;
            if (last && has_next) S.a_ready(nxt);
            if constexpr (SP2) {
            PG8_LDB(B0, 0, 0); PG8_LDB(B1, 0, 1); PG8_SCHED; PG8_LDA(At, 0, 0); PG8_STAGEA(PG8_SA(1, 1), a1 + hstep, voffA);
            PG8_WAIT_V(8); PG8_WAIT_L(0); PG8_BAR; PG8_MMA(0, 0, At, B0); PG8_MMA(0, 1, At, B1); PG8_BAR; PG8_SCHED;
            PG8_LDA(At, 0, 1); PG8_STAGE(PG8_SB(0, 0), b2, voffB); PG8_STAGE(PG8_SB(0, 1), b2 + hstep, voffB); PG8_STAGEA(PG8_SA(0, 0), a2, voffA);
            PG8_WAIT_V(8); PG8_WAIT_L(0); PG8_BAR; PG8_MMA(1, 0, At, B0); PG8_MMA(1, 1, At, B1); PG8_BAR; PG8_SCHED;
            PG8_LDB(B0, 1, 0); PG8_LDB(B1, 1, 1); PG8_SCHED; PG8_LDA(At, 1, 0); PG8_STAGEA(PG8_SA(0, 1), a2 + hstep, voffA);
            PG8_WAIT_V(8); PG8_WAIT_L(0); PG8_BAR; PG8_MMA(0, 0, At, B0); PG8_MMA(0, 1, At, B1); PG8_BAR; PG8_SCHED;
            PG8_LDA(At, 1, 1); PG8_STAGE(PG8_SB(1, 0), b3, voffB); PG8_STAGE(PG8_SB(1, 1), b3 + hstep, voffB); PG8_STAGEA(PG8_SA(1, 0), a3, voffA);
            PG8_WAIT_V(8); PG8_WAIT_L(0); PG8_BAR; PG8_MMA(1, 0, At, B0); PG8_MMA(1, 1, At, B1); PG8_BAR; PG8_SCHED;
            } else {
            PG8_LDB(B0, 0, 0); PG8_SCHED; PG8_LDA(At, 0, 0); PG8_STAGEA(PG8_SA(1, 1), a1 + hstep, voffA);
            PG8_WAIT_L(8); PG8_BAR; PG8_WAIT_L(0); PG8_MMA(0, 0, At, B0); PG8_BAR; PG8_SCHED;
            PG8_LDB(B1, 0, 1); PG8_STAGE(PG8_SB(0, 0), b2, voffB);
            PG8_BAR; PG8_WAIT_L(0); PG8_MMA(0, 1, At, B1); PG8_BAR;
            PG8_LDA(At, 0, 1); PG8_STAGEA(PG8_SA(0, 0), a2, voffA);
            PG8_BAR; PG8_WAIT_L(0); PG8_MMA(1, 0, At, B0); PG8_BAR; PG8_SCHED;
            PG8_STAGE(PG8_SB(0, 1), b2 + hstep, voffB);
            PG8_WAIT_V(6); PG8_BAR; PG8_MMA(1, 1, At, B1); PG8_BAR;
            PG8_LDB(B0, 1, 0); PG8_SCHED; PG8_LDA(At, 1, 0); PG8_STAGEA(PG8_SA(0, 1), a2 + hstep, voffA);
            PG8_WAIT_L(8); PG8_BAR; PG8_WAIT_L(0); PG8_MMA(0, 0, At, B0); PG8_BAR; PG8_SCHED;
            PG8_LDB(B1, 1, 1); PG8_STAGE(PG8_SB(1, 0), b3, voffB);
            PG8_BAR; PG8_WAIT_L(0); PG8_MMA(0, 1, At, B1); PG8_BAR;
            PG8_LDA(At, 1, 1); PG8_STAGEA(PG8_SA(1, 0), a3, voffA);
            PG8_BAR; PG8_WAIT_L(0); PG8_MMA(1, 0, At, B0); PG8_BAR; PG8_SCHED;
            PG8_STAGE(PG8_SB(1, 1), b3 + hstep, voffB);
            PG8_WAIT_V(6); PG8_BAR; PG8_MMA(1, 1, At, B1); PG8_BAR;
            }
        }
        if constexpr (ALIGN_EPI) { if (wr == 0) PG8_BAR; }
        if constexpr (!Epi::AFTER_DRAIN) { E(acc, cur, wr, wc, fr, fq); S.done(cur); }
        if (!has_next) break;
#pragma unroll
        for (int a = 0; a < 2; ++a)
#pragma unroll
            for (int b = 0; b < 2; ++b)
#pragma unroll
                for (int m = 0; m < 4; ++m)
#pragma unroll
                    for (int n = 0; n < 2; ++n) acc[a][b][m][n] = (f32x4){0.f, 0.f, 0.f, 0.f};
        cur = nxt; cA = nA; cB = nB; ++ui;
        if constexpr (ALIGN_EPI) { if (wr == 1) PG8_BAR; }
    }
    PG8_WAIT_V(0);
    if constexpr (!ALIGN_EPI) { if (wr == 0) PG8_BAR; }
    PG8_BAR;
    if constexpr (Epi::AFTER_DRAIN) { E.fused(acc, cur, wr, wc, fr, fq, lds, wid, lane); S.done(cur); }
#undef PG8_SA
#undef PG8_SB
#undef PG8_STAGE
#undef PG8_STAGEA
#undef PG8_LDA
#undef PG8_LDB
#undef PG8_MMA
#undef PG8_WAIT_V
#undef PG8_WAIT_L
#undef PG8_BAR
#undef PG8_SCHED
}
}
#define XB_TMO      128
#define XB_XCNT(j)  (256  + 64 * (j))
#define XB_XSUB(j)  (1280 + 64 * (j))
#define XB_XGEN(j)  (2304 + 64 * (j))
#define XB_TOP      3328
#define XB_TOPGEN   3392
#define XCD_BAR_WORDS 3456
#define XB_SPIN_CAP (1u << 18)

__device__ __forceinline__ unsigned xb_ld(unsigned* p)              { return __hip_atomic_load(p, __ATOMIC_RELAXED, __HIP_MEMORY_SCOPE_AGENT); }
__device__ __forceinline__ unsigned xb_add(unsigned* p, unsigned v) { return __hip_atomic_fetch_add(p, v, __ATOMIC_RELAXED, __HIP_MEMORY_SCOPE_AGENT); }
__device__ __forceinline__ unsigned xb_xcc_id() { return (unsigned)__builtin_amdgcn_s_getreg((3 << 11) | 20) & 0xFu; }
#define XB_SPIN(cond, bar) do { unsigned _sp = 0; while (cond) { __builtin_amdgcn_s_sleep(1); \
    if ((++_sp & 255u) == 0u) { if (xb_ld(&(bar)[XB_TMO])) break; if (_sp > XB_SPIN_CAP) { atomicAdd(&(bar)[XB_TMO], 1u); break; } } } } while (0)

struct XcdBarrier {
    unsigned* bar; unsigned x;
    volatile LAS unsigned* st;
};

__device__ __forceinline__ XcdBarrier xcd_barrier_post(unsigned* bar, volatile LAS unsigned* st) {
    XcdBarrier b; b.bar = bar; b.x = xb_xcc_id(); b.st = st;
    if (threadIdx.x == 0) (void)xb_add(&bar[XB_XCNT(b.x)], 1u);
    return b;
}
__device__ __forceinline__ void xcd_barrier_complete(unsigned* bar, unsigned x, unsigned& nloc, unsigned& nx) {
    const unsigned G = gridDim.x * gridDim.y * gridDim.z;
    unsigned sum, cnt, mine, sp = 0u;
    for (;;) {
        sum = 0u; cnt = 0u; mine = 0u;
#pragma unroll
        for (unsigned j = 0; j < 16; ++j) { const unsigned c = xb_ld(&bar[XB_XCNT(j)]); sum += c; cnt += (c > 0u) ? 1u : 0u; mine = (j == x) ? c : mine; }
        if (sum == G) break;
        __builtin_amdgcn_s_sleep(1);
        if ((++sp & 255u) == 0u) { if (xb_ld(&bar[XB_TMO])) break; if (sp > XB_SPIN_CAP) { atomicAdd(&bar[XB_TMO], 1u); break; } }
    }
    nloc = mine > 0u ? mine : 1u; nx = cnt > 0u ? cnt : 1u;
}

__device__ __forceinline__ void xcd_barrier(const XcdBarrier& b) {
    asm volatile("s_waitcnt vmcnt(0)" ::: "memory");
    __syncthreads();
    if (threadIdx.x == 0) {
        unsigned* bar = b.bar;
        __builtin_amdgcn_s_waitcnt(0);
        unsigned nloc = b.st[0], nx = b.st[1];
        if (nloc == 0u) { xcd_barrier_complete(bar, b.x, nloc, nx); b.st[0] = nloc; b.st[1] = nx; }
        const unsigned old = xb_add(&bar[XB_XSUB(b.x)], 1u);
        const unsigned gen = old / nloc;
        if (old + 1u == (gen + 1u) * nloc) {
            __builtin_amdgcn_fence(__ATOMIC_RELEASE, "agent");
            asm volatile("s_waitcnt vmcnt(0)" ::: "memory");
            const unsigned og = xb_add(&bar[XB_TOP], 1u);
            const unsigned tg = og / nx;
            if (og + 1u == (tg + 1u) * nx) xb_add(&bar[XB_TOPGEN], 1u);
            else XB_SPIN(xb_ld(&bar[XB_TOPGEN]) == tg, bar);
            __builtin_amdgcn_fence(__ATOMIC_ACQUIRE, "agent");
            xb_add(&bar[XB_XGEN(b.x)], 1u);
            asm volatile("s_waitcnt vmcnt(0)" ::: "memory");
        } else {
            XB_SPIN(xb_ld(&bar[XB_XGEN(b.x)]) == gen, bar);
            __builtin_amdgcn_fence(__ATOMIC_ACQUIRE, "agent");
            asm volatile("s_waitcnt vmcnt(0)" ::: "memory");
        }
    }
    __syncthreads();
}

constexpr int NB = 8, SEQ = 8192, DM = 1024, DEPTH = 2;
constexpr int T = NB * SEQ;
constexpr int INW = 1280, DFF = 2816, NMODW = 6 * DM;
constexpr int KCH = 32;
constexpr float EPS = 1e-6f;
constexpr float LOG2E = 1.4426950408889634f;

#define LAS __attribute__((address_space(3)))
typedef unsigned short bf16;
typedef unsigned v4u __attribute__((ext_vector_type(4)));
typedef unsigned v2u __attribute__((ext_vector_type(2)));
typedef float f32x4 __attribute__((ext_vector_type(4)));
typedef short bf16x8 __attribute__((ext_vector_type(8)));

constexpr size_t MiB = 1u << 20;
constexpr size_t WS_MODP = 640 * MiB;
constexpr size_t WS_MODF = 8 * MiB;
constexpr size_t WS_CS = 9 * MiB;
constexpr size_t WS_W = 16 * MiB, W_LAYER = 24 * MiB;
constexpr size_t W_IN = 0, W_OUT = 3 * MiB, W_GU = 5 * MiB, W_DN = 16 * MiB, W_PW = 22 * MiB;
constexpr size_t WS_H = 64 * MiB;
constexpr size_t WS_MIX = 192 * MiB;
constexpr size_t WS_PROJ = 320 * MiB;
constexpr size_t WS_CONCAT = 480 * MiB;
constexpr size_t WS_ACT = 320 * MiB;
constexpr size_t WS_XA = 672 * MiB;
constexpr size_t WS_XB = 800 * MiB;
constexpr size_t WS_END = 928 * MiB;

constexpr int RING_BYTES = 131072;
constexpr int LDS_BYTES = 147456;

struct Args {
    const float* x; const float* c; const int* pos; const float* ada_w; const float* ada_b; const float* w_in; const float* b_in;
    const float* sinks; const float* pool_w; const float* pool_scale; const float* w_out; const float* w_gate; const float* w_up;
    const float* w_down; const float* g_pre_mix; const float* g_post_mix; const float* g_pre_ffn; const float* g_post_ffn;
    float* out; unsigned char* ws;
};

__device__ __constant__ double c_inv_freq[8] = {1.0, 0.19392274474868576, 0.03760603093086393, 0.007292664737217109,
                                                0.001414213562373095, 0.0002742481756762073, 5.318295896944988e-05, 1.031338537721246e-05};

__device__ __forceinline__ unsigned pk2(float lo, float hi) { return pg8::cvt_pk_bf16(lo, hi); }
__device__ __forceinline__ float bf_lo(unsigned w) { return __uint_as_float(w << 16); }
__device__ __forceinline__ float bf_hi(unsigned w) { return __uint_as_float(w & 0xffff0000u); }
__device__ __forceinline__ float wave_sum(float v) {
#pragma unroll
    for (int o = 1; o < 64; o <<= 1) v += __shfl_xor(v, o);
    return v;
}

namespace pg8 {
struct EpiInProj {
    static constexpr bool PERM = true, AFTER_DRAIN = false;
    bf16_t* O; const float* bias; const float* cs;
    __device__ __forceinline__ void operator()(const f32x4 (&acc)[2][2][4][2], const Unit& u, int wr, int wc, int fr, int fq) const {
        const int row0 = u.pm * BM + wr * 64 + fr; const int colt = u.pn * BM; const int col0 = colt + wc * 32 + 8 * fq;
        f32x4 bv[2][2];
#pragma unroll
        for (int bj = 0; bj < 2; ++bj)
#pragma unroll
            for (int n = 0; n < 2; ++n) bv[bj][n] = *(const f32x4*)(bias + col0 + bj * HALF + 4 * n);
        const bool rot_wave = (colt < 640) && ((wc & 1) == 0);
#pragma unroll
        for (int ai = 0; ai < 2; ++ai)
#pragma unroll
        for (int mh = 0; mh < 2; ++mh) {
            f32x4 cc[2][4];
#pragma unroll
            for (int mm = 0; mm < 2; ++mm)
#pragma unroll
                for (int q = 0; q < 4; ++q) cc[mm][q] = (f32x4){1.f, 1.f, 1.f, 1.f};
            if (rot_wave && fq < 2) {
#pragma unroll
                for (int mm = 0; mm < 2; ++mm) { const float* cr = cs + (size_t)(row0 + ai * HALF + (2 * mh + mm) * 16) * 16;
#pragma unroll
                    for (int q = 0; q < 4; ++q) cc[mm][q] = *(const f32x4*)(cr + 4 * q); }
            }
#pragma unroll
            for (int mm = 0; mm < 2; ++mm) {
                const int m = 2 * mh + mm;
                const int row = row0 + ai * HALF + m * 16;
                bf16_t* rowp = O + (size_t)row * INW + col0;
#pragma unroll
                for (int bj = 0; bj < 2; ++bj) {
                    f32x4 v0 = acc[ai][bj][m][0] + bv[bj][0], v1 = acc[ai][bj][m][1] + bv[bj][1];
                    const int cb = colt + bj * HALF;
                    if (rot_wave && cb < 640) {
                        f32x4 p0, p1;
#pragma unroll
                        for (int e = 0; e < 4; ++e) { p0[e] = __shfl_xor(v0[e], 16); p1[e] = __shfl_xor(v1[e], 16); }
                        if (fq == 0) { v0 = v0 * cc[mm][0] - p0 * cc[mm][2]; v1 = v1 * cc[mm][1] - p1 * cc[mm][3]; }
                        else if (fq == 1) { v0 = v0 * cc[mm][0] + p0 * cc[mm][2]; v1 = v1 * cc[mm][1] + p1 * cc[mm][3]; }
                    }
                    if (cb < 512) { v0 = v0 * 0.125f; v1 = v1 * 0.125f; }
                    u32x4 w; w.x = cvt_pk_bf16(v0[0], v0[1]); w.y = cvt_pk_bf16(v0[2], v0[3]); w.z = cvt_pk_bf16(v1[0], v1[1]); w.w = cvt_pk_bf16(v1[2], v1[3]);
                    *(u32x4*)(rowp + bj * HALF) = w;
                }
            }
        }
    }
};
struct EpiSwiGLU {
    static constexpr bool PERM = true, AFTER_DRAIN = false;
    bf16_t* O;
    __device__ __forceinline__ void operator()(const f32x4 (&acc)[2][2][4][2], const Unit& u, int wr, int wc, int fr, int fq) const {
        typedef float f32x2 __attribute__((ext_vector_type(2)));
        const int row0 = u.pm * BM + wr * 64 + fr; const int col0 = u.pn * HALF + wc * 32 + 8 * fq;
#pragma unroll
        for (int ai = 0; ai < 2; ++ai)
#pragma unroll
            for (int m = 0; m < 4; ++m) {
                bf16_t* rowp = O + (size_t)(row0 + ai * HALF + m * 16) * DFF + col0;
                f32x2 G[4], U[4], t[4], r[4];
#pragma unroll
                for (int n = 0; n < 2; ++n) { G[2 * n] = (f32x2){acc[ai][0][m][n][0], acc[ai][0][m][n][1]}; G[2 * n + 1] = (f32x2){acc[ai][0][m][n][2], acc[ai][0][m][n][3]};
                                              U[2 * n] = (f32x2){acc[ai][1][m][n][0], acc[ai][1][m][n][1]}; U[2 * n + 1] = (f32x2){acc[ai][1][m][n][2], acc[ai][1][m][n][3]}; }
#pragma unroll
                for (int q = 0; q < 4; ++q) { t[q].x = __builtin_amdgcn_exp2f(G[q].x); t[q].y = __builtin_amdgcn_exp2f(G[q].y); }
#pragma unroll
                for (int q = 0; q < 4; ++q) { t[q] = t[q] + 1.0f; r[q] = G[q] * U[q]; }
#pragma unroll
                for (int q = 0; q < 4; ++q) { t[q].x = __builtin_amdgcn_rcpf(t[q].x); t[q].y = __builtin_amdgcn_rcpf(t[q].y); }
#pragma unroll
                for (int q = 0; q < 4; ++q) r[q] = r[q] * t[q];
                u32x4 w; w.x = cvt_pk_bf16(r[0].x, r[0].y); w.y = cvt_pk_bf16(r[1].x, r[1].y); w.z = cvt_pk_bf16(r[2].x, r[2].y); w.w = cvt_pk_bf16(r[3].x, r[3].y);
                *(u32x4*)rowp = w;
            }
    }
};
struct DualOrder {
    StaticOrder so; int c, rounds, hot;
    __device__ bool next(int i, Unit& u) const { if (hot) { if (i >= rounds) return false; u.pm = (c % 8) * 2 + ((c / 8) & 1); u.pn = ((c / 8) >> 1) & 3; return true; } return so.next(i, u); }
    __device__ __forceinline__ void a_ready(const Unit&) const {}
    __device__ __forceinline__ void done(const Unit&) const {}
};
}

__device__ __forceinline__ void transpose_item(const float* W, int K, int N, bf16* WT, int drow0, LAS float* scr, int k0, int n0, int lane, float wscale = 1.0f) {
#pragma unroll
    for (int ih = 0; ih < 32; ih += 16) {
        float tv[16];
#pragma unroll
        for (int i = 0; i < 16; ++i) tv[i] = __builtin_nontemporal_load(W + (size_t)(k0 + 2 * (ih + i) + (lane >> 5)) * N + n0 + (lane & 31));
#pragma unroll
        for (int i = 0; i < 16; ++i) scr[(2 * (ih + i) + (lane >> 5)) * 33 + (lane & 31)] = tv[i] * wscale;
    }
    asm volatile("s_waitcnt lgkmcnt(0)" ::: "memory");
    const int c = lane & 7;
#pragma unroll
    for (int j = 0; j < 4; ++j) { const int n = (lane >> 3) + 8 * j; const LAS float* s = scr + (8 * c) * 33 + n;
        v4u o; o.x = pk2(s[0 * 33], s[1 * 33]); o.y = pk2(s[2 * 33], s[3 * 33]); o.z = pk2(s[4 * 33], s[5 * 33]); o.w = pk2(s[6 * 33], s[7 * 33]);
        *(v4u*)(WT + (size_t)(drow0 + n) * K + k0 + 8 * c) = o; }
    asm volatile("s_waitcnt lgkmcnt(0)" ::: "memory");
}

__device__ __forceinline__ void prologue(const Args& a, LAS unsigned char* lds) {
    int tid_ = threadIdx.x; asm volatile("" : "+v"(tid_)); const int tid = tid_, lane = tid & 63, wave = tid >> 6;
    unsigned char* ws = a.ws;
    __syncthreads();
    {
        LAS float* sc = (LAS float*)lds;
        for (int i = tid; i < NB * DM; i += 512) { const float v = a.c[i]; sc[i] = v / (1.0f + __expf(-v)); }
        __syncthreads();
        float* modp = (float*)(ws + WS_MODP);
        for (int item = blockIdx.x; item < DEPTH * KCH * 12; item += gridDim.x) {
            const int l = item / (KCH * 12), r = item % (KCH * 12), kc = r / 12, cb = r % 12, n = cb * 512 + tid;
            constexpr int KPI = DM / KCH;
            const float* w = a.ada_w + ((size_t)l * DM + kc * KPI) * NMODW + n;
            float acc[8];
#pragma unroll
            for (int b = 0; b < 8; ++b) acc[b] = 0.f;
#pragma unroll 1
            for (int kh = 0; kh < KPI; kh += 16) {
                float wv[16];
#pragma unroll
                for (int k = 0; k < 16; ++k) wv[k] = __builtin_nontemporal_load(w + (size_t)(kh + k) * NMODW);
#pragma unroll
                for (int k = 0; k < 16; ++k) {
                    const LAS float* sp = sc + kc * KPI + kh + k;
#pragma unroll
                    for (int b = 0; b < 8; ++b) acc[b] += sp[b * DM] * wv[k];
                    if ((k & 3) == 3) asm volatile("" ::: "memory");
                }
            }
#pragma unroll
            for (int b = 0; b < 8; ++b) modp[((size_t)(l * KCH + kc) * 8 + b) * NMODW + n] = acc[b];
        }
        __syncthreads();
    }
    {
        float* cs = (float*)(ws + WS_CS);
        for (int idx = blockIdx.x * 512 + tid; idx < T * 8; idx += gridDim.x * 512) {
            const int row = idx >> 3, j = idx & 7;
            const double rev = (double)a.pos[row] * c_inv_freq[j] * 0.15915494309189535;
            const float fr = (float)(rev - floor(rev));
            cs[(size_t)row * 16 + j] = __builtin_amdgcn_cosf(fr);
            cs[(size_t)row * 16 + 8 + j] = __builtin_amdgcn_sinf(fr);
        }
    }
    {
        LAS float* scr = (LAS float*)(lds + wave * 16384);
        const int gw = blockIdx.x * 8 + wave, ngw = gridDim.x * 8;
        constexpr int I_IN = 16 * 40, I_OUT = 16 * 32, I_G = 16 * 88, I_D = 44 * 32, I_P = 4 * 8;
        constexpr int PER_L = I_IN + I_OUT + 2 * I_G + I_D + I_P;
        for (int it = gw; it < DEPTH * PER_L; it += ngw) {
            const int l = it / PER_L; int r = it % PER_L;
            unsigned char* wl = ws + WS_W + (size_t)l * W_LAYER;
            if (r < I_IN) { const int kb = r / 40, nb = r % 40; transpose_item(a.w_in + (size_t)l * DM * INW, DM, INW, (bf16*)(wl + W_IN), 32 * nb, scr, 64 * kb, 32 * nb, lane); continue; } r -= I_IN;
            if (r < I_OUT) { const int kb = r / 32, nb = r % 32; transpose_item(a.w_out + (size_t)l * DM * DM, DM, DM, (bf16*)(wl + W_OUT), 32 * nb, scr, 64 * kb, 32 * nb, lane); continue; } r -= I_OUT;
            if (r < 2 * I_G) { const int up = r >= I_G; if (up) r -= I_G; const int kb = r / 88, nb = r % 88, n0 = 32 * nb;
                transpose_item((up ? a.w_up : a.w_gate) + (size_t)l * DM * DFF, DM, DFF, (bf16*)(wl + W_GU), 256 * (n0 >> 7) + (n0 & 127) + (up ? 128 : 0), scr, 64 * kb, n0, lane, up ? -0.6931471805599453f : -1.4426950408889634f); continue; } r -= 2 * I_G;
            if (r < I_D) { const int kb = r / 32, nb = r % 32; transpose_item(a.w_down + (size_t)l * DFF * DM, DFF, DM, (bf16*)(wl + W_DN), 32 * nb, scr, 64 * kb, 32 * nb, lane); continue; } r -= I_D;
            { const int gi = r / 8, q = r % 8, kb = q / 4, nb = q % 4;
              transpose_item(a.pool_w + ((size_t)l * 4 + gi) * 128 * 128, 128, 128, (bf16*)(wl + W_PW) + (size_t)gi * 128 * 128, 32 * nb, scr, 64 * kb, 32 * nb, lane); }
        }
    }
}

__device__ __forceinline__ float mod_val(const Args& a, int l, int b, int idx, int col) {
    const float* modp = (const float*)(a.ws + WS_MODP);
    const int n = idx * DM + col;
    float s = a.ada_b[l * NMODW + n];
#pragma unroll
    for (int kc = 0; kc < KCH; ++kc) s += modp[((size_t)(l * KCH + kc) * 8 + b) * NMODW + n];
    return s;
}
__device__ __forceinline__ float mod_fin(const Args& a, int l, int b, int idx, int col) {
    return ((const float*)(a.ws + WS_MODF))[((size_t)(l * 8 + b)) * NMODW + idx * DM + col];
}
__device__ __forceinline__ void mod_finalize(const Args& a) {
    float* modf = (float*)(a.ws + WS_MODF);
    for (int i = blockIdx.x * 512 + threadIdx.x; i < DEPTH * 8 * NMODW; i += gridDim.x * 512) {
        const int l = i / (8 * NMODW), r = i % (8 * NMODW), b = r / NMODW, n = r % NMODW;
        modf[i] = mod_val(a, l, b, n / DM, n % DM);
    }
}
__device__ __forceinline__ void unpack8(const v4u w, float (&f)[8]) {
#pragma unroll
    for (int e = 0; e < 4; ++e) { f[2 * e] = bf_lo(w[e]); f[2 * e + 1] = bf_hi(w[e]); }
}
__device__ __forceinline__ v4u pack8(const float (&f)[8]) { return (v4u){pk2(f[0], f[1]), pk2(f[2], f[3]), pk2(f[4], f[5]), pk2(f[6], f[7])}; }
__device__ __forceinline__ void rowwise_phase(const Args& a, LAS unsigned char* lds, bool from_partials, bool has_y, bool has_h, bool xin_bf, int xout_mode,
        const void* xin, const bf16* y, float* xout, bf16* xoutb, bf16* hout,
        int l_y, int gate_idx, const float* g_post, int l_h, int shift_idx, int scale_idx, const float* g_pre) {
    int tid_ = threadIdx.x; asm volatile("" : "+v"(tid_)); const int tid = tid_, lane = tid & 63, wave = tid >> 6;
    LAS float* vec = (LAS float*)lds;
    for (int tile = blockIdx.x; tile < T / 256; tile += gridDim.x) {
        const int b = tile / (SEQ / 256);
        __syncthreads();
        for (int col = tid; col < DM; col += 512) {
            if (from_partials) {
                if (has_y) vec[col] = mod_val(a, l_y, b, gate_idx, col) * g_post[col];
                if (has_h) { vec[DM + col] = g_pre[col] * (1.0f + mod_val(a, l_h, b, scale_idx, col)); vec[2 * DM + col] = mod_val(a, l_h, b, shift_idx, col); }
            } else {
                if (has_y) vec[col] = mod_fin(a, l_y, b, gate_idx, col) * g_post[col];
                if (has_h) { vec[DM + col] = g_pre[col] * (1.0f + mod_fin(a, l_h, b, scale_idx, col)); vec[2 * DM + col] = mod_fin(a, l_h, b, shift_idx, col); }
            }
        }
        __syncthreads();
#pragma unroll 1
        for (int r = wave * 4; r < 256; r += 32) {
            float v[4][2][8]; v4u yv[4][2];
#pragma unroll
            for (int h = 0; h < 4; ++h)
#pragma unroll
                for (int j = 0; j < 2; ++j) { const size_t off = ((size_t)tile * 256 + r + h) * DM + 8 * lane + 512 * j;
                    if (xin_bf) unpack8(__builtin_nontemporal_load((const v4u*)((const bf16*)xin + off)), v[h][j]);
                    else { const f32x4 p0 = __builtin_nontemporal_load((const f32x4*)((const float*)xin + off)), p1 = __builtin_nontemporal_load((const f32x4*)((const float*)xin + off + 4));
                        v[h][j][0] = p0.x; v[h][j][1] = p0.y; v[h][j][2] = p0.z; v[h][j][3] = p0.w; v[h][j][4] = p1.x; v[h][j][5] = p1.y; v[h][j][6] = p1.z; v[h][j][7] = p1.w; }
                    yv[h][j] = has_y ? __builtin_nontemporal_load((const v4u*)(y + off)) : (v4u){0u, 0u, 0u, 0u}; }
            if (has_y) {
                float rstd[4];
#pragma unroll
                for (int h = 0; h < 4; ++h) { float ss = 0.f;
#pragma unroll
                    for (int j = 0; j < 2; ++j) { float yf[8]; unpack8(yv[h][j], yf);
#pragma unroll
                        for (int e = 0; e < 8; ++e) ss += yf[e] * yf[e]; }
                    rstd[h] = __builtin_amdgcn_rsqf(wave_sum(ss) * (1.0f / DM) + EPS); }
#pragma unroll
                for (int j = 0; j < 2; ++j) { const LAS float* gpp = vec + 8 * lane + 512 * j; const f32x4 g0 = *(const LAS f32x4*)gpp, g1 = *(const LAS f32x4*)(gpp + 4);
                    const float gp[8] = {g0.x, g0.y, g0.z, g0.w, g1.x, g1.y, g1.z, g1.w};
#pragma unroll
                    for (int h = 0; h < 4; ++h) { float yf[8]; unpack8(yv[h][j], yf);
#pragma unroll
                        for (int e = 0; e < 8; ++e) v[h][j][e] += gp[e] * (yf[e] * rstd[h]); } }
            }
            if (xout_mode == 1) {
#pragma unroll
                for (int h = 0; h < 4; ++h)
#pragma unroll
                    for (int j = 0; j < 2; ++j) { float* o = xout + ((size_t)tile * 256 + r + h) * DM + 8 * lane + 512 * j;
                        __builtin_nontemporal_store((f32x4){v[h][j][0], v[h][j][1], v[h][j][2], v[h][j][3]}, (f32x4*)o); __builtin_nontemporal_store((f32x4){v[h][j][4], v[h][j][5], v[h][j][6], v[h][j][7]}, (f32x4*)(o + 4)); }
            } else if (xout_mode == 2) {
#pragma unroll
                for (int h = 0; h < 4; ++h)
#pragma unroll
                    for (int j = 0; j < 2; ++j) { const v4u w = pack8(v[h][j]);
                        __builtin_nontemporal_store(w, (v4u*)(xoutb + ((size_t)tile * 256 + r + h) * DM + 8 * lane + 512 * j));
                        unpack8(w, v[h][j]); }
            }
            if (has_h) {
                float rstd[4];
#pragma unroll
                for (int h = 0; h < 4; ++h) { float ss = 0.f;
#pragma unroll
                    for (int j = 0; j < 2; ++j)
#pragma unroll
                        for (int e = 0; e < 8; ++e) ss += v[h][j][e] * v[h][j][e];
                    rstd[h] = __builtin_amdgcn_rsqf(wave_sum(ss) * (1.0f / DM) + EPS); }
#pragma unroll
                for (int j = 0; j < 2; ++j) { const LAS float* gsp = vec + DM + 8 * lane + 512 * j; const LAS float* shp = vec + 2 * DM + 8 * lane + 512 * j;
                    const f32x4 a0 = *(const LAS f32x4*)gsp, a1 = *(const LAS f32x4*)(gsp + 4), b0 = *(const LAS f32x4*)shp, b1 = *(const LAS f32x4*)(shp + 4);
                    const float gs[8] = {a0.x, a0.y, a0.z, a0.w, a1.x, a1.y, a1.z, a1.w}, sh[8] = {b0.x, b0.y, b0.z, b0.w, b1.x, b1.y, b1.z, b1.w};
#pragma unroll
                    for (int h = 0; h < 4; ++h) { float hv[8];
#pragma unroll
                        for (int e = 0; e < 8; ++e) hv[e] = v[h][j][e] * rstd[h] * gs[e] + sh[e];
                        *(v4u*)(hout + ((size_t)tile * 256 + r + h) * DM + 8 * lane + 512 * j) = pack8(hv); } }
            }
        }
    }
}

typedef short v4i16a_t __attribute__((ext_vector_type(4)));
__device__ __forceinline__ v2u lds_tr_a(const LAS bf16* p) { return __builtin_bit_cast(v2u, __builtin_amdgcn_ds_read_tr16_b64_v4i16((LAS v4i16a_t*)p)); }
__device__ __forceinline__ void attn_phase(LAS unsigned char* lds, const bf16* PROJ, bf16* CONCAT, const float* sinks) {
    int tid_ = threadIdx.x; asm volatile("" : "+v"(tid_)); const int tid = tid_, lane = tid & 63, wave = tid >> 6, fr = lane & 15, fq = lane >> 4;
    LAS bf16* Ks = (LAS bf16*)lds;
    LAS bf16* Vs = (LAS bf16*)(lds + 36864);
    v4u kv[4], vv[4];
#define ATT_LOAD_KV(uu) do { const int kh_ = (uu) & 1, n_ = ((uu) >> 1) & 63, b_ = (uu) >> 7; const long rb_ = (long)b_ * SEQ + n_ * 128 - 128; \
        _Pragma("unroll") for (int i = 0; i < 4; ++i) { const int kj = lane + 64 * i; kv[i] = (v4u){0u, 0u, 0u, 0u}; vv[i] = (v4u){0u, 0u, 0u, 0u}; \
            if (n_ > 0 || kj >= 128) { const bf16* p = PROJ + (size_t)(rb_ + kj) * INW + kh_ * 64 + wave * 8; kv[i] = *(const v4u*)(p + 512); vv[i] = *(const v4u*)(p + 640); } } } while (0)
    bf16x8 qf[4][2];
#define ATT_LOAD_Q(uu) do { const int kh_ = (uu) & 1, n_ = ((uu) >> 1) & 63, b_ = (uu) >> 7; const size_t qr_ = (size_t)b_ * SEQ + n_ * 128 + (wave & 1) * 64 + fr; \
        _Pragma("unroll") for (int i = 0; i < 4; ++i) { const bf16* qp = PROJ + (qr_ + 16 * i) * INW + (kh_ * 4 + (wave >> 1)) * 64 + 8 * fq; \
            qf[i][0] = __builtin_nontemporal_load((const bf16x8*)qp); qf[i][1] = __builtin_nontemporal_load((const bf16x8*)(qp + 32)); } } while (0)
    if ((int)blockIdx.x < NB * 64 * 2) { ATT_LOAD_KV((int)blockIdx.x); ATT_LOAD_Q((int)blockIdx.x); }
    for (int u = blockIdx.x; u < NB * 64 * 2; u += gridDim.x) {
        const int kh = u & 1, n = (u >> 1) & 63, b = u >> 7;
        const int g = wave >> 1, h = kh * 4 + g;
        const size_t qrow0 = (size_t)b * SEQ + n * 128 + (wave & 1) * 64 + fr;
#pragma unroll
        for (int i = 0; i < 4; ++i) { const int kj = lane + 64 * i;
            *(LAS v4u*)(Ks + kj * 72 + wave * 8) = kv[i];
            *(LAS v4u*)(Vs + kj * 72 + wave * 8) = vv[i]; }
        __syncthreads();
        if (u + (int)gridDim.x < NB * 64 * 2) ATT_LOAD_KV(u + (int)gridDim.x);
        const float sink = sinks[h];
        const int firstblk = (n == 0);
#pragma unroll
        for (int p = 0; p < 2; ++p) {
            const int q16a = (wave & 1) * 4 + 2 * p, kt0 = q16a;
            f32x4 st[2][10];
            bf16x8 kfr[10][2];
            const LAS bf16* kp0 = Ks + (16 * kt0 + fr) * 72 + 8 * fq;
#define ATT_LDK(t) do { kfr[t][0] = *(const LAS bf16x8*)(kp0 + (t) * 16 * 72); kfr[t][1] = *(const LAS bf16x8*)(kp0 + (t) * 16 * 72 + 32); } while (0)
            ATT_LDK(0);
#pragma unroll
            for (int t = 0; t < 10; ++t) {
                if (t + 1 < 10) ATT_LDK(t + 1);
#pragma unroll
                for (int x = 0; x < 2; ++x) {
                    if (x + 8 - t == 9 || x + 8 - t == -1) { st[x][t] = (f32x4){-1e30f, -1e30f, -1e30f, -1e30f}; continue; }
                    f32x4 acc = (f32x4){0.f, 0.f, 0.f, 0.f};
                    acc = __builtin_amdgcn_mfma_f32_16x16x32_bf16(kfr[t][0], qf[2 * p + x][0], acc, 0, 0, 0);
                    acc = __builtin_amdgcn_mfma_f32_16x16x32_bf16(kfr[t][1], qf[2 * p + x][1], acc, 0, 0, 0);
                    st[x][t] = acc;
                }
            }
#undef ATT_LDK
            float inv[2];
#pragma unroll
            for (int x = 0; x < 2; ++x) {
                float mx = -1e30f;
#pragma unroll
                for (int t = 0; t < 10; ++t) {
                    const int D = x + 8 - t;
                    if (D == 9 || D == -1) continue;
                    const bool tile_off = firstblk && (kt0 + t < 8);
#pragma unroll
                    for (int r = 0; r < 4; ++r) { const int dl = fr - 4 * fq - r;
                        bool valid = !tile_off;
                        if (D == 8) valid = valid && (dl < 0);
                        if (D == 0) valid = valid && (dl >= 0);
                        const float sv = valid ? st[x][t][r] : -1e30f; st[x][t][r] = sv; mx = fmaxf(mx, sv); }
                }
                mx = fmaxf(mx, __shfl_xor(mx, 16)); mx = fmaxf(mx, __shfl_xor(mx, 32)); mx = fmaxf(mx, sink);
                const float mb = mx * LOG2E;
                float lsum = 0.f;
#pragma unroll
                for (int t = 0; t < 10; ++t) {
                    const int D = x + 8 - t;
                    if (D == 9 || D == -1) { st[x][t] = (f32x4){0.f, 0.f, 0.f, 0.f}; continue; }
#pragma unroll
                    for (int r = 0; r < 4; ++r) { const float pe = __builtin_amdgcn_exp2f(st[x][t][r] * LOG2E - mb); st[x][t][r] = pe; lsum += pe; }
                }
                lsum += __shfl_xor(lsum, 16); lsum += __shfl_xor(lsum, 32); lsum += __builtin_amdgcn_exp2f(sink * LOG2E - mb);
                inv[x] = 1.0f / lsum;
            }
            f32x4 ot[2][4];
#pragma unroll
            for (int x = 0; x < 2; ++x)
#pragma unroll
                for (int dt = 0; dt < 4; ++dt) ot[x][dt] = (f32x4){0.f, 0.f, 0.f, 0.f};
            const LAS bf16* vp0 = Vs + (16 * kt0 + 4 * fq + (fr >> 2)) * 72 + 4 * (fr & 3);
            v2u vlo[5][4], vhi[5][4];
#define ATT_LDV(s) do { _Pragma("unroll") for (int dt = 0; dt < 4; ++dt) { vlo[s][dt] = lds_tr_a(vp0 + (s) * 32 * 72 + 16 * dt); vhi[s][dt] = lds_tr_a(vp0 + (s) * 32 * 72 + 16 * 72 + 16 * dt); } } while (0)
#pragma unroll
            for (int s2 = 0; s2 < 5; ++s2) {
                ATT_LDV(s2);
                bf16x8 pf[2];
#pragma unroll
                for (int x = 0; x < 2; ++x) { v4u pw; pw.x = pk2(st[x][2 * s2][0], st[x][2 * s2][1]); pw.y = pk2(st[x][2 * s2][2], st[x][2 * s2][3]);
                    pw.z = pk2(st[x][2 * s2 + 1][0], st[x][2 * s2 + 1][1]); pw.w = pk2(st[x][2 * s2 + 1][2], st[x][2 * s2 + 1][3]); pf[x] = __builtin_bit_cast(bf16x8, pw); }
#pragma unroll
                for (int dt = 0; dt < 4; ++dt) {
                    const bf16x8 vf = __builtin_bit_cast(bf16x8, (v4u){vlo[s2][dt].x, vlo[s2][dt].y, vhi[s2][dt].x, vhi[s2][dt].y});
#pragma unroll
                    for (int x = 0; x < 2; ++x) ot[x][dt] = __builtin_amdgcn_mfma_f32_16x16x32_bf16(vf, pf[x], ot[x][dt], 0, 0, 0);
                }
            }
#undef ATT_LDV
#pragma unroll
            for (int x = 0; x < 2; ++x) {
                LAS bf16* stg = (LAS bf16*)(lds + 73728) + (wave * 2 + x) * (16 * 72);
#pragma unroll
                for (int dt = 0; dt < 4; ++dt) *(LAS v2u*)(stg + fr * 72 + 16 * dt + 4 * fq) = (v2u){pk2(ot[x][dt][0] * inv[x], ot[x][dt][1] * inv[x]), pk2(ot[x][dt][2] * inv[x], ot[x][dt][3] * inv[x])};
                bf16* op = CONCAT + (qrow0 - fr + 16 * (2 * p + x)) * DM + h * 64;
#pragma unroll
                for (int i = 0; i < 2; ++i) { const int row = 8 * i + (lane >> 3), chn = lane & 7;
                    *(v4u*)(op + (size_t)row * DM + chn * 8) = *(const LAS v4u*)(stg + row * 72 + chn * 8); }
            }
        }
        if (u + (int)gridDim.x < NB * 64 * 2) ATT_LOAD_Q(u + (int)gridDim.x);
        __syncthreads();
    }
#undef ATT_LOAD_KV
#undef ATT_LOAD_Q
}

constexpr int PL_US = 136;
template <int W> __device__ __forceinline__ void pool_load(const bf16* PROJ, int gi, int tt, int lane, v4u (&raw)[8]) {
    const size_t t0 = (size_t)tt * 16; const int s0 = (int)(t0 & (SEQ - 1));
    const int ch = lane & 15, rs = lane >> 4;
#pragma unroll
    for (int i = 0; i < 8; ++i) { const int r = rs + 4 * i;
        raw[i] = (v4u){0u, 0u, 0u, 0u};
        if (4 * i + 3 >= 17 - W) { if (s0 - 16 + r >= 0) raw[i] = *(const v4u*)(PROJ + (t0 - 16 + r) * INW + 768 + gi * 128 + ch * 8); } }
}
typedef short v4i16_t __attribute__((ext_vector_type(4)));
__device__ __forceinline__ v2u lds_tr(const LAS bf16* p) { return __builtin_bit_cast(v2u, __builtin_amdgcn_ds_read_tr16_b64_v4i16((LAS v4i16_t*)p)); }
template <int W> __device__ __forceinline__ void pool_compute(bf16* CONCAT, const LAS bf16* wl, LAS bf16* ust, const float* pscale, int gi, int tt, int lane, const v4u (&raw)[8]) {
    const int fr = lane & 15, fq = lane >> 4;
    const size_t t0 = (size_t)tt * 16; const int s0 = (int)(t0 & (SEQ - 1));
    {
        const int ch = lane & 15, rs = lane >> 4;
#pragma unroll
        for (int i = 0; i < 8; ++i) { const int r = rs + 4 * i; if (4 * i + 3 >= 17 - W) *(LAS v4u*)(ust + r * PL_US + ch * 8) = raw[i]; }
    }
    const int s = s0 + fr;
    const int cnt = (s + 1 < W) ? (s + 1) : W;
    const float invc = 1.0f / (float)cnt;
    bf16x8 band;
    { float bv[8];
#pragma unroll
      for (int j = 0; j < 8; ++j) { const int rel = 8 * fq + j - 16 - fr;
          bv[j] = ((rel > -W && rel <= 0) ? 1.0f : 0.0f) - ((rel == 0) ? (float)cnt : 0.0f); }
      band = __builtin_bit_cast(bf16x8, (v4u){pk2(bv[0], bv[1]), pk2(bv[2], bv[3]), pk2(bv[4], bv[5]), pk2(bv[6], bv[7])}); }
    f32x4 pl[8];
    const LAS bf16* trp = ust + (8 * fq + ((lane & 15) >> 2)) * PL_US + 4 * (lane & 3);
#pragma unroll
    for (int a = 0; a < 8; ++a) {
        const v2u lo = lds_tr(trp + 16 * a), hi = lds_tr(trp + 4 * PL_US + 16 * a);
        const bf16x8 ua = __builtin_bit_cast(bf16x8, (v4u){lo.x, lo.y, hi.x, hi.y});
        pl[a] = __builtin_amdgcn_mfma_f32_16x16x32_bf16(ua, band, (f32x4){0.f, 0.f, 0.f, 0.f}, 0, 0, 0);
    }
    bf16x8 pf[4];
#pragma unroll
    for (int ks = 0; ks < 4; ++ks)
        pf[ks] = __builtin_bit_cast(bf16x8, (v4u){pk2(pl[2 * ks][0] * invc, pl[2 * ks][1] * invc), pk2(pl[2 * ks][2] * invc, pl[2 * ks][3] * invc),
                                                  pk2(pl[2 * ks + 1][0] * invc, pl[2 * ks + 1][1] * invc), pk2(pl[2 * ks + 1][2] * invc, pl[2 * ks + 1][3] * invc)});
#pragma unroll
    for (int nt = 0; nt < 8; ++nt) {
        f32x4 acc = (f32x4){0.f, 0.f, 0.f, 0.f};
        const LAS bf16* wp = wl + (16 * nt + fr) * PL_US + 4 * fq;
#pragma unroll
        for (int ks = 0; ks < 4; ++ks) { const v2u lo = *(const LAS v2u*)(wp + 32 * ks), hi = *(const LAS v2u*)(wp + 32 * ks + 16);
            acc = __builtin_amdgcn_mfma_f32_16x16x32_bf16(__builtin_bit_cast(bf16x8, (v4u){lo.x, lo.y, hi.x, hi.y}), pf[ks], acc, 0, 0, 0); }
        const int d = gi * 128 + 16 * nt + 4 * fq;
        const f32x4 sc = *(const f32x4*)(pscale + d);
        *(LAS v2u*)(ust + fr * PL_US + 16 * nt + 4 * fq) = (v2u){pk2(acc[0] * sc.x, acc[1] * sc.y), pk2(acc[2] * sc.z, acc[3] * sc.w)};
    }
#pragma unroll
    for (int i = 0; i < 4; ++i) { const int row = 4 * i + (lane >> 4), chn = lane & 15;
        const v4u w = *(const LAS v4u*)(ust + row * PL_US + chn * 8);
        *(v4u*)(CONCAT + (t0 + row) * DM + 512 + gi * 128 + chn * 8) = w; }
}
template <int W> __device__ __forceinline__ void pool_group(const bf16* PROJ, bf16* CONCAT, const LAS bf16* wl, LAS bf16* ust, const float* pscale, int gi, int gw, int ngw, int lane) {
    v4u ra[8], rb[8];
    {
        const int ch = lane & 15, rs = lane >> 4;
#pragma unroll
        for (int i = 0; i < 8; ++i) if (!(4 * i + 3 >= 17 - W)) *(LAS v4u*)(ust + (rs + 4 * i) * PL_US + ch * 8) = (v4u){0u, 0u, 0u, 0u};
    }
    int tt = gw;
    if (tt < T / 16) pool_load<W>(PROJ, gi, tt, lane, ra);
    while (tt < T / 16) {
        const int tn = tt + ngw;
        if (tn < T / 16) pool_load<W>(PROJ, gi, tn, lane, rb);
        pool_compute<W>(CONCAT, wl, ust, pscale, gi, tt, lane, ra);
        tt = tn;
        if (tt >= T / 16) break;
        const int tn2 = tt + ngw;
        if (tn2 < T / 16) pool_load<W>(PROJ, gi, tn2, lane, ra);
        pool_compute<W>(CONCAT, wl, ust, pscale, gi, tt, lane, rb);
        tt = tn2;
    }
}
__device__ __forceinline__ void pool_phase(LAS unsigned char* lds, const bf16* PROJ, bf16* CONCAT, const bf16* PWT, const float* pscale) {
    int tid_ = threadIdx.x; asm volatile("" : "+v"(tid_)); const int tid = tid_, lane = tid & 63, wave = tid >> 6;
    LAS bf16* wl = (LAS bf16*)lds;
    LAS bf16* ust = (LAS bf16*)(lds + 36864 + wave * 8704);
    const bool quad = (gridDim.x & 3) == 0;
    const int gw = quad ? (int)(blockIdx.x >> 2) * 8 + wave : (int)blockIdx.x * 8 + wave, ngw = quad ? (int)(gridDim.x >> 2) * 8 : (int)gridDim.x * 8;
#pragma unroll 1
    for (int g = 0; g < (quad ? 1 : 4); ++g) {
        const int gi = quad ? (int)(blockIdx.x & 3) : g;
        __syncthreads();
        { const int row = tid >> 2, q = tid & 3; const bf16* src = PWT + ((size_t)gi * 128 + row) * 128 + q * 32;
#pragma unroll
          for (int e = 0; e < 4; ++e) *(LAS v4u*)(wl + row * PL_US + q * 32 + e * 8) = *(const v4u*)(src + e * 8); }
        __syncthreads();
        if (gi == 0) pool_group<2>(PROJ, CONCAT, wl, ust, pscale, gi, gw, ngw, lane);
        else if (gi == 1) pool_group<4>(PROJ, CONCAT, wl, ust, pscale, gi, gw, ngw, lane);
        else if (gi == 2) pool_group<8>(PROJ, CONCAT, wl, ust, pscale, gi, gw, ngw, lane);
        else pool_group<16>(PROJ, CONCAT, wl, ust, pscale, gi, gw, ngw, lane);
    }
    __syncthreads();
}

#ifndef REP_P
#define REP_P 1
#endif
#ifndef REP_G
#define REP_G 1
#endif
#ifndef REP_R
#define REP_R 1
#endif
#ifndef REP_G
#define REP_G 1
#endif
#ifndef REP_IN
#define REP_IN REP_G
#endif
#ifndef REP_GU
#define REP_GU REP_G
#endif
#ifndef REP_DN
#define REP_DN REP_G
#endif
#ifndef REP_PL
#define REP_PL 1
#endif
#ifndef REP_A
#define REP_A 1
#endif
__global__ void __launch_bounds__(512, 2) fwd_kernel(Args a) {
    extern __shared__ __attribute__((aligned(16))) unsigned char lds_raw[];
    cg::grid_group grid = cg::this_grid();
    LAS unsigned char* lds = (LAS unsigned char*)lds_raw;
    unsigned char* ws = a.ws;
    bf16* H = (bf16*)(ws + WS_H); bf16* MIX = (bf16*)(ws + WS_MIX); bf16* PROJ = (bf16*)(ws + WS_PROJ);
    bf16* CONCAT = (bf16*)(ws + WS_CONCAT); bf16* ACT = (bf16*)(ws + WS_ACT);
    const float* cs = (const float*)(ws + WS_CS); bf16* XA = (bf16*)(ws + WS_XA); bf16* XB = (bf16*)(ws + WS_XB);
    volatile LAS unsigned* MISC = (volatile LAS unsigned*)(lds + RING_BYTES + 64);
    if (threadIdx.x == 0) { MISC[0] = 0u; MISC[1] = 0u; }
    __syncthreads();
    XcdBarrier bar = xcd_barrier_post((unsigned*)ws, MISC);
#define SEAM() xcd_barrier(bar)

    for (int rep = 0; rep < REP_P; ++rep) prologue(a, lds);
    if (a.ws == nullptr) grid.sync();
    SEAM();
    for (int rep = 0; rep < REP_R; ++rep) rowwise_phase(a, lds, true, false, true, false, 2, a.x, nullptr, nullptr, XB, H, 0, 0, nullptr, 0, 0, 1, a.g_pre_mix);
    mod_finalize(a);
    SEAM();
#pragma unroll 1
    for (int l = 0; l < DEPTH; ++l) {
        unsigned char* wl = ws + WS_W + (size_t)l * W_LAYER;
        for (int rep = 0; rep < REP_IN; ++rep) {
            pg8::Gemm g{H, (const bf16*)(wl + W_IN), T, INW, DM}; pg8::StaticOrder S; S.init(T, INW, gridDim.x, blockIdx.x);
            pg8::EpiInProj E{PROJ, a.b_in + l * INW, cs};
            pg8::gemm_phase<pg8::EpiInProj, pg8::StaticOrder, true, true>(lds, g, S, E);
        }
        SEAM();
        for (int rep = 0; rep < REP_A; ++rep) attn_phase(lds, PROJ, CONCAT, a.sinks + l * 8);
        for (int rep = 0; rep < REP_PL; ++rep) pool_phase(lds, PROJ, CONCAT, (const bf16*)(wl + W_PW), a.pool_scale + l * 512);
        SEAM();
        for (int rep = 0; rep < REP_G; ++rep) {
            pg8::Gemm g{CONCAT, (const bf16*)(wl + W_OUT), T, DM, DM}; pg8::StaticOrder S; S.init(T, DM, gridDim.x, blockIdx.x);
            pg8::EpiBf16<0> E{MIX, DM, nullptr, 0, 0, 1.f};
            pg8::gemm_phase<pg8::EpiBf16<0>, pg8::StaticOrder, true, true>(lds, g, S, E);
        }
        SEAM();
        for (int rep = 0; rep < REP_R; ++rep) rowwise_phase(a, lds, false, true, true, true, 2, XB, MIX, nullptr, XA, H, l, 2, a.g_post_mix + l * DM, l, 3, 4, a.g_pre_ffn + l * DM);
        SEAM();
#if defined(PROBE_HOT)
#pragma unroll 1
        for (int rep = 0; rep < 2; ++rep) {
            pg8::Gemm g{H, (const bf16*)(wl + W_GU), T, 2 * DFF, rep == 0 ? PROBE_HOT_K : DM}; pg8::DualOrder S; S.so.init(T, 2 * DFF, gridDim.x, blockIdx.x); S.c = blockIdx.x; S.rounds = 22; S.hot = (rep == 0);
            pg8::EpiSwiGLU E{rep == 0 ? MIX : ACT};
            pg8::gemm_phase<pg8::EpiSwiGLU, pg8::DualOrder, true, true>(lds, g, S, E);
            if (rep == 0) SEAM();
        }
#else
#if defined(FFN_SPLIT)
#pragma unroll 1
        for (int hf = 0; hf < 2; ++hf) {
            const size_t r0 = (size_t)hf * (T / 2);
            {
                pg8::Gemm g{H + r0 * DM, (const bf16*)(wl + W_GU), T / 2, 2 * DFF, DM}; pg8::StaticOrder S; S.init(T / 2, 2 * DFF, gridDim.x, blockIdx.x);
                pg8::EpiSwiGLU E{ACT + r0 * DFF};
                pg8::gemm_phase<pg8::EpiSwiGLU, pg8::StaticOrder, true, true>(lds, g, S, E);
            }
            SEAM();
            {
                pg8::Gemm g{ACT + r0 * DFF, (const bf16*)(wl + W_DN), T / 2, DM, DFF}; pg8::StaticOrder S; S.init(T / 2, DM, gridDim.x, blockIdx.x, 1);
                pg8::EpiBf16<0> E{MIX + r0 * DM, DM, nullptr, 0, 0, 1.f};
                pg8::gemm_phase<pg8::EpiBf16<0>, pg8::StaticOrder, true, true>(lds, g, S, E);
            }
            SEAM();
        }
#else
        for (int rep = 0; rep < REP_GU; ++rep) {
            pg8::Gemm g{H, (const bf16*)(wl + W_GU), T, 2 * DFF, DM}; pg8::StaticOrder S; S.init(T, 2 * DFF, gridDim.x, blockIdx.x);
            pg8::EpiSwiGLU E{ACT};
            pg8::gemm_phase<pg8::EpiSwiGLU, pg8::StaticOrder, true, true>(lds, g, S, E);
        }
        SEAM();
        for (int rep = 0; rep < REP_DN; ++rep) {
            pg8::Gemm g{ACT, (const bf16*)(wl + W_DN), T, DM, DFF}; pg8::StaticOrder S; S.init(T, DM, gridDim.x, blockIdx.x, 1);
            pg8::EpiBf16<0> E{MIX, DM, nullptr, 0, 0, 1.f};
            pg8::gemm_phase<pg8::EpiBf16<0>, pg8::StaticOrder, true, true>(lds, g, S, E);
        }
        SEAM();
#endif
#endif
        const bool more = (l + 1 < DEPTH);
        for (int rep = 0; rep < REP_R; ++rep) rowwise_phase(a, lds, false, true, more, true, more ? 2 : 1, XA, MIX, a.out, XB, H, l, 5, a.g_post_ffn + l * DM, l + 1, 0, 1, a.g_pre_mix + (more ? (l + 1) * DM : 0));
        if (more) SEAM();
    }
}

extern "C" void kernel_launch(void* const* d_in, const int* in_sizes, int n_in, void* d_out, int out_size, void* d_ws, size_t ws_size, hipStream_t stream) {
    static int grid_blocks = 0;
    if (grid_blocks == 0) {
        if (n_in != 18 || out_size != T * DM || ws_size < WS_END) { fprintf(stderr, "kernel_launch: unexpected shapes (n_in %d, out %d, ws %zu)\n", n_in, out_size, ws_size); grid_blocks = -1; return; }
        int dev = 0, cus = 0, per_cu = 0;
        hipGetDevice(&dev);
        hipDeviceGetAttribute(&cus, hipDeviceAttributeMultiprocessorCount, dev);
        if (hipFuncSetAttribute((const void*)fwd_kernel, hipFuncAttributeMaxDynamicSharedMemorySize, LDS_BYTES) != hipSuccess) { fprintf(stderr, "kernel_launch: hipFuncSetAttribute failed\n"); grid_blocks = -1; return; }
        if (hipOccupancyMaxActiveBlocksPerMultiprocessor(&per_cu, (const void*)fwd_kernel, 512, LDS_BYTES) != hipSuccess || per_cu < 1) { fprintf(stderr, "kernel_launch: occupancy query gave %d\n", per_cu); per_cu = 1; }
        (void)hipGetLastError();
        grid_blocks = cus * per_cu;
    }
    if (grid_blocks < 0) return;
    if (hipMemsetAsync(d_ws, 0, 65536, stream) != hipSuccess) { fprintf(stderr, "kernel_launch: memset failed\n"); return; }
    Args a{};
    a.x = (const float*)d_in[0]; a.c = (const float*)d_in[1]; a.pos = (const int*)d_in[2]; a.ada_w = (const float*)d_in[3]; a.ada_b = (const float*)d_in[4];
    a.w_in = (const float*)d_in[5]; a.b_in = (const float*)d_in[6]; a.sinks = (const float*)d_in[7]; a.pool_w = (const float*)d_in[8]; a.pool_scale = (const float*)d_in[9];
    a.w_out = (const float*)d_in[10]; a.w_gate = (const float*)d_in[11]; a.w_up = (const float*)d_in[12]; a.w_down = (const float*)d_in[13];
    a.g_pre_mix = (const float*)d_in[14]; a.g_post_mix = (const float*)d_in[15]; a.g_pre_ffn = (const float*)d_in[16]; a.g_post_ffn = (const float*)d_in[17];
    a.out = (float*)d_out; a.ws = (unsigned char*)d_ws;
    void* args[] = {&a};
    hipError_t e = hipLaunchCooperativeKernel((const void*)fwd_kernel, dim3(grid_blocks), dim3(512), args, LDS_BYTES, stream);
    if (e != hipSuccess) fprintf(stderr, "cooperative launch failed: %s (grid %d)\n", hipGetErrorString(e), grid_blocks);
}
```

```cpp
#include <hip/hip_runtime.h>
#include <hip/hip_cooperative_groups.h>
#include <cstdio>
#include <cstdint>
namespace cg = cooperative_groups;
#define LAS __attribute__((address_space(3)))
namespace pg8 {
#define PG8_LAS __attribute__((address_space(3)))
typedef unsigned short bf16_t;
typedef short bf16x8 __attribute__((ext_vector_type(8)));
typedef float f32x4 __attribute__((ext_vector_type(4)));
typedef unsigned u32x4 __attribute__((ext_vector_type(4)));
constexpr int BM = 256, BK = 64, HALF = 128, HTB = HALF * BK * 2  , STAGE_BYTES = 8 * HTB, NXCD = 8, WGM = 8;

__host__ __device__ __forceinline__ int lds_byte(int r, int c) { const int st = (r >> 4) * 2 + (c >> 5), rr = r & 15, cc = c & 31, ob = rr * 64 + cc * 2; return st * 1024 + (ob ^ (((ob >> 9) & 1) << 5)); }
__host__ __device__ __forceinline__ void stage_rc(int b, int& R, int& C) { const int st = b / 1024, sb = b % 1024, swz = sb ^ (((sb >> 9) & 1) << 5); R = (st >> 1) * 16 + swz / 64; C = (st & 1) * 32 + (swz % 64) / 2; }
__host__ __device__ __forceinline__ int perm32(int rho) { const int n = rho >> 4, i = rho & 15; return 8 * (i >> 2) + 4 * n + (i & 3); }

struct Unit { int pm, pn; };
struct Gemm { const bf16_t* A; const bf16_t* Bt; int M, N, K; };

struct StaticOrder {
    int nM, nN, nwg, G, c, rev;
    __host__ __device__ void init(int M, int N, int G_, int c_, int rev_ = 0) { nM = M / BM; nN = N / BM; nwg = nM * nN; G = G_; c = c_; rev = rev_; }
    __host__ __device__ bool next(int i, Unit& u) const {
        const long L = (long)i * G + c; if (L >= nwg) return false;
        int wgid = (int)L; { const int q = nwg / NXCD, r = nwg % NXCD, xcd = wgid % NXCD, off = wgid / NXCD; wgid = (xcd < r ? xcd * (q + 1) : r * (q + 1) + (xcd - r) * q) + off; }
        const int nig = WGM * nN, gid = wgid / nig, fm = gid * WGM, gsz = (nM - fm) < WGM ? (nM - fm) : WGM;
        u.pm = fm + ((wgid % nig) % gsz); u.pn = (wgid % nig) / gsz; if (rev) u.pm = nM - 1 - u.pm; return true;
    }
    __device__ __forceinline__ void a_ready(const Unit&) const {}
    __device__ __forceinline__ void done(const Unit&) const {}
};

__device__ __forceinline__ unsigned cvt_pk_bf16(float lo, float hi) { unsigned r; asm volatile("v_cvt_pk_bf16_f32 %0, %1, %2" : "=v"(r) : "v"(lo), "v"(hi)); return r; }
typedef float f32x2 __attribute__((ext_vector_type(2)));
__device__ __forceinline__ f32x2 gelu_pk(f32x2 v) {
    const f32x2 av = __builtin_elementwise_abs(v), d = av * 0.2316418882f + 1.0f;
    f32x2 t; t.x = __builtin_amdgcn_rcpf(d.x); t.y = __builtin_amdgcn_rcpf(d.y);
    f32x2 q = t * 0.5307027145f + (-0.7265760135f); q = q * t + 0.7107068705f; q = q * t + (-0.142248368f); q = q * t + 0.127414796f; q = q * t;
    const f32x2 s = (v * v) * (-0.72134752044f);
    f32x2 e; e.x = __builtin_amdgcn_exp2f(s.x); e.y = __builtin_amdgcn_exp2f(s.y);
    const f32x2 m = v * (q * e), r = v - m;
    f32x2 o; o.x = v.x < 0.f ? m.x : r.x; o.y = v.y < 0.f ? m.y : r.y; return o;
}

template <int ACT  > struct EpiBf16 {
    static constexpr bool PERM = true, AFTER_DRAIN = false; static_assert(ACT == 0 || ACT == 1, "EpiBf16: ACT is 0 (none) or 1 (gelu_pk)");
    bf16_t* O; int ldc; const float* bias; int split_cols; size_t split_stride; float scale0;
    __device__ __forceinline__ void operator()(const f32x4 (&acc)[2][2][4][2], const Unit& u, int wr, int wc, int fr, int fq) const {
        const int row0 = u.pm * BM + wr * 64 + fr; int colt = u.pn * BM; bf16_t* base = O;
        float sc = 1.f; if (split_cols) { const int t = colt / split_cols; base += (size_t)t * split_stride; colt -= t * split_cols; if (t == 0) sc = scale0; }
        const int col0 = colt + wc * 32 + 8 * fq, bcol0 = u.pn * BM + wc * 32 + 8 * fq;
        f32x4 bv[2][2];
#pragma unroll
        for (int bj = 0; bj < 2; ++bj)
#pragma unroll
            for (int n = 0; n < 2; ++n) bv[bj][n] = bias ? *(const f32x4*)(bias + bcol0 + bj * HALF + 4 * n) : (f32x4){0.f, 0.f, 0.f, 0.f};
#pragma unroll
        for (int ai = 0; ai < 2; ++ai)
#pragma unroll
            for (int m = 0; m < 4; ++m) { bf16_t* rowp = base + (size_t)(row0 + ai * HALF + m * 16) * ldc + col0;
#pragma unroll
                for (int bj = 0; bj < 2; ++bj) { f32x4 v0 = acc[ai][bj][m][0] + bv[bj][0], v1 = acc[ai][bj][m][1] + bv[bj][1];
                    if (ACT == 1) { f32x2 a = gelu_pk((f32x2){v0[0], v0[1]}), b = gelu_pk((f32x2){v0[2], v0[3]}), c = gelu_pk((f32x2){v1[0], v1[1]}), d = gelu_pk((f32x2){v1[2], v1[3]});
                        v0 = (f32x4){a.x, a.y, b.x, b.y}; v1 = (f32x4){c.x, c.y, d.x, d.y}; }
                    v0 = v0 * sc; v1 = v1 * sc; u32x4 w; w.x = cvt_pk_bf16(v0[0], v0[1]); w.y = cvt_pk_bf16(v0[2], v0[3]); w.z = cvt_pk_bf16(v1[0], v1[1]); w.w = cvt_pk_bf16(v1[2], v1[3]);
                    *(u32x4*)(rowp + bj * HALF) = w; } }
    }
};
template <class Epi, class Sched, bool ALIGN_EPI = false, bool SP2 = false, int A_AUX = 0  >
__device__ __forceinline__ void gemm_phase(PG8_LAS unsigned char* lds, const Gemm g, const Sched& S, const Epi& E) {
    int tid_ = threadIdx.x; asm volatile("" : "+v"(tid_)); const int tid = tid_, wid = __builtin_amdgcn_readfirstlane(tid >> 6), lane = tid & 63, wr = wid >> 2, wc = wid & 3, fr = lane & 15, fq = lane >> 4;
    const int K = g.K, nt = K / BK;
    unsigned voffA[2], voffB[2];
#pragma unroll
    for (int i = 0; i < 2; ++i) { int R, C; stage_rc(tid * 16 + i * 8192, R, C); const int Rb = Epi::PERM ? ((R & ~31) + perm32(R & 31)) : R;
        voffA[i] = (unsigned)(R * K + C) * 2u; voffB[i] = (unsigned)(Rb * K + C) * 2u; }
    const size_t kstep = (size_t)(BK * 2);
    const size_t hstep = (size_t)HALF * K * 2;
    const size_t tstep = 2 * hstep;
    const unsigned ldsw = (unsigned)wid * 1024u;
    const int aoff = lds_byte(wr * 64 + fr, fq * 8), boff = lds_byte(wc * 32 + fr, fq * 8);
#define PG8_SA(b, h) (((b) * 2 + (h)) * HTB)
#define PG8_SB(b, h) ((4 + (b) * 2 + (h)) * HTB)
#define PG8_STAGE(bufoff, gbase, voff) do { _Pragma("unroll") for (int _i = 0; _i < 2; ++_i) \
        __builtin_amdgcn_global_load_lds((const unsigned*)((const char*)(gbase) + (voff)[_i]), (PG8_LAS unsigned*)(lds + (bufoff) + ldsw + _i * 8192), 16, 0, 0); } while (0)
#define PG8_STAGEA(bufoff, gbase, voff) do { _Pragma("unroll") for (int _i = 0; _i < 2; ++_i) \
        __builtin_amdgcn_global_load_lds((const unsigned*)((const char*)(gbase) + (voff)[_i]), (PG8_LAS unsigned*)(lds + (bufoff) + ldsw + _i * 8192), 16, 0, A_AUX); } while (0)
#define PG8_LDA(dst, b, h) do { _Pragma("unroll") for (int m = 0; m < 4; ++m) _Pragma("unroll") for (int k = 0; k < 2; ++k) dst[m][k] = *(const PG8_LAS bf16x8*)(lds + PG8_SA(b, h) + aoff + m * 2048 + k * 1024); } while (0)
#define PG8_LDB(dst, b, h) do { _Pragma("unroll") for (int n = 0; n < 2; ++n) _Pragma("unroll") for (int k = 0; k < 2; ++k) dst[n][k] = *(const PG8_LAS bf16x8*)(lds + PG8_SB(b, h) + boff + n * 2048 + k * 1024); } while (0)
#define PG8_MMA(ai, bj, At, Bt) do { __builtin_amdgcn_s_setprio(1); _Pragma("unroll") for (int m = 0; m < 4; ++m) _Pragma("unroll") for (int n = 0; n < 2; ++n) _Pragma("unroll") for (int k = 0; k < 2; ++k) \
        acc[ai][bj][m][n] = __builtin_amdgcn_mfma_f32_16x16x32_bf16(Bt[n][k], At[m][k], acc[ai][bj][m][n], 0, 0, 0); __builtin_amdgcn_s_setprio(0); } while (0)
#define PG8_WAIT_V(n) asm volatile("s_waitcnt vmcnt(" #n ")" ::: "memory")
#define PG8_WAIT_L(n) asm volatile("s_waitcnt lgkmcnt(" #n ")" ::: "memory")
#define PG8_BAR __builtin_amdgcn_s_barrier()
#define PG8_SCHED __builtin_amdgcn_sched_barrier(0)
    Unit cur, nxt; int ui = 0;
    if (!S.next(0, cur)) return;
    f32x4 acc[2][2][4][2];
#pragma unroll
    for (int a = 0; a < 2; ++a)
#pragma unroll
        for (int b = 0; b < 2; ++b)
#pragma unroll
            for (int m = 0; m < 4; ++m)
#pragma unroll
                for (int n = 0; n < 2; ++n) acc[a][b][m][n] = (f32x4){0.f, 0.f, 0.f, 0.f};
    bf16x8 At[4][2], B0[2][2], B1[2][2];
    const char* cA = (const char*)g.A + (size_t)cur.pm * tstep; const char* cB = (const char*)g.Bt + (size_t)cur.pn * tstep;
    S.a_ready(cur);
    if constexpr (SP2) {
        PG8_STAGE(PG8_SB(0, 0), cB, voffB); PG8_STAGE(PG8_SB(0, 1), cB + hstep, voffB); PG8_STAGEA(PG8_SA(0, 0), cA, voffA); PG8_STAGEA(PG8_SA(0, 1), cA + hstep, voffA);
        if (wr == 1) PG8_BAR;
        PG8_WAIT_V(2); PG8_BAR;
        PG8_STAGE(PG8_SB(1, 0), cB + kstep, voffB); PG8_STAGEA(PG8_SA(1, 0), cA + kstep, voffA); PG8_STAGE(PG8_SB(1, 1), cB + hstep + kstep, voffB);
        PG8_WAIT_V(6); PG8_BAR;
    } else {
        PG8_STAGE(PG8_SB(0, 0), cB, voffB); PG8_STAGEA(PG8_SA(0, 0), cA, voffA); PG8_STAGE(PG8_SB(0, 1), cB + hstep, voffB); PG8_STAGEA(PG8_SA(0, 1), cA + hstep, voffA);
        if (wr == 1) PG8_BAR;
        PG8_WAIT_V(4); PG8_BAR;
        PG8_STAGE(PG8_SB(1, 0), cB + kstep, voffB); PG8_STAGEA(PG8_SA(1, 0), cA + kstep, voffA); PG8_STAGE(PG8_SB(1, 1), cB + hstep + kstep, voffB);
        PG8_WAIT_V(6); PG8_BAR;
    }
    for (;;) {
        const bool has_next = S.next(ui + 1, nxt);
        const char* nA = has_next ? (const char*)g.A + (size_t)nxt.pm * tstep : cA; const char* nB = has_next ? (const char*)g.Bt + (size_t)nxt.pn * tstep : cB;
        for (int t = 0; t < nt; t += 2) {
            const bool last = (t == nt - 2);
            const char* a1 = cA + (size_t)(t + 1) * kstep;
            const char* a2 = last ? nA : cA + (size_t)(t + 2) * kstep; const char* b2 = last ? nB : cB + (size_t)(t + 2) * kstep;
            const char* a3 = a2 + kstep; const char* b3 = b2 + kstep;
            if (last && has_next) S.a_ready(nxt);
            if constexpr (SP2) {
            PG8_LDB(B0, 0, 0); PG8_LDB(B1, 0, 1); PG8_SCHED; PG8_LDA(At, 0, 0); PG8_STAGEA(PG8_SA(1, 1), a1 + hstep, voffA);
            PG8_WAIT_V(8); PG8_WAIT_L(0); PG8_BAR; PG8_MMA(0, 0, At, B0); PG8_MMA(0, 1, At, B1); PG8_BAR; PG8_SCHED;
            PG8_LDA(At, 0, 1); PG8_STAGE(PG8_SB(0, 0), b2, voffB); PG8_STAGE(PG8_SB(0, 1), b2 + hstep, voffB); PG8_STAGEA(PG8_SA(0, 0), a2, voffA);
            PG8_WAIT_V(8); PG8_WAIT_L(0); PG8_BAR; PG8_MMA(1, 0, At, B0); PG8_MMA(1, 1, At, B1); PG8_BAR; PG8_SCHED;
            PG8_LDB(B0, 1, 0); PG8_LDB(B1, 1, 1); PG8_SCHED; PG8_LDA(At, 1, 0); PG8_STAGEA(PG8_SA(0, 1), a2 + hstep, voffA);
            PG8_WAIT_V(8); PG8_WAIT_L(0); PG8_BAR; PG8_MMA(0, 0, At, B0); PG8_MMA(0, 1, At, B1); PG8_BAR; PG8_SCHED;
            PG8_LDA(At, 1, 1); PG8_STAGE(PG8_SB(1, 0), b3, voffB); PG8_STAGE(PG8_SB(1, 1), b3 + hstep, voffB); PG8_STAGEA(PG8_SA(1, 0), a3, voffA);
            PG8_WAIT_V(8); PG8_WAIT_L(0); PG8_BAR; PG8_MMA(1, 0, At, B0); PG8_MMA(1, 1, At, B1); PG8_BAR; PG8_SCHED;
            } else {
            PG8_LDB(B0, 0, 0); PG8_SCHED; PG8_LDA(At, 0, 0); PG8_STAGEA(PG8_SA(1, 1), a1 + hstep, voffA);
            PG8_WAIT_L(8); PG8_BAR; PG8_WAIT_L(0); PG8_MMA(0, 0, At, B0); PG8_BAR; PG8_SCHED;
            PG8_LDB(B1, 0, 1); PG8_STAGE(PG8_SB(0, 0), b2, voffB);
            PG8_BAR; PG8_WAIT_L(0); PG8_MMA(0, 1, At, B1); PG8_BAR;
            PG8_LDA(At, 0, 1); PG8_STAGEA(PG8_SA(0, 0), a2, voffA);
            PG8_BAR; PG8_WAIT_L(0); PG8_MMA(1, 0, At, B0); PG8_BAR; PG8_SCHED;
            PG8_STAGE(PG8_SB(0, 1), b2 + hstep, voffB);
            PG8_WAIT_V(6); PG8_BAR; PG8_MMA(1, 1, At, B1); PG8_BAR;
            PG8_LDB(B0, 1, 0); PG8_SCHED; PG8_LDA(At, 1, 0); PG8_STAGEA(PG8_SA(0, 1), a2 + hstep, voffA);
            PG8_WAIT_L(8); PG8_BAR; PG8_WAIT_L(0); PG8_MMA(0, 0, At, B0); PG8_BAR; PG8_SCHED;
            PG8_LDB(B1, 1, 1); PG8_STAGE(PG8_SB(1, 0), b3, voffB);
            PG8_BAR; PG8_WAIT_L(0); PG8_MMA(0, 1, At, B1); PG8_BAR;
            PG8_LDA(At, 1, 1); PG8_STAGEA(PG8_SA(1, 0), a3, voffA);
            PG8_BAR; PG8_WAIT_L(0); PG8_MMA(1, 0, At, B0); PG8_BAR; PG8_SCHED;
            PG8_STAGE(PG8_SB(1, 1), b3 + hstep, voffB);
            PG8_WAIT_V(6); PG8_BAR; PG8_MMA(1, 1, At, B1); PG8_BAR;
            }
        }
        if constexpr (ALIGN_EPI) { if (wr == 0) PG8_BAR; }
        if constexpr (!Epi::AFTER_DRAIN) { E(acc, cur, wr, wc, fr, fq); S.done(cur); }
        if (!has_next) break;
#pragma unroll
        for (int a = 0; a < 2; ++a)
#pragma unroll
            for (int b = 0; b < 2; ++b)
#pragma unroll
                for (int m = 0; m < 4; ++m)
#pragma unroll
                    for (int n = 0; n < 2; ++n) acc[a][b][m][n] = (f32x4){0.f, 0.f, 0.f, 0.f};
        cur = nxt; cA = nA; cB = nB; ++ui;
        if constexpr (ALIGN_EPI) { if (wr == 1) PG8_BAR; }
    }
    PG8_WAIT_V(0);
    if constexpr (!ALIGN_EPI) { if (wr == 0) PG8_BAR; }
    PG8_BAR;
    if constexpr (Epi::AFTER_DRAIN) { E.fused(acc, cur, wr, wc, fr, fq, lds, wid, lane); S.done(cur); }
#undef PG8_SA
#undef PG8_SB
#undef PG8_STAGE
#undef PG8_STAGEA
#undef PG8_LDA
#undef PG8_LDB
#undef PG8_MMA
#undef PG8_WAIT_V
#undef PG8_WAIT_L
#undef PG8_BAR
#undef PG8_SCHED
}
}
#define XB_TMO      128
#define XB_XCNT(j)  (256  + 64 * (j))
#define XB_XSUB(j)  (1280 + 64 * (j))
#define XB_XGEN(j)  (2304 + 64 * (j))
#define XB_TOP      3328
#define XB_TOPGEN   3392
#define XCD_BAR_WORDS 3456
#define XB_SPIN_CAP (1u << 18)

__device__ __forceinline__ unsigned xb_ld(unsigned* p)              { return __hip_atomic_load(p, __ATOMIC_RELAXED, __HIP_MEMORY_SCOPE_AGENT); }
__device__ __forceinline__ unsigned xb_add(unsigned* p, unsigned v) { return __hip_atomic_fetch_add(p, v, __ATOMIC_RELAXED, __HIP_MEMORY_SCOPE_AGENT); }
__device__ __forceinline__ unsigned xb_xcc_id() { return (unsigned)__builtin_amdgcn_s_getreg((3 << 11) | 20) & 0xFu; }
#define XB_SPIN(cond, bar) do { unsigned _sp = 0; while (cond) { __builtin_amdgcn_s_sleep(1); \
    if ((++_sp & 255u) == 0u) { if (xb_ld(&(bar)[XB_TMO])) break; if (_sp > XB_SPIN_CAP) { atomicAdd(&(bar)[XB_TMO], 1u); break; } } } } while (0)

struct XcdBarrier {
    unsigned* bar; unsigned x;
    volatile LAS unsigned* st;
};

__device__ __forceinline__ XcdBarrier xcd_barrier_post(unsigned* bar, volatile LAS unsigned* st) {
    XcdBarrier b; b.bar = bar; b.x = xb_xcc_id(); b.st = st;
    if (threadIdx.x == 0) (void)xb_add(&bar[XB_XCNT(b.x)], 1u);
    return b;
}
__device__ __forceinline__ void xcd_barrier_complete(unsigned* bar, unsigned x, unsigned& nloc, unsigned& nx) {
    const unsigned G = gridDim.x * gridDim.y * gridDim.z;
    unsigned sum, cnt, mine, sp = 0u;
    for (;;) {
        sum = 0u; cnt = 0u; mine = 0u;
#pragma unroll
        for (unsigned j = 0; j < 16; ++j) { const unsigned c = xb_ld(&bar[XB_XCNT(j)]); sum += c; cnt += (c > 0u) ? 1u : 0u; mine = (j == x) ? c : mine; }
        if (sum == G) break;
        __builtin_amdgcn_s_sleep(1);
        if ((++sp & 255u) == 0u) { if (xb_ld(&bar[XB_TMO])) break; if (sp > XB_SPIN_CAP) { atomicAdd(&bar[XB_TMO], 1u); break; } }
    }
    nloc = mine > 0u ? mine : 1u; nx = cnt > 0u ? cnt : 1u;
}

__device__ __forceinline__ void xcd_barrier(const XcdBarrier& b) {
    asm volatile("s_waitcnt vmcnt(0)" ::: "memory");
    __syncthreads();
    if (threadIdx.x == 0) {
        unsigned* bar = b.bar;
        __builtin_amdgcn_s_waitcnt(0);
        unsigned nloc = b.st[0], nx = b.st[1];
        if (nloc == 0u) { xcd_barrier_complete(bar, b.x, nloc, nx); b.st[0] = nloc; b.st[1] = nx; }
        const unsigned old = xb_add(&bar[XB_XSUB(b.x)], 1u);
        const unsigned gen = old / nloc;
        if (old + 1u == (gen + 1u) * nloc) {
            __builtin_amdgcn_fence(__ATOMIC_RELEASE, "agent");
            asm volatile("s_waitcnt vmcnt(0)" ::: "memory");
            const unsigned og = xb_add(&bar[XB_TOP], 1u);
            const unsigned tg = og / nx;
            if (og + 1u == (tg + 1u) * nx) xb_add(&bar[XB_TOPGEN], 1u);
            else XB_SPIN(xb_ld(&bar[XB_TOPGEN]) == tg, bar);
            __builtin_amdgcn_fence(__ATOMIC_ACQUIRE, "agent");
            xb_add(&bar[XB_XGEN(b.x)], 1u);
            asm volatile("s_waitcnt vmcnt(0)" ::: "memory");
        } else {
            XB_SPIN(xb_ld(&bar[XB_XGEN(b.x)]) == gen, bar);
            __builtin_amdgcn_fence(__ATOMIC_ACQUIRE, "agent");
            asm volatile("s_waitcnt vmcnt(0)" ::: "memory");
        }
    }
    __syncthreads();
}

constexpr int NB = 8, SEQ = 8192, DM = 1024, DEPTH = 2;
constexpr int T = NB * SEQ;
constexpr int INW = 1280, DFF = 2816, NMODW = 6 * DM;
constexpr int KCH = 32;
constexpr float EPS = 1e-6f;
constexpr float LOG2E = 1.4426950408889634f;

#define LAS __attribute__((address_space(3)))
typedef unsigned short bf16;
typedef unsigned v4u __attribute__((ext_vector_type(4)));
typedef unsigned v2u __attribute__((ext_vector_type(2)));
typedef float f32x4 __attribute__((ext_vector_type(4)));
typedef short bf16x8 __attribute__((ext_vector_type(8)));

constexpr size_t MiB = 1u << 20;
constexpr size_t WS_MODP = 640 * MiB;
constexpr size_t WS_MODF = 8 * MiB;
constexpr size_t WS_CS = 9 * MiB;
constexpr size_t WS_W = 16 * MiB, W_LAYER = 24 * MiB;
constexpr size_t W_IN = 0, W_OUT = 3 * MiB, W_GU = 5 * MiB, W_DN = 16 * MiB, W_PW = 22 * MiB;
constexpr size_t WS_H = 64 * MiB;
constexpr size_t WS_MIX = WS_H;
constexpr size_t WS_PROJ = 320 * MiB;
constexpr size_t WS_CONCAT = 480 * MiB;
constexpr size_t WS_ACT = 320 * MiB;
constexpr size_t WS_XA = 672 * MiB;
constexpr size_t WS_XB = 800 * MiB;
constexpr size_t WS_END = 928 * MiB;

constexpr int RING_BYTES = 131072;
constexpr int LDS_BYTES = 147456;

struct Args {
    const float* x; const float* c; const int* pos; const float* ada_w; const float* ada_b; const float* w_in; const float* b_in;
    const float* sinks; const float* pool_w; const float* pool_scale; const float* w_out; const float* w_gate; const float* w_up;
    const float* w_down; const float* g_pre_mix; const float* g_post_mix; const float* g_pre_ffn; const float* g_post_ffn;
    float* out; unsigned char* ws;
};

__device__ __constant__ double c_inv_freq[8] = {1.0, 0.19392274474868576, 0.03760603093086393, 0.007292664737217109,
                                                0.001414213562373095, 0.0002742481756762073, 5.318295896944988e-05, 1.031338537721246e-05};

__device__ __forceinline__ unsigned pk2(float lo, float hi) { return pg8::cvt_pk_bf16(lo, hi); }
__device__ __forceinline__ float bf_lo(unsigned w) { return __uint_as_float(w << 16); }
__device__ __forceinline__ float bf_hi(unsigned w) { return __uint_as_float(w & 0xffff0000u); }
__device__ __forceinline__ float wave_sum(float v) {
#pragma unroll
    for (int o = 1; o < 64; o <<= 1) v += __shfl_xor(v, o);
    return v;
}

namespace pg8 {
struct EpiInProj {
    static constexpr bool PERM = true, AFTER_DRAIN = false;
    bf16_t* O; const float* bias; const float* cs;
    __device__ __forceinline__ void operator()(const f32x4 (&acc)[2][2][4][2], const Unit& u, int wr, int wc, int fr, int fq) const {
        const int row0 = u.pm * BM + wr * 64 + fr; const int colt = u.pn * BM; const int col0 = colt + wc * 32 + 8 * fq;
        f32x4 bv[2][2];
#pragma unroll
        for (int bj = 0; bj < 2; ++bj)
#pragma unroll
            for (int n = 0; n < 2; ++n) bv[bj][n] = *(const f32x4*)(bias + col0 + bj * HALF + 4 * n);
        const bool rot_wave = (colt < 640) && ((wc & 1) == 0);
#pragma unroll
        for (int ai = 0; ai < 2; ++ai)
#pragma unroll
        for (int mh = 0; mh < 2; ++mh) {
            f32x4 cc[2][4];
#pragma unroll
            for (int mm = 0; mm < 2; ++mm)
#pragma unroll
                for (int q = 0; q < 4; ++q) cc[mm][q] = (f32x4){1.f, 1.f, 1.f, 1.f};
            if (rot_wave && fq < 2) {
#pragma unroll
                for (int mm = 0; mm < 2; ++mm) { const float* cr = cs + (size_t)(row0 + ai * HALF + (2 * mh + mm) * 16) * 16;
#pragma unroll
                    for (int q = 0; q < 4; ++q) cc[mm][q] = *(const f32x4*)(cr + 4 * q); }
            }
#pragma unroll
            for (int mm = 0; mm < 2; ++mm) {
                const int m = 2 * mh + mm;
                const int row = row0 + ai * HALF + m * 16;
                bf16_t* rowp = O + (size_t)row * INW + col0;
#pragma unroll
                for (int bj = 0; bj < 2; ++bj) {
                    f32x4 v0 = acc[ai][bj][m][0] + bv[bj][0], v1 = acc[ai][bj][m][1] + bv[bj][1];
                    const int cb = colt + bj * HALF;
                    if (rot_wave && cb < 640) {
                        f32x4 p0, p1;
#pragma unroll
                        for (int e = 0; e < 4; ++e) { p0[e] = __shfl_xor(v0[e], 16); p1[e] = __shfl_xor(v1[e], 16); }
                        if (fq == 0) { v0 = v0 * cc[mm][0] - p0 * cc[mm][2]; v1 = v1 * cc[mm][1] - p1 * cc[mm][3]; }
                        else if (fq == 1) { v0 = v0 * cc[mm][0] + p0 * cc[mm][2]; v1 = v1 * cc[mm][1] + p1 * cc[mm][3]; }
                    }
                    if (cb < 512) { v0 = v0 * 0.125f; v1 = v1 * 0.125f; }
                    u32x4 w; w.x = cvt_pk_bf16(v0[0], v0[1]); w.y = cvt_pk_bf16(v0[2], v0[3]); w.z = cvt_pk_bf16(v1[0], v1[1]); w.w = cvt_pk_bf16(v1[2], v1[3]);
                    *(u32x4*)(rowp + bj * HALF) = w;
                }
            }
        }
    }
};
struct EpiSwiGLU {
    static constexpr bool PERM = true, AFTER_DRAIN = false;
    bf16_t* O;
    __device__ __forceinline__ void operator()(const f32x4 (&acc)[2][2][4][2], const Unit& u, int wr, int wc, int fr, int fq) const {
        typedef float f32x2 __attribute__((ext_vector_type(2)));
        const int row0 = u.pm * BM + wr * 64 + fr; const int col0 = u.pn * HALF + wc * 32 + 8 * fq;
#pragma unroll
        for (int ai = 0; ai < 2; ++ai)
#pragma unroll
            for (int m = 0; m < 4; ++m) {
                bf16_t* rowp = O + (size_t)(row0 + ai * HALF + m * 16) * DFF + col0;
                f32x2 G[4], U[4], t[4], r[4];
#pragma unroll
                for (int n = 0; n < 2; ++n) { G[2 * n] = (f32x2){acc[ai][0][m][n][0], acc[ai][0][m][n][1]}; G[2 * n + 1] = (f32x2){acc[ai][0][m][n][2], acc[ai][0][m][n][3]};
                                              U[2 * n] = (f32x2){acc[ai][1][m][n][0], acc[ai][1][m][n][1]}; U[2 * n + 1] = (f32x2){acc[ai][1][m][n][2], acc[ai][1][m][n][3]}; }
#pragma unroll
                for (int q = 0; q < 4; ++q) { t[q].x = __builtin_amdgcn_exp2f(G[q].x); t[q].y = __builtin_amdgcn_exp2f(G[q].y); }
#pragma unroll
                for (int q = 0; q < 4; ++q) { t[q] = t[q] + 1.0f; r[q] = G[q] * U[q]; }
#pragma unroll
                for (int q = 0; q < 4; ++q) { t[q].x = __builtin_amdgcn_rcpf(t[q].x); t[q].y = __builtin_amdgcn_rcpf(t[q].y); }
#pragma unroll
                for (int q = 0; q < 4; ++q) r[q] = r[q] * t[q];
                u32x4 w; w.x = cvt_pk_bf16(r[0].x, r[0].y); w.y = cvt_pk_bf16(r[1].x, r[1].y); w.z = cvt_pk_bf16(r[2].x, r[2].y); w.w = cvt_pk_bf16(r[3].x, r[3].y);
                *(u32x4*)rowp = w;
            }
    }
};
struct DualOrder {
    StaticOrder so; int c, rounds, hot;
    __device__ bool next(int i, Unit& u) const { if (hot) { if (i >= rounds) return false; u.pm = (c % 8) * 2 + ((c / 8) & 1); u.pn = ((c / 8) >> 1) & 3; return true; } return so.next(i, u); }
    __device__ __forceinline__ void a_ready(const Unit&) const {}
    __device__ __forceinline__ void done(const Unit&) const {}
};
}

__device__ __forceinline__ void transpose_item(const float* W, int K, int N, bf16* WT, int drow0, LAS float* scr, int k0, int n0, int lane, float wscale = 1.0f) {
#pragma unroll
    for (int ih = 0; ih < 32; ih += 16) {
        float tv[16];
#pragma unroll
        for (int i = 0; i < 16; ++i) tv[i] = __builtin_nontemporal_load(W + (size_t)(k0 + 2 * (ih + i) + (lane >> 5)) * N + n0 + (lane & 31));
#pragma unroll
        for (int i = 0; i < 16; ++i) scr[(2 * (ih + i) + (lane >> 5)) * 33 + (lane & 31)] = tv[i] * wscale;
    }
    asm volatile("s_waitcnt lgkmcnt(0)" ::: "memory");
    const int c = lane & 7;
#pragma unroll
    for (int j = 0; j < 4; ++j) { const int n = (lane >> 3) + 8 * j; const LAS float* s = scr + (8 * c) * 33 + n;
        v4u o; o.x = pk2(s[0 * 33], s[1 * 33]); o.y = pk2(s[2 * 33], s[3 * 33]); o.z = pk2(s[4 * 33], s[5 * 33]); o.w = pk2(s[6 * 33], s[7 * 33]);
        *(v4u*)(WT + (size_t)(drow0 + n) * K + k0 + 8 * c) = o; }
    asm volatile("s_waitcnt lgkmcnt(0)" ::: "memory");
}

__device__ __forceinline__ void prologue(const Args& a, LAS unsigned char* lds) {
    int tid_ = threadIdx.x; asm volatile("" : "+v"(tid_)); const int tid = tid_, lane = tid & 63, wave = tid >> 6;
    unsigned char* ws = a.ws;
    __syncthreads();
    {
        LAS float* sc = (LAS float*)lds;
        for (int i = tid; i < NB * DM; i += 512) { const float v = a.c[i]; sc[i] = v / (1.0f + __expf(-v)); }
        __syncthreads();
        float* modp = (float*)(ws + WS_MODP);
        for (int item = blockIdx.x; item < DEPTH * KCH * 12; item += gridDim.x) {
            const int l = item / (KCH * 12), r = item % (KCH * 12), kc = r / 12, cb = r % 12, n = cb * 512 + tid;
            constexpr int KPI = DM / KCH;
            const float* w = a.ada_w + ((size_t)l * DM + kc * KPI) * NMODW + n;
            float acc[8];
#pragma unroll
            for (int b = 0; b < 8; ++b) acc[b] = 0.f;
#pragma unroll 1
            for (int kh = 0; kh < KPI; kh += 16) {
                float wv[16];
#pragma unroll
                for (int k = 0; k < 16; ++k) wv[k] = __builtin_nontemporal_load(w + (size_t)(kh + k) * NMODW);
#pragma unroll
                for (int k = 0; k < 16; ++k) {
                    const LAS float* sp = sc + kc * KPI + kh + k;
#pragma unroll
                    for (int b = 0; b < 8; ++b) acc[b] += sp[b * DM] * wv[k];
                    if ((k & 3) == 3) asm volatile("" ::: "memory");
                }
            }
#pragma unroll
            for (int b = 0; b < 8; ++b) modp[((size_t)(l * KCH + kc) * 8 + b) * NMODW + n] = acc[b];
        }
        __syncthreads();
    }
    {
        float* cs = (float*)(ws + WS_CS);
        for (int idx = blockIdx.x * 512 + tid; idx < T * 8; idx += gridDim.x * 512) {
            const int row = idx >> 3, j = idx & 7;
            const double rev = (double)a.pos[row] * c_inv_freq[j] * 0.15915494309189535;
            const float fr = (float)(rev - floor(rev));
            cs[(size_t)row * 16 + j] = __builtin_amdgcn_cosf(fr);
            cs[(size_t)row * 16 + 8 + j] = __builtin_amdgcn_sinf(fr);
        }
    }
    {
        LAS float* scr = (LAS float*)(lds + wave * 16384);
        const int gw = blockIdx.x * 8 + wave, ngw = gridDim.x * 8;
        constexpr int I_IN = 16 * 40, I_OUT = 16 * 32, I_G = 16 * 88, I_D = 44 * 32, I_P = 4 * 8;
        constexpr int PER_L = I_IN + I_OUT + 2 * I_G + I_D + I_P;
        for (int it = gw; it < DEPTH * PER_L; it += ngw) {
            const int l = it / PER_L; int r = it % PER_L;
            unsigned char* wl = ws + WS_W + (size_t)l * W_LAYER;
            if (r < I_IN) { const int kb = r / 40, nb = r % 40; transpose_item(a.w_in + (size_t)l * DM * INW, DM, INW, (bf16*)(wl + W_IN), 32 * nb, scr, 64 * kb, 32 * nb, lane); continue; } r -= I_IN;
            if (r < I_OUT) { const int kb = r / 32, nb = r % 32; transpose_item(a.w_out + (size_t)l * DM * DM, DM, DM, (bf16*)(wl + W_OUT), 32 * nb, scr, 64 * kb, 32 * nb, lane); continue; } r -= I_OUT;
            if (r < 2 * I_G) { const int up = r >= I_G; if (up) r -= I_G; const int kb = r / 88, nb = r % 88, n0 = 32 * nb;
                transpose_item((up ? a.w_up : a.w_gate) + (size_t)l * DM * DFF, DM, DFF, (bf16*)(wl + W_GU), 256 * (n0 >> 7) + (n0 & 127) + (up ? 128 : 0), scr, 64 * kb, n0, lane, up ? -0.6931471805599453f : -1.4426950408889634f); continue; } r -= 2 * I_G;
            if (r < I_D) { const int kb = r / 32, nb = r % 32; transpose_item(a.w_down + (size_t)l * DFF * DM, DFF, DM, (bf16*)(wl + W_DN), 32 * nb, scr, 64 * kb, 32 * nb, lane); continue; } r -= I_D;
            { const int gi = r / 8, q = r % 8, kb = q / 4, nb = q % 4;
              transpose_item(a.pool_w + ((size_t)l * 4 + gi) * 128 * 128, 128, 128, (bf16*)(wl + W_PW) + (size_t)gi * 128 * 128, 32 * nb, scr, 64 * kb, 32 * nb, lane); }
        }
    }
}

__device__ __forceinline__ float mod_val(const Args& a, int l, int b, int idx, int col) {
    const float* modp = (const float*)(a.ws + WS_MODP);
    const int n = idx * DM + col;
    float s = a.ada_b[l * NMODW + n];
#pragma unroll
    for (int kc = 0; kc < KCH; ++kc) s += modp[((size_t)(l * KCH + kc) * 8 + b) * NMODW + n];
    return s;
}
__device__ __forceinline__ float mod_fin(const Args& a, int l, int b, int idx, int col) {
    return ((const float*)(a.ws + WS_MODF))[((size_t)(l * 8 + b)) * NMODW + idx * DM + col];
}
__device__ __forceinline__ void mod_finalize(const Args& a) {
    float* modf = (float*)(a.ws + WS_MODF);
    for (int i = blockIdx.x * 512 + threadIdx.x; i < DEPTH * 8 * NMODW; i += gridDim.x * 512) {
        const int l = i / (8 * NMODW), r = i % (8 * NMODW), b = r / NMODW, n = r % NMODW;
        modf[i] = mod_val(a, l, b, n / DM, n % DM);
    }
}
__device__ __forceinline__ void unpack8(const v4u w, float (&f)[8]) {
#pragma unroll
    for (int e = 0; e < 4; ++e) { f[2 * e] = bf_lo(w[e]); f[2 * e + 1] = bf_hi(w[e]); }
}
__device__ __forceinline__ v4u pack8(const float (&f)[8]) { return (v4u){pk2(f[0], f[1]), pk2(f[2], f[3]), pk2(f[4], f[5]), pk2(f[6], f[7])}; }
__device__ __forceinline__ void rowwise_phase(const Args& a, LAS unsigned char* lds, bool from_partials, bool has_y, bool has_h, bool xin_bf, int xout_mode,
        const void* xin, const bf16* y, float* xout, bf16* xoutb, bf16* hout,
        int l_y, int gate_idx, const float* g_post, int l_h, int shift_idx, int scale_idx, const float* g_pre) {
    int tid_ = threadIdx.x; asm volatile("" : "+v"(tid_)); const int tid = tid_, lane = tid & 63, wave = tid >> 6;
    LAS float* vec = (LAS float*)lds;
    for (int tile = blockIdx.x; tile < T / 256; tile += gridDim.x) {
        const int b = tile / (SEQ / 256);
        __syncthreads();
        for (int col = tid; col < DM; col += 512) {
            if (from_partials) {
                if (has_y) vec[col] = mod_val(a, l_y, b, gate_idx, col) * g_post[col];
                if (has_h) { vec[DM + col] = g_pre[col] * (1.0f + mod_val(a, l_h, b, scale_idx, col)); vec[2 * DM + col] = mod_val(a, l_h, b, shift_idx, col); }
            } else {
                if (has_y) vec[col] = mod_fin(a, l_y, b, gate_idx, col) * g_post[col];
                if (has_h) { vec[DM + col] = g_pre[col] * (1.0f + mod_fin(a, l_h, b, scale_idx, col)); vec[2 * DM + col] = mod_fin(a, l_h, b, shift_idx, col); }
            }
        }
        __syncthreads();
#pragma unroll 1
        for (int r = wave * 4; r < 256; r += 32) {
            float v[4][2][8]; v4u yv[4][2];
#pragma unroll
            for (int h = 0; h < 4; ++h)
#pragma unroll
                for (int j = 0; j < 2; ++j) { const size_t off = ((size_t)tile * 256 + r + h) * DM + 8 * lane + 512 * j;
                    if (xin_bf) unpack8(__builtin_nontemporal_load((const v4u*)((const bf16*)xin + off)), v[h][j]);
                    else { const f32x4 p0 = __builtin_nontemporal_load((const f32x4*)((const float*)xin + off)), p1 = __builtin_nontemporal_load((const f32x4*)((const float*)xin + off + 4));
                        v[h][j][0] = p0.x; v[h][j][1] = p0.y; v[h][j][2] = p0.z; v[h][j][3] = p0.w; v[h][j][4] = p1.x; v[h][j][5] = p1.y; v[h][j][6] = p1.z; v[h][j][7] = p1.w; }
                    yv[h][j] = has_y ? __builtin_nontemporal_load((const v4u*)(y + off)) : (v4u){0u, 0u, 0u, 0u}; }
            if (has_y) {
                float rstd[4];
#pragma unroll
                for (int h = 0; h < 4; ++h) { float ss = 0.f;
#pragma unroll
                    for (int j = 0; j < 2; ++j) { float yf[8]; unpack8(yv[h][j], yf);
#pragma unroll
                        for (int e = 0; e < 8; ++e) ss += yf[e] * yf[e]; }
                    rstd[h] = __builtin_amdgcn_rsqf(wave_sum(ss) * (1.0f / DM) + EPS); }
#pragma unroll
                for (int j = 0; j < 2; ++j) { const LAS float* gpp = vec + 8 * lane + 512 * j; const f32x4 g0 = *(const LAS f32x4*)gpp, g1 = *(const LAS f32x4*)(gpp + 4);
                    const float gp[8] = {g0.x, g0.y, g0.z, g0.w, g1.x, g1.y, g1.z, g1.w};
#pragma unroll
                    for (int h = 0; h < 4; ++h) { float yf[8]; unpack8(yv[h][j], yf);
#pragma unroll
                        for (int e = 0; e < 8; ++e) v[h][j][e] += gp[e] * (yf[e] * rstd[h]); } }
            }
            if (xout_mode == 1) {
#pragma unroll
                for (int h = 0; h < 4; ++h)
#pragma unroll
                    for (int j = 0; j < 2; ++j) { float* o = xout + ((size_t)tile * 256 + r + h) * DM + 8 * lane + 512 * j;
                        __builtin_nontemporal_store((f32x4){v[h][j][0], v[h][j][1], v[h][j][2], v[h][j][3]}, (f32x4*)o); __builtin_nontemporal_store((f32x4){v[h][j][4], v[h][j][5], v[h][j][6], v[h][j][7]}, (f32x4*)(o + 4)); }
            } else if (xout_mode == 2) {
#pragma unroll
                for (int h = 0; h < 4; ++h)
#pragma unroll
                    for (int j = 0; j < 2; ++j) { const v4u w = pack8(v[h][j]);
                        __builtin_nontemporal_store(w, (v4u*)(xoutb + ((size_t)tile * 256 + r + h) * DM + 8 * lane + 512 * j));
                        unpack8(w, v[h][j]); }
            }
            if (has_h) {
                float rstd[4];
#pragma unroll
                for (int h = 0; h < 4; ++h) { float ss = 0.f;
#pragma unroll
                    for (int j = 0; j < 2; ++j)
#pragma unroll
                        for (int e = 0; e < 8; ++e) ss += v[h][j][e] * v[h][j][e];
                    rstd[h] = __builtin_amdgcn_rsqf(wave_sum(ss) * (1.0f / DM) + EPS); }
#pragma unroll
                for (int j = 0; j < 2; ++j) { const LAS float* gsp = vec + DM + 8 * lane + 512 * j; const LAS float* shp = vec + 2 * DM + 8 * lane + 512 * j;
                    const f32x4 a0 = *(const LAS f32x4*)gsp, a1 = *(const LAS f32x4*)(gsp + 4), b0 = *(const LAS f32x4*)shp, b1 = *(const LAS f32x4*)(shp + 4);
                    const float gs[8] = {a0.x, a0.y, a0.z, a0.w, a1.x, a1.y, a1.z, a1.w}, sh[8] = {b0.x, b0.y, b0.z, b0.w, b1.x, b1.y, b1.z, b1.w};
#pragma unroll
                    for (int h = 0; h < 4; ++h) { float hv[8];
#pragma unroll
                        for (int e = 0; e < 8; ++e) hv[e] = v[h][j][e] * rstd[h] * gs[e] + sh[e];
                        *(v4u*)(hout + ((size_t)tile * 256 + r + h) * DM + 8 * lane + 512 * j) = pack8(hv); } }
            }
        }
    }
}

typedef short v4i16a_t __attribute__((ext_vector_type(4)));
__device__ __forceinline__ v2u lds_tr_a(const LAS bf16* p) { return __builtin_bit_cast(v2u, __builtin_amdgcn_ds_read_tr16_b64_v4i16((LAS v4i16a_t*)p)); }
__device__ __forceinline__ void attn_phase(LAS unsigned char* lds, const bf16* PROJ, bf16* CONCAT, const float* sinks) {
    int tid_ = threadIdx.x; asm volatile("" : "+v"(tid_)); const int tid = tid_, lane = tid & 63, wave = tid >> 6, fr = lane & 15, fq = lane >> 4;
    LAS bf16* Ks = (LAS bf16*)lds;
    LAS bf16* Vs = (LAS bf16*)(lds + 36864);
    v4u kv[4], vv[4];
#define ATT_LOAD_KV(uu) do { const int kh_ = (uu) & 1, n_ = ((uu) >> 1) & 63, b_ = (uu) >> 7; const long rb_ = (long)b_ * SEQ + n_ * 128 - 128; \
        _Pragma("unroll") for (int i = 0; i < 4; ++i) { const int kj = lane + 64 * i; kv[i] = (v4u){0u, 0u, 0u, 0u}; vv[i] = (v4u){0u, 0u, 0u, 0u}; \
            if (n_ > 0 || kj >= 128) { const bf16* p = PROJ + (size_t)(rb_ + kj) * INW + kh_ * 64 + wave * 8; kv[i] = *(const v4u*)(p + 512); vv[i] = *(const v4u*)(p + 640); } } } while (0)
    bf16x8 qf[4][2];
#define ATT_LOAD_Q(uu) do { const int kh_ = (uu) & 1, n_ = ((uu) >> 1) & 63, b_ = (uu) >> 7; const size_t qr_ = (size_t)b_ * SEQ + n_ * 128 + (wave & 1) * 64 + fr; \
        _Pragma("unroll") for (int i = 0; i < 4; ++i) { const bf16* qp = PROJ + (qr_ + 16 * i) * INW + (kh_ * 4 + (wave >> 1)) * 64 + 8 * fq; \
            qf[i][0] = __builtin_nontemporal_load((const bf16x8*)qp); qf[i][1] = __builtin_nontemporal_load((const bf16x8*)(qp + 32)); } } while (0)
    if ((int)blockIdx.x < NB * 64 * 2) { ATT_LOAD_KV((int)blockIdx.x); ATT_LOAD_Q((int)blockIdx.x); }
    for (int u = blockIdx.x; u < NB * 64 * 2; u += gridDim.x) {
        const int kh = u & 1, n = (u >> 1) & 63, b = u >> 7;
        const int g = wave >> 1, h = kh * 4 + g;
        const size_t qrow0 = (size_t)b * SEQ + n * 128 + (wave & 1) * 64 + fr;
#pragma unroll
        for (int i = 0; i < 4; ++i) { const int kj = lane + 64 * i;
            *(LAS v4u*)(Ks + kj * 72 + wave * 8) = kv[i];
            *(LAS v4u*)(Vs + kj * 72 + wave * 8) = vv[i]; }
        __syncthreads();
        if (u + (int)gridDim.x < NB * 64 * 2) ATT_LOAD_KV(u + (int)gridDim.x);
        const float sink = sinks[h];
        const int firstblk = (n == 0);
#pragma unroll
        for (int p = 0; p < 2; ++p) {
            const int q16a = (wave & 1) * 4 + 2 * p, kt0 = q16a;
            f32x4 st[2][10];
            bf16x8 kfr[10][2];
            const LAS bf16* kp0 = Ks + (16 * kt0 + fr) * 72 + 8 * fq;
#define ATT_LDK(t) do { kfr[t][0] = *(const LAS bf16x8*)(kp0 + (t) * 16 * 72); kfr[t][1] = *(const LAS bf16x8*)(kp0 + (t) * 16 * 72 + 32); } while (0)
            ATT_LDK(0);
#pragma unroll
            for (int t = 0; t < 10; ++t) {
                if (t + 1 < 10) ATT_LDK(t + 1);
#pragma unroll
                for (int x = 0; x < 2; ++x) {
                    if (x + 8 - t == 9 || x + 8 - t == -1) { st[x][t] = (f32x4){-1e30f, -1e30f, -1e30f, -1e30f}; continue; }
                    f32x4 acc = (f32x4){0.f, 0.f, 0.f, 0.f};
                    acc = __builtin_amdgcn_mfma_f32_16x16x32_bf16(kfr[t][0], qf[2 * p + x][0], acc, 0, 0, 0);
                    acc = __builtin_amdgcn_mfma_f32_16x16x32_bf16(kfr[t][1], qf[2 * p + x][1], acc, 0, 0, 0);
                    st[x][t] = acc;
                }
            }
#undef ATT_LDK
            float inv[2];
#pragma unroll
            for (int x = 0; x < 2; ++x) {
                float mx = -1e30f;
#pragma unroll
                for (int t = 0; t < 10; ++t) {
                    const int D = x + 8 - t;
                    if (D == 9 || D == -1) continue;
                    const bool tile_off = firstblk && (kt0 + t < 8);
#pragma unroll
                    for (int r = 0; r < 4; ++r) { const int dl = fr - 4 * fq - r;
                        bool valid = !tile_off;
                        if (D == 8) valid = valid && (dl < 0);
                        if (D == 0) valid = valid && (dl >= 0);
                        const float sv = valid ? st[x][t][r] : -1e30f; st[x][t][r] = sv; mx = fmaxf(mx, sv); }
                }
                mx = fmaxf(mx, __shfl_xor(mx, 16)); mx = fmaxf(mx, __shfl_xor(mx, 32)); mx = fmaxf(mx, sink);
                const float mb = mx * LOG2E;
                float lsum = 0.f;
#pragma unroll
                for (int t = 0; t < 10; ++t) {
                    const int D = x + 8 - t;
                    if (D == 9 || D == -1) { st[x][t] = (f32x4){0.f, 0.f, 0.f, 0.f}; continue; }
#pragma unroll
                    for (int r = 0; r < 4; ++r) { const float pe = __builtin_amdgcn_exp2f(st[x][t][r] * LOG2E - mb); st[x][t][r] = pe; lsum += pe; }
                }
                lsum += __shfl_xor(lsum, 16); lsum += __shfl_xor(lsum, 32); lsum += __builtin_amdgcn_exp2f(sink * LOG2E - mb);
                inv[x] = 1.0f / lsum;
            }
            f32x4 ot[2][4];
#pragma unroll
            for (int x = 0; x < 2; ++x)
#pragma unroll
                for (int dt = 0; dt < 4; ++dt) ot[x][dt] = (f32x4){0.f, 0.f, 0.f, 0.f};
            const LAS bf16* vp0 = Vs + (16 * kt0 + 4 * fq + (fr >> 2)) * 72 + 4 * (fr & 3);
            v2u vlo[5][4], vhi[5][4];
#define ATT_LDV(s) do { _Pragma("unroll") for (int dt = 0; dt < 4; ++dt) { vlo[s][dt] = lds_tr_a(vp0 + (s) * 32 * 72 + 16 * dt); vhi[s][dt] = lds_tr_a(vp0 + (s) * 32 * 72 + 16 * 72 + 16 * dt); } } while (0)
#pragma unroll
            for (int s2 = 0; s2 < 5; ++s2) {
                ATT_LDV(s2);
                bf16x8 pf[2];
#pragma unroll
                for (int x = 0; x < 2; ++x) { v4u pw; pw.x = pk2(st[x][2 * s2][0], st[x][2 * s2][1]); pw.y = pk2(st[x][2 * s2][2], st[x][2 * s2][3]);
                    pw.z = pk2(st[x][2 * s2 + 1][0], st[x][2 * s2 + 1][1]); pw.w = pk2(st[x][2 * s2 + 1][2], st[x][2 * s2 + 1][3]); pf[x] = __builtin_bit_cast(bf16x8, pw); }
#pragma unroll
                for (int dt = 0; dt < 4; ++dt) {
                    const bf16x8 vf = __builtin_bit_cast(bf16x8, (v4u){vlo[s2][dt].x, vlo[s2][dt].y, vhi[s2][dt].x, vhi[s2][dt].y});
#pragma unroll
                    for (int x = 0; x < 2; ++x) ot[x][dt] = __builtin_amdgcn_mfma_f32_16x16x32_bf16(vf, pf[x], ot[x][dt], 0, 0, 0);
                }
            }
#undef ATT_LDV
#pragma unroll
            for (int x = 0; x < 2; ++x) {
                LAS bf16* stg = (LAS bf16*)(lds + 73728) + (wave * 2 + x) * (16 * 72);
#pragma unroll
                for (int dt = 0; dt < 4; ++dt) *(LAS v2u*)(stg + fr * 72 + 16 * dt + 4 * fq) = (v2u){pk2(ot[x][dt][0] * inv[x], ot[x][dt][1] * inv[x]), pk2(ot[x][dt][2] * inv[x], ot[x][dt][3] * inv[x])};
                bf16* op = CONCAT + (qrow0 - fr + 16 * (2 * p + x)) * DM + h * 64;
#pragma unroll
                for (int i = 0; i < 2; ++i) { const int row = 8 * i + (lane >> 3), chn = lane & 7;
                    *(v4u*)(op + (size_t)row * DM + chn * 8) = *(const LAS v4u*)(stg + row * 72 + chn * 8); }
            }
        }
        if (u + (int)gridDim.x < NB * 64 * 2) ATT_LOAD_Q(u + (int)gridDim.x);
        __syncthreads();
    }
#undef ATT_LOAD_KV
#undef ATT_LOAD_Q
}

constexpr int PL_US = 136;
template <int W> __device__ __forceinline__ void pool_load(const bf16* PROJ, int gi, int tt, int lane, v4u (&raw)[8]) {
    const size_t t0 = (size_t)tt * 16; const int s0 = (int)(t0 & (SEQ - 1));
    const int ch = lane & 15, rs = lane >> 4;
#pragma unroll
    for (int i = 0; i < 8; ++i) { const int r = rs + 4 * i;
        raw[i] = (v4u){0u, 0u, 0u, 0u};
        if (4 * i + 3 >= 17 - W) { if (s0 - 16 + r >= 0) raw[i] = *(const v4u*)(PROJ + (t0 - 16 + r) * INW + 768 + gi * 128 + ch * 8); } }
}
typedef short v4i16_t __attribute__((ext_vector_type(4)));
__device__ __forceinline__ v2u lds_tr(const LAS bf16* p) { return __builtin_bit_cast(v2u, __builtin_amdgcn_ds_read_tr16_b64_v4i16((LAS v4i16_t*)p)); }
template <int W> __device__ __forceinline__ void pool_compute(bf16* CONCAT, const LAS bf16* wl, LAS bf16* ust, const float* pscale, int gi, int tt, int lane, const v4u (&raw)[8]) {
    const int fr = lane & 15, fq = lane >> 4;
    const size_t t0 = (size_t)tt * 16; const int s0 = (int)(t0 & (SEQ - 1));
    {
        const int ch = lane & 15, rs = lane >> 4;
#pragma unroll
        for (int i = 0; i < 8; ++i) { const int r = rs + 4 * i; if (4 * i + 3 >= 17 - W) *(LAS v4u*)(ust + r * PL_US + ch * 8) = raw[i]; }
    }
    const int s = s0 + fr;
    const int cnt = (s + 1 < W) ? (s + 1) : W;
    const float invc = 1.0f / (float)cnt;
    bf16x8 band;
    { float bv[8];
#pragma unroll
      for (int j = 0; j < 8; ++j) { const int rel = 8 * fq + j - 16 - fr;
          bv[j] = ((rel > -W && rel <= 0) ? 1.0f : 0.0f) - ((rel == 0) ? (float)cnt : 0.0f); }
      band = __builtin_bit_cast(bf16x8, (v4u){pk2(bv[0], bv[1]), pk2(bv[2], bv[3]), pk2(bv[4], bv[5]), pk2(bv[6], bv[7])}); }
    f32x4 pl[8];
    const LAS bf16* trp = ust + (8 * fq + ((lane & 15) >> 2)) * PL_US + 4 * (lane & 3);
#pragma unroll
    for (int a = 0; a < 8; ++a) {
        const v2u lo = lds_tr(trp + 16 * a), hi = lds_tr(trp + 4 * PL_US + 16 * a);
        const bf16x8 ua = __builtin_bit_cast(bf16x8, (v4u){lo.x, lo.y, hi.x, hi.y});
        pl[a] = __builtin_amdgcn_mfma_f32_16x16x32_bf16(ua, band, (f32x4){0.f, 0.f, 0.f, 0.f}, 0, 0, 0);
    }
    bf16x8 pf[4];
#pragma unroll
    for (int ks = 0; ks < 4; ++ks)
        pf[ks] = __builtin_bit_cast(bf16x8, (v4u){pk2(pl[2 * ks][0] * invc, pl[2 * ks][1] * invc), pk2(pl[2 * ks][2] * invc, pl[2 * ks][3] * invc),
                                                  pk2(pl[2 * ks + 1][0] * invc, pl[2 * ks + 1][1] * invc), pk2(pl[2 * ks + 1][2] * invc, pl[2 * ks + 1][3] * invc)});
#pragma unroll
    for (int nt = 0; nt < 8; ++nt) {
        f32x4 acc = (f32x4){0.f, 0.f, 0.f, 0.f};
        const LAS bf16* wp = wl + (16 * nt + fr) * PL_US + 4 * fq;
#pragma unroll
        for (int ks = 0; ks < 4; ++ks) { const v2u lo = *(const LAS v2u*)(wp + 32 * ks), hi = *(const LAS v2u*)(wp + 32 * ks + 16);
            acc = __builtin_amdgcn_mfma_f32_16x16x32_bf16(__builtin_bit_cast(bf16x8, (v4u){lo.x, lo.y, hi.x, hi.y}), pf[ks], acc, 0, 0, 0); }
        const int d = gi * 128 + 16 * nt + 4 * fq;
        const f32x4 sc = *(const f32x4*)(pscale + d);
        *(LAS v2u*)(ust + fr * PL_US + 16 * nt + 4 * fq) = (v2u){pk2(acc[0] * sc.x, acc[1] * sc.y), pk2(acc[2] * sc.z, acc[3] * sc.w)};
    }
#pragma unroll
    for (int i = 0; i < 4; ++i) { const int row = 4 * i + (lane >> 4), chn = lane & 15;
        const v4u w = *(const LAS v4u*)(ust + row * PL_US + chn * 8);
        *(v4u*)(CONCAT + (t0 + row) * DM + 512 + gi * 128 + chn * 8) = w; }
}
template <int W> __device__ __forceinline__ void pool_group(const bf16* PROJ, bf16* CONCAT, const LAS bf16* wl, LAS bf16* ust, const float* pscale, int gi, int gw, int ngw, int lane) {
    v4u ra[8], rb[8];
    {
        const int ch = lane & 15, rs = lane >> 4;
#pragma unroll
        for (int i = 0; i < 8; ++i) if (!(4 * i + 3 >= 17 - W)) *(LAS v4u*)(ust + (rs + 4 * i) * PL_US + ch * 8) = (v4u){0u, 0u, 0u, 0u};
    }
    int tt = gw;
    if (tt < T / 16) pool_load<W>(PROJ, gi, tt, lane, ra);
    while (tt < T / 16) {
        const int tn = tt + ngw;
        if (tn < T / 16) pool_load<W>(PROJ, gi, tn, lane, rb);
        pool_compute<W>(CONCAT, wl, ust, pscale, gi, tt, lane, ra);
        tt = tn;
        if (tt >= T / 16) break;
        const int tn2 = tt + ngw;
        if (tn2 < T / 16) pool_load<W>(PROJ, gi, tn2, lane, ra);
        pool_compute<W>(CONCAT, wl, ust, pscale, gi, tt, lane, rb);
        tt = tn2;
    }
}
__device__ __forceinline__ void pool_phase(LAS unsigned char* lds, const bf16* PROJ, bf16* CONCAT, const bf16* PWT, const float* pscale) {
    int tid_ = threadIdx.x; asm volatile("" : "+v"(tid_)); const int tid = tid_, lane = tid & 63, wave = tid >> 6;
    LAS bf16* wl = (LAS bf16*)lds;
    LAS bf16* ust = (LAS bf16*)(lds + 36864 + wave * 8704);
    const bool quad = (gridDim.x & 3) == 0;
    const int gw = quad ? (int)(blockIdx.x >> 2) * 8 + wave : (int)blockIdx.x * 8 + wave, ngw = quad ? (int)(gridDim.x >> 2) * 8 : (int)gridDim.x * 8;
#pragma unroll 1
    for (int g = 0; g < (quad ? 1 : 4); ++g) {
        const int gi = quad ? (int)(blockIdx.x & 3) : g;
        __syncthreads();
        { const int row = tid >> 2, q = tid & 3; const bf16* src = PWT + ((size_t)gi * 128 + row) * 128 + q * 32;
#pragma unroll
          for (int e = 0; e < 4; ++e) *(LAS v4u*)(wl + row * PL_US + q * 32 + e * 8) = *(const v4u*)(src + e * 8); }
        __syncthreads();
        if (gi == 0) pool_group<2>(PROJ, CONCAT, wl, ust, pscale, gi, gw, ngw, lane);
        else if (gi == 1) pool_group<4>(PROJ, CONCAT, wl, ust, pscale, gi, gw, ngw, lane);
        else if (gi == 2) pool_group<8>(PROJ, CONCAT, wl, ust, pscale, gi, gw, ngw, lane);
        else pool_group<16>(PROJ, CONCAT, wl, ust, pscale, gi, gw, ngw, lane);
    }
    __syncthreads();
}

#ifndef REP_P
#define REP_P 1
#endif
#ifndef REP_G
#define REP_G 1
#endif
#ifndef REP_R
#define REP_R 1
#endif
#ifndef REP_G
#define REP_G 1
#endif
#ifndef REP_IN
#define REP_IN REP_G
#endif
#ifndef REP_GU
#define REP_GU REP_G
#endif
#ifndef REP_DN
#define REP_DN REP_G
#endif
#ifndef REP_PL
#define REP_PL 1
#endif
#ifndef REP_A
#define REP_A 1
#endif
__global__ void __launch_bounds__(512, 2) fwd_kernel(Args a) {
    extern __shared__ __attribute__((aligned(16))) unsigned char lds_raw[];
    cg::grid_group grid = cg::this_grid();
    LAS unsigned char* lds = (LAS unsigned char*)lds_raw;
    unsigned char* ws = a.ws;
    bf16* H = (bf16*)(ws + WS_H); bf16* MIX = (bf16*)(ws + WS_MIX); bf16* PROJ = (bf16*)(ws + WS_PROJ);
    bf16* CONCAT = (bf16*)(ws + WS_CONCAT); bf16* ACT = (bf16*)(ws + WS_ACT);
    const float* cs = (const float*)(ws + WS_CS); bf16* XA = (bf16*)(ws + WS_XA); bf16* XB = (bf16*)(ws + WS_XB);
    volatile LAS unsigned* MISC = (volatile LAS unsigned*)(lds + RING_BYTES + 64);
    if (threadIdx.x == 0) { MISC[0] = 0u; MISC[1] = 0u; }
    __syncthreads();
    XcdBarrier bar = xcd_barrier_post((unsigned*)ws, MISC);
#ifndef REP_S
#define REP_S 1
#endif
#define SEAM() do { for (int rs_ = 0; rs_ < REP_S; ++rs_) xcd_barrier(bar); } while (0)

    for (int rep = 0; rep < REP_P; ++rep) prologue(a, lds);
    if (a.ws == nullptr) grid.sync();
    SEAM();
    for (int rep = 0; rep < REP_R; ++rep) rowwise_phase(a, lds, true, false, true, false, 2, a.x, nullptr, nullptr, XB, H, 0, 0, nullptr, 0, 0, 1, a.g_pre_mix);
    mod_finalize(a);
    SEAM();
#pragma unroll 1
    for (int l = 0; l < DEPTH; ++l) {
        unsigned char* wl = ws + WS_W + (size_t)l * W_LAYER;
        for (int rep = 0; rep < REP_IN; ++rep) {
            pg8::Gemm g{H, (const bf16*)(wl + W_IN), T, INW, DM}; pg8::StaticOrder S; S.init(T, INW, gridDim.x, blockIdx.x);
            pg8::EpiInProj E{PROJ, a.b_in + l * INW, cs};
            pg8::gemm_phase<pg8::EpiInProj, pg8::StaticOrder, true, true>(lds, g, S, E);
        }
        SEAM();
        for (int rep = 0; rep < REP_A; ++rep) attn_phase(lds, PROJ, CONCAT, a.sinks + l * 8);
        for (int rep = 0; rep < REP_PL; ++rep) pool_phase(lds, PROJ, CONCAT, (const bf16*)(wl + W_PW), a.pool_scale + l * 512);
        SEAM();
        for (int rep = 0; rep < REP_G; ++rep) {
            pg8::Gemm g{CONCAT, (const bf16*)(wl + W_OUT), T, DM, DM}; pg8::StaticOrder S; S.init(T, DM, gridDim.x, blockIdx.x);
            pg8::EpiBf16<0> E{MIX, DM, nullptr, 0, 0, 1.f};
            pg8::gemm_phase<pg8::EpiBf16<0>, pg8::StaticOrder, true, true>(lds, g, S, E);
        }
        SEAM();
        for (int rep = 0; rep < REP_R; ++rep) rowwise_phase(a, lds, false, true, true, true, 2, XB, MIX, nullptr, XA, H, l, 2, a.g_post_mix + l * DM, l, 3, 4, a.g_pre_ffn + l * DM);
        SEAM();
#if defined(PROBE_HOT)
#pragma unroll 1
        for (int rep = 0; rep < 2; ++rep) {
            pg8::Gemm g{H, (const bf16*)(wl + W_GU), T, 2 * DFF, rep == 0 ? PROBE_HOT_K : DM}; pg8::DualOrder S; S.so.init(T, 2 * DFF, gridDim.x, blockIdx.x); S.c = blockIdx.x; S.rounds = 22; S.hot = (rep == 0);
            pg8::EpiSwiGLU E{rep == 0 ? MIX : ACT};
            pg8::gemm_phase<pg8::EpiSwiGLU, pg8::DualOrder, true, true>(lds, g, S, E);
            if (rep == 0) SEAM();
        }
#else
#if defined(FFN_SPLIT)
#pragma unroll 1
        for (int hf = 0; hf < 2; ++hf) {
            const size_t r0 = (size_t)hf * (T / 2);
            {
                pg8::Gemm g{H + r0 * DM, (const bf16*)(wl + W_GU), T / 2, 2 * DFF, DM}; pg8::StaticOrder S; S.init(T / 2, 2 * DFF, gridDim.x, blockIdx.x);
                pg8::EpiSwiGLU E{ACT + r0 * DFF};
                pg8::gemm_phase<pg8::EpiSwiGLU, pg8::StaticOrder, true, true>(lds, g, S, E);
            }
            SEAM();
            {
                pg8::Gemm g{ACT + r0 * DFF, (const bf16*)(wl + W_DN), T / 2, DM, DFF}; pg8::StaticOrder S; S.init(T / 2, DM, gridDim.x, blockIdx.x, 1);
                pg8::EpiBf16<0> E{MIX + r0 * DM, DM, nullptr, 0, 0, 1.f};
                pg8::gemm_phase<pg8::EpiBf16<0>, pg8::StaticOrder, true, true>(lds, g, S, E);
            }
            SEAM();
        }
#else
        for (int rep = 0; rep < REP_GU; ++rep) {
            pg8::Gemm g{H, (const bf16*)(wl + W_GU), T, 2 * DFF, DM}; pg8::StaticOrder S; S.init(T, 2 * DFF, gridDim.x, blockIdx.x);
            pg8::EpiSwiGLU E{ACT};
            pg8::gemm_phase<pg8::EpiSwiGLU, pg8::StaticOrder, true, true>(lds, g, S, E);
        }
        SEAM();
        for (int rep = 0; rep < REP_DN; ++rep) {
            pg8::Gemm g{ACT, (const bf16*)(wl + W_DN), T, DM, DFF}; pg8::StaticOrder S; S.init(T, DM, gridDim.x, blockIdx.x, 1);
            pg8::EpiBf16<0> E{MIX, DM, nullptr, 0, 0, 1.f};
            pg8::gemm_phase<pg8::EpiBf16<0>, pg8::StaticOrder, true, true>(lds, g, S, E);
        }
        SEAM();
#endif
#endif
        const bool more = (l + 1 < DEPTH);
        for (int rep = 0; rep < REP_R; ++rep) rowwise_phase(a, lds, false, true, more, true, more ? 2 : 1, XA, MIX, a.out, XB, H, l, 5, a.g_post_ffn + l * DM, l + 1, 0, 1, a.g_pre_mix + (more ? (l + 1) * DM : 0));
        if (more) SEAM();
    }
}

extern "C" void kernel_launch(void* const* d_in, const int* in_sizes, int n_in, void* d_out, int out_size, void* d_ws, size_t ws_size, hipStream_t stream) {
    static int grid_blocks = 0;
    if (grid_blocks == 0) {
        if (n_in != 18 || out_size != T * DM || ws_size < WS_END) { fprintf(stderr, "kernel_launch: unexpected shapes (n_in %d, out %d, ws %zu)\n", n_in, out_size, ws_size); grid_blocks = -1; return; }
        int dev = 0, cus = 0, per_cu = 0;
        hipGetDevice(&dev);
        hipDeviceGetAttribute(&cus, hipDeviceAttributeMultiprocessorCount, dev);
        if (hipFuncSetAttribute((const void*)fwd_kernel, hipFuncAttributeMaxDynamicSharedMemorySize, LDS_BYTES) != hipSuccess) { fprintf(stderr, "kernel_launch: hipFuncSetAttribute failed\n"); grid_blocks = -1; return; }
        if (hipOccupancyMaxActiveBlocksPerMultiprocessor(&per_cu, (const void*)fwd_kernel, 512, LDS_BYTES) != hipSuccess || per_cu < 1) { fprintf(stderr, "kernel_launch: occupancy query gave %d\n", per_cu); per_cu = 1; }
        (void)hipGetLastError();
        grid_blocks = cus * per_cu;
    }
    if (grid_blocks < 0) return;
    if (hipMemsetAsync(d_ws, 0, 65536, stream) != hipSuccess) { fprintf(stderr, "kernel_launch: memset failed\n"); return; }
    Args a{};
    a.x = (const float*)d_in[0]; a.c = (const float*)d_in[1]; a.pos = (const int*)d_in[2]; a.ada_w = (const float*)d_in[3]; a.ada_b = (const float*)d_in[4];
    a.w_in = (const float*)d_in[5]; a.b_in = (const float*)d_in[6]; a.sinks = (const float*)d_in[7]; a.pool_w = (const float*)d_in[8]; a.pool_scale = (const float*)d_in[9];
    a.w_out = (const float*)d_in[10]; a.w_gate = (const float*)d_in[11]; a.w_up = (const float*)d_in[12]; a.w_down = (const float*)d_in[13];
    a.g_pre_mix = (const float*)d_in[14]; a.g_post_mix = (const float*)d_in[15]; a.g_pre_ffn = (const float*)d_in[16]; a.g_post_ffn = (const float*)d_in[17];
    a.out = (float*)d_out; a.ws = (unsigned char*)d_ws;
    void* args[] = {&a};
    hipError_t e = hipLaunchCooperativeKernel((const void*)fwd_kernel, dim3(grid_blocks), dim3(512), args, LDS_BYTES, stream);
    if (e != hipSuccess) fprintf(stderr, "cooperative launch failed: %s (grid %d)\n", hipGetErrorString(e), grid_blocks);
}
```

```cpp
#include <hip/hip_runtime.h>
#include <hip/hip_cooperative_groups.h>
#include <cstdio>
#include <cstdint>
namespace cg = cooperative_groups;
#define LAS __attribute__((address_space(3)))
namespace pg8 {
#define PG8_LAS __attribute__((address_space(3)))
typedef unsigned short bf16_t;
typedef short bf16x8 __attribute__((ext_vector_type(8)));
typedef float f32x4 __attribute__((ext_vector_type(4)));
typedef unsigned u32x4 __attribute__((ext_vector_type(4)));
constexpr int BM = 256, BK = 64, HALF = 128, HTB = HALF * BK * 2  , STAGE_BYTES = 8 * HTB, NXCD = 8, WGM = 8;

__host__ __device__ __forceinline__ int lds_byte(int r, int c) { const int st = (r >> 4) * 2 + (c >> 5), rr = r & 15, cc = c & 31, ob = rr * 64 + cc * 2; return st * 1024 + (ob ^ (((ob >> 9) & 1) << 5)); }
__host__ __device__ __forceinline__ void stage_rc(int b, int& R, int& C) { const int st = b / 1024, sb = b % 1024, swz = sb ^ (((sb >> 9) & 1) << 5); R = (st >> 1) * 16 + swz / 64; C = (st & 1) * 32 + (swz % 64) / 2; }
__host__ __device__ __forceinline__ int perm32(int rho) { const int n = rho >> 4, i = rho & 15; return 8 * (i >> 2) + 4 * n + (i & 3); }

struct Unit { int pm, pn; };
struct Gemm { const bf16_t* A; const bf16_t* Bt; int M, N, K; };

struct StaticOrder {
    int nM, nN, nwg, G, c, rev;
    __host__ __device__ void init(int M, int N, int G_, int c_, int rev_ = 0) { nM = M / BM; nN = N / BM; nwg = nM * nN; G = G_; c = c_; rev = rev_; }
    __host__ __device__ bool next(int i, Unit& u) const {
        const long L = (long)i * G + c; if (L >= nwg) return false;
        int wgid = (int)L; { const int q = nwg / NXCD, r = nwg % NXCD, xcd = wgid % NXCD, off = wgid / NXCD; wgid = (xcd < r ? xcd * (q + 1) : r * (q + 1) + (xcd - r) * q) + off; }
        const int nig = WGM * nN, gid = wgid / nig, fm = gid * WGM, gsz = (nM - fm) < WGM ? (nM - fm) : WGM;
        u.pm = fm + ((wgid % nig) % gsz); u.pn = (wgid % nig) / gsz; if (rev) u.pm = nM - 1 - u.pm; return true;
    }
    __device__ __forceinline__ void a_ready(const Unit&) const {}
    __device__ __forceinline__ void done(const Unit&) const {}
};

__device__ __forceinline__ unsigned cvt_pk_bf16(float lo, float hi) { unsigned r; asm volatile("v_cvt_pk_bf16_f32 %0, %1, %2" : "=v"(r) : "v"(lo), "v"(hi)); return r; }
typedef float f32x2 __attribute__((ext_vector_type(2)));
__device__ __forceinline__ f32x2 gelu_pk(f32x2 v) {
    const f32x2 av = __builtin_elementwise_abs(v), d = av * 0.2316418882f + 1.0f;
    f32x2 t; t.x = __builtin_amdgcn_rcpf(d.x); t.y = __builtin_amdgcn_rcpf(d.y);
    f32x2 q = t * 0.5307027145f + (-0.7265760135f); q = q * t + 0.7107068705f; q = q * t + (-0.142248368f); q = q * t + 0.127414796f; q = q * t;
    const f32x2 s = (v * v) * (-0.72134752044f);
    f32x2 e; e.x = __builtin_amdgcn_exp2f(s.x); e.y = __builtin_amdgcn_exp2f(s.y);
    const f32x2 m = v * (q * e), r = v - m;
    f32x2 o; o.x = v.x < 0.f ? m.x : r.x; o.y = v.y < 0.f ? m.y : r.y; return o;
}

template <int ACT  > struct EpiBf16 {
    static constexpr bool PERM = true, AFTER_DRAIN = false; static_assert(ACT == 0 || ACT == 1, "EpiBf16: ACT is 0 (none) or 1 (gelu_pk)");
    bf16_t* O; int ldc; const float* bias; int split_cols; size_t split_stride; float scale0;
    __device__ __forceinline__ void operator()(const f32x4 (&acc)[2][2][4][2], const Unit& u, int wr, int wc, int fr, int fq) const {
        const int row0 = u.pm * BM + wr * 64 + fr; int colt = u.pn * BM; bf16_t* base = O;
        float sc = 1.f; if (split_cols) { const int t = colt / split_cols; base += (size_t)t * split_stride; colt -= t * split_cols; if (t == 0) sc = scale0; }
        const int col0 = colt + wc * 32 + 8 * fq, bcol0 = u.pn * BM + wc * 32 + 8 * fq;
        f32x4 bv[2][2];
#pragma unroll
        for (int bj = 0; bj < 2; ++bj)
#pragma unroll
            for (int n = 0; n < 2; ++n) bv[bj][n] = bias ? *(const f32x4*)(bias + bcol0 + bj * HALF + 4 * n) : (f32x4){0.f, 0.f, 0.f, 0.f};
#pragma unroll
        for (int ai = 0; ai < 2; ++ai)
#pragma unroll
            for (int m = 0; m < 4; ++m) { bf16_t* rowp = base + (size_t)(row0 + ai * HALF + m * 16) * ldc + col0;
#pragma unroll
                for (int bj = 0; bj < 2; ++bj) { f32x4 v0 = acc[ai][bj][m][0] + bv[bj][0], v1 = acc[ai][bj][m][1] + bv[bj][1];
                    if (ACT == 1) { f32x2 a = gelu_pk((f32x2){v0[0], v0[1]}), b = gelu_pk((f32x2){v0[2], v0[3]}), c = gelu_pk((f32x2){v1[0], v1[1]}), d = gelu_pk((f32x2){v1[2], v1[3]});
                        v0 = (f32x4){a.x, a.y, b.x, b.y}; v1 = (f32x4){c.x, c.y, d.x, d.y}; }
                    v0 = v0 * sc; v1 = v1 * sc; u32x4 w; w.x = cvt_pk_bf16(v0[0], v0[1]); w.y = cvt_pk_bf16(v0[2], v0[3]); w.z = cvt_pk_bf16(v1[0], v1[1]); w.w = cvt_pk_bf16(v1[2], v1[3]);
                    *(u32x4*)(rowp + bj * HALF) = w; } }
    }
};
template <class Epi, class Sched, bool ALIGN_EPI = false, bool SP2 = false, int A_AUX = 0  >
__device__ __forceinline__ void gemm_phase(PG8_LAS unsigned char* lds, const Gemm g, const Sched& S, const Epi& E) {
    int tid_ = threadIdx.x; asm volatile("" : "+v"(tid_)); const int tid = tid_, wid = __builtin_amdgcn_readfirstlane(tid >> 6), lane = tid & 63, wr = wid >> 2, wc = wid & 3, fr = lane & 15, fq = lane >> 4;
    const int K = g.K, nt = K / BK;
    unsigned voffA[2], voffB[2];
#pragma unroll
    for (int i = 0; i < 2; ++i) { int R, C; stage_rc(tid * 16 + i * 8192, R, C); const int Rb = Epi::PERM ? ((R & ~31) + perm32(R & 31)) : R;
        voffA[i] = (unsigned)(R * K + C) * 2u; voffB[i] = (unsigned)(Rb * K + C) * 2u; }
    const size_t kstep = (size_t)(BK * 2);
    const size_t hstep = (size_t)HALF * K * 2;
    const size_t tstep = 2 * hstep;
    const unsigned ldsw = (unsigned)wid * 1024u;
    const int aoff = lds_byte(wr * 64 + fr, fq * 8), boff = lds_byte(wc * 32 + fr, fq * 8);
#define PG8_SA(b, h) (((b) * 2 + (h)) * HTB)
#define PG8_SB(b, h) ((4 + (b) * 2 + (h)) * HTB)
#define PG8_STAGE(bufoff, gbase, voff) do { _Pragma("unroll") for (int _i = 0; _i < 2; ++_i) \
        __builtin_amdgcn_global_load_lds((const unsigned*)((const char*)(gbase) + (voff)[_i]), (PG8_LAS unsigned*)(lds + (bufoff) + ldsw + _i * 8192), 16, 0, 0); } while (0)
#define PG8_STAGEA(bufoff, gbase, voff) do { _Pragma("unroll") for (int _i = 0; _i < 2; ++_i) \
        __builtin_amdgcn_global_load_lds((const unsigned*)((const char*)(gbase) + (voff)[_i]), (PG8_LAS unsigned*)(lds + (bufoff) + ldsw + _i * 8192), 16, 0, A_AUX); } while (0)
#define PG8_LDA(dst, b, h) do { _Pragma("unroll") for (int m = 0; m < 4; ++m) _Pragma("unroll") for (int k = 0; k < 2; ++k) dst[m][k] = *(const PG8_LAS bf16x8*)(lds + PG8_SA(b, h) + aoff + m * 2048 + k * 1024); } while (0)
#define PG8_LDB(dst, b, h) do { _Pragma("unroll") for (int n = 0; n < 2; ++n) _Pragma("unroll") for (int k = 0; k < 2; ++k) dst[n][k] = *(const PG8_LAS bf16x8*)(lds + PG8_SB(b, h) + boff + n * 2048 + k * 1024); } while (0)
#define PG8_MMA(ai, bj, At, Bt) do { __builtin_amdgcn_s_setprio(1); _Pragma("unroll") for (int m = 0; m < 4; ++m) _Pragma("unroll") for (int n = 0; n < 2; ++n) _Pragma("unroll") for (int k = 0; k < 2; ++k) \
        acc[ai][bj][m][n] = __builtin_amdgcn_mfma_f32_16x16x32_bf16(Bt[n][k], At[m][k], acc[ai][bj][m][n], 0, 0, 0); __builtin_amdgcn_s_setprio(0); } while (0)
#define PG8_WAIT_V(n) asm volatile("s_waitcnt vmcnt(" #n ")" ::: "memory")
#define PG8_WAIT_L(n) asm volatile("s_waitcnt lgkmcnt(" #n ")" ::: "memory")
#define PG8_BAR __builtin_amdgcn_s_barrier()
#define PG8_SCHED __builtin_amdgcn_sched_barrier(0)
    Unit cur, nxt; int ui = 0;
    if (!S.next(0, cur)) return;
    f32x4 acc[2][2][4][2];
#pragma unroll
    for (int a = 0; a < 2; ++a)
#pragma unroll
        for (int b = 0; b < 2; ++b)
#pragma unroll
            for (int m = 0; m < 4; ++m)
#pragma unroll
                for (int n = 0; n < 2; ++n) acc[a][b][m][n] = (f32x4){0.f, 0.f, 0.f, 0.f};
    bf16x8 At[4][2], B0[2][2], B1[2][2];
    const char* cA = (const char*)g.A + (size_t)cur.pm * tstep; const char* cB = (const char*)g.Bt + (size_t)cur.pn * tstep;
    S.a_ready(cur);
    if constexpr (SP2) {
        PG8_STAGE(PG8_SB(0, 0), cB, voffB); PG8_STAGE(PG8_SB(0, 1), cB + hstep, voffB); PG8_STAGEA(PG8_SA(0, 0), cA, voffA); PG8_STAGEA(PG8_SA(0, 1), cA + hstep, voffA);
        if (wr == 1) PG8_BAR;
        PG8_WAIT_V(2); PG8_BAR;
        PG8_STAGE(PG8_SB(1, 0), cB + kstep, voffB); PG8_STAGEA(PG8_SA(1, 0), cA + kstep, voffA); PG8_STAGE(PG8_SB(1, 1), cB + hstep + kstep, voffB);
        PG8_WAIT_V(6); PG8_BAR;
    } else {
        PG8_STAGE(PG8_SB(0, 0), cB, voffB); PG8_STAGEA(PG8_SA(0, 0), cA, voffA); PG8_STAGE(PG8_SB(0, 1), cB + hstep, voffB); PG8_STAGEA(PG8_SA(0, 1), cA + hstep, voffA);
        if (wr == 1) PG8_BAR;
        PG8_WAIT_V(4); PG8_BAR;
        PG8_STAGE(PG8_SB(1, 0), cB + kstep, voffB); PG8_STAGEA(PG8_SA(1, 0), cA + kstep, voffA); PG8_STAGE(PG8_SB(1, 1), cB + hstep + kstep, voffB);
        PG8_WAIT_V(6); PG8_BAR;
    }
    for (;;) {
        const bool has_next = S.next(ui + 1, nxt);
        const char* nA = has_next ? (const char*)g.A + (size_t)nxt.pm * tstep : cA; const char* nB = has_next ? (const char*)g.Bt + (size_t)nxt.pn * tstep : cB;
        for (int t = 0; t < nt; t += 2) {
            const bool last = (t == nt - 2);
            const char* a1 = cA + (size_t)(t + 1) * kstep;
            const char* a2 = last ? nA : cA + (size_t)(t + 2) * kstep; const char* b2 = last ? nB : cB + (size_t)(t + 2) * kstep;
            const char* a3 = a2 + kstep; const char* b3 = b2 + kstep;
            if (last && has_next) S.a_ready(nxt);
            if constexpr (SP2) {
            PG8_LDB(B0, 0, 0); PG8_LDB(B1, 0, 1); PG8_SCHED; PG8_LDA(At, 0, 0); PG8_STAGEA(PG8_SA(1, 1), a1 + hstep, voffA);
            PG8_WAIT_V(8); PG8_WAIT_L(0); PG8_BAR; PG8_MMA(0, 0, At, B0); PG8_MMA(0, 1, At, B1); PG8_BAR; PG8_SCHED;
            PG8_LDA(At, 0, 1); PG8_STAGE(PG8_SB(0, 0), b2, voffB); PG8_STAGE(PG8_SB(0, 1), b2 + hstep, voffB); PG8_STAGEA(PG8_SA(0, 0), a2, voffA);
            PG8_WAIT_V(8); PG8_WAIT_L(0); PG8_BAR; PG8_MMA(1, 0, At, B0); PG8_MMA(1, 1, At, B1); PG8_BAR; PG8_SCHED;
            PG8_LDB(B0, 1, 0); PG8_LDB(B1, 1, 1); PG8_SCHED; PG8_LDA(At, 1, 0); PG8_STAGEA(PG8_SA(0, 1), a2 + hstep, voffA);
            PG8_WAIT_V(8); PG8_WAIT_L(0); PG8_BAR; PG8_MMA(0, 0, At, B0); PG8_MMA(0, 1, At, B1); PG8_BAR; PG8_SCHED;
            PG8_LDA(At, 1, 1); PG8_STAGE(PG8_SB(1, 0), b3, voffB); PG8_STAGE(PG8_SB(1, 1), b3 + hstep, voffB); PG8_STAGEA(PG8_SA(1, 0), a3, voffA);
            PG8_WAIT_V(8); PG8_WAIT_L(0); PG8_BAR; PG8_MMA(1, 0, At, B0); PG8_MMA(1, 1, At, B1); PG8_BAR; PG8_SCHED;
            } else {
            PG8_LDB(B0, 0, 0); PG8_SCHED; PG8_LDA(At, 0, 0); PG8_STAGEA(PG8_SA(1, 1), a1 + hstep, voffA);
            PG8_WAIT_L(8); PG8_BAR; PG8_WAIT_L(0); PG8_MMA(0, 0, At, B0); PG8_BAR; PG8_SCHED;
            PG8_LDB(B1, 0, 1); PG8_STAGE(PG8_SB(0, 0), b2, voffB);
            PG8_BAR; PG8_WAIT_L(0); PG8_MMA(0, 1, At, B1); PG8_BAR;
            PG8_LDA(At, 0, 1); PG8_STAGEA(PG8_SA(0, 0), a2, voffA);
            PG8_BAR; PG8_WAIT_L(0); PG8_MMA(1, 0, At, B0); PG8_BAR; PG8_SCHED;
            PG8_STAGE(PG8_SB(0, 1), b2 + hstep, voffB);
            PG8_WAIT_V(6); PG8_BAR; PG8_MMA(1, 1, At, B1); PG8_BAR;
            PG8_LDB(B0, 1, 0); PG8_SCHED; PG8_LDA(At, 1, 0); PG8_STAGEA(PG8_SA(0, 1), a2 + hstep, voffA);
            PG8_WAIT_L(8); PG8_BAR; PG8_WAIT_L(0); PG8_MMA(0, 0, At, B0); PG8_BAR; PG8_SCHED;
            PG8_LDB(B1, 1, 1); PG8_STAGE(PG8_SB(1, 0), b3, voffB);
            PG8_BAR; PG8_WAIT_L(0); PG8_MMA(0, 1, At, B1); PG8_BAR;
            PG8_LDA(At, 1, 1); PG8_STAGEA(PG8_SA(1, 0), a3, voffA);
            PG8_BAR; PG8_WAIT_L(0); PG8_MMA(1, 0, At, B0); PG8_BAR; PG8_SCHED;
            PG8_STAGE(PG8_SB(1, 1), b3 + hstep, voffB);
            PG8_WAIT_V(6); PG8_BAR; PG8_MMA(1, 1, At, B1); PG8_BAR;
            }
        }
        if constexpr (ALIGN_EPI) { if (wr == 0) PG8_BAR; }
        if constexpr (!Epi::AFTER_DRAIN) { E(acc, cur, wr, wc, fr, fq); S.done(cur); }
        if (!has_next) break;
#pragma unroll
        for (int a = 0; a < 2; ++a)
#pragma unroll
            for (int b = 0; b < 2; ++b)
#pragma unroll
                for (int m = 0; m < 4; ++m)
#pragma unroll
                    for (int n = 0; n < 2; ++n) acc[a][b][m][n] = (f32x4){0.f, 0.f, 0.f, 0.f};
        cur = nxt; cA = nA; cB = nB; ++ui;
        if constexpr (ALIGN_EPI) { if (wr == 1) PG8_BAR; }
    }
    PG8_WAIT_V(0);
    if constexpr (!ALIGN_EPI) { if (wr == 0) PG8_BAR; }
    PG8_BAR;
    if constexpr (Epi::AFTER_DRAIN) { E.fused(acc, cur, wr, wc, fr, fq, lds, wid, lane); S.done(cur); }
#undef PG8_SA
#undef PG8_SB
#undef PG8_STAGE
#undef PG8_STAGEA
#undef PG8_LDA
#undef PG8_LDB
#undef PG8_MMA
#undef PG8_WAIT_V
#undef PG8_WAIT_L
#undef PG8_BAR
#undef PG8_SCHED
}
}
#define XB_TMO      128
#define XB_XCNT(j)  (256  + 64 * (j))
#define XB_XSUB(j)  (1280 + 64 * (j))
#define XB_XGEN(j)  (2304 + 64 * (j))
#define XB_TOP      3328
#define XB_TOPGEN   3392
#define XCD_BAR_WORDS 3456
#define XB_SPIN_CAP (1u << 18)

__device__ __forceinline__ unsigned xb_ld(unsigned* p)              { return __hip_atomic_load(p, __ATOMIC_RELAXED, __HIP_MEMORY_SCOPE_AGENT); }
__device__ __forceinline__ unsigned xb_add(unsigned* p, unsigned v) { return __hip_atomic_fetch_add(p, v, __ATOMIC_RELAXED, __HIP_MEMORY_SCOPE_AGENT); }
__device__ __forceinline__ unsigned xb_xcc_id() { return (unsigned)__builtin_amdgcn_s_getreg((3 << 11) | 20) & 0xFu; }
#define XB_SPIN(cond, bar) do { unsigned _sp = 0; while (cond) { __builtin_amdgcn_s_sleep(1); \
    if ((++_sp & 255u) == 0u) { if (xb_ld(&(bar)[XB_TMO])) break; if (_sp > XB_SPIN_CAP) { atomicAdd(&(bar)[XB_TMO], 1u); break; } } } } while (0)

struct XcdBarrier {
    unsigned* bar; unsigned x;
    volatile LAS unsigned* st;
};

__device__ __forceinline__ XcdBarrier xcd_barrier_post(unsigned* bar, volatile LAS unsigned* st) {
    XcdBarrier b; b.bar = bar; b.x = xb_xcc_id(); b.st = st;
    if (threadIdx.x == 0) (void)xb_add(&bar[XB_XCNT(b.x)], 1u);
    return b;
}
__device__ __forceinline__ void xcd_barrier_complete(unsigned* bar, unsigned x, unsigned& nloc, unsigned& nx) {
    const unsigned G = gridDim.x * gridDim.y * gridDim.z;
    unsigned sum, cnt, mine, sp = 0u;
    for (;;) {
        sum = 0u; cnt = 0u; mine = 0u;
#pragma unroll
        for (unsigned j = 0; j < 16; ++j) { const unsigned c = xb_ld(&bar[XB_XCNT(j)]); sum += c; cnt += (c > 0u) ? 1u : 0u; mine = (j == x) ? c : mine; }
        if (sum == G) break;
        __builtin_amdgcn_s_sleep(1);
        if ((++sp & 255u) == 0u) { if (xb_ld(&bar[XB_TMO])) break; if (sp > XB_SPIN_CAP) { atomicAdd(&bar[XB_TMO], 1u); break; } }
    }
    nloc = mine > 0u ? mine : 1u; nx = cnt > 0u ? cnt : 1u;
}

__device__ __forceinline__ void xcd_barrier(const XcdBarrier& b) {
    asm volatile("s_waitcnt vmcnt(0)" ::: "memory");
    __syncthreads();
    if (threadIdx.x == 0) {
        unsigned* bar = b.bar;
        __builtin_amdgcn_s_waitcnt(0);
        unsigned nloc = b.st[0], nx = b.st[1];
        if (nloc == 0u) { xcd_barrier_complete(bar, b.x, nloc, nx); b.st[0] = nloc; b.st[1] = nx; }
        const unsigned old = xb_add(&bar[XB_XSUB(b.x)], 1u);
        const unsigned gen = old / nloc;
        if (old + 1u == (gen + 1u) * nloc) {
            __builtin_amdgcn_fence(__ATOMIC_RELEASE, "agent");
            asm volatile("s_waitcnt vmcnt(0)" ::: "memory");
            const unsigned og = xb_add(&bar[XB_TOP], 1u);
            const unsigned tg = og / nx;
            if (og + 1u == (tg + 1u) * nx) xb_add(&bar[XB_TOPGEN], 1u);
            else XB_SPIN(xb_ld(&bar[XB_TOPGEN]) == tg, bar);
            __builtin_amdgcn_fence(__ATOMIC_ACQUIRE, "agent");
            xb_add(&bar[XB_XGEN(b.x)], 1u);
            asm volatile("s_waitcnt vmcnt(0)" ::: "memory");
        } else {
            XB_SPIN(xb_ld(&bar[XB_XGEN(b.x)]) == gen, bar);
            __builtin_amdgcn_fence(__ATOMIC_ACQUIRE, "agent");
            asm volatile("s_waitcnt vmcnt(0)" ::: "memory");
        }
    }
    __syncthreads();
}

constexpr int NB = 8, SEQ = 8192, DM = 1024, DEPTH = 2;
constexpr int T = NB * SEQ;
constexpr int INW = 1280, DFF = 2816, NMODW = 6 * DM;
constexpr int KCH = 32;
constexpr float EPS = 1e-6f;
constexpr float LOG2E = 1.4426950408889634f;

#define LAS __attribute__((address_space(3)))
typedef unsigned short bf16;
typedef unsigned v4u __attribute__((ext_vector_type(4)));
typedef unsigned v2u __attribute__((ext_vector_type(2)));
typedef float f32x4 __attribute__((ext_vector_type(4)));
typedef short bf16x8 __attribute__((ext_vector_type(8)));

constexpr size_t MiB = 1u << 20;
constexpr size_t WS_MODP = 640 * MiB;
constexpr size_t WS_MODF = 8 * MiB;
constexpr size_t WS_CS = 9 * MiB;
constexpr size_t WS_W = 16 * MiB, W_LAYER = 24 * MiB;
constexpr size_t W_IN = 0, W_OUT = 3 * MiB, W_GU = 5 * MiB, W_DN = 16 * MiB, W_PW = 22 * MiB;
constexpr size_t WS_H = 64 * MiB;
constexpr size_t WS_MIX = 192 * MiB;
constexpr size_t WS_PROJ = 320 * MiB;
constexpr size_t WS_CONCAT = 480 * MiB;
constexpr size_t WS_ACT = 320 * MiB;
constexpr size_t WS_XA = 672 * MiB;
constexpr size_t WS_XB = 800 * MiB;
constexpr size_t WS_END = 928 * MiB;

constexpr int RING_BYTES = 131072;
constexpr int LDS_BYTES = 147456;

struct Args {
    const float* x; const float* c; const int* pos; const float* ada_w; const float* ada_b; const float* w_in; const float* b_in;
    const float* sinks; const float* pool_w; const float* pool_scale; const float* w_out; const float* w_gate; const float* w_up;
    const float* w_down; const float* g_pre_mix; const float* g_post_mix; const float* g_pre_ffn; const float* g_post_ffn;
    float* out; unsigned char* ws;
};

__device__ __constant__ double c_inv_freq[8] = {1.0, 0.19392274474868576, 0.03760603093086393, 0.007292664737217109,
                                                0.001414213562373095, 0.0002742481756762073, 5.318295896944988e-05, 1.031338537721246e-05};

__device__ __forceinline__ unsigned pk2(float lo, float hi) { return pg8::cvt_pk_bf16(lo, hi); }
__device__ __forceinline__ float bf_lo(unsigned w) { return __uint_as_float(w << 16); }
__device__ __forceinline__ float bf_hi(unsigned w) { return __uint_as_float(w & 0xffff0000u); }
__device__ __forceinline__ float wave_sum(float v) {
#pragma unroll
    for (int o = 1; o < 64; o <<= 1) v += __shfl_xor(v, o);
    return v;
}

namespace pg8 {
struct EpiInProj {
    static constexpr bool PERM = true, AFTER_DRAIN = false;
    bf16_t* O; const float* bias; const float* cs;
    __device__ __forceinline__ void operator()(const f32x4 (&acc)[2][2][4][2], const Unit& u, int wr, int wc, int fr, int fq) const {
        const int row0 = u.pm * BM + wr * 64 + fr; const int colt = u.pn * BM; const int col0 = colt + wc * 32 + 8 * fq;
        f32x4 bv[2][2];
#pragma unroll
        for (int bj = 0; bj < 2; ++bj)
#pragma unroll
            for (int n = 0; n < 2; ++n) bv[bj][n] = *(const f32x4*)(bias + col0 + bj * HALF + 4 * n);
        const bool rot_wave = (colt < 640) && ((wc & 1) == 0);
#pragma unroll
        for (int ai = 0; ai < 2; ++ai)
#pragma unroll
        for (int mh = 0; mh < 2; ++mh) {
            f32x4 cc[2][4];
#pragma unroll
            for (int mm = 0; mm < 2; ++mm)
#pragma unroll
                for (int q = 0; q < 4; ++q) cc[mm][q] = (f32x4){1.f, 1.f, 1.f, 1.f};
            if (rot_wave && fq < 2) {
#pragma unroll
                for (int mm = 0; mm < 2; ++mm) { const float* cr = cs + (size_t)(row0 + ai * HALF + (2 * mh + mm) * 16) * 16;
#pragma unroll
                    for (int q = 0; q < 4; ++q) cc[mm][q] = *(const f32x4*)(cr + 4 * q); }
            }
#pragma unroll
            for (int mm = 0; mm < 2; ++mm) {
                const int m = 2 * mh + mm;
                const int row = row0 + ai * HALF + m * 16;
                bf16_t* rowp = O + (size_t)row * INW + col0;
#pragma unroll
                for (int bj = 0; bj < 2; ++bj) {
                    f32x4 v0 = acc[ai][bj][m][0] + bv[bj][0], v1 = acc[ai][bj][m][1] + bv[bj][1];
                    const int cb = colt + bj * HALF;
                    if (rot_wave && cb < 640) {
                        f32x4 p0, p1;
#pragma unroll
                        for (int e = 0; e < 4; ++e) { p0[e] = __shfl_xor(v0[e], 16); p1[e] = __shfl_xor(v1[e], 16); }
                        if (fq == 0) { v0 = v0 * cc[mm][0] - p0 * cc[mm][2]; v1 = v1 * cc[mm][1] - p1 * cc[mm][3]; }
                        else if (fq == 1) { v0 = v0 * cc[mm][0] + p0 * cc[mm][2]; v1 = v1 * cc[mm][1] + p1 * cc[mm][3]; }
                    }
                    if (cb < 512) { v0 = v0 * 0.125f; v1 = v1 * 0.125f; }
                    u32x4 w; w.x = cvt_pk_bf16(v0[0], v0[1]); w.y = cvt_pk_bf16(v0[2], v0[3]); w.z = cvt_pk_bf16(v1[0], v1[1]); w.w = cvt_pk_bf16(v1[2], v1[3]);
                    *(u32x4*)(rowp + bj * HALF) = w;
                }
            }
        }
    }
};
struct EpiSwiGLU {
    static constexpr bool PERM = true, AFTER_DRAIN = false;
    bf16_t* O;
    __device__ __forceinline__ void operator()(const f32x4 (&acc)[2][2][4][2], const Unit& u, int wr, int wc, int fr, int fq) const {
        typedef float f32x2 __attribute__((ext_vector_type(2)));
        const int row0 = u.pm * BM + wr * 64 + fr; const int col0 = u.pn * HALF + wc * 32 + 8 * fq;
#pragma unroll
        for (int ai = 0; ai < 2; ++ai)
#pragma unroll
            for (int m = 0; m < 4; ++m) {
                bf16_t* rowp = O + (size_t)(row0 + ai * HALF + m * 16) * DFF + col0;
                f32x2 G[4], U[4], t[4], r[4];
#pragma unroll
                for (int n = 0; n < 2; ++n) { G[2 * n] = (f32x2){acc[ai][0][m][n][0], acc[ai][0][m][n][1]}; G[2 * n + 1] = (f32x2){acc[ai][0][m][n][2], acc[ai][0][m][n][3]};
                                              U[2 * n] = (f32x2){acc[ai][1][m][n][0], acc[ai][1][m][n][1]}; U[2 * n + 1] = (f32x2){acc[ai][1][m][n][2], acc[ai][1][m][n][3]}; }
#pragma unroll
                for (int q = 0; q < 4; ++q) { t[q].x = __builtin_amdgcn_exp2f(G[q].x); t[q].y = __builtin_amdgcn_exp2f(G[q].y); }
#pragma unroll
                for (int q = 0; q < 4; ++q) { t[q] = t[q] + 1.0f; r[q] = G[q] * U[q]; }
#pragma unroll
                for (int q = 0; q < 4; ++q) { t[q].x = __builtin_amdgcn_rcpf(t[q].x); t[q].y = __builtin_amdgcn_rcpf(t[q].y); }
#pragma unroll
                for (int q = 0; q < 4; ++q) r[q] = r[q] * t[q];
                u32x4 w; w.x = cvt_pk_bf16(r[0].x, r[0].y); w.y = cvt_pk_bf16(r[1].x, r[1].y); w.z = cvt_pk_bf16(r[2].x, r[2].y); w.w = cvt_pk_bf16(r[3].x, r[3].y);
                *(u32x4*)rowp = w;
            }
    }
};
struct DualOrder {
    StaticOrder so; int c, rounds, hot;
    __device__ bool next(int i, Unit& u) const { if (hot) { if (i >= rounds) return false; u.pm = (c % 8) * 2 + ((c / 8) & 1); u.pn = ((c / 8) >> 1) & 3; return true; } return so.next(i, u); }
    __device__ __forceinline__ void a_ready(const Unit&) const {}
    __device__ __forceinline__ void done(const Unit&) const {}
};
}

__device__ __forceinline__ void transpose_item(const float* W, int K, int N, bf16* WT, int drow0, LAS float* scr, int k0, int n0, int lane, float wscale = 1.0f) {
#pragma unroll
    for (int ih = 0; ih < 32; ih += 16) {
        float tv[16];
#pragma unroll
        for (int i = 0; i < 16; ++i) tv[i] = __builtin_nontemporal_load(W + (size_t)(k0 + 2 * (ih + i) + (lane >> 5)) * N + n0 + (lane & 31));
#pragma unroll
        for (int i = 0; i < 16; ++i) scr[(2 * (ih + i) + (lane >> 5)) * 33 + (lane & 31)] = tv[i] * wscale;
    }
    asm volatile("s_waitcnt lgkmcnt(0)" ::: "memory");
    const int c = lane & 7;
#pragma unroll
    for (int j = 0; j < 4; ++j) { const int n = (lane >> 3) + 8 * j; const LAS float* s = scr + (8 * c) * 33 + n;
        v4u o; o.x = pk2(s[0 * 33], s[1 * 33]); o.y = pk2(s[2 * 33], s[3 * 33]); o.z = pk2(s[4 * 33], s[5 * 33]); o.w = pk2(s[6 * 33], s[7 * 33]);
        *(v4u*)(WT + (size_t)(drow0 + n) * K + k0 + 8 * c) = o; }
    asm volatile("s_waitcnt lgkmcnt(0)" ::: "memory");
}

__device__ __forceinline__ void prologue(const Args& a, LAS unsigned char* lds) {
    int tid_ = threadIdx.x; asm volatile("" : "+v"(tid_)); const int tid = tid_, lane = tid & 63, wave = tid >> 6;
    unsigned char* ws = a.ws;
    __syncthreads();
    {
        LAS float* sc = (LAS float*)lds;
        for (int i = tid; i < NB * DM; i += 512) { const float v = a.c[i]; sc[i] = v / (1.0f + __expf(-v)); }
        __syncthreads();
        float* modp = (float*)(ws + WS_MODP);
        for (int item = blockIdx.x; item < DEPTH * KCH * 12; item += gridDim.x) {
            const int l = item / (KCH * 12), r = item % (KCH * 12), kc = r / 12, cb = r % 12, n = cb * 512 + tid;
            constexpr int KPI = DM / KCH;
            const float* w = a.ada_w + ((size_t)l * DM + kc * KPI) * NMODW + n;
            float acc[8];
#pragma unroll
            for (int b = 0; b < 8; ++b) acc[b] = 0.f;
#pragma unroll 1
            for (int kh = 0; kh < KPI; kh += 16) {
                float wv[16];
#pragma unroll
                for (int k = 0; k < 16; ++k) wv[k] = __builtin_nontemporal_load(w + (size_t)(kh + k) * NMODW);
#pragma unroll
                for (int k = 0; k < 16; ++k) {
                    const LAS float* sp = sc + kc * KPI + kh + k;
#pragma unroll
                    for (int b = 0; b < 8; ++b) acc[b] += sp[b * DM] * wv[k];
                    if ((k & 3) == 3) asm volatile("" ::: "memory");
                }
            }
#pragma unroll
            for (int b = 0; b < 8; ++b) modp[((size_t)(l * KCH + kc) * 8 + b) * NMODW + n] = acc[b];
        }
        __syncthreads();
    }
    {
        float* cs = (float*)(ws + WS_CS);
        for (int idx = blockIdx.x * 512 + tid; idx < T * 8; idx += gridDim.x * 512) {
            const int row = idx >> 3, j = idx & 7;
            const double rev = (double)a.pos[row] * c_inv_freq[j] * 0.15915494309189535;
            const float fr = (float)(rev - floor(rev));
            cs[(size_t)row * 16 + j] = __builtin_amdgcn_cosf(fr);
            cs[(size_t)row * 16 + 8 + j] = __builtin_amdgcn_sinf(fr);
        }
    }
    {
        for (int item = blockIdx.x; item < DEPTH * 128; item += gridDim.x) {
            const int l = item >> 7, r = item & 127, gi = r >> 5, c0 = ((r >> 1) & 15) * 8, n = (r & 1) * 512 + tid;
            const float* wo = a.w_out + (size_t)l * DM * DM + (size_t)(512 + gi * 128) * DM + n;
            const float* pw = a.pool_w + ((size_t)(l * 4 + gi) * 128 + c0) * 128;
            const float* ps = a.pool_scale + l * 512 + gi * 128;
            float acc[8];
#pragma unroll
            for (int c = 0; c < 8; ++c) acc[c] = 0.f;
#pragma unroll 1
            for (int d0 = 0; d0 < 128; d0 += 16) {
                float wv[16];
#pragma unroll
                for (int d = 0; d < 16; ++d) wv[d] = wo[(size_t)(d0 + d) * DM] * ps[d0 + d];
#pragma unroll
                for (int d = 0; d < 16; ++d)
#pragma unroll
                    for (int c = 0; c < 8; ++c) acc[c] += pw[c * 128 + d0 + d] * wv[d];
            }
            bf16* dst = (bf16*)(ws + WS_W + (size_t)l * W_LAYER + W_OUT) + (size_t)n * DM + 512 + gi * 128 + c0;
            *(v4u*)dst = (v4u){pk2(acc[0], acc[1]), pk2(acc[2], acc[3]), pk2(acc[4], acc[5]), pk2(acc[6], acc[7])};
        }
    }
    {
        LAS float* scr = (LAS float*)(lds + wave * 16384);
        const int gw = blockIdx.x * 8 + wave, ngw = gridDim.x * 8;
        constexpr int I_IN = 16 * 40, I_OUT = 8 * 32  , I_G = 16 * 88, I_D = 44 * 32;
        constexpr int PER_L = I_IN + I_OUT + 2 * I_G + I_D;
        for (int it = gw; it < DEPTH * PER_L; it += ngw) {
            const int l = it / PER_L; int r = it % PER_L;
            unsigned char* wl = ws + WS_W + (size_t)l * W_LAYER;
            if (r < I_IN) { const int kb = r / 40, nb = r % 40; transpose_item(a.w_in + (size_t)l * DM * INW, DM, INW, (bf16*)(wl + W_IN), 32 * nb, scr, 64 * kb, 32 * nb, lane); continue; } r -= I_IN;
            if (r < I_OUT) { const int kb = r / 32, nb = r % 32; transpose_item(a.w_out + (size_t)l * DM * DM, DM, DM, (bf16*)(wl + W_OUT), 32 * nb, scr, 64 * kb, 32 * nb, lane); continue; } r -= I_OUT;
            if (r < 2 * I_G) { const int up = r >= I_G; if (up) r -= I_G; const int kb = r / 88, nb = r % 88, n0 = 32 * nb;
                transpose_item((up ? a.w_up : a.w_gate) + (size_t)l * DM * DFF, DM, DFF, (bf16*)(wl + W_GU), 256 * (n0 >> 7) + (n0 & 127) + (up ? 128 : 0), scr, 64 * kb, n0, lane, up ? -0.6931471805599453f : -1.4426950408889634f); continue; } r -= 2 * I_G;
            if (r < I_D) { const int kb = r / 32, nb = r % 32; transpose_item(a.w_down + (size_t)l * DFF * DM, DFF, DM, (bf16*)(wl + W_DN), 32 * nb, scr, 64 * kb, 32 * nb, lane); }
        }
    }
}

__device__ __forceinline__ float mod_val(const Args& a, int l, int b, int idx, int col) {
    const float* modp = (const float*)(a.ws + WS_MODP);
    const int n = idx * DM + col;
    float s = a.ada_b[l * NMODW + n];
#pragma unroll
    for (int kc = 0; kc < KCH; ++kc) s += modp[((size_t)(l * KCH + kc) * 8 + b) * NMODW + n];
    return s;
}
__device__ __forceinline__ float mod_fin(const Args& a, int l, int b, int idx, int col) {
    return ((const float*)(a.ws + WS_MODF))[((size_t)(l * 8 + b)) * NMODW + idx * DM + col];
}
__device__ __forceinline__ void mod_finalize(const Args& a) {
    float* modf = (float*)(a.ws + WS_MODF);
    for (int i = blockIdx.x * 512 + threadIdx.x; i < DEPTH * 8 * NMODW; i += gridDim.x * 512) {
        const int l = i / (8 * NMODW), r = i % (8 * NMODW), b = r / NMODW, n = r % NMODW;
        modf[i] = mod_val(a, l, b, n / DM, n % DM);
    }
}
__device__ __forceinline__ void unpack8(const v4u w, float (&f)[8]) {
#pragma unroll
    for (int e = 0; e < 4; ++e) { f[2 * e] = bf_lo(w[e]); f[2 * e + 1] = bf_hi(w[e]); }
}
__device__ __forceinline__ v4u pack8(const float (&f)[8]) { return (v4u){pk2(f[0], f[1]), pk2(f[2], f[3]), pk2(f[4], f[5]), pk2(f[6], f[7])}; }
__device__ __forceinline__ void rowwise_phase(const Args& a, LAS unsigned char* lds, bool from_partials, bool has_y, bool has_h, bool xin_bf, int xout_mode,
        const void* xin, const bf16* y, float* xout, bf16* xoutb, bf16* hout,
        int l_y, int gate_idx, const float* g_post, int l_h, int shift_idx, int scale_idx, const float* g_pre) {
    int tid_ = threadIdx.x; asm volatile("" : "+v"(tid_)); const int tid = tid_, lane = tid & 63, wave = tid >> 6;
    LAS float* vec = (LAS float*)lds;
    for (int tile = blockIdx.x; tile < T / 256; tile += gridDim.x) {
        const int b = tile / (SEQ / 256);
        __syncthreads();
        for (int col = tid; col < DM; col += 512) {
            if (from_partials) {
                if (has_y) vec[col] = mod_val(a, l_y, b, gate_idx, col) * g_post[col];
                if (has_h) { vec[DM + col] = g_pre[col] * (1.0f + mod_val(a, l_h, b, scale_idx, col)); vec[2 * DM + col] = mod_val(a, l_h, b, shift_idx, col); }
            } else {
                if (has_y) vec[col] = mod_fin(a, l_y, b, gate_idx, col) * g_post[col];
                if (has_h) { vec[DM + col] = g_pre[col] * (1.0f + mod_fin(a, l_h, b, scale_idx, col)); vec[2 * DM + col] = mod_fin(a, l_h, b, shift_idx, col); }
            }
        }
        __syncthreads();
#pragma unroll 1
        for (int r = wave * 4; r < 256; r += 32) {
            float v[4][2][8]; v4u yv[4][2];
#pragma unroll
            for (int h = 0; h < 4; ++h)
#pragma unroll
                for (int j = 0; j < 2; ++j) { const size_t off = ((size_t)tile * 256 + r + h) * DM + 8 * lane + 512 * j;
                    if (xin_bf) unpack8(__builtin_nontemporal_load((const v4u*)((const bf16*)xin + off)), v[h][j]);
                    else { const f32x4 p0 = __builtin_nontemporal_load((const f32x4*)((const float*)xin + off)), p1 = __builtin_nontemporal_load((const f32x4*)((const float*)xin + off + 4));
                        v[h][j][0] = p0.x; v[h][j][1] = p0.y; v[h][j][2] = p0.z; v[h][j][3] = p0.w; v[h][j][4] = p1.x; v[h][j][5] = p1.y; v[h][j][6] = p1.z; v[h][j][7] = p1.w; }
                    yv[h][j] = has_y ? __builtin_nontemporal_load((const v4u*)(y + off)) : (v4u){0u, 0u, 0u, 0u}; }
            if (has_y) {
                float rstd[4];
#pragma unroll
                for (int h = 0; h < 4; ++h) { float ss = 0.f;
#pragma unroll
                    for (int j = 0; j < 2; ++j) { float yf[8]; unpack8(yv[h][j], yf);
#pragma unroll
                        for (int e = 0; e < 8; ++e) ss += yf[e] * yf[e]; }
                    rstd[h] = __builtin_amdgcn_rsqf(wave_sum(ss) * (1.0f / DM) + EPS); }
#pragma unroll
                for (int j = 0; j < 2; ++j) { const LAS float* gpp = vec + 8 * lane + 512 * j; const f32x4 g0 = *(const LAS f32x4*)gpp, g1 = *(const LAS f32x4*)(gpp + 4);
                    const float gp[8] = {g0.x, g0.y, g0.z, g0.w, g1.x, g1.y, g1.z, g1.w};
#pragma unroll
                    for (int h = 0; h < 4; ++h) { float yf[8]; unpack8(yv[h][j], yf);
#pragma unroll
                        for (int e = 0; e < 8; ++e) v[h][j][e] += gp[e] * (yf[e] * rstd[h]); } }
            }
            if (xout_mode == 1) {
#pragma unroll
                for (int h = 0; h < 4; ++h)
#pragma unroll
                    for (int j = 0; j < 2; ++j) { float* o = xout + ((size_t)tile * 256 + r + h) * DM + 8 * lane + 512 * j;
                        __builtin_nontemporal_store((f32x4){v[h][j][0], v[h][j][1], v[h][j][2], v[h][j][3]}, (f32x4*)o); __builtin_nontemporal_store((f32x4){v[h][j][4], v[h][j][5], v[h][j][6], v[h][j][7]}, (f32x4*)(o + 4)); }
            } else if (xout_mode == 2) {
#pragma unroll
                for (int h = 0; h < 4; ++h)
#pragma unroll
                    for (int j = 0; j < 2; ++j) { const v4u w = pack8(v[h][j]);
                        __builtin_nontemporal_store(w, (v4u*)(xoutb + ((size_t)tile * 256 + r + h) * DM + 8 * lane + 512 * j));
                        unpack8(w, v[h][j]); }
            }
            if (has_h) {
                float rstd[4];
#pragma unroll
                for (int h = 0; h < 4; ++h) { float ss = 0.f;
#pragma unroll
                    for (int j = 0; j < 2; ++j)
#pragma unroll
                        for (int e = 0; e < 8; ++e) ss += v[h][j][e] * v[h][j][e];
                    rstd[h] = __builtin_amdgcn_rsqf(wave_sum(ss) * (1.0f / DM) + EPS); }
#pragma unroll
                for (int j = 0; j < 2; ++j) { const LAS float* gsp = vec + DM + 8 * lane + 512 * j; const LAS float* shp = vec + 2 * DM + 8 * lane + 512 * j;
                    const f32x4 a0 = *(const LAS f32x4*)gsp, a1 = *(const LAS f32x4*)(gsp + 4), b0 = *(const LAS f32x4*)shp, b1 = *(const LAS f32x4*)(shp + 4);
                    const float gs[8] = {a0.x, a0.y, a0.z, a0.w, a1.x, a1.y, a1.z, a1.w}, sh[8] = {b0.x, b0.y, b0.z, b0.w, b1.x, b1.y, b1.z, b1.w};
#pragma unroll
                    for (int h = 0; h < 4; ++h) { float hv[8];
#pragma unroll
                        for (int e = 0; e < 8; ++e) hv[e] = v[h][j][e] * rstd[h] * gs[e] + sh[e];
                        *(v4u*)(hout + ((size_t)tile * 256 + r + h) * DM + 8 * lane + 512 * j) = pack8(hv); } }
            }
        }
    }
}

typedef short v4i16a_t __attribute__((ext_vector_type(4)));
__device__ __forceinline__ v2u lds_tr_a(const LAS bf16* p) { return __builtin_bit_cast(v2u, __builtin_amdgcn_ds_read_tr16_b64_v4i16((LAS v4i16a_t*)p)); }
__device__ __forceinline__ void attn_phase(LAS unsigned char* lds, const bf16* PROJ, bf16* CONCAT, const float* sinks) {
    int tid_ = threadIdx.x; asm volatile("" : "+v"(tid_)); const int tid = tid_, lane = tid & 63, wave = tid >> 6, fr = lane & 15, fq = lane >> 4;
    LAS bf16* Ks = (LAS bf16*)lds;
    LAS bf16* Vs = (LAS bf16*)(lds + 36864);
    v4u kv[4], vv[4];
#define ATT_LOAD_KV(uu) do { const int kh_ = (uu) & 1, n_ = ((uu) >> 1) & 63, b_ = (uu) >> 7; const long rb_ = (long)b_ * SEQ + n_ * 128 - 128; \
        _Pragma("unroll") for (int i = 0; i < 4; ++i) { const int kj = lane + 64 * i; kv[i] = (v4u){0u, 0u, 0u, 0u}; vv[i] = (v4u){0u, 0u, 0u, 0u}; \
            if (n_ > 0 || kj >= 128) { const bf16* p = PROJ + (size_t)(rb_ + kj) * INW + kh_ * 64 + wave * 8; kv[i] = *(const v4u*)(p + 512); vv[i] = *(const v4u*)(p + 640); } } } while (0)
    bf16x8 qf[4][2];
#define ATT_LOAD_Q(uu) do { const int kh_ = (uu) & 1, n_ = ((uu) >> 1) & 63, b_ = (uu) >> 7; const size_t qr_ = (size_t)b_ * SEQ + n_ * 128 + (wave & 1) * 64 + fr; \
        _Pragma("unroll") for (int i = 0; i < 4; ++i) { const bf16* qp = PROJ + (qr_ + 16 * i) * INW + (kh_ * 4 + (wave >> 1)) * 64 + 8 * fq; \
            qf[i][0] = __builtin_nontemporal_load((const bf16x8*)qp); qf[i][1] = __builtin_nontemporal_load((const bf16x8*)(qp + 32)); } } while (0)
    const bool xmap = (gridDim.x == 256);
#define ATT_UNIT(lin) (xmap ? ((((lin) >> 8) * 2 + (((lin) & 7) >> 2)) * 128 + (32 * ((lin) & 1) + (((lin) & 255) >> 3)) * 2 + ((((lin) & 7) >> 1) & 1)) : (lin))
    if ((int)blockIdx.x < NB * 64 * 2) { ATT_LOAD_KV(ATT_UNIT((int)blockIdx.x)); ATT_LOAD_Q(ATT_UNIT((int)blockIdx.x)); }
    for (int ul = blockIdx.x; ul < NB * 64 * 2; ul += gridDim.x) {
        const int u = ATT_UNIT(ul);
        const int kh = u & 1, n = (u >> 1) & 63, b = u >> 7;
        const int g = wave >> 1, h = kh * 4 + g;
        const size_t qrow0 = (size_t)b * SEQ + n * 128 + (wave & 1) * 64 + fr;
#pragma unroll
        for (int i = 0; i < 4; ++i) { const int kj = lane + 64 * i;
            *(LAS v4u*)(Ks + kj * 72 + wave * 8) = kv[i];
            *(LAS v4u*)(Vs + kj * 72 + wave * 8) = vv[i]; }
        __syncthreads();
        if (ul + (int)gridDim.x < NB * 64 * 2) ATT_LOAD_KV(ATT_UNIT(ul + (int)gridDim.x));
        const float sink = sinks[h];
        const int firstblk = (n == 0);
#pragma unroll
        for (int p = 0; p < 2; ++p) {
            const int q16a = (wave & 1) * 4 + 2 * p, kt0 = q16a;
            f32x4 st[2][10];
            bf16x8 kfr[10][2];
            const LAS bf16* kp0 = Ks + (16 * kt0 + fr) * 72 + 8 * fq;
#define ATT_LDK(t) do { kfr[t][0] = *(const LAS bf16x8*)(kp0 + (t) * 16 * 72); kfr[t][1] = *(const LAS bf16x8*)(kp0 + (t) * 16 * 72 + 32); } while (0)
            ATT_LDK(0);
#pragma unroll
            for (int t = 0; t < 10; ++t) {
                if (t + 1 < 10) ATT_LDK(t + 1);
#pragma unroll
                for (int x = 0; x < 2; ++x) {
                    if (x + 8 - t == 9 || x + 8 - t == -1) { st[x][t] = (f32x4){-1e30f, -1e30f, -1e30f, -1e30f}; continue; }
                    f32x4 acc = (f32x4){0.f, 0.f, 0.f, 0.f};
                    acc = __builtin_amdgcn_mfma_f32_16x16x32_bf16(kfr[t][0], qf[2 * p + x][0], acc, 0, 0, 0);
                    acc = __builtin_amdgcn_mfma_f32_16x16x32_bf16(kfr[t][1], qf[2 * p + x][1], acc, 0, 0, 0);
                    st[x][t] = acc;
                }
            }
#undef ATT_LDK
            float inv[2];
#pragma unroll
            for (int x = 0; x < 2; ++x) {
                float mx = -1e30f;
#pragma unroll
                for (int t = 0; t < 10; ++t) {
                    const int D = x + 8 - t;
                    if (D == 9 || D == -1) continue;
                    const bool tile_off = firstblk && (kt0 + t < 8);
#pragma unroll
                    for (int r = 0; r < 4; ++r) { const int dl = fr - 4 * fq - r;
                        bool valid = !tile_off;
                        if (D == 8) valid = valid && (dl < 0);
                        if (D == 0) valid = valid && (dl >= 0);
                        const float sv = valid ? st[x][t][r] : -1e30f; st[x][t][r] = sv; mx = fmaxf(mx, sv); }
                }
                mx = fmaxf(mx, __shfl_xor(mx, 16)); mx = fmaxf(mx, __shfl_xor(mx, 32)); mx = fmaxf(mx, sink);
                const float mb = mx * LOG2E;
                float lsum = 0.f;
#pragma unroll
                for (int t = 0; t < 10; ++t) {
                    const int D = x + 8 - t;
                    if (D == 9 || D == -1) { st[x][t] = (f32x4){0.f, 0.f, 0.f, 0.f}; continue; }
#pragma unroll
                    for (int r = 0; r < 4; ++r) { const float pe = __builtin_amdgcn_exp2f(st[x][t][r] * LOG2E - mb); st[x][t][r] = pe; lsum += pe; }
                }
                lsum += __shfl_xor(lsum, 16); lsum += __shfl_xor(lsum, 32); lsum += __builtin_amdgcn_exp2f(sink * LOG2E - mb);
                inv[x] = 1.0f / lsum;
            }
            f32x4 ot[2][4];
#pragma unroll
            for (int x = 0; x < 2; ++x)
#pragma unroll
                for (int dt = 0; dt < 4; ++dt) ot[x][dt] = (f32x4){0.f, 0.f, 0.f, 0.f};
            const LAS bf16* vp0 = Vs + (16 * kt0 + 4 * fq + (fr >> 2)) * 72 + 4 * (fr & 3);
            v2u vlo[5][4], vhi[5][4];
#define ATT_LDV(s) do { _Pragma("unroll") for (int dt = 0; dt < 4; ++dt) { vlo[s][dt] = lds_tr_a(vp0 + (s) * 32 * 72 + 16 * dt); vhi[s][dt] = lds_tr_a(vp0 + (s) * 32 * 72 + 16 * 72 + 16 * dt); } } while (0)
#pragma unroll
            for (int s2 = 0; s2 < 5; ++s2) {
                ATT_LDV(s2);
                bf16x8 pf[2];
#pragma unroll
                for (int x = 0; x < 2; ++x) { v4u pw; pw.x = pk2(st[x][2 * s2][0], st[x][2 * s2][1]); pw.y = pk2(st[x][2 * s2][2], st[x][2 * s2][3]);
                    pw.z = pk2(st[x][2 * s2 + 1][0], st[x][2 * s2 + 1][1]); pw.w = pk2(st[x][2 * s2 + 1][2], st[x][2 * s2 + 1][3]); pf[x] = __builtin_bit_cast(bf16x8, pw); }
#pragma unroll
                for (int dt = 0; dt < 4; ++dt) {
                    const bf16x8 vf = __builtin_bit_cast(bf16x8, (v4u){vlo[s2][dt].x, vlo[s2][dt].y, vhi[s2][dt].x, vhi[s2][dt].y});
#pragma unroll
                    for (int x = 0; x < 2; ++x) ot[x][dt] = __builtin_amdgcn_mfma_f32_16x16x32_bf16(vf, pf[x], ot[x][dt], 0, 0, 0);
                }
            }
#undef ATT_LDV
#pragma unroll
            for (int x = 0; x < 2; ++x) {
                LAS bf16* stg = (LAS bf16*)(lds + 73728) + (wave * 2 + x) * (16 * 72);
#pragma unroll
                for (int dt = 0; dt < 4; ++dt) *(LAS v2u*)(stg + fr * 72 + 16 * dt + 4 * fq) = (v2u){pk2(ot[x][dt][0] * inv[x], ot[x][dt][1] * inv[x]), pk2(ot[x][dt][2] * inv[x], ot[x][dt][3] * inv[x])};
                bf16* op = CONCAT + (qrow0 - fr + 16 * (2 * p + x)) * DM + h * 64;
#pragma unroll
                for (int i = 0; i < 2; ++i) { const int row = 8 * i + (lane >> 3), chn = lane & 7;
                    *(v4u*)(op + (size_t)row * DM + chn * 8) = *(const LAS v4u*)(stg + row * 72 + chn * 8); }
            }
        }
        if (ul + (int)gridDim.x < NB * 64 * 2) ATT_LOAD_Q(ATT_UNIT(ul + (int)gridDim.x));
        __syncthreads();
    }
#undef ATT_LOAD_KV
#undef ATT_LOAD_Q
#undef ATT_UNIT
}

constexpr int PL_US = 136;
template <int W> __device__ __forceinline__ void pool_load(const bf16* PROJ, int gi, int tt, int lane, v4u (&raw)[8]) {
    const size_t t0 = (size_t)tt * 16; const int s0 = (int)(t0 & (SEQ - 1));
    const int ch = lane & 15, rs = lane >> 4;
#pragma unroll
    for (int i = 0; i < 8; ++i) { const int r = rs + 4 * i;
        raw[i] = (v4u){0u, 0u, 0u, 0u};
        if (4 * i + 3 >= 17 - W) { if (s0 - 16 + r >= 0) raw[i] = *(const v4u*)(PROJ + (t0 - 16 + r) * INW + 768 + gi * 128 + ch * 8); } }
}
typedef short v4i16_t __attribute__((ext_vector_type(4)));
__device__ __forceinline__ v2u lds_tr(const LAS bf16* p) { return __builtin_bit_cast(v2u, __builtin_amdgcn_ds_read_tr16_b64_v4i16((LAS v4i16_t*)p)); }
template <int W> __device__ __forceinline__ void pool_compute(bf16* CONCAT, LAS bf16* ust, int gi, int tt, int lane, const v4u (&raw)[8]) {
    const int fr = lane & 15, fq = lane >> 4;
    const size_t t0 = (size_t)tt * 16; const int s0 = (int)(t0 & (SEQ - 1));
    {
        const int ch = lane & 15, rs = lane >> 4;
#pragma unroll
        for (int i = 0; i < 8; ++i) { const int r = rs + 4 * i; if (4 * i + 3 >= 17 - W) *(LAS v4u*)(ust + r * PL_US + ch * 8) = raw[i]; }
    }
    const int s = s0 + fr;
    const int cnt = (s + 1 < W) ? (s + 1) : W;
    const float invc = 1.0f / (float)cnt;
    bf16x8 band;
    { float bv[8];
#pragma unroll
      for (int j = 0; j < 8; ++j) { const int rel = 8 * fq + j - 16 - fr;
          bv[j] = ((rel > -W && rel <= 0) ? 1.0f : 0.0f) - ((rel == 0) ? (float)cnt : 0.0f); }
      band = __builtin_bit_cast(bf16x8, (v4u){pk2(bv[0], bv[1]), pk2(bv[2], bv[3]), pk2(bv[4], bv[5]), pk2(bv[6], bv[7])}); }
    f32x4 pl[8];
    const LAS bf16* trp = ust + (8 * fq + ((lane & 15) >> 2)) * PL_US + 4 * (lane & 3);
#pragma unroll
    for (int a = 0; a < 8; ++a) {
        const v2u lo = lds_tr(trp + 16 * a), hi = lds_tr(trp + 4 * PL_US + 16 * a);
        const bf16x8 ua = __builtin_bit_cast(bf16x8, (v4u){lo.x, lo.y, hi.x, hi.y});
        pl[a] = __builtin_amdgcn_mfma_f32_16x16x32_bf16(ua, band, (f32x4){0.f, 0.f, 0.f, 0.f}, 0, 0, 0);
    }
#pragma unroll
    for (int a = 0; a < 8; ++a) *(LAS v2u*)(ust + fr * PL_US + 16 * a + 4 * fq) = (v2u){pk2(pl[a][0] * invc, pl[a][1] * invc), pk2(pl[a][2] * invc, pl[a][3] * invc)};
#pragma unroll
    for (int i = 0; i < 4; ++i) { const int row = 4 * i + (lane >> 4), chn = lane & 15;
        const v4u w = *(const LAS v4u*)(ust + row * PL_US + chn * 8);
        *(v4u*)(CONCAT + (t0 + row) * DM + 512 + gi * 128 + chn * 8) = w; }
}
template <int W> __device__ __forceinline__ void pool_group(const bf16* PROJ, bf16* CONCAT, LAS bf16* ust, int gi, int gw, int ngw, int lane) {
    v4u ra[8], rb[8];
    {
        const int ch = lane & 15, rs = lane >> 4;
#pragma unroll
        for (int i = 0; i < 8; ++i) if (!(4 * i + 3 >= 17 - W)) *(LAS v4u*)(ust + (rs + 4 * i) * PL_US + ch * 8) = (v4u){0u, 0u, 0u, 0u};
    }
    int tt = gw;
    if (tt < T / 16) pool_load<W>(PROJ, gi, tt, lane, ra);
    while (tt < T / 16) {
        const int tn = tt + ngw;
        if (tn < T / 16) pool_load<W>(PROJ, gi, tn, lane, rb);
        pool_compute<W>(CONCAT, ust, gi, tt, lane, ra);
        tt = tn;
        if (tt >= T / 16) break;
        const int tn2 = tt + ngw;
        if (tn2 < T / 16) pool_load<W>(PROJ, gi, tn2, lane, ra);
        pool_compute<W>(CONCAT, ust, gi, tt, lane, rb);
        tt = tn2;
    }
}
__device__ __forceinline__ void pool_phase(LAS unsigned char* lds, const bf16* PROJ, bf16* CONCAT) {
    int tid_ = threadIdx.x; asm volatile("" : "+v"(tid_)); const int tid = tid_, lane = tid & 63, wave = tid >> 6;
    LAS bf16* ust = (LAS bf16*)(lds + wave * 8704);
    __syncthreads();
#pragma unroll 1
    for (int gi = 0; gi < 4; ++gi) {
        const int gw = blockIdx.x * 8 + wave, ngw = gridDim.x * 8;
        if (gi == 0) pool_group<2>(PROJ, CONCAT, ust, gi, gw, ngw, lane);
        else if (gi == 1) pool_group<4>(PROJ, CONCAT, ust, gi, gw, ngw, lane);
        else if (gi == 2) pool_group<8>(PROJ, CONCAT, ust, gi, gw, ngw, lane);
        else pool_group<16>(PROJ, CONCAT, ust, gi, gw, ngw, lane);
    }
    __syncthreads();
}

#ifndef REP_P
#define REP_P 1
#endif
#ifndef REP_G
#define REP_G 1
#endif
#ifndef REP_R
#define REP_R 1
#endif
#ifndef REP_G
#define REP_G 1
#endif
#ifndef REP_IN
#define REP_IN REP_G
#endif
#ifndef REP_GU
#define REP_GU REP_G
#endif
#ifndef REP_DN
#define REP_DN REP_G
#endif
#ifndef REP_PL
#define REP_PL 1
#endif
#ifndef REP_A
#define REP_A 1
#endif
__global__ void __launch_bounds__(512, 2) fwd_kernel(Args a) {
    extern __shared__ __attribute__((aligned(16))) unsigned char lds_raw[];
    cg::grid_group grid = cg::this_grid();
    LAS unsigned char* lds = (LAS unsigned char*)lds_raw;
    unsigned char* ws = a.ws;
    bf16* H = (bf16*)(ws + WS_H); bf16* MIX = (bf16*)(ws + WS_MIX); bf16* PROJ = (bf16*)(ws + WS_PROJ);
    bf16* CONCAT = (bf16*)(ws + WS_CONCAT); bf16* ACT = (bf16*)(ws + WS_ACT);
    const float* cs = (const float*)(ws + WS_CS); bf16* XA = (bf16*)(ws + WS_XA); bf16* XB = (bf16*)(ws + WS_XB);
    volatile LAS unsigned* MISC = (volatile LAS unsigned*)(lds + RING_BYTES + 64);
    if (threadIdx.x == 0) { MISC[0] = 0u; MISC[1] = 0u; }
    __syncthreads();
    XcdBarrier bar = xcd_barrier_post((unsigned*)ws, MISC);
#ifndef REP_S
#define REP_S 1
#endif
#define SEAM() do { for (int rs_ = 0; rs_ < REP_S; ++rs_) xcd_barrier(bar); } while (0)

    for (int rep = 0; rep < REP_P; ++rep) prologue(a, lds);
    if (a.ws == nullptr) grid.sync();
    SEAM();
    for (int rep = 0; rep < REP_R; ++rep) rowwise_phase(a, lds, true, false, true, false, 2, a.x, nullptr, nullptr, XB, H, 0, 0, nullptr, 0, 0, 1, a.g_pre_mix);
    mod_finalize(a);
    SEAM();
#pragma unroll 1
    for (int l = 0; l < DEPTH; ++l) {
        unsigned char* wl = ws + WS_W + (size_t)l * W_LAYER;
        for (int rep = 0; rep < REP_IN; ++rep) {
            pg8::Gemm g{H, (const bf16*)(wl + W_IN), T, INW, DM}; pg8::StaticOrder S; S.init(T, INW, gridDim.x, blockIdx.x);
            pg8::EpiInProj E{PROJ, a.b_in + l * INW, cs};
            pg8::gemm_phase<pg8::EpiInProj, pg8::StaticOrder, true, true>(lds, g, S, E);
        }
        SEAM();
        for (int rep = 0; rep < REP_A; ++rep) attn_phase(lds, PROJ, CONCAT, a.sinks + l * 8);
        for (int rep = 0; rep < REP_PL; ++rep) pool_phase(lds, PROJ, CONCAT);
        SEAM();
        for (int rep = 0; rep < REP_G; ++rep) {
            pg8::Gemm g{CONCAT, (const bf16*)(wl + W_OUT), T, DM, DM}; pg8::StaticOrder S; S.init(T, DM, gridDim.x, blockIdx.x);
            pg8::EpiBf16<0> E{MIX, DM, nullptr, 0, 0, 1.f};
            pg8::gemm_phase<pg8::EpiBf16<0>, pg8::StaticOrder, true, true>(lds, g, S, E);
        }
        SEAM();
        for (int rep = 0; rep < REP_R; ++rep) rowwise_phase(a, lds, false, true, true, true, 2, XB, MIX, nullptr, XA, H, l, 2, a.g_post_mix + l * DM, l, 3, 4, a.g_pre_ffn + l * DM);
        SEAM();
#if defined(PROBE_HOT)
#pragma unroll 1
        for (int rep = 0; rep < 2; ++rep) {
            pg8::Gemm g{H, (const bf16*)(wl + W_GU), T, 2 * DFF, rep == 0 ? PROBE_HOT_K : DM}; pg8::DualOrder S; S.so.init(T, 2 * DFF, gridDim.x, blockIdx.x); S.c = blockIdx.x; S.rounds = 22; S.hot = (rep == 0);
            pg8::EpiSwiGLU E{rep == 0 ? MIX : ACT};
            pg8::gemm_phase<pg8::EpiSwiGLU, pg8::DualOrder, true, true>(lds, g, S, E);
            if (rep == 0) SEAM();
        }
#else
#if defined(FFN_SPLIT)
#pragma unroll 1
        for (int hf = 0; hf < 2; ++hf) {
            const size_t r0 = (size_t)hf * (T / 2);
            {
                pg8::Gemm g{H + r0 * DM, (const bf16*)(wl + W_GU), T / 2, 2 * DFF, DM}; pg8::StaticOrder S; S.init(T / 2, 2 * DFF, gridDim.x, blockIdx.x);
                pg8::EpiSwiGLU E{ACT + r0 * DFF};
                pg8::gemm_phase<pg8::EpiSwiGLU, pg8::StaticOrder, true, true>(lds, g, S, E);
            }
            SEAM();
            {
                pg8::Gemm g{ACT + r0 * DFF, (const bf16*)(wl + W_DN), T / 2, DM, DFF}; pg8::StaticOrder S; S.init(T / 2, DM, gridDim.x, blockIdx.x, 1);
                pg8::EpiBf16<0> E{MIX + r0 * DM, DM, nullptr, 0, 0, 1.f};
                pg8::gemm_phase<pg8::EpiBf16<0>, pg8::StaticOrder, true, true>(lds, g, S, E);
            }
            SEAM();
        }
#else
        for (int rep = 0; rep < REP_GU; ++rep) {
            pg8::Gemm g{H, (const bf16*)(wl + W_GU), T, 2 * DFF, DM}; pg8::StaticOrder S; S.init(T, 2 * DFF, gridDim.x, blockIdx.x);
            pg8::EpiSwiGLU E{ACT};
            pg8::gemm_phase<pg8::EpiSwiGLU, pg8::StaticOrder, true, true>(lds, g, S, E);
        }
        SEAM();
        for (int rep = 0; rep < REP_DN; ++rep) {
            pg8::Gemm g{ACT, (const bf16*)(wl + W_DN), T, DM, DFF}; pg8::StaticOrder S; S.init(T, DM, gridDim.x, blockIdx.x, 1);
            pg8::EpiBf16<0> E{MIX, DM, nullptr, 0, 0, 1.f};
            pg8::gemm_phase<pg8::EpiBf16<0>, pg8::StaticOrder, true, true>(lds, g, S, E);
        }
        SEAM();
#endif
#endif
        const bool more = (l + 1 < DEPTH);
        for (int rep = 0; rep < REP_R; ++rep) rowwise_phase(a, lds, false, true, more, true, more ? 2 : 1, XA, MIX, a.out, XB, H, l, 5, a.g_post_ffn + l * DM, l + 1, 0, 1, a.g_pre_mix + (more ? (l + 1) * DM : 0));
        if (more) SEAM();
    }
}

extern "C" void kernel_launch(void* const* d_in, const int* in_sizes, int n_in, void* d_out, int out_size, void* d_ws, size_t ws_size, hipStream_t stream) {
    static int grid_blocks = 0;
    if (grid_blocks == 0) {
        if (n_in != 18 || out_size != T * DM || ws_size < WS_END) { fprintf(stderr, "kernel_launch: unexpected shapes (n_in %d, out %d, ws %zu)\n", n_in, out_size, ws_size); grid_blocks = -1; return; }
        int dev = 0, cus = 0, per_cu = 0;
        hipGetDevice(&dev);
        hipDeviceGetAttribute(&cus, hipDeviceAttributeMultiprocessorCount, dev);
        if (hipFuncSetAttribute((const void*)fwd_kernel, hipFuncAttributeMaxDynamicSharedMemorySize, LDS_BYTES) != hipSuccess) { fprintf(stderr, "kernel_launch: hipFuncSetAttribute failed\n"); grid_blocks = -1; return; }
        if (hipOccupancyMaxActiveBlocksPerMultiprocessor(&per_cu, (const void*)fwd_kernel, 512, LDS_BYTES) != hipSuccess || per_cu < 1) { fprintf(stderr, "kernel_launch: occupancy query gave %d\n", per_cu); per_cu = 1; }
        (void)hipGetLastError();
        grid_blocks = cus * per_cu;
    }
    if (grid_blocks < 0) return;
    if (hipMemsetAsync(d_ws, 0, 65536, stream) != hipSuccess) { fprintf(stderr, "kernel_launch: memset failed\n"); return; }
    Args a{};
    a.x = (const float*)d_in[0]; a.c = (const float*)d_in[1]; a.pos = (const int*)d_in[2]; a.ada_w = (const float*)d_in[3]; a.ada_b = (const float*)d_in[4];
    a.w_in = (const float*)d_in[5]; a.b_in = (const float*)d_in[6]; a.sinks = (const float*)d_in[7]; a.pool_w = (const float*)d_in[8]; a.pool_scale = (const float*)d_in[9];
    a.w_out = (const float*)d_in[10]; a.w_gate = (const float*)d_in[11]; a.w_up = (const float*)d_in[12]; a.w_down = (const float*)d_in[13];
    a.g_pre_mix = (const float*)d_in[14]; a.g_post_mix = (const float*)d_in[15]; a.g_pre_ffn = (const float*)d_in[16]; a.g_post_ffn = (const float*)d_in[17];
    a.out = (float*)d_out; a.ws = (unsigned char*)d_ws;
    void* args[] = {&a};
    hipError_t e = hipLaunchCooperativeKernel((const void*)fwd_kernel, dim3(grid_blocks), dim3(512), args, LDS_BYTES, stream);
    if (e != hipSuccess) fprintf(stderr, "cooperative launch failed: %s (grid %d)\n", hipGetErrorString(e), grid_blocks);
}
```

```cpp
#include <hip/hip_runtime.h>
#include <hip/hip_cooperative_groups.h>
#include <cstdio>
#include <cstdint>
namespace cg = cooperative_groups;
#define LAS __attribute__((address_space(3)))
namespace pg8 {
#define PG8_LAS __attribute__((address_space(3)))
typedef unsigned short bf16_t;
typedef short bf16x8 __attribute__((ext_vector_type(8)));
typedef float f32x4 __attribute__((ext_vector_type(4)));
typedef unsigned u32x4 __attribute__((ext_vector_type(4)));
constexpr int BM = 256, BK = 64, HALF = 128, HTB = HALF * BK * 2  , STAGE_BYTES = 8 * HTB, NXCD = 8, WGM = 4;

__host__ __device__ __forceinline__ int lds_byte(int r, int c) { const int st = (r >> 4) * 2 + (c >> 5), rr = r & 15, cc = c & 31, ob = rr * 64 + cc * 2; return st * 1024 + (ob ^ (((ob >> 9) & 1) << 5)); }
__host__ __device__ __forceinline__ void stage_rc(int b, int& R, int& C) { const int st = b / 1024, sb = b % 1024, swz = sb ^ (((sb >> 9) & 1) << 5); R = (st >> 1) * 16 + swz / 64; C = (st & 1) * 32 + (swz % 64) / 2; }
__host__ __device__ __forceinline__ int perm32(int rho) { const int n = rho >> 4, i = rho & 15; return 8 * (i >> 2) + 4 * n + (i & 3); }

struct Unit { int pm, pn; };
struct Gemm { const bf16_t* A; const bf16_t* Bt; int M, N, K; };

struct StaticOrder {
    int nM, nN, nwg, G, c, rev;
    __host__ __device__ void init(int M, int N, int G_, int c_, int rev_ = 0) { nM = M / BM; nN = N / BM; nwg = nM * nN; G = G_; c = c_; rev = rev_; }
    __host__ __device__ bool next(int i, Unit& u) const {
        const long L = (long)i * G + c; if (L >= nwg) return false;
        int wgid = (int)L; { const int q = nwg / NXCD, r = nwg % NXCD, xcd = wgid % NXCD, off = wgid / NXCD; wgid = (xcd < r ? xcd * (q + 1) : r * (q + 1) + (xcd - r) * q) + off; }
        const int nig = WGM * nN, gid = wgid / nig, fm = gid * WGM, gsz = (nM - fm) < WGM ? (nM - fm) : WGM;
        u.pm = fm + ((wgid % nig) % gsz); u.pn = (wgid % nig) / gsz; if (rev) u.pm = nM - 1 - u.pm; return true;
    }
    __device__ __forceinline__ void a_ready(const Unit&) const {}
    __device__ __forceinline__ void done(const Unit&) const {}
};

__device__ __forceinline__ unsigned cvt_pk_bf16(float lo, float hi) { unsigned r; asm volatile("v_cvt_pk_bf16_f32 %0, %1, %2" : "=v"(r) : "v"(lo), "v"(hi)); return r; }
typedef float f32x2 __attribute__((ext_vector_type(2)));
__device__ __forceinline__ f32x2 gelu_pk(f32x2 v) {
    const f32x2 av = __builtin_elementwise_abs(v), d = av * 0.2316418882f + 1.0f;
    f32x2 t; t.x = __builtin_amdgcn_rcpf(d.x); t.y = __builtin_amdgcn_rcpf(d.y);
    f32x2 q = t * 0.5307027145f + (-0.7265760135f); q = q * t + 0.7107068705f; q = q * t + (-0.142248368f); q = q * t + 0.127414796f; q = q * t;
    const f32x2 s = (v * v) * (-0.72134752044f);
    f32x2 e; e.x = __builtin_amdgcn_exp2f(s.x); e.y = __builtin_amdgcn_exp2f(s.y);
    const f32x2 m = v * (q * e), r = v - m;
    f32x2 o; o.x = v.x < 0.f ? m.x : r.x; o.y = v.y < 0.f ? m.y : r.y; return o;
}

template <int ACT  > struct EpiBf16 {
    static constexpr bool PERM = true, AFTER_DRAIN = false; static_assert(ACT == 0 || ACT == 1, "EpiBf16: ACT is 0 (none) or 1 (gelu_pk)");
    bf16_t* O; int ldc; const float* bias; int split_cols; size_t split_stride; float scale0;
    __device__ __forceinline__ void operator()(const f32x4 (&acc)[2][2][4][2], const Unit& u, int wr, int wc, int fr, int fq) const {
        const int row0 = u.pm * BM + wr * 64 + fr; int colt = u.pn * BM; bf16_t* base = O;
        float sc = 1.f; if (split_cols) { const int t = colt / split_cols; base += (size_t)t * split_stride; colt -= t * split_cols; if (t == 0) sc = scale0; }
        const int col0 = colt + wc * 32 + 8 * fq, bcol0 = u.pn * BM + wc * 32 + 8 * fq;
        f32x4 bv[2][2];
#pragma unroll
        for (int bj = 0; bj < 2; ++bj)
#pragma unroll
            for (int n = 0; n < 2; ++n) bv[bj][n] = bias ? *(const f32x4*)(bias + bcol0 + bj * HALF + 4 * n) : (f32x4){0.f, 0.f, 0.f, 0.f};
#pragma unroll
        for (int ai = 0; ai < 2; ++ai)
#pragma unroll
            for (int m = 0; m < 4; ++m) { bf16_t* rowp = base + (size_t)(row0 + ai * HALF + m * 16) * ldc + col0;
#pragma unroll
                for (int bj = 0; bj < 2; ++bj) { f32x4 v0 = acc[ai][bj][m][0] + bv[bj][0], v1 = acc[ai][bj][m][1] + bv[bj][1];
                    if (ACT == 1) { f32x2 a = gelu_pk((f32x2){v0[0], v0[1]}), b = gelu_pk((f32x2){v0[2], v0[3]}), c = gelu_pk((f32x2){v1[0], v1[1]}), d = gelu_pk((f32x2){v1[2], v1[3]});
                        v0 = (f32x4){a.x, a.y, b.x, b.y}; v1 = (f32x4){c.x, c.y, d.x, d.y}; }
                    v0 = v0 * sc; v1 = v1 * sc; u32x4 w; w.x = cvt_pk_bf16(v0[0], v0[1]); w.y = cvt_pk_bf16(v0[2], v0[3]); w.z = cvt_pk_bf16(v1[0], v1[1]); w.w = cvt_pk_bf16(v1[2], v1[3]);
                    *(u32x4*)(rowp + bj * HALF) = w; } }
    }
};
template <class Epi, class Sched, bool ALIGN_EPI = false, bool SP2 = false, int A_AUX = 0  >
__device__ __forceinline__ void gemm_phase(PG8_LAS unsigned char* lds, const Gemm g, const Sched& S, const Epi& E) {
    int tid_ = threadIdx.x; asm volatile("" : "+v"(tid_)); const int tid = tid_, wid = __builtin_amdgcn_readfirstlane(tid >> 6), lane = tid & 63, wr = wid >> 2, wc = wid & 3, fr = lane & 15, fq = lane >> 4;
    const int K = g.K, nt = K / BK;
    unsigned voffA[2], voffB[2];
#pragma unroll
    for (int i = 0; i < 2; ++i) { int R, C; stage_rc(tid * 16 + i * 8192, R, C); const int Rb = Epi::PERM ? ((R & ~31) + perm32(R & 31)) : R;
        voffA[i] = (unsigned)(R * K + C) * 2u; voffB[i] = (unsigned)(Rb * K + C) * 2u; }
    const size_t kstep = (size_t)(BK * 2);
    const size_t hstep = (size_t)HALF * K * 2;
    const size_t tstep = 2 * hstep;
    const unsigned ldsw = (unsigned)wid * 1024u;
    const int aoff = lds_byte(wr * 64 + fr, fq * 8), boff = lds_byte(wc * 32 + fr, fq * 8);
#define PG8_SA(b, h) (((b) * 2 + (h)) * HTB)
#define PG8_SB(b, h) ((4 + (b) * 2 + (h)) * HTB)
#define PG8_STAGE(bufoff, gbase, voff) do { _Pragma("unroll") for (int _i = 0; _i < 2; ++_i) \
        __builtin_amdgcn_global_load_lds((const unsigned*)((const char*)(gbase) + (voff)[_i]), (PG8_LAS unsigned*)(lds + (bufoff) + ldsw + _i * 8192), 16, 0, 0); } while (0)
#define PG8_STAGEA(bufoff, gbase, voff) do { _Pragma("unroll") for (int _i = 0; _i < 2; ++_i) \
        __builtin_amdgcn_global_load_lds((const unsigned*)((const char*)(gbase) + (voff)[_i]), (PG8_LAS unsigned*)(lds + (bufoff) + ldsw + _i * 8192), 16, 0, A_AUX); } while (0)
#define PG8_LDA(dst, b, h) do { _Pragma("unroll") for (int m = 0; m < 4; ++m) _Pragma("unroll") for (int k = 0; k < 2; ++k) dst[m][k] = *(const PG8_LAS bf16x8*)(lds + PG8_SA(b, h) + aoff + m * 2048 + k * 1024); } while (0)
#define PG8_LDB(dst, b, h) do { _Pragma("unroll") for (int n = 0; n < 2; ++n) _Pragma("unroll") for (int k = 0; k < 2; ++k) dst[n][k] = *(const PG8_LAS bf16x8*)(lds + PG8_SB(b, h) + boff + n * 2048 + k * 1024); } while (0)
#define PG8_MMA(ai, bj, At, Bt) do { __builtin_amdgcn_s_setprio(1); _Pragma("unroll") for (int m = 0; m < 4; ++m) _Pragma("unroll") for (int n = 0; n < 2; ++n) _Pragma("unroll") for (int k = 0; k < 2; ++k) \
        acc[ai][bj][m][n] = __builtin_amdgcn_mfma_f32_16x16x32_bf16(Bt[n][k], At[m][k], acc[ai][bj][m][n], 0, 0, 0); __builtin_amdgcn_s_setprio(0); } while (0)
#define PG8_WAIT_V(n) asm volatile("s_waitcnt vmcnt(" #n ")" ::: "memory")
#define PG8_WAIT_L(n) asm volatile("s_waitcnt lgkmcnt(" #n ")" ::: "memory")
#define PG8_BAR __builtin_amdgcn_s_barrier()
#define PG8_SCHED __builtin_amdgcn_sched_barrier(0)
    Unit cur, nxt; int ui = 0;
    if (!S.next(0, cur)) return;
    f32x4 acc[2][2][4][2];
#pragma unroll
    for (int a = 0; a < 2; ++a)
#pragma unroll
        for (int b = 0; b < 2; ++b)
#pragma unroll
            for (int m = 0; m < 4; ++m)
#pragma unroll
                for (int n = 0; n < 2; ++n) acc[a][b][m][n] = (f32x4){0.f, 0.f, 0.f, 0.f};
    bf16x8 At[4][2], B0[2][2], B1[2][2];
    const char* cA = (const char*)g.A + (size_t)cur.pm * tstep; const char* cB = (const char*)g.Bt + (size_t)cur.pn * tstep;
    S.a_ready(cur);
    if constexpr (SP2) {
        PG8_STAGE(PG8_SB(0, 0), cB, voffB); PG8_STAGE(PG8_SB(0, 1), cB + hstep, voffB); PG8_STAGEA(PG8_SA(0, 0), cA, voffA); PG8_STAGEA(PG8_SA(0, 1), cA + hstep, voffA);
        if (wr == 1) PG8_BAR;
        PG8_WAIT_V(2); PG8_BAR;
        PG8_STAGE(PG8_SB(1, 0), cB + kstep, voffB); PG8_STAGEA(PG8_SA(1, 0), cA + kstep, voffA); PG8_STAGE(PG8_SB(1, 1), cB + hstep + kstep, voffB);
        PG8_WAIT_V(6); PG8_BAR;
    } else {
        PG8_STAGE(PG8_SB(0, 0), cB, voffB); PG8_STAGEA(PG8_SA(0, 0), cA, voffA); PG8_STAGE(PG8_SB(0, 1), cB + hstep, voffB); PG8_STAGEA(PG8_SA(0, 1), cA + hstep, voffA);
        if (wr == 1) PG8_BAR;
        PG8_WAIT_V(4); PG8_BAR;
        PG8_STAGE(PG8_SB(1, 0), cB + kstep, voffB); PG8_STAGEA(PG8_SA(1, 0), cA + kstep, voffA); PG8_STAGE(PG8_SB(1, 1), cB + hstep + kstep, voffB);
        PG8_WAIT_V(6); PG8_BAR;
    }
    for (;;) {
        const bool has_next = S.next(ui + 1, nxt);
        const char* nA = has_next ? (const char*)g.A + (size_t)nxt.pm * tstep : cA; const char* nB = has_next ? (const char*)g.Bt + (size_t)nxt.pn * tstep : cB;
        for (int t = 0; t < nt; t += 2) {
            const bool last = (t == nt - 2);
            const char* a1 = cA + (size_t)(t + 1) * kstep;
            const char* a2 = last ? nA : cA + (size_t)(t + 2) * kstep; const char* b2 = last ? nB : cB + (size_t)(t + 2) * kstep;
            const char* a3 = a2 + kstep; const char* b3 = b2 + kstep;
            if (last && has_next) S.a_ready(nxt);
            if constexpr (SP2) {
            PG8_LDB(B0, 0, 0); PG8_LDB(B1, 0, 1); PG8_SCHED; PG8_LDA(At, 0, 0); PG8_STAGEA(PG8_SA(1, 1), a1 + hstep, voffA);
            PG8_WAIT_V(8); PG8_WAIT_L(0); PG8_BAR; PG8_MMA(0, 0, At, B0); PG8_MMA(0, 1, At, B1); PG8_BAR; PG8_SCHED;
            PG8_LDA(At, 0, 1); PG8_STAGE(PG8_SB(0, 0), b2, voffB); PG8_STAGE(PG8_SB(0, 1), b2 + hstep, voffB); PG8_STAGEA(PG8_SA(0, 0), a2, voffA);
            PG8_WAIT_V(8); PG8_WAIT_L(0); PG8_BAR; PG8_MMA(1, 0, At, B0); PG8_MMA(1, 1, At, B1); PG8_BAR; PG8_SCHED;
            PG8_LDB(B0, 1, 0); PG8_LDB(B1, 1, 1); PG8_SCHED; PG8_LDA(At, 1, 0); PG8_STAGEA(PG8_SA(0, 1), a2 + hstep, voffA);
            PG8_WAIT_V(8); PG8_WAIT_L(0); PG8_BAR; PG8_MMA(0, 0, At, B0); PG8_MMA(0, 1, At, B1); PG8_BAR; PG8_SCHED;
            PG8_LDA(At, 1, 1); PG8_STAGE(PG8_SB(1, 0), b3, voffB); PG8_STAGE(PG8_SB(1, 1), b3 + hstep, voffB); PG8_STAGEA(PG8_SA(1, 0), a3, voffA);
            PG8_WAIT_V(8); PG8_WAIT_L(0); PG8_BAR; PG8_MMA(1, 0, At, B0); PG8_MMA(1, 1, At, B1); PG8_BAR; PG8_SCHED;
            } else {
            PG8_LDB(B0, 0, 0); PG8_SCHED; PG8_LDA(At, 0, 0); PG8_STAGEA(PG8_SA(1, 1), a1 + hstep, voffA);
            PG8_WAIT_L(8); PG8_BAR; PG8_WAIT_L(0); PG8_MMA(0, 0, At, B0); PG8_BAR; PG8_SCHED;
            PG8_LDB(B1, 0, 1); PG8_STAGE(PG8_SB(0, 0), b2, voffB);
            PG8_BAR; PG8_WAIT_L(0); PG8_MMA(0, 1, At, B1); PG8_BAR;
            PG8_LDA(At, 0, 1); PG8_STAGEA(PG8_SA(0, 0), a2, voffA);
            PG8_BAR; PG8_WAIT_L(0); PG8_MMA(1, 0, At, B0); PG8_BAR; PG8_SCHED;
            PG8_STAGE(PG8_SB(0, 1), b2 + hstep, voffB);
            PG8_WAIT_V(6); PG8_BAR; PG8_MMA(1, 1, At, B1); PG8_BAR;
            PG8_LDB(B0, 1, 0); PG8_SCHED; PG8_LDA(At, 1, 0); PG8_STAGEA(PG8_SA(0, 1), a2 + hstep, voffA);
            PG8_WAIT_L(8); PG8_BAR; PG8_WAIT_L(0); PG8_MMA(0, 0, At, B0); PG8_BAR; PG8_SCHED;
            PG8_LDB(B1, 1, 1); PG8_STAGE(PG8_SB(1, 0), b3, voffB);
            PG8_BAR; PG8_WAIT_L(0); PG8_MMA(0, 1, At, B1); PG8_BAR;
            PG8_LDA(At, 1, 1); PG8_STAGEA(PG8_SA(1, 0), a3, voffA);
            PG8_BAR; PG8_WAIT_L(0); PG8_MMA(1, 0, At, B0); PG8_BAR; PG8_SCHED;
            PG8_STAGE(PG8_SB(1, 1), b3 + hstep, voffB);
            PG8_WAIT_V(6); PG8_BAR; PG8_MMA(1, 1, At, B1); PG8_BAR;
            }
        }
        if constexpr (ALIGN_EPI) { if (wr == 0) PG8_BAR; }
        if constexpr (!Epi::AFTER_DRAIN) { E(acc, cur, wr, wc, fr, fq); S.done(cur); }
        if (!has_next) break;
#pragma unroll
        for (int a = 0; a < 2; ++a)
#pragma unroll
            for (int b = 0; b < 2; ++b)
#pragma unroll
                for (int m = 0; m < 4; ++m)
#pragma unroll
                    for (int n = 0; n < 2; ++n) acc[a][b][m][n] = (f32x4){0.f, 0.f, 0.f, 0.f};
        cur = nxt; cA = nA; cB = nB; ++ui;
        if constexpr (ALIGN_EPI) { if (wr == 1) PG8_BAR; }
    }
    PG8_WAIT_V(0);
    if constexpr (!ALIGN_EPI) { if (wr == 0) PG8_BAR; }
    PG8_BAR;
    if constexpr (Epi::AFTER_DRAIN) { E.fused(acc, cur, wr, wc, fr, fq, lds, wid, lane); S.done(cur); }
#undef PG8_SA
#undef PG8_SB
#undef PG8_STAGE
#undef PG8_STAGEA
#undef PG8_LDA
#undef PG8_LDB
#undef PG8_MMA
#undef PG8_WAIT_V
#undef PG8_WAIT_L
#undef PG8_BAR
#undef PG8_SCHED
}
}
#define XB_TMO      128
#define XB_XCNT(j)  (256  + 64 * (j))
#define XB_XSUB(j)  (1280 + 64 * (j))
#define XB_XGEN(j)  (2304 + 64 * (j))
#define XB_TOP      3328
#define XB_TOPGEN   3392
#define XCD_BAR_WORDS 3456
#define XB_SPIN_CAP (1u << 18)

__device__ __forceinline__ unsigned xb_ld(unsigned* p)              { return __hip_atomic_load(p, __ATOMIC_RELAXED, __HIP_MEMORY_SCOPE_AGENT); }
__device__ __forceinline__ unsigned xb_add(unsigned* p, unsigned v) { return __hip_atomic_fetch_add(p, v, __ATOMIC_RELAXED, __HIP_MEMORY_SCOPE_AGENT); }
__device__ __forceinline__ unsigned xb_xcc_id() { return (unsigned)__builtin_amdgcn_s_getreg((3 << 11) | 20) & 0xFu; }
#define XB_SPIN(cond, bar) do { unsigned _sp = 0; while (cond) { __builtin_amdgcn_s_sleep(1); \
    if ((++_sp & 255u) == 0u) { if (xb_ld(&(bar)[XB_TMO])) break; if (_sp > XB_SPIN_CAP) { atomicAdd(&(bar)[XB_TMO], 1u); break; } } } } while (0)

struct XcdBarrier {
    unsigned* bar; unsigned x;
    volatile LAS unsigned* st;
};

__device__ __forceinline__ XcdBarrier xcd_barrier_post(unsigned* bar, volatile LAS unsigned* st) {
    XcdBarrier b; b.bar = bar; b.x = xb_xcc_id(); b.st = st;
    if (threadIdx.x == 0) (void)xb_add(&bar[XB_XCNT(b.x)], 1u);
    return b;
}
__device__ __forceinline__ void xcd_barrier_complete(unsigned* bar, unsigned x, unsigned& nloc, unsigned& nx) {
    const unsigned G = gridDim.x * gridDim.y * gridDim.z;
    unsigned sum, cnt, mine, sp = 0u;
    for (;;) {
        sum = 0u; cnt = 0u; mine = 0u;
#pragma unroll
        for (unsigned j = 0; j < 16; ++j) { const unsigned c = xb_ld(&bar[XB_XCNT(j)]); sum += c; cnt += (c > 0u) ? 1u : 0u; mine = (j == x) ? c : mine; }
        if (sum == G) break;
        __builtin_amdgcn_s_sleep(1);
        if ((++sp & 255u) == 0u) { if (xb_ld(&bar[XB_TMO])) break; if (sp > XB_SPIN_CAP) { atomicAdd(&bar[XB_TMO], 1u); break; } }
    }
    nloc = mine > 0u ? mine : 1u; nx = cnt > 0u ? cnt : 1u;
}

__device__ __forceinline__ void xcd_barrier(const XcdBarrier& b) {
    asm volatile("s_waitcnt vmcnt(0)" ::: "memory");
    __syncthreads();
    if (threadIdx.x == 0) {
        unsigned* bar = b.bar;
        __builtin_amdgcn_s_waitcnt(0);
        unsigned nloc = b.st[0], nx = b.st[1];
        if (nloc == 0u) { xcd_barrier_complete(bar, b.x, nloc, nx); b.st[0] = nloc; b.st[1] = nx; }
        const unsigned old = xb_add(&bar[XB_XSUB(b.x)], 1u);
        const unsigned gen = old / nloc;
        if (old + 1u == (gen + 1u) * nloc) {
            __builtin_amdgcn_fence(__ATOMIC_RELEASE, "agent");
            asm volatile("s_waitcnt vmcnt(0)" ::: "memory");
            const unsigned og = xb_add(&bar[XB_TOP], 1u);
            const unsigned tg = og / nx;
            if (og + 1u == (tg + 1u) * nx) xb_add(&bar[XB_TOPGEN], 1u);
            else XB_SPIN(xb_ld(&bar[XB_TOPGEN]) == tg, bar);
            __builtin_amdgcn_fence(__ATOMIC_ACQUIRE, "agent");
            xb_add(&bar[XB_XGEN(b.x)], 1u);
            asm volatile("s_waitcnt vmcnt(0)" ::: "memory");
        } else {
            XB_SPIN(xb_ld(&bar[XB_XGEN(b.x)]) == gen, bar);
            __builtin_amdgcn_fence(__ATOMIC_ACQUIRE, "agent");
            asm volatile("s_waitcnt vmcnt(0)" ::: "memory");
        }
    }
    __syncthreads();
}

constexpr int NB = 8, SEQ = 8192, DM = 1024, DEPTH = 2;
constexpr int T = NB * SEQ;
constexpr int INW = 1280, DFF = 2816, NMODW = 6 * DM;
constexpr int KCH = 32;
constexpr float EPS = 1e-6f;
constexpr float LOG2E = 1.4426950408889634f;

#define LAS __attribute__((address_space(3)))
typedef unsigned short bf16;
typedef unsigned v4u __attribute__((ext_vector_type(4)));
typedef unsigned v2u __attribute__((ext_vector_type(2)));
typedef float f32x4 __attribute__((ext_vector_type(4)));
typedef short bf16x8 __attribute__((ext_vector_type(8)));

constexpr size_t MiB = 1u << 20;
constexpr size_t WS_MODP = 640 * MiB;
constexpr size_t WS_MODF = 8 * MiB;
constexpr size_t WS_CS = 9 * MiB;
constexpr size_t WS_W = 16 * MiB, W_LAYER = 24 * MiB;
constexpr size_t W_IN = 0, W_OUT = 3 * MiB, W_GU = 5 * MiB, W_DN = 16 * MiB, W_PW = 22 * MiB;
constexpr size_t WS_H = 64 * MiB;
constexpr size_t WS_MIX = 192 * MiB;
constexpr size_t WS_PROJ = 320 * MiB;
constexpr size_t WS_CONCAT = 480 * MiB;
constexpr size_t WS_ACT = 320 * MiB;
constexpr size_t WS_XA = 672 * MiB;
constexpr size_t WS_XB = 800 * MiB;
constexpr size_t WS_END = 928 * MiB;

constexpr int RING_BYTES = 131072;
constexpr int LDS_BYTES = 147456;

struct Args {
    const float* x; const float* c; const int* pos; const float* ada_w; const float* ada_b; const float* w_in; const float* b_in;
    const float* sinks; const float* pool_w; const float* pool_scale; const float* w_out; const float* w_gate; const float* w_up;
    const float* w_down; const float* g_pre_mix; const float* g_post_mix; const float* g_pre_ffn; const float* g_post_ffn;
    float* out; unsigned char* ws;
};

__device__ __constant__ double c_inv_freq[8] = {1.0, 0.19392274474868576, 0.03760603093086393, 0.007292664737217109,
                                                0.001414213562373095, 0.0002742481756762073, 5.318295896944988e-05, 1.031338537721246e-05};

__device__ __forceinline__ unsigned pk2(float lo, float hi) { return pg8::cvt_pk_bf16(lo, hi); }
__device__ __forceinline__ float bf_lo(unsigned w) { return __uint_as_float(w << 16); }
__device__ __forceinline__ float bf_hi(unsigned w) { return __uint_as_float(w & 0xffff0000u); }
__device__ __forceinline__ float wave_sum(float v) {
#pragma unroll
    for (int o = 1; o < 64; o <<= 1) v += __shfl_xor(v, o);
    return v;
}

namespace pg8 {
struct EpiInProj {
    static constexpr bool PERM = true, AFTER_DRAIN = false;
    bf16_t* O; const float* bias; const float* cs;
    __device__ __forceinline__ void operator()(const f32x4 (&acc)[2][2][4][2], const Unit& u, int wr, int wc, int fr, int fq) const {
        const int row0 = u.pm * BM + wr * 64 + fr; const int colt = u.pn * BM; const int col0 = colt + wc * 32 + 8 * fq;
        f32x4 bv[2][2];
#pragma unroll
        for (int bj = 0; bj < 2; ++bj)
#pragma unroll
            for (int n = 0; n < 2; ++n) bv[bj][n] = *(const f32x4*)(bias + col0 + bj * HALF + 4 * n);
        const bool rot_wave = (colt < 640) && ((wc & 1) == 0);
#pragma unroll
        for (int ai = 0; ai < 2; ++ai)
#pragma unroll
        for (int mh = 0; mh < 2; ++mh) {
            f32x4 cc[2][4];
#pragma unroll
            for (int mm = 0; mm < 2; ++mm)
#pragma unroll
                for (int q = 0; q < 4; ++q) cc[mm][q] = (f32x4){1.f, 1.f, 1.f, 1.f};
            if (rot_wave && fq < 2) {
#pragma unroll
                for (int mm = 0; mm < 2; ++mm) { const float* cr = cs + (size_t)(row0 + ai * HALF + (2 * mh + mm) * 16) * 16;
#pragma unroll
                    for (int q = 0; q < 4; ++q) cc[mm][q] = *(const f32x4*)(cr + 4 * q); }
            }
#pragma unroll
            for (int mm = 0; mm < 2; ++mm) {
                const int m = 2 * mh + mm;
                const int row = row0 + ai * HALF + m * 16;
                bf16_t* rowp = O + (size_t)row * INW + col0;
#pragma unroll
                for (int bj = 0; bj < 2; ++bj) {
                    f32x4 v0 = acc[ai][bj][m][0] + bv[bj][0], v1 = acc[ai][bj][m][1] + bv[bj][1];
                    const int cb = colt + bj * HALF;
                    if (rot_wave && cb < 640) {
                        f32x4 p0, p1;
#pragma unroll
                        for (int e = 0; e < 4; ++e) { p0[e] = __shfl_xor(v0[e], 16); p1[e] = __shfl_xor(v1[e], 16); }
                        if (fq == 0) { v0 = v0 * cc[mm][0] - p0 * cc[mm][2]; v1 = v1 * cc[mm][1] - p1 * cc[mm][3]; }
                        else if (fq == 1) { v0 = v0 * cc[mm][0] + p0 * cc[mm][2]; v1 = v1 * cc[mm][1] + p1 * cc[mm][3]; }
                    }
                    if (cb < 512) { v0 = v0 * 0.125f; v1 = v1 * 0.125f; }
                    u32x4 w; w.x = cvt_pk_bf16(v0[0], v0[1]); w.y = cvt_pk_bf16(v0[2], v0[3]); w.z = cvt_pk_bf16(v1[0], v1[1]); w.w = cvt_pk_bf16(v1[2], v1[3]);
                    *(u32x4*)(rowp + bj * HALF) = w;
                }
            }
        }
    }
};
struct EpiSwiGLU {
    static constexpr bool PERM = true, AFTER_DRAIN = false;
    bf16_t* O;
    __device__ __forceinline__ void operator()(const f32x4 (&acc)[2][2][4][2], const Unit& u, int wr, int wc, int fr, int fq) const {
        typedef float f32x2 __attribute__((ext_vector_type(2)));
        const int row0 = u.pm * BM + wr * 64 + fr; const int col0 = u.pn * HALF + wc * 32 + 8 * fq;
#pragma unroll
        for (int ai = 0; ai < 2; ++ai)
#pragma unroll
            for (int m = 0; m < 4; ++m) {
                bf16_t* rowp = O + (size_t)(row0 + ai * HALF + m * 16) * DFF + col0;
                f32x2 G[4], U[4], t[4], r[4];
#pragma unroll
                for (int n = 0; n < 2; ++n) { G[2 * n] = (f32x2){acc[ai][0][m][n][0], acc[ai][0][m][n][1]}; G[2 * n + 1] = (f32x2){acc[ai][0][m][n][2], acc[ai][0][m][n][3]};
                                              U[2 * n] = (f32x2){acc[ai][1][m][n][0], acc[ai][1][m][n][1]}; U[2 * n + 1] = (f32x2){acc[ai][1][m][n][2], acc[ai][1][m][n][3]}; }
#pragma unroll
                for (int q = 0; q < 4; ++q) { t[q].x = __builtin_amdgcn_exp2f(G[q].x); t[q].y = __builtin_amdgcn_exp2f(G[q].y); }
#pragma unroll
                for (int q = 0; q < 4; ++q) { t[q] = t[q] + 1.0f; r[q] = G[q] * U[q]; }
#pragma unroll
                for (int q = 0; q < 4; ++q) { t[q].x = __builtin_amdgcn_rcpf(t[q].x); t[q].y = __builtin_amdgcn_rcpf(t[q].y); }
#pragma unroll
                for (int q = 0; q < 4; ++q) r[q] = r[q] * t[q];
                u32x4 w; w.x = cvt_pk_bf16(r[0].x, r[0].y); w.y = cvt_pk_bf16(r[1].x, r[1].y); w.z = cvt_pk_bf16(r[2].x, r[2].y); w.w = cvt_pk_bf16(r[3].x, r[3].y);
                *(u32x4*)rowp = w;
            }
    }
};
struct DualOrder {
    StaticOrder so; int c, rounds, hot;
    __device__ bool next(int i, Unit& u) const { if (hot) { if (i >= rounds) return false; u.pm = (c % 8) * 2 + ((c / 8) & 1); u.pn = ((c / 8) >> 1) & 3; return true; } return so.next(i, u); }
    __device__ __forceinline__ void a_ready(const Unit&) const {}
    __device__ __forceinline__ void done(const Unit&) const {}
};
}

__device__ __forceinline__ void transpose_item(const float* W, int K, int N, bf16* WT, int drow0, LAS float* scr, int k0, int n0, int lane, float wscale = 1.0f) {
#pragma unroll
    for (int ih = 0; ih < 32; ih += 16) {
        float tv[16];
#pragma unroll
        for (int i = 0; i < 16; ++i) tv[i] = __builtin_nontemporal_load(W + (size_t)(k0 + 2 * (ih + i) + (lane >> 5)) * N + n0 + (lane & 31));
#pragma unroll
        for (int i = 0; i < 16; ++i) scr[(2 * (ih + i) + (lane >> 5)) * 33 + (lane & 31)] = tv[i] * wscale;
    }
    asm volatile("s_waitcnt lgkmcnt(0)" ::: "memory");
    const int c = lane & 7;
#pragma unroll
    for (int j = 0; j < 4; ++j) { const int n = (lane >> 3) + 8 * j; const LAS float* s = scr + (8 * c) * 33 + n;
        v4u o; o.x = pk2(s[0 * 33], s[1 * 33]); o.y = pk2(s[2 * 33], s[3 * 33]); o.z = pk2(s[4 * 33], s[5 * 33]); o.w = pk2(s[6 * 33], s[7 * 33]);
        *(v4u*)(WT + (size_t)(drow0 + n) * K + k0 + 8 * c) = o; }
    asm volatile("s_waitcnt lgkmcnt(0)" ::: "memory");
}

__device__ __forceinline__ void prologue(const Args& a, LAS unsigned char* lds) {
    int tid_ = threadIdx.x; asm volatile("" : "+v"(tid_)); const int tid = tid_, lane = tid & 63, wave = tid >> 6;
    unsigned char* ws = a.ws;
    __syncthreads();
    {
        LAS float* sc = (LAS float*)lds;
        for (int i = tid; i < NB * DM; i += 512) { const float v = a.c[i]; sc[i] = v / (1.0f + __expf(-v)); }
        __syncthreads();
        float* modp = (float*)(ws + WS_MODP);
        for (int item = blockIdx.x; item < DEPTH * KCH * 12; item += gridDim.x) {
            const int l = item / (KCH * 12), r = item % (KCH * 12), kc = r / 12, cb = r % 12, n = cb * 512 + tid;
            constexpr int KPI = DM / KCH;
            const float* w = a.ada_w + ((size_t)l * DM + kc * KPI) * NMODW + n;
            float acc[8];
#pragma unroll
            for (int b = 0; b < 8; ++b) acc[b] = 0.f;
#pragma unroll 1
            for (int kh = 0; kh < KPI; kh += 16) {
                float wv[16];
#pragma unroll
                for (int k = 0; k < 16; ++k) wv[k] = __builtin_nontemporal_load(w + (size_t)(kh + k) * NMODW);
#pragma unroll
                for (int k = 0; k < 16; ++k) {
                    const LAS float* sp = sc + kc * KPI + kh + k;
#pragma unroll
                    for (int b = 0; b < 8; ++b) acc[b] += sp[b * DM] * wv[k];
                    if ((k & 3) == 3) asm volatile("" ::: "memory");
                }
            }
#pragma unroll
            for (int b = 0; b < 8; ++b) modp[((size_t)(l * KCH + kc) * 8 + b) * NMODW + n] = acc[b];
        }
        __syncthreads();
    }
    {
        float* cs = (float*)(ws + WS_CS);
        for (int idx = blockIdx.x * 512 + tid; idx < T * 8; idx += gridDim.x * 512) {
            const int row = idx >> 3, j = idx & 7;
            const double rev = (double)a.pos[row] * c_inv_freq[j] * 0.15915494309189535;
            const float fr = (float)(rev - floor(rev));
            cs[(size_t)row * 16 + j] = __builtin_amdgcn_cosf(fr);
            cs[(size_t)row * 16 + 8 + j] = __builtin_amdgcn_sinf(fr);
        }
    }
    {
        for (int item = blockIdx.x; item < DEPTH * 128; item += gridDim.x) {
            const int l = item >> 7, r = item & 127, gi = r >> 5, c0 = ((r >> 1) & 15) * 8, n = (r & 1) * 512 + tid;
            const float* wo = a.w_out + (size_t)l * DM * DM + (size_t)(512 + gi * 128) * DM + n;
            const float* pw = a.pool_w + ((size_t)(l * 4 + gi) * 128 + c0) * 128;
            const float* ps = a.pool_scale + l * 512 + gi * 128;
            float acc[8];
#pragma unroll
            for (int c = 0; c < 8; ++c) acc[c] = 0.f;
#pragma unroll 1
            for (int d0 = 0; d0 < 128; d0 += 16) {
                float wv[16];
#pragma unroll
                for (int d = 0; d < 16; ++d) wv[d] = wo[(size_t)(d0 + d) * DM] * ps[d0 + d];
#pragma unroll
                for (int d = 0; d < 16; ++d)
#pragma unroll
                    for (int c = 0; c < 8; ++c) acc[c] += pw[c * 128 + d0 + d] * wv[d];
            }
            bf16* dst = (bf16*)(ws + WS_W + (size_t)l * W_LAYER + W_OUT) + (size_t)n * DM + 512 + gi * 128 + c0;
            *(v4u*)dst = (v4u){pk2(acc[0], acc[1]), pk2(acc[2], acc[3]), pk2(acc[4], acc[5]), pk2(acc[6], acc[7])};
        }
    }
    {
        LAS float* scr = (LAS float*)(lds + wave * 16384);
        const int gw = blockIdx.x * 8 + wave, ngw = gridDim.x * 8;
        constexpr int I_IN = 16 * 40, I_OUT = 8 * 32  , I_G = 16 * 88, I_D = 44 * 32;
        constexpr int PER_L = I_IN + I_OUT + 2 * I_G + I_D;
        for (int it = gw; it < DEPTH * PER_L; it += ngw) {
            const int l = it / PER_L; int r = it % PER_L;
            unsigned char* wl = ws + WS_W + (size_t)l * W_LAYER;
            if (r < I_IN) { const int kb = r / 40, nb = r % 40; transpose_item(a.w_in + (size_t)l * DM * INW, DM, INW, (bf16*)(wl + W_IN), 32 * nb, scr, 64 * kb, 32 * nb, lane); continue; } r -= I_IN;
            if (r < I_OUT) { const int kb = r / 32, nb = r % 32; transpose_item(a.w_out + (size_t)l * DM * DM, DM, DM, (bf16*)(wl + W_OUT), 32 * nb, scr, 64 * kb, 32 * nb, lane); continue; } r -= I_OUT;
            if (r < 2 * I_G) { const int up = r >= I_G; if (up) r -= I_G; const int kb = r / 88, nb = r % 88, n0 = 32 * nb;
                transpose_item((up ? a.w_up : a.w_gate) + (size_t)l * DM * DFF, DM, DFF, (bf16*)(wl + W_GU), 256 * (n0 >> 7) + (n0 & 127) + (up ? 128 : 0), scr, 64 * kb, n0, lane, up ? -0.6931471805599453f : -1.4426950408889634f); continue; } r -= 2 * I_G;
            if (r < I_D) { const int kb = r / 32, nb = r % 32; transpose_item(a.w_down + (size_t)l * DFF * DM, DFF, DM, (bf16*)(wl + W_DN), 32 * nb, scr, 64 * kb, 32 * nb, lane); }
        }
    }
}

__device__ __forceinline__ float mod_val(const Args& a, int l, int b, int idx, int col) {
    const float* modp = (const float*)(a.ws + WS_MODP);
    const int n = idx * DM + col;
    float s = a.ada_b[l * NMODW + n];
#pragma unroll
    for (int kc = 0; kc < KCH; ++kc) s += modp[((size_t)(l * KCH + kc) * 8 + b) * NMODW + n];
    return s;
}
__device__ __forceinline__ float mod_fin(const Args& a, int l, int b, int idx, int col) {
    return ((const float*)(a.ws + WS_MODF))[((size_t)(l * 8 + b)) * NMODW + idx * DM + col];
}
__device__ __forceinline__ void mod_finalize(const Args& a) {
    float* modf = (float*)(a.ws + WS_MODF);
    for (int i = blockIdx.x * 512 + threadIdx.x; i < DEPTH * 8 * NMODW; i += gridDim.x * 512) {
        const int l = i / (8 * NMODW), r = i % (8 * NMODW), b = r / NMODW, n = r % NMODW;
        modf[i] = mod_val(a, l, b, n / DM, n % DM);
    }
}
__device__ __forceinline__ void unpack8(const v4u w, float (&f)[8]) {
#pragma unroll
    for (int e = 0; e < 4; ++e) { f[2 * e] = bf_lo(w[e]); f[2 * e + 1] = bf_hi(w[e]); }
}
__device__ __forceinline__ v4u pack8(const float (&f)[8]) { return (v4u){pk2(f[0], f[1]), pk2(f[2], f[3]), pk2(f[4], f[5]), pk2(f[6], f[7])}; }
__device__ __forceinline__ void rowwise_phase(const Args& a, LAS unsigned char* lds, bool from_partials, bool has_y, bool has_h, bool xin_bf, int xout_mode,
        const void* xin, const bf16* y, float* xout, bf16* xoutb, bf16* hout,
        int l_y, int gate_idx, const float* g_post, int l_h, int shift_idx, int scale_idx, const float* g_pre) {
    int tid_ = threadIdx.x; asm volatile("" : "+v"(tid_)); const int tid = tid_, lane = tid & 63, wave = tid >> 6;
    LAS float* vec = (LAS float*)lds;
    for (int tile = blockIdx.x; tile < T / 256; tile += gridDim.x) {
        const int b = tile / (SEQ / 256);
        __syncthreads();
        for (int col = tid; col < DM; col += 512) {
            if (from_partials) {
                if (has_y) vec[col] = mod_val(a, l_y, b, gate_idx, col) * g_post[col];
                if (has_h) { vec[DM + col] = g_pre[col] * (1.0f + mod_val(a, l_h, b, scale_idx, col)); vec[2 * DM + col] = mod_val(a, l_h, b, shift_idx, col); }
            } else {
                if (has_y) vec[col] = mod_fin(a, l_y, b, gate_idx, col) * g_post[col];
                if (has_h) { vec[DM + col] = g_pre[col] * (1.0f + mod_fin(a, l_h, b, scale_idx, col)); vec[2 * DM + col] = mod_fin(a, l_h, b, shift_idx, col); }
            }
        }
        __syncthreads();
#pragma unroll 1
        for (int r = wave * 4; r < 256; r += 32) {
            float v[4][2][8]; v4u yv[4][2];
#pragma unroll
            for (int h = 0; h < 4; ++h)
#pragma unroll
                for (int j = 0; j < 2; ++j) { const size_t off = ((size_t)tile * 256 + r + h) * DM + 8 * lane + 512 * j;
                    if (xin_bf) unpack8(__builtin_nontemporal_load((const v4u*)((const bf16*)xin + off)), v[h][j]);
                    else { const f32x4 p0 = __builtin_nontemporal_load((const f32x4*)((const float*)xin + off)), p1 = __builtin_nontemporal_load((const f32x4*)((const float*)xin + off + 4));
                        v[h][j][0] = p0.x; v[h][j][1] = p0.y; v[h][j][2] = p0.z; v[h][j][3] = p0.w; v[h][j][4] = p1.x; v[h][j][5] = p1.y; v[h][j][6] = p1.z; v[h][j][7] = p1.w; }
                    yv[h][j] = has_y ? __builtin_nontemporal_load((const v4u*)(y + off)) : (v4u){0u, 0u, 0u, 0u}; }
            if (has_y) {
                float rstd[4];
#pragma unroll
                for (int h = 0; h < 4; ++h) { float ss = 0.f;
#pragma unroll
                    for (int j = 0; j < 2; ++j) { float yf[8]; unpack8(yv[h][j], yf);
#pragma unroll
                        for (int e = 0; e < 8; ++e) ss += yf[e] * yf[e]; }
                    rstd[h] = __builtin_amdgcn_rsqf(wave_sum(ss) * (1.0f / DM) + EPS); }
#pragma unroll
                for (int j = 0; j < 2; ++j) { const LAS float* gpp = vec + 8 * lane + 512 * j; const f32x4 g0 = *(const LAS f32x4*)gpp, g1 = *(const LAS f32x4*)(gpp + 4);
                    const float gp[8] = {g0.x, g0.y, g0.z, g0.w, g1.x, g1.y, g1.z, g1.w};
#pragma unroll
                    for (int h = 0; h < 4; ++h) { float yf[8]; unpack8(yv[h][j], yf);
#pragma unroll
                        for (int e = 0; e < 8; ++e) v[h][j][e] += gp[e] * (yf[e] * rstd[h]); } }
            }
            if (xout_mode == 1) {
#pragma unroll
                for (int h = 0; h < 4; ++h)
#pragma unroll
                    for (int j = 0; j < 2; ++j) { float* o = xout + ((size_t)tile * 256 + r + h) * DM + 8 * lane + 512 * j;
                        __builtin_nontemporal_store((f32x4){v[h][j][0], v[h][j][1], v[h][j][2], v[h][j][3]}, (f32x4*)o); __builtin_nontemporal_store((f32x4){v[h][j][4], v[h][j][5], v[h][j][6], v[h][j][7]}, (f32x4*)(o + 4)); }
            } else if (xout_mode == 2) {
#pragma unroll
                for (int h = 0; h < 4; ++h)
#pragma unroll
                    for (int j = 0; j < 2; ++j) { const v4u w = pack8(v[h][j]);
                        __builtin_nontemporal_store(w, (v4u*)(xoutb + ((size_t)tile * 256 + r + h) * DM + 8 * lane + 512 * j));
                        unpack8(w, v[h][j]); }
            }
            if (has_h) {
                float rstd[4];
#pragma unroll
                for (int h = 0; h < 4; ++h) { float ss = 0.f;
#pragma unroll
                    for (int j = 0; j < 2; ++j)
#pragma unroll
                        for (int e = 0; e < 8; ++e) ss += v[h][j][e] * v[h][j][e];
                    rstd[h] = __builtin_amdgcn_rsqf(wave_sum(ss) * (1.0f / DM) + EPS); }
#pragma unroll
                for (int j = 0; j < 2; ++j) { const LAS float* gsp = vec + DM + 8 * lane + 512 * j; const LAS float* shp = vec + 2 * DM + 8 * lane + 512 * j;
                    const f32x4 a0 = *(const LAS f32x4*)gsp, a1 = *(const LAS f32x4*)(gsp + 4), b0 = *(const LAS f32x4*)shp, b1 = *(const LAS f32x4*)(shp + 4);
                    const float gs[8] = {a0.x, a0.y, a0.z, a0.w, a1.x, a1.y, a1.z, a1.w}, sh[8] = {b0.x, b0.y, b0.z, b0.w, b1.x, b1.y, b1.z, b1.w};
#pragma unroll
                    for (int h = 0; h < 4; ++h) { float hv[8];
#pragma unroll
                        for (int e = 0; e < 8; ++e) hv[e] = v[h][j][e] * rstd[h] * gs[e] + sh[e];
                        *(v4u*)(hout + ((size_t)tile * 256 + r + h) * DM + 8 * lane + 512 * j) = pack8(hv); } }
            }
        }
    }
}

typedef short v4i16a_t __attribute__((ext_vector_type(4)));
__device__ __forceinline__ v2u lds_tr_a(const LAS bf16* p) { return __builtin_bit_cast(v2u, __builtin_amdgcn_ds_read_tr16_b64_v4i16((LAS v4i16a_t*)p)); }
__device__ __forceinline__ void attn_phase(LAS unsigned char* lds, const bf16* PROJ, bf16* CONCAT, const float* sinks) {
    int tid_ = threadIdx.x; asm volatile("" : "+v"(tid_)); const int tid = tid_, lane = tid & 63, wave = tid >> 6, fr = lane & 15, fq = lane >> 4;
    LAS bf16* Ks = (LAS bf16*)lds;
    LAS bf16* Vs = (LAS bf16*)(lds + 36864);
    v4u kv[4], vv[4];
#define ATT_LOAD_KV(uu) do { const int kh_ = (uu) & 1, n_ = ((uu) >> 1) & 63, b_ = (uu) >> 7; const long rb_ = (long)b_ * SEQ + n_ * 128 - 128; \
        _Pragma("unroll") for (int i = 0; i < 4; ++i) { const int kj = lane + 64 * i; kv[i] = (v4u){0u, 0u, 0u, 0u}; vv[i] = (v4u){0u, 0u, 0u, 0u}; \
            if (n_ > 0 || kj >= 128) { const bf16* p = PROJ + (size_t)(rb_ + kj) * INW + kh_ * 64 + wave * 8; kv[i] = *(const v4u*)(p + 512); vv[i] = *(const v4u*)(p + 640); } } } while (0)
    bf16x8 qf[4][2];
#define ATT_LOAD_Q(uu) do { const int kh_ = (uu) & 1, n_ = ((uu) >> 1) & 63, b_ = (uu) >> 7; const size_t qr_ = (size_t)b_ * SEQ + n_ * 128 + (wave & 1) * 64 + fr; \
        _Pragma("unroll") for (int i = 0; i < 4; ++i) { const bf16* qp = PROJ + (qr_ + 16 * i) * INW + (kh_ * 4 + (wave >> 1)) * 64 + 8 * fq; \
            qf[i][0] = __builtin_nontemporal_load((const bf16x8*)qp); qf[i][1] = __builtin_nontemporal_load((const bf16x8*)(qp + 32)); } } while (0)
    const bool xmap = (gridDim.x == 256);
#define ATT_UNIT(lin) (xmap ? ((((lin) >> 8) * 2 + (((lin) & 7) >> 2)) * 128 + (32 * ((lin) & 1) + (((lin) & 255) >> 3)) * 2 + ((((lin) & 7) >> 1) & 1)) : (lin))
    if ((int)blockIdx.x < NB * 64 * 2) { ATT_LOAD_KV(ATT_UNIT((int)blockIdx.x)); ATT_LOAD_Q(ATT_UNIT((int)blockIdx.x)); }
    for (int ul = blockIdx.x; ul < NB * 64 * 2; ul += gridDim.x) {
        const int u = ATT_UNIT(ul);
        const int kh = u & 1, n = (u >> 1) & 63, b = u >> 7;
        const int g = wave >> 1, h = kh * 4 + g;
        const size_t qrow0 = (size_t)b * SEQ + n * 128 + (wave & 1) * 64 + fr;
#pragma unroll
        for (int i = 0; i < 4; ++i) { const int kj = lane + 64 * i;
            *(LAS v4u*)(Ks + kj * 72 + wave * 8) = kv[i];
            *(LAS v4u*)(Vs + kj * 72 + wave * 8) = vv[i]; }
        __syncthreads();
        if (ul + (int)gridDim.x < NB * 64 * 2) ATT_LOAD_KV(ATT_UNIT(ul + (int)gridDim.x));
        const float sink = sinks[h];
        const int firstblk = (n == 0);
#pragma unroll
        for (int p = 0; p < 2; ++p) {
            const int q16a = (wave & 1) * 4 + 2 * p, kt0 = q16a;
            f32x4 st[2][10];
            bf16x8 kfr[10][2];
            const LAS bf16* kp0 = Ks + (16 * kt0 + fr) * 72 + 8 * fq;
#define ATT_LDK(t) do { kfr[t][0] = *(const LAS bf16x8*)(kp0 + (t) * 16 * 72); kfr[t][1] = *(const LAS bf16x8*)(kp0 + (t) * 16 * 72 + 32); } while (0)
            ATT_LDK(0);
#pragma unroll
            for (int t = 0; t < 10; ++t) {
                if (t + 1 < 10) ATT_LDK(t + 1);
#pragma unroll
                for (int x = 0; x < 2; ++x) {
                    if (x + 8 - t == 9 || x + 8 - t == -1) { st[x][t] = (f32x4){-1e30f, -1e30f, -1e30f, -1e30f}; continue; }
                    f32x4 acc = (f32x4){0.f, 0.f, 0.f, 0.f};
                    acc = __builtin_amdgcn_mfma_f32_16x16x32_bf16(kfr[t][0], qf[2 * p + x][0], acc, 0, 0, 0);
                    acc = __builtin_amdgcn_mfma_f32_16x16x32_bf16(kfr[t][1], qf[2 * p + x][1], acc, 0, 0, 0);
                    st[x][t] = acc;
                }
            }
#undef ATT_LDK
            float inv[2];
#pragma unroll
            for (int x = 0; x < 2; ++x) {
                float mx = -1e30f;
#pragma unroll
                for (int t = 0; t < 10; ++t) {
                    const int D = x + 8 - t;
                    if (D == 9 || D == -1) continue;
                    const bool tile_off = firstblk && (kt0 + t < 8);
#pragma unroll
                    for (int r = 0; r < 4; ++r) { const int dl = fr - 4 * fq - r;
                        bool valid = !tile_off;
                        if (D == 8) valid = valid && (dl < 0);
                        if (D == 0) valid = valid && (dl >= 0);
                        const float sv = valid ? st[x][t][r] : -1e30f; st[x][t][r] = sv; mx = fmaxf(mx, sv); }
                }
                mx = fmaxf(mx, __shfl_xor(mx, 16)); mx = fmaxf(mx, __shfl_xor(mx, 32)); mx = fmaxf(mx, sink);
                const float mb = mx * LOG2E;
                float lsum = 0.f;
#pragma unroll
                for (int t = 0; t < 10; ++t) {
                    const int D = x + 8 - t;
                    if (D == 9 || D == -1) { st[x][t] = (f32x4){0.f, 0.f, 0.f, 0.f}; continue; }
#pragma unroll
                    for (int r = 0; r < 4; ++r) { const float pe = __builtin_amdgcn_exp2f(st[x][t][r] * LOG2E - mb); st[x][t][r] = pe; lsum += pe; }
                }
                lsum += __shfl_xor(lsum, 16); lsum += __shfl_xor(lsum, 32); lsum += __builtin_amdgcn_exp2f(sink * LOG2E - mb);
                inv[x] = 1.0f / lsum;
            }
            f32x4 ot[2][4];
#pragma unroll
            for (int x = 0; x < 2; ++x)
#pragma unroll
                for (int dt = 0; dt < 4; ++dt) ot[x][dt] = (f32x4){0.f, 0.f, 0.f, 0.f};
            const LAS bf16* vp0 = Vs + (16 * kt0 + 4 * fq + (fr >> 2)) * 72 + 4 * (fr & 3);
            v2u vlo[5][4], vhi[5][4];
#define ATT_LDV(s) do { _Pragma("unroll") for (int dt = 0; dt < 4; ++dt) { vlo[s][dt] = lds_tr_a(vp0 + (s) * 32 * 72 + 16 * dt); vhi[s][dt] = lds_tr_a(vp0 + (s) * 32 * 72 + 16 * 72 + 16 * dt); } } while (0)
#pragma unroll
            for (int s2 = 0; s2 < 5; ++s2) {
                ATT_LDV(s2);
                bf16x8 pf[2];
#pragma unroll
                for (int x = 0; x < 2; ++x) { v4u pw; pw.x = pk2(st[x][2 * s2][0], st[x][2 * s2][1]); pw.y = pk2(st[x][2 * s2][2], st[x][2 * s2][3]);
                    pw.z = pk2(st[x][2 * s2 + 1][0], st[x][2 * s2 + 1][1]); pw.w = pk2(st[x][2 * s2 + 1][2], st[x][2 * s2 + 1][3]); pf[x] = __builtin_bit_cast(bf16x8, pw); }
#pragma unroll
                for (int dt = 0; dt < 4; ++dt) {
                    const bf16x8 vf = __builtin_bit_cast(bf16x8, (v4u){vlo[s2][dt].x, vlo[s2][dt].y, vhi[s2][dt].x, vhi[s2][dt].y});
#pragma unroll
                    for (int x = 0; x < 2; ++x) ot[x][dt] = __builtin_amdgcn_mfma_f32_16x16x32_bf16(vf, pf[x], ot[x][dt], 0, 0, 0);
                }
            }
#undef ATT_LDV
#pragma unroll
            for (int x = 0; x < 2; ++x) {
                LAS bf16* stg = (LAS bf16*)(lds + 73728) + (wave * 2 + x) * (16 * 72);
#pragma unroll
                for (int dt = 0; dt < 4; ++dt) *(LAS v2u*)(stg + fr * 72 + 16 * dt + 4 * fq) = (v2u){pk2(ot[x][dt][0] * inv[x], ot[x][dt][1] * inv[x]), pk2(ot[x][dt][2] * inv[x], ot[x][dt][3] * inv[x])};
                bf16* op = CONCAT + (qrow0 - fr + 16 * (2 * p + x)) * DM + h * 64;
#pragma unroll
                for (int i = 0; i < 2; ++i) { const int row = 8 * i + (lane >> 3), chn = lane & 7;
                    *(v4u*)(op + (size_t)row * DM + chn * 8) = *(const LAS v4u*)(stg + row * 72 + chn * 8); }
            }
        }
        if (ul + (int)gridDim.x < NB * 64 * 2) ATT_LOAD_Q(ATT_UNIT(ul + (int)gridDim.x));
        __syncthreads();
    }
#undef ATT_LOAD_KV
#undef ATT_LOAD_Q
#undef ATT_UNIT
}

constexpr int PL_US = 136;
template <int W> __device__ __forceinline__ void pool_load(const bf16* PROJ, int gi, int tt, int lane, v4u (&raw)[8]) {
    const size_t t0 = (size_t)tt * 16; const int s0 = (int)(t0 & (SEQ - 1));
    const int ch = lane & 15, rs = lane >> 4;
#pragma unroll
    for (int i = 0; i < 8; ++i) { const int r = rs + 4 * i;
        raw[i] = (v4u){0u, 0u, 0u, 0u};
        if (4 * i + 3 >= 17 - W) { if (s0 - 16 + r >= 0) raw[i] = *(const v4u*)(PROJ + (t0 - 16 + r) * INW + 768 + gi * 128 + ch * 8); } }
}
typedef short v4i16_t __attribute__((ext_vector_type(4)));
__device__ __forceinline__ v2u lds_tr(const LAS bf16* p) { return __builtin_bit_cast(v2u, __builtin_amdgcn_ds_read_tr16_b64_v4i16((LAS v4i16_t*)p)); }
template <int W> __device__ __forceinline__ void pool_compute(bf16* CONCAT, LAS bf16* ust, int gi, int tt, int lane, const v4u (&raw)[8]) {
    const int fr = lane & 15, fq = lane >> 4;
    const size_t t0 = (size_t)tt * 16; const int s0 = (int)(t0 & (SEQ - 1));
    {
        const int ch = lane & 15, rs = lane >> 4;
#pragma unroll
        for (int i = 0; i < 8; ++i) { const int r = rs + 4 * i; if (4 * i + 3 >= 17 - W) *(LAS v4u*)(ust + r * PL_US + ch * 8) = raw[i]; }
    }
    const int s = s0 + fr;
    const int cnt = (s + 1 < W) ? (s + 1) : W;
    const float invc = 1.0f / (float)cnt;
    bf16x8 band;
    { float bv[8];
#pragma unroll
      for (int j = 0; j < 8; ++j) { const int rel = 8 * fq + j - 16 - fr;
          bv[j] = ((rel > -W && rel <= 0) ? 1.0f : 0.0f) - ((rel == 0) ? (float)cnt : 0.0f); }
      band = __builtin_bit_cast(bf16x8, (v4u){pk2(bv[0], bv[1]), pk2(bv[2], bv[3]), pk2(bv[4], bv[5]), pk2(bv[6], bv[7])}); }
    f32x4 pl[8];
    const LAS bf16* trp = ust + (8 * fq + ((lane & 15) >> 2)) * PL_US + 4 * (lane & 3);
#pragma unroll
    for (int a = 0; a < 8; ++a) {
        const v2u lo = lds_tr(trp + 16 * a), hi = lds_tr(trp + 4 * PL_US + 16 * a);
        const bf16x8 ua = __builtin_bit_cast(bf16x8, (v4u){lo.x, lo.y, hi.x, hi.y});
        pl[a] = __builtin_amdgcn_mfma_f32_16x16x32_bf16(ua, band, (f32x4){0.f, 0.f, 0.f, 0.f}, 0, 0, 0);
    }
#pragma unroll
    for (int a = 0; a < 8; ++a) *(LAS v2u*)(ust + fr * PL_US + 16 * a + 4 * fq) = (v2u){pk2(pl[a][0] * invc, pl[a][1] * invc), pk2(pl[a][2] * invc, pl[a][3] * invc)};
#pragma unroll
    for (int i = 0; i < 4; ++i) { const int row = 4 * i + (lane >> 4), chn = lane & 15;
        const v4u w = *(const LAS v4u*)(ust + row * PL_US + chn * 8);
        *(v4u*)(CONCAT + (t0 + row) * DM + 512 + gi * 128 + chn * 8) = w; }
}
template <int W> __device__ __forceinline__ void pool_group(const bf16* PROJ, bf16* CONCAT, LAS bf16* ust, int gi, int gw, int ngw, int lane) {
    v4u ra[8], rb[8];
    {
        const int ch = lane & 15, rs = lane >> 4;
#pragma unroll
        for (int i = 0; i < 8; ++i) if (!(4 * i + 3 >= 17 - W)) *(LAS v4u*)(ust + (rs + 4 * i) * PL_US + ch * 8) = (v4u){0u, 0u, 0u, 0u};
    }
    int tt = gw;
    if (tt < T / 16) pool_load<W>(PROJ, gi, tt, lane, ra);
    while (tt < T / 16) {
        const int tn = tt + ngw;
        if (tn < T / 16) pool_load<W>(PROJ, gi, tn, lane, rb);
        pool_compute<W>(CONCAT, ust, gi, tt, lane, ra);
        tt = tn;
        if (tt >= T / 16) break;
        const int tn2 = tt + ngw;
        if (tn2 < T / 16) pool_load<W>(PROJ, gi, tn2, lane, ra);
        pool_compute<W>(CONCAT, ust, gi, tt, lane, rb);
        tt = tn2;
    }
}
__device__ __forceinline__ void pool_phase(LAS unsigned char* lds, const bf16* PROJ, bf16* CONCAT) {
    int tid_ = threadIdx.x; asm volatile("" : "+v"(tid_)); const int tid = tid_, lane = tid & 63, wave = tid >> 6;
    LAS bf16* ust = (LAS bf16*)(lds + wave * 8704);
    __syncthreads();
#pragma unroll 1
    for (int gi = 0; gi < 4; ++gi) {
        const int gw = blockIdx.x * 8 + wave, ngw = gridDim.x * 8;
        if (gi == 0) pool_group<2>(PROJ, CONCAT, ust, gi, gw, ngw, lane);
        else if (gi == 1) pool_group<4>(PROJ, CONCAT, ust, gi, gw, ngw, lane);
        else if (gi == 2) pool_group<8>(PROJ, CONCAT, ust, gi, gw, ngw, lane);
        else pool_group<16>(PROJ, CONCAT, ust, gi, gw, ngw, lane);
    }
    __syncthreads();
}

#ifndef REP_P
#define REP_P 1
#endif
#ifndef REP_G
#define REP_G 1
#endif
#ifndef REP_R
#define REP_R 1
#endif
#ifndef REP_G
#define REP_G 1
#endif
#ifndef REP_IN
#define REP_IN REP_G
#endif
#ifndef REP_GU
#define REP_GU REP_G
#endif
#ifndef REP_DN
#define REP_DN REP_G
#endif
#ifndef REP_PL
#define REP_PL 1
#endif
#ifndef REP_A
#define REP_A 1
#endif
__global__ void __launch_bounds__(512, 2) fwd_kernel(Args a) {
    extern __shared__ __attribute__((aligned(16))) unsigned char lds_raw[];
    cg::grid_group grid = cg::this_grid();
    LAS unsigned char* lds = (LAS unsigned char*)lds_raw;
    unsigned char* ws = a.ws;
    bf16* H = (bf16*)(ws + WS_H); bf16* MIX = (bf16*)(ws + WS_MIX); bf16* PROJ = (bf16*)(ws + WS_PROJ);
    bf16* CONCAT = (bf16*)(ws + WS_CONCAT); bf16* ACT = (bf16*)(ws + WS_ACT);
    const float* cs = (const float*)(ws + WS_CS); bf16* XA = (bf16*)(ws + WS_XA); bf16* XB = (bf16*)(ws + WS_XB);
    volatile LAS unsigned* MISC = (volatile LAS unsigned*)(lds + RING_BYTES + 64);
    if (threadIdx.x == 0) { MISC[0] = 0u; MISC[1] = 0u; }
    __syncthreads();
    XcdBarrier bar = xcd_barrier_post((unsigned*)ws, MISC);
#ifndef REP_S
#define REP_S 1
#endif
#define SEAM() do { for (int rs_ = 0; rs_ < REP_S; ++rs_) xcd_barrier(bar); } while (0)

    for (int rep = 0; rep < REP_P; ++rep) prologue(a, lds);
    if (a.ws == nullptr) grid.sync();
    SEAM();
    for (int rep = 0; rep < REP_R; ++rep) rowwise_phase(a, lds, true, false, true, false, 2, a.x, nullptr, nullptr, XB, H, 0, 0, nullptr, 0, 0, 1, a.g_pre_mix);
    mod_finalize(a);
    SEAM();
#pragma unroll 1
    for (int l = 0; l < DEPTH; ++l) {
        unsigned char* wl = ws + WS_W + (size_t)l * W_LAYER;
        for (int rep = 0; rep < REP_IN; ++rep) {
            pg8::Gemm g{H, (const bf16*)(wl + W_IN), T, INW, DM}; pg8::StaticOrder S; S.init(T, INW, gridDim.x, blockIdx.x);
            pg8::EpiInProj E{PROJ, a.b_in + l * INW, cs};
            pg8::gemm_phase<pg8::EpiInProj, pg8::StaticOrder, true, true>(lds, g, S, E);
        }
        SEAM();
        for (int rep = 0; rep < REP_A; ++rep) attn_phase(lds, PROJ, CONCAT, a.sinks + l * 8);
        for (int rep = 0; rep < REP_PL; ++rep) pool_phase(lds, PROJ, CONCAT);
        SEAM();
        for (int rep = 0; rep < REP_G; ++rep) {
            pg8::Gemm g{CONCAT, (const bf16*)(wl + W_OUT), T, DM, DM}; pg8::StaticOrder S; S.init(T, DM, gridDim.x, blockIdx.x);
            pg8::EpiBf16<0> E{MIX, DM, nullptr, 0, 0, 1.f};
            pg8::gemm_phase<pg8::EpiBf16<0>, pg8::StaticOrder, true, true>(lds, g, S, E);
        }
        SEAM();
        for (int rep = 0; rep < REP_R; ++rep) rowwise_phase(a, lds, false, true, true, true, 2, XB, MIX, nullptr, XA, H, l, 2, a.g_post_mix + l * DM, l, 3, 4, a.g_pre_ffn + l * DM);
        SEAM();
#if defined(PROBE_HOT)
#pragma unroll 1
        for (int rep = 0; rep < 2; ++rep) {
            pg8::Gemm g{H, (const bf16*)(wl + W_GU), T, 2 * DFF, rep == 0 ? PROBE_HOT_K : DM}; pg8::DualOrder S; S.so.init(T, 2 * DFF, gridDim.x, blockIdx.x); S.c = blockIdx.x; S.rounds = 22; S.hot = (rep == 0);
            pg8::EpiSwiGLU E{rep == 0 ? MIX : ACT};
            pg8::gemm_phase<pg8::EpiSwiGLU, pg8::DualOrder, true, true>(lds, g, S, E);
            if (rep == 0) SEAM();
        }
#else
#if defined(FFN_SPLIT)
#pragma unroll 1
        for (int hf = 0; hf < 2; ++hf) {
            const size_t r0 = (size_t)hf * (T / 2);
            {
                pg8::Gemm g{H + r0 * DM, (const bf16*)(wl + W_GU), T / 2, 2 * DFF, DM}; pg8::StaticOrder S; S.init(T / 2, 2 * DFF, gridDim.x, blockIdx.x);
                pg8::EpiSwiGLU E{ACT + r0 * DFF};
                pg8::gemm_phase<pg8::EpiSwiGLU, pg8::StaticOrder, true, true>(lds, g, S, E);
            }
            SEAM();
            {
                pg8::Gemm g{ACT + r0 * DFF, (const bf16*)(wl + W_DN), T / 2, DM, DFF}; pg8::StaticOrder S; S.init(T / 2, DM, gridDim.x, blockIdx.x, 1);
                pg8::EpiBf16<0> E{MIX + r0 * DM, DM, nullptr, 0, 0, 1.f};
                pg8::gemm_phase<pg8::EpiBf16<0>, pg8::StaticOrder, true, true>(lds, g, S, E);
            }
            SEAM();
        }
#else
        for (int rep = 0; rep < REP_GU; ++rep) {
            pg8::Gemm g{H, (const bf16*)(wl + W_GU), T, 2 * DFF, DM}; pg8::StaticOrder S; S.init(T, 2 * DFF, gridDim.x, blockIdx.x);
            pg8::EpiSwiGLU E{ACT};
            pg8::gemm_phase<pg8::EpiSwiGLU, pg8::StaticOrder, true, true>(lds, g, S, E);
        }
        SEAM();
        for (int rep = 0; rep < REP_DN; ++rep) {
            pg8::Gemm g{ACT, (const bf16*)(wl + W_DN), T, DM, DFF}; pg8::StaticOrder S; S.init(T, DM, gridDim.x, blockIdx.x, 1);
            pg8::EpiBf16<0> E{MIX, DM, nullptr, 0, 0, 1.f};
            pg8::gemm_phase<pg8::EpiBf16<0>, pg8::StaticOrder, true, true>(lds, g, S, E);
        }
        SEAM();
#endif
#endif
        const bool more = (l + 1 < DEPTH);
        for (int rep = 0; rep < REP_R; ++rep) rowwise_phase(a, lds, false, true, more, true, more ? 2 : 1, XA, MIX, a.out, XB, H, l, 5, a.g_post_ffn + l * DM, l + 1, 0, 1, a.g_pre_mix + (more ? (l + 1) * DM : 0));
        if (more) SEAM();
    }
}

extern "C" void kernel_launch(void* const* d_in, const int* in_sizes, int n_in, void* d_out, int out_size, void* d_ws, size_t ws_size, hipStream_t stream) {
    static int grid_blocks = 0;
    if (grid_blocks == 0) {
        if (n_in != 18 || out_size != T * DM || ws_size < WS_END) { fprintf(stderr, "kernel_launch: unexpected shapes (n_in %d, out %d, ws %zu)\n", n_in, out_size, ws_size); grid_blocks = -1; return; }
        int dev = 0, cus = 0, per_cu = 0;
        hipGetDevice(&dev);
        hipDeviceGetAttribute(&cus, hipDeviceAttributeMultiprocessorCount, dev);
        if (hipFuncSetAttribute((const void*)fwd_kernel, hipFuncAttributeMaxDynamicSharedMemorySize, LDS_BYTES) != hipSuccess) { fprintf(stderr, "kernel_launch: hipFuncSetAttribute failed\n"); grid_blocks = -1; return; }
        if (hipOccupancyMaxActiveBlocksPerMultiprocessor(&per_cu, (const void*)fwd_kernel, 512, LDS_BYTES) != hipSuccess || per_cu < 1) { fprintf(stderr, "kernel_launch: occupancy query gave %d\n", per_cu); per_cu = 1; }
        (void)hipGetLastError();
        grid_blocks = cus * per_cu;
    }
    if (grid_blocks < 0) return;
    if (hipMemsetAsync(d_ws, 0, 65536, stream) != hipSuccess) { fprintf(stderr, "kernel_launch: memset failed\n"); return; }
    Args a{};
    a.x = (const float*)d_in[0]; a.c = (const float*)d_in[1]; a.pos = (const int*)d_in[2]; a.ada_w = (const float*)d_in[3]; a.ada_b = (const float*)d_in[4];
    a.w_in = (const float*)d_in[5]; a.b_in = (const float*)d_in[6]; a.sinks = (const float*)d_in[7]; a.pool_w = (const float*)d_in[8]; a.pool_scale = (const float*)d_in[9];
    a.w_out = (const float*)d_in[10]; a.w_gate = (const float*)d_in[11]; a.w_up = (const float*)d_in[12]; a.w_down = (const float*)d_in[13];
    a.g_pre_mix = (const float*)d_in[14]; a.g_post_mix = (const float*)d_in[15]; a.g_pre_ffn = (const float*)d_in[16]; a.g_post_ffn = (const float*)d_in[17];
    a.out = (float*)d_out; a.ws = (unsigned char*)d_ws;
    void* args[] = {&a};
    hipError_t e = hipLaunchCooperativeKernel((const void*)fwd_kernel, dim3(grid_blocks), dim3(512), args, LDS_BYTES, stream);
    if (e != hipSuccess) fprintf(stderr, "cooperative launch failed: %s (grid %d)\n", hipGetErrorString(e), grid_blocks);
}
```
